# Optimizing an MI355X kernel written in HIP

```python
import jax, jax.numpy as jnp
from jax import lax
import numpy as np

D_MODEL = 4096
BATCH = 2
SEQ = 4096
DEPTH = 2

CHUNK = 64
MIX_WIDTH = D_MODEL
SGU_BLOCK = 128
SGU_WIDTH = MIX_WIDTH // 4
SGU_HEAD_DIM = 128
SGU_HEADS = SGU_WIDTH // SGU_HEAD_DIM
MLA_NOPE_DIM = 128
MLA_ROPE_DIM = 64
MLA_V_DIM = 128
MLA_WIDTH = MIX_WIDTH // 2
MLA_HEADS = MLA_WIDTH // MLA_V_DIM
MLA_Q_RANK = D_MODEL // 4
MLA_KV_RANK = D_MODEL // 8
Q_BLOCK = 128
RET_WIDTH = MIX_WIDTH // 4
RET_V_DIM = 128
RET_HEADS = RET_WIDTH // RET_V_DIM
RET_QK_DIM = RET_V_DIM // 2
FF_DIM = 4 * D_MODEL
ROPE_THETA = 10000.0
NORM_EPS = 1e-6

IN_SIZES = (SGU_WIDTH, SGU_WIDTH,
            MLA_Q_RANK, MLA_KV_RANK, MLA_ROPE_DIM,
            RET_HEADS * RET_QK_DIM, RET_HEADS * RET_QK_DIM, RET_WIDTH, RET_WIDTH)
IN_WIDTH = sum(IN_SIZES)

kernel_name = "hybrid_sgu_mla_retention_sandwich"


def rms_norm(x, g):
    xf = x.astype(jnp.float32)
    y = xf * lax.rsqrt(jnp.mean(xf * xf, axis=-1, keepdims=True) + NORM_EPS)
    return (y * g.astype(jnp.float32)).astype(x.dtype)


def layer_norm(x, g, b):
    xf = x.astype(jnp.float32)
    mu = jnp.mean(xf, axis=-1, keepdims=True)
    xc = xf - mu
    y = xc * lax.rsqrt(jnp.mean(xc * xc, axis=-1, keepdims=True) + NORM_EPS)
    return (y * g.astype(jnp.float32) + b.astype(jnp.float32)).astype(x.dtype)


def rope_tables(seq_len, dim):
    inv_freq = 1.0 / (ROPE_THETA ** (jnp.arange(0, dim, 2, dtype=jnp.float32) / dim))
    ang = jnp.arange(seq_len, dtype=jnp.float32)[:, None] * inv_freq[None, :]
    return jnp.cos(ang), jnp.sin(ang)


def apply_rope(x, cos, sin):
    x1, x2 = jnp.split(x, 2, axis=-1)
    c = cos[None, :, None, :].astype(x.dtype)
    s = sin[None, :, None, :].astype(x.dtype)
    return jnp.concatenate([x1 * c - x2 * s, x1 * s + x2 * c], axis=-1)


def sgu_mixer(u, v, ln_g, ln_b, w_s, b_s):
    bsz, s_len, _ = u.shape
    v = layer_norm(v.reshape(bsz, s_len, SGU_HEADS, SGU_HEAD_DIM),
                   ln_g.reshape(SGU_HEADS, SGU_HEAD_DIM), ln_b.reshape(SGU_HEADS, SGU_HEAD_DIM))
    v = v.reshape(bsz, s_len // SGU_BLOCK, SGU_BLOCK, SGU_HEADS, SGU_HEAD_DIM)
    pos_chunk = jnp.arange(SGU_BLOCK) // CHUNK
    mask = pos_chunk[None, :] <= pos_chunk[:, None]
    w = jnp.where(mask[None], w_s, 0.0).astype(v.dtype)
    mixed = jnp.einsum('gij,bnjgc->bnigc', w, v) + b_s.T[None, None, :, :, None].astype(v.dtype)
    return u * mixed.reshape(bsz, s_len, SGU_WIDTH)


def mla_mixer(c_q, c_kv, k_rope, q_norm, wq_b, kv_norm, wkv_b, cos, sin):
    bsz, s_len, _ = c_q.shape
    q = (rms_norm(c_q, q_norm) @ wq_b).reshape(bsz, s_len, MLA_HEADS, MLA_NOPE_DIM + MLA_ROPE_DIM)
    q_nope = q[..., :MLA_NOPE_DIM]
    q_rope = apply_rope(q[..., MLA_NOPE_DIM:], cos, sin)
    kv = (rms_norm(c_kv, kv_norm) @ wkv_b).reshape(bsz, s_len, MLA_HEADS, MLA_NOPE_DIM + MLA_V_DIM)
    k_nope = kv[..., :MLA_NOPE_DIM]
    val = kv[..., MLA_NOPE_DIM:]
    k_rope = apply_rope(k_rope[:, :, None, :], cos, sin)[:, :, 0, :]
    scale = (MLA_NOPE_DIM + MLA_ROPE_DIM) ** -0.5
    n_blk = s_len // Q_BLOCK
    qn_blocks = q_nope.reshape(bsz, n_blk, Q_BLOCK, MLA_HEADS, MLA_NOPE_DIM).transpose(1, 0, 2, 3, 4)
    qr_blocks = q_rope.reshape(bsz, n_blk, Q_BLOCK, MLA_HEADS, MLA_ROPE_DIM).transpose(1, 0, 2, 3, 4)
    k_chunk = jnp.arange(s_len) // CHUNK

    def attend(args):
        qn, qr, blk = args
        s = (jnp.einsum('bqhd,bkhd->bhqk', qn, k_nope)
             + jnp.einsum('bqhr,bkr->bhqk', qr, k_rope)).astype(jnp.float32) * scale
        q_chunk = (blk * Q_BLOCK + jnp.arange(Q_BLOCK)) // CHUNK
        mask = k_chunk[None, :] <= q_chunk[:, None]
        s = jnp.where(mask[None, None], s, -jnp.inf)
        p = jax.nn.softmax(s, axis=-1).astype(val.dtype)
        return jnp.einsum('bhqk,bkhd->bqhd', p, val)

    out = lax.map(attend, (qn_blocks, qr_blocks, jnp.arange(n_blk)))
    return out.transpose(1, 0, 2, 3, 4).reshape(bsz, s_len, MLA_WIDTH)


def retention_mixer(q, k, v, gate, cos, sin):
    bsz, s_len, _ = q.shape
    n_chunk = s_len // CHUNK
    dt = q.dtype
    q = apply_rope(q.reshape(bsz, s_len, RET_HEADS, RET_QK_DIM), cos, sin) * (RET_QK_DIM ** -0.5)
    k = apply_rope(k.reshape(bsz, s_len, RET_HEADS, RET_QK_DIM), cos, sin)
    qc = q.reshape(bsz, n_chunk, CHUNK, RET_HEADS, RET_QK_DIM)
    kc = k.reshape(bsz, n_chunk, CHUNK, RET_HEADS, RET_QK_DIM)
    vc = v.reshape(bsz, n_chunk, CHUNK, RET_HEADS, RET_V_DIM)
    log_gamma = jnp.log1p(-jnp.exp2(-5.0 - jnp.arange(RET_HEADS, dtype=jnp.float32)))
    idx = jnp.arange(CHUNK, dtype=jnp.float32)
    intra_decay = jnp.exp(log_gamma[:, None, None] * jnp.abs(idx[:, None] - idx[None, :]))
    q_decay = jnp.exp(log_gamma[None, :] * (idx[:, None] + 1.0))
    k_decay = jnp.exp(log_gamma[None, :] * (CHUNK - 1.0 - idx[:, None]))
    chunk_decay = jnp.exp(log_gamma * CHUNK)
    scores = jnp.einsum('bclhd,bcmhd->bchlm', qc, kc) * intra_decay.astype(dt)
    intra_out = jnp.einsum('bchlm,bcmhe->bclhe', scores, vc)
    kv_chunks = jnp.einsum('bclhd,bclhe->cbhde', kc * k_decay[None, None, :, :, None].astype(dt), vc)

    def step(state, kv_c):
        return chunk_decay[None, :, None, None] * state + kv_c, state

    init = jnp.zeros((bsz, RET_HEADS, RET_QK_DIM, RET_V_DIM), jnp.float32)
    _, prev_states = lax.scan(step, init, kv_chunks.astype(jnp.float32))
    cross_out = jnp.einsum('bclhd,cbhde->bclhe', qc * q_decay[None, None, :, :, None].astype(dt),
                           prev_states.astype(dt))
    o = (intra_out + cross_out).reshape(bsz, s_len, RET_HEADS, RET_V_DIM).astype(jnp.float32)
    o = o * lax.rsqrt(jnp.mean(o * o, axis=-1, keepdims=True) + NORM_EPS)
    return jax.nn.silu(gate) * o.reshape(bsz, s_len, RET_WIDTH).astype(dt)


def hybrid_layer(x, n_mix_pre, n_mix_post, n_ffn_pre, n_ffn_post, w_in,
                 sgu_ln_g, sgu_ln_b, sgu_w, sgu_b,
                 mla_q_norm, mla_wq_b, mla_kv_norm, mla_wkv_b,
                 w_out, w_up, w_down, cos, sin):
    h = rms_norm(x, n_mix_pre)
    proj = h @ w_in
    offsets = [int(o) for o in np.cumsum(IN_SIZES)[:-1]]
    u, v, c_q, c_kv, k_rope, r_q, r_k, r_v, r_g = jnp.split(proj, offsets, axis=-1)
    out_a = sgu_mixer(u, v, sgu_ln_g, sgu_ln_b, sgu_w, sgu_b)
    out_b = mla_mixer(c_q, c_kv, k_rope, mla_q_norm, mla_wq_b, mla_kv_norm, mla_wkv_b, cos, sin)
    out_c = retention_mixer(r_q, r_k, r_v, r_g, cos, sin)
    mixed = jnp.concatenate([out_a, out_b, out_c], axis=-1) @ w_out
    x = x + rms_norm(mixed, n_mix_post)
    h = rms_norm(x, n_ffn_pre)
    f = jnp.square(jax.nn.relu(h @ w_up)) @ w_down
    return x + rms_norm(f, n_ffn_post)


def setup_inputs(seed: int = 0) -> dict:
    key = jax.random.key(seed)
    ks = jax.random.split(key, 20)

    def nrm(k, shape, scale):
        return jax.random.normal(k, shape, jnp.float32) * scale

    L = DEPTH
    return {
        "x": nrm(ks[0], (BATCH, SEQ, D_MODEL), 1.0),
        "norm_mix_pre": 1.0 + nrm(ks[1], (L, D_MODEL), 0.02),
        "norm_mix_post": 1.0 + nrm(ks[2], (L, D_MODEL), 0.02),
        "norm_ffn_pre": 1.0 + nrm(ks[3], (L, D_MODEL), 0.02),
        "norm_ffn_post": 1.0 + nrm(ks[4], (L, D_MODEL), 0.02),
        "w_in": nrm(ks[5], (L, D_MODEL, IN_WIDTH), D_MODEL ** -0.5),
        "sgu_ln_g": 1.0 + nrm(ks[6], (L, SGU_WIDTH), 0.02),
        "sgu_ln_b": nrm(ks[7], (L, SGU_WIDTH), 0.02),
        "sgu_w": nrm(ks[8], (L, SGU_HEADS, SGU_BLOCK, SGU_BLOCK), SGU_BLOCK ** -0.5),
        "sgu_b": 1.0 + nrm(ks[9], (L, SGU_HEADS, SGU_BLOCK), 0.1),
        "mla_q_norm": 1.0 + nrm(ks[10], (L, MLA_Q_RANK), 0.02),
        "mla_wq_b": nrm(ks[11], (L, MLA_Q_RANK, MLA_HEADS * (MLA_NOPE_DIM + MLA_ROPE_DIM)), MLA_Q_RANK ** -0.5),
        "mla_kv_norm": 1.0 + nrm(ks[12], (L, MLA_KV_RANK), 0.02),
        "mla_wkv_b": nrm(ks[13], (L, MLA_KV_RANK, MLA_HEADS * (MLA_NOPE_DIM + MLA_V_DIM)), MLA_KV_RANK ** -0.5),
        "w_out": nrm(ks[14], (L, MIX_WIDTH, D_MODEL), MIX_WIDTH ** -0.5),
        "w_up": nrm(ks[15], (L, D_MODEL, FF_DIM), D_MODEL ** -0.5),
        "w_down": nrm(ks[16], (L, FF_DIM, D_MODEL), FF_DIM ** -0.5),
    }


def reference(x, norm_mix_pre, norm_mix_post, norm_ffn_pre, norm_ffn_post, w_in,
              sgu_ln_g, sgu_ln_b, sgu_w, sgu_b,
              mla_q_norm, mla_wq_b, mla_kv_norm, mla_wkv_b,
              w_out, w_up, w_down):
    cos, sin = rope_tables(x.shape[1], MLA_ROPE_DIM)
    for l in range(DEPTH):
        x = hybrid_layer(x, norm_mix_pre[l], norm_mix_post[l], norm_ffn_pre[l], norm_ffn_post[l], w_in[l],
                         sgu_ln_g[l], sgu_ln_b[l], sgu_w[l], sgu_b[l],
                         mla_q_norm[l], mla_wq_b[l], mla_kv_norm[l], mla_wkv_b[l],
                         w_out[l], w_up[l], w_down[l], cos, sin)
    return x
```

```cpp
#include <hip/hip_runtime.h>
#include <cstdio>
#include <cstdint>
namespace pg8 {
#define PG8_LAS __attribute__((address_space(3)))
typedef unsigned short bf16_t;
typedef short bf16x8 __attribute__((ext_vector_type(8)));
typedef float f32x4 __attribute__((ext_vector_type(4)));
typedef unsigned u32x4 __attribute__((ext_vector_type(4)));
constexpr int BM = 256, BK = 64, HALF = 128, HTB = HALF * BK * 2  , STAGE_BYTES = 8 * HTB, NXCD = 8, WGM = 8;

__host__ __device__ __forceinline__ int lds_byte(int r, int c) { const int st = (r >> 4) * 2 + (c >> 5), rr = r & 15, cc = c & 31, ob = rr * 64 + cc * 2; return st * 1024 + (ob ^ (((ob >> 9) & 1) << 5)); }
__host__ __device__ __forceinline__ void stage_rc(int b, int& R, int& C) { const int st = b / 1024, sb = b % 1024, swz = sb ^ (((sb >> 9) & 1) << 5); R = (st >> 1) * 16 + swz / 64; C = (st & 1) * 32 + (swz % 64) / 2; }
__host__ __device__ __forceinline__ int perm32(int rho) { const int n = rho >> 4, i = rho & 15; return 8 * (i >> 2) + 4 * n + (i & 3); }

struct Unit { int pm, pn; };
struct Gemm { const bf16_t* A; const bf16_t* Bt; int M, N, K, lda; };

struct StaticOrder {
    int nM, nN, nwg, G, c;
    __host__ __device__ void init(int M, int N, int G_, int c_) { nM = M / BM; nN = N / BM; nwg = nM * nN; G = G_; c = c_; }
    __host__ __device__ bool next(int i, Unit& u) const {
        const long L = (long)i * G + c; if (L >= nwg) return false;
        int wgid = (int)L; { const int q = nwg / NXCD, r = nwg % NXCD, xcd = wgid % NXCD, off = wgid / NXCD; wgid = (xcd < r ? xcd * (q + 1) : r * (q + 1) + (xcd - r) * q) + off; }
        const int nig = WGM * nN, gid = wgid / nig, fm = gid * WGM, gsz = (nM - fm) < WGM ? (nM - fm) : WGM;
        u.pm = fm + ((wgid % nig) % gsz); u.pn = (wgid % nig) / gsz; return true;
    }
    __device__ __forceinline__ void a_ready(const Unit&) const {}
    __device__ __forceinline__ void done(const Unit&) const {}
};
__device__ __forceinline__ unsigned cvt_pk_bf16(float lo, float hi) { unsigned r; asm volatile("v_cvt_pk_bf16_f32 %0, %1, %2" : "=v"(r) : "v"(lo), "v"(hi)); return r; }
__device__ __forceinline__ void rope8(f32x4& v0, f32x4& v1, const float* tab) {
    const f32x4 t0 = *(const f32x4*)tab, t1 = *(const f32x4*)(tab + 4);
    f32x4 a, b;
    a[0] = v0[0] * t0[0] - v0[1] * t0[1]; a[1] = v0[0] * t0[1] + v0[1] * t0[0];
    a[2] = v0[2] * t0[2] - v0[3] * t0[3]; a[3] = v0[2] * t0[3] + v0[3] * t0[2];
    b[0] = v1[0] * t1[0] - v1[1] * t1[1]; b[1] = v1[0] * t1[1] + v1[1] * t1[0];
    b[2] = v1[2] * t1[2] - v1[3] * t1[3]; b[3] = v1[2] * t1[3] + v1[3] * t1[2];
    v0 = a; v1 = b;
}
template <int MODE> struct Epi {
    static constexpr bool PERM = true, AFTER_DRAIN = false;
    bf16_t* O; int ldc; const float* rope; float* ssq;
    __device__ __forceinline__ void operator()(const f32x4 (&acc)[2][2][4][2], const Unit& u, int wr, int wc, int fr, int fq) const {
        const int row0 = u.pm * BM + wr * 64 + fr, colt = u.pn * BM + wc * 32 + 8 * fq;
        const bool want_ss = (MODE == 2) && u.pn >= 8 && u.pn < 14;
#pragma unroll
        for (int ai = 0; ai < 2; ++ai)
#pragma unroll
            for (int m = 0; m < 4; ++m) {
                const int row = row0 + ai * HALF + m * 16;
                float rs = 1.f;
                if (MODE == 3) { const f32x4* s = (const f32x4*)(ssq + (size_t)row * 24); const f32x4 a = s[0], b = s[1], c = s[2], d = s[3];
                    const float t = ((a[0] + a[1]) + (a[2] + a[3])) + ((b[0] + b[1]) + (b[2] + b[3])) + ((c[0] + c[1]) + (c[2] + c[3])) + ((d[0] + d[1]) + (d[2] + d[3]));
                    rs = 1.0f / sqrtf(t * (1.0f / 1024.0f) + 1e-6f); }
                if (MODE == 4) { const f32x4* s = (const f32x4*)(ssq + (size_t)row * 24); const f32x4 a = s[4], b = s[5];
                    const float t = ((a[0] + a[1]) + (a[2] + a[3])) + ((b[0] + b[1]) + (b[2] + b[3]));
                    rs = 1.0f / sqrtf(t * (1.0f / 512.0f) + 1e-6f); }
                float part = 0.f;
#pragma unroll
                for (int bj = 0; bj < 2; ++bj) {
                    const int col = colt + bj * HALF;
                    f32x4 v0 = acc[ai][bj][m][0], v1 = acc[ai][bj][m][1];
                    if (MODE == 1) {
#pragma unroll
                        for (int j = 0; j < 4; ++j) { const float p = fmaxf(v0[j], 0.f), q = fmaxf(v1[j], 0.f); v0[j] = p * p; v1[j] = q * q; } }
                    if (MODE == 2) {
                        if (want_ss) part += ((v0[0] * v0[0] + v0[1] * v0[1]) + (v0[2] * v0[2] + v0[3] * v0[3])) + ((v1[0] * v1[0] + v1[1] * v1[1]) + (v1[2] * v1[2] + v1[3] * v1[3]));
                        if (col >= 3584 && col < 4672) rope8(v0, v1, rope + ((size_t)(row & 4095) * 32 + ((col & 63) >> 1)) * 2); }
                    if (MODE == 3) { v0 = v0 * rs; v1 = v1 * rs; if ((col % 192) >= 128) rope8(v0, v1, rope + ((size_t)(row & 4095) * 32 + ((col & 63) >> 1)) * 2); }
                    if (MODE == 4) { v0 = v0 * rs; v1 = v1 * rs; }
                    u32x4 w; w.x = cvt_pk_bf16(v0[0], v0[1]); w.y = cvt_pk_bf16(v0[2], v0[3]); w.z = cvt_pk_bf16(v1[0], v1[1]); w.w = cvt_pk_bf16(v1[2], v1[3]);
                    *(u32x4*)(O + (size_t)row * ldc + col) = w;
                }
                if (want_ss) { part += __shfl_xor(part, 16); part += __shfl_xor(part, 32); if (fq == 0) ssq[(size_t)row * 24 + (u.pn - 8) * 4 + wc] = part; }
            }
    }
};
template <class Epi, class Sched, bool ALIGN_EPI = false, bool SP2 = false>
__device__ __forceinline__ void gemm_phase(PG8_LAS unsigned char* lds, const Gemm g, const Sched& S, const Epi& E) {
    int tid_ = threadIdx.x; asm volatile("" : "+v"(tid_));
    const int tid = tid_, wid = __builtin_amdgcn_readfirstlane(tid >> 6), lane = tid & 63, wr = wid >> 2, wc = wid & 3, fr = lane & 15, fq = lane >> 4;
    const int K = g.K, nt = K / BK;
    unsigned voffA[2], voffB[2];
#pragma unroll
    for (int i = 0; i < 2; ++i) { int R, C; stage_rc(tid * 16 + i * 8192, R, C); const int Rb = Epi::PERM ? ((R & ~31) + perm32(R & 31)) : R;
        voffA[i] = (unsigned)(R * g.lda + C) * 2u; voffB[i] = (unsigned)(Rb * K + C) * 2u; }
    const size_t kstep = (size_t)(BK * 2);
    const size_t hstep = (size_t)HALF * K * 2;
    const size_t tstep = 2 * hstep; const size_t hstepA = (size_t)HALF * g.lda * 2, tstepA = 2 * hstepA;
    const unsigned ldsw = (unsigned)wid * 1024u;
    const int aoff = lds_byte(wr * 64 + fr, fq * 8), boff = lds_byte(wc * 32 + fr, fq * 8);
#define PG8_SA(b, h) (((b) * 2 + (h)) * HTB)
#define PG8_SB(b, h) ((4 + (b) * 2 + (h)) * HTB)
#define PG8_STAGE(bufoff, gbase, voff) do { _Pragma("unroll") for (int _i = 0; _i < 2; ++_i) \
        __builtin_amdgcn_global_load_lds((const unsigned*)((const char*)(gbase) + (voff)[_i]), (PG8_LAS unsigned*)(lds + (bufoff) + ldsw + _i * 8192), 16, 0, 0); } while (0)
#define PG8_LDA(dst, b, h) do { _Pragma("unroll") for (int m = 0; m < 4; ++m) _Pragma("unroll") for (int k = 0; k < 2; ++k) dst[m][k] = *(const PG8_LAS bf16x8*)(lds + PG8_SA(b, h) + aoff + m * 2048 + k * 1024); } while (0)
#define PG8_LDB(dst, b, h) do { _Pragma("unroll") for (int n = 0; n < 2; ++n) _Pragma("unroll") for (int k = 0; k < 2; ++k) dst[n][k] = *(const PG8_LAS bf16x8*)(lds + PG8_SB(b, h) + boff + n * 2048 + k * 1024); } while (0)
#define PG8_MMA(ai, bj, At, Bt) do { __builtin_amdgcn_s_setprio(1); _Pragma("unroll") for (int m = 0; m < 4; ++m) _Pragma("unroll") for (int n = 0; n < 2; ++n) _Pragma("unroll") for (int k = 0; k < 2; ++k) \
        acc[ai][bj][m][n] = __builtin_amdgcn_mfma_f32_16x16x32_bf16(Bt[n][k], At[m][k], acc[ai][bj][m][n], 0, 0, 0); __builtin_amdgcn_s_setprio(0); } while (0)
#define PG8_WAIT_V(n) asm volatile("s_waitcnt vmcnt(" #n ")" ::: "memory")
#define PG8_WAIT_L(n) asm volatile("s_waitcnt lgkmcnt(" #n ")" ::: "memory")
#define PG8_BAR __builtin_amdgcn_s_barrier()
#define PG8_SCHED __builtin_amdgcn_sched_barrier(0)
    Unit cur, nxt; int ui = 0;
    if (!S.next(0, cur)) return;
    f32x4 acc[2][2][4][2];
#pragma unroll
    for (int a = 0; a < 2; ++a)
#pragma unroll
        for (int b = 0; b < 2; ++b)
#pragma unroll
            for (int m = 0; m < 4; ++m)
#pragma unroll
                for (int n = 0; n < 2; ++n) acc[a][b][m][n] = (f32x4){0.f, 0.f, 0.f, 0.f};
    bf16x8 At[4][2], B0[2][2], B1[2][2];
    const char* cA = (const char*)g.A + (size_t)cur.pm * tstepA; const char* cB = (const char*)g.Bt + (size_t)cur.pn * tstep;
    S.a_ready(cur);
    if constexpr (SP2) {
        PG8_STAGE(PG8_SB(0, 0), cB, voffB); PG8_STAGE(PG8_SB(0, 1), cB + hstep, voffB); PG8_STAGE(PG8_SA(0, 0), cA, voffA); PG8_STAGE(PG8_SA(0, 1), cA + hstepA, voffA);
        if (wr == 1) PG8_BAR;
        PG8_WAIT_V(2); PG8_BAR;
        PG8_STAGE(PG8_SB(1, 0), cB + kstep, voffB); PG8_STAGE(PG8_SA(1, 0), cA + kstep, voffA); PG8_STAGE(PG8_SB(1, 1), cB + hstep + kstep, voffB);
        PG8_WAIT_V(6); PG8_BAR;
    } else {
        PG8_STAGE(PG8_SB(0, 0), cB, voffB); PG8_STAGE(PG8_SA(0, 0), cA, voffA); PG8_STAGE(PG8_SB(0, 1), cB + hstep, voffB); PG8_STAGE(PG8_SA(0, 1), cA + hstepA, voffA);
        if (wr == 1) PG8_BAR;
        PG8_WAIT_V(4); PG8_BAR;
        PG8_STAGE(PG8_SB(1, 0), cB + kstep, voffB); PG8_STAGE(PG8_SA(1, 0), cA + kstep, voffA); PG8_STAGE(PG8_SB(1, 1), cB + hstep + kstep, voffB);
        PG8_WAIT_V(6); PG8_BAR;
    }
    for (;;) {
        const bool has_next = S.next(ui + 1, nxt);
        const char* nA = has_next ? (const char*)g.A + (size_t)nxt.pm * tstepA : cA; const char* nB = has_next ? (const char*)g.Bt + (size_t)nxt.pn * tstep : cB;
        for (int t = 0; t < nt; t += 2) {
            const bool last = (t == nt - 2);
            const char* a1 = cA + (size_t)(t + 1) * kstep;
            const char* a2 = last ? nA : cA + (size_t)(t + 2) * kstep; const char* b2 = last ? nB : cB + (size_t)(t + 2) * kstep;
            const char* a3 = a2 + kstep; const char* b3 = b2 + kstep;
            if (last && has_next) S.a_ready(nxt);
            if constexpr (SP2) {
            PG8_LDB(B0, 0, 0); PG8_LDB(B1, 0, 1); PG8_SCHED; PG8_LDA(At, 0, 0); PG8_STAGE(PG8_SA(1, 1), a1 + hstepA, voffA);
            PG8_WAIT_V(8); PG8_WAIT_L(0); PG8_BAR; PG8_MMA(0, 0, At, B0); PG8_MMA(0, 1, At, B1); PG8_BAR; PG8_SCHED;
            PG8_LDA(At, 0, 1); PG8_STAGE(PG8_SB(0, 0), b2, voffB); PG8_STAGE(PG8_SB(0, 1), b2 + hstep, voffB); PG8_STAGE(PG8_SA(0, 0), a2, voffA);
            PG8_WAIT_V(8); PG8_WAIT_L(0); PG8_BAR; PG8_MMA(1, 0, At, B0); PG8_MMA(1, 1, At, B1); PG8_BAR; PG8_SCHED;
            PG8_LDB(B0, 1, 0); PG8_LDB(B1, 1, 1); PG8_SCHED; PG8_LDA(At, 1, 0); PG8_STAGE(PG8_SA(0, 1), a2 + hstepA, voffA);
            PG8_WAIT_V(8); PG8_WAIT_L(0); PG8_BAR; PG8_MMA(0, 0, At, B0); PG8_MMA(0, 1, At, B1); PG8_BAR; PG8_SCHED;
            PG8_LDA(At, 1, 1); PG8_STAGE(PG8_SB(1, 0), b3, voffB); PG8_STAGE(PG8_SB(1, 1), b3 + hstep, voffB); PG8_STAGE(PG8_SA(1, 0), a3, voffA);
            PG8_WAIT_V(8); PG8_WAIT_L(0); PG8_BAR; PG8_MMA(1, 0, At, B0); PG8_MMA(1, 1, At, B1); PG8_BAR; PG8_SCHED;
            } else {
            PG8_LDB(B0, 0, 0); PG8_SCHED; PG8_LDA(At, 0, 0); PG8_STAGE(PG8_SA(1, 1), a1 + hstepA, voffA);
            PG8_WAIT_L(8); PG8_BAR; PG8_WAIT_L(0); PG8_MMA(0, 0, At, B0); PG8_BAR; PG8_SCHED;
            PG8_LDB(B1, 0, 1); PG8_STAGE(PG8_SB(0, 0), b2, voffB);
            PG8_BAR; PG8_WAIT_L(0); PG8_MMA(0, 1, At, B1); PG8_BAR;
            PG8_LDA(At, 0, 1); PG8_STAGE(PG8_SA(0, 0), a2, voffA);
            PG8_BAR; PG8_WAIT_L(0); PG8_MMA(1, 0, At, B0); PG8_BAR; PG8_SCHED;
            PG8_STAGE(PG8_SB(0, 1), b2 + hstep, voffB);
            PG8_WAIT_V(6); PG8_BAR; PG8_MMA(1, 1, At, B1); PG8_BAR;
            PG8_LDB(B0, 1, 0); PG8_SCHED; PG8_LDA(At, 1, 0); PG8_STAGE(PG8_SA(0, 1), a2 + hstepA, voffA);
            PG8_WAIT_L(8); PG8_BAR; PG8_WAIT_L(0); PG8_MMA(0, 0, At, B0); PG8_BAR; PG8_SCHED;
            PG8_LDB(B1, 1, 1); PG8_STAGE(PG8_SB(1, 0), b3, voffB);
            PG8_BAR; PG8_WAIT_L(0); PG8_MMA(0, 1, At, B1); PG8_BAR;
            PG8_LDA(At, 1, 1); PG8_STAGE(PG8_SA(1, 0), a3, voffA);
            PG8_BAR; PG8_WAIT_L(0); PG8_MMA(1, 0, At, B0); PG8_BAR; PG8_SCHED;
            PG8_STAGE(PG8_SB(1, 1), b3 + hstep, voffB);
            PG8_WAIT_V(6); PG8_BAR; PG8_MMA(1, 1, At, B1); PG8_BAR;
            }
        }
        if constexpr (ALIGN_EPI) { if (wr == 0) PG8_BAR; }
        if constexpr (!Epi::AFTER_DRAIN) { E(acc, cur, wr, wc, fr, fq); S.done(cur); }
        if (!has_next) break;
#pragma unroll
        for (int a = 0; a < 2; ++a)
#pragma unroll
            for (int b = 0; b < 2; ++b)
#pragma unroll
                for (int m = 0; m < 4; ++m)
#pragma unroll
                    for (int n = 0; n < 2; ++n) acc[a][b][m][n] = (f32x4){0.f, 0.f, 0.f, 0.f};
        cur = nxt; cA = nA; cB = nB; ++ui;
        if constexpr (ALIGN_EPI) { if (wr == 1) PG8_BAR; }
    }
    PG8_WAIT_V(0);
    if constexpr (!ALIGN_EPI) { if (wr == 0) PG8_BAR; }
    PG8_BAR;
    if constexpr (Epi::AFTER_DRAIN) { E.fused(acc, cur, wr, wc, fr, fq, lds, wid, lane); S.done(cur); }
#undef PG8_SA
#undef PG8_SB
#undef PG8_STAGE
#undef PG8_LDA
#undef PG8_LDB
#undef PG8_MMA
#undef PG8_WAIT_V
#undef PG8_WAIT_L
#undef PG8_BAR
#undef PG8_SCHED
}
}
namespace att {
#define ATT_LAS __attribute__((address_space(3)))
typedef unsigned short bf16;
using bf16x8 = __attribute__((ext_vector_type(8))) short;
using s16x4  = __attribute__((ext_vector_type(4))) short;
using f32x16 = __attribute__((ext_vector_type(16))) float;
using u32x4  = __attribute__((ext_vector_type(4))) unsigned;
constexpr float SCALE = 0.07216878364870322f;
constexpr float THR = 8.f;
constexpr int SHM_V = 16384, SHM_K = 16384, SHM_R = 8192;
constexpr int OFF_V = 0, OFF_K = 2 * SHM_V, OFF_R = OFF_K + 2 * SHM_K, OFF_WS = OFF_R + 2 * SHM_R, ATT_LDS_BYTES = OFF_WS + 8 * 64 * 4;
#define KSWZ(row, colB) ((row) * 256 + ((colB) ^ (((row) & 7) << 4)))
#define RSWZ(row, colB) ((row) * 128 + ((colB) ^ (((row) & 7) << 4)))
#define SBAR() __builtin_amdgcn_sched_barrier(0)
__device__ __forceinline__ int crow(int r, int hi) { return (r & 3) + 8 * (r >> 2) + 4 * hi; }
__device__ __forceinline__ unsigned cvtpk(float lo, float hi) { unsigned r; asm volatile("v_cvt_pk_bf16_f32 %0, %1, %2" : "=v"(r) : "v"(lo), "v"(hi)); return r; }
__device__ __forceinline__ void partialSM(f32x16& p0, f32x16& p1, float& m_reg, float& mn, float& alpha) {
  constexpr float C = SCALE * 1.4426950408889634f;
  float pmax = p0[0];
#pragma unroll
  for (int r = 1; r < 16; ++r) pmax = fmaxf(pmax, p0[r]);
#pragma unroll
  for (int r = 0; r < 16; ++r) pmax = fmaxf(pmax, p1[r]);
  { auto rr = __builtin_amdgcn_permlane32_swap(__float_as_uint(pmax), __float_as_uint(pmax), false, false);
    pmax = fmaxf(__uint_as_float(rr[0]), __uint_as_float(rr[1])); }
  if (__builtin_expect(__all(pmax - m_reg <= THR / SCALE), 1)) { mn = m_reg; alpha = 1.f; }
  else { mn = fmaxf(m_reg, pmax); alpha = __builtin_amdgcn_exp2f((m_reg - mn) * C); m_reg = mn; }
  float mnC = -mn * C;
#pragma unroll
  for (int r = 0; r < 16; ++r) p0[r] = fmaf(p0[r], C, mnC);
#pragma unroll
  for (int r = 0; r < 16; ++r) p1[r] = fmaf(p1[r], C, mnC);
#pragma unroll
  for (int r = 0; r < 16; ++r) p0[r] = __builtin_amdgcn_exp2f(p0[r]);
}
__device__ __forceinline__ void finishSM(f32x16& p0, f32x16& p1, float alpha, float& l_reg, bf16x8& pa0, bf16x8& pa1, bf16x8& pa2, bf16x8& pa3) {
#pragma unroll
  for (int r = 0; r < 16; ++r) p1[r] = __builtin_amdgcn_exp2f(p1[r]);
  float ps = 0;
#pragma unroll
  for (int r = 0; r < 16; ++r) ps += p0[r];
#pragma unroll
  for (int r = 0; r < 16; ++r) ps += p1[r];
  { auto rr = __builtin_amdgcn_permlane32_swap(__float_as_uint(ps), __float_as_uint(ps), false, false);
    ps = __uint_as_float(rr[0]) + __uint_as_float(rr[1]); }
  l_reg = l_reg * alpha + ps;
#define PK4(P, BASE, OUT) do { unsigned a0 = cvtpk(P[BASE + 0], P[BASE + 1]), a1 = cvtpk(P[BASE + 2], P[BASE + 3]);   \
    unsigned b0 = cvtpk(P[BASE + 4], P[BASE + 5]), b1 = cvtpk(P[BASE + 6], P[BASE + 7]);                              \
    auto r0 = __builtin_amdgcn_permlane32_swap(a0, b0, false, false); auto r1 = __builtin_amdgcn_permlane32_swap(a1, b1, false, false); \
    u32x4 w = {r0[0], r1[0], r0[1], r1[1]}; OUT = *reinterpret_cast<bf16x8*>(&w); } while (0)
  PK4(p0, 0, pa0); PK4(p0, 8, pa1); PK4(p1, 0, pa2); PK4(p1, 8, pa3);
#undef PK4
}
__device__ __forceinline__ void qkt(f32x16& p0, f32x16& p1, const ATT_LAS char* Ks, const ATT_LAS char* Rs, const bf16x8* qr, int r32, int hi) {
  p0 = f32x16{}; p1 = f32x16{};
#pragma unroll
  for (int d0 = 0; d0 < 8; ++d0) { const int cb = (d0 * 16 + hi * 8) * 2;
    const bf16x8 b0 = *reinterpret_cast<const ATT_LAS bf16x8*>(Ks + KSWZ(r32, cb));
    const bf16x8 b1 = *reinterpret_cast<const ATT_LAS bf16x8*>(Ks + KSWZ(32 + r32, cb));
    p0 = __builtin_amdgcn_mfma_f32_32x32x16_bf16(b0, qr[d0], p0, 0, 0, 0);
    p1 = __builtin_amdgcn_mfma_f32_32x32x16_bf16(b1, qr[d0], p1, 0, 0, 0); }
#pragma unroll
  for (int d0 = 0; d0 < 4; ++d0) { const int cb = (d0 * 16 + hi * 8) * 2;
    const bf16x8 b0 = *reinterpret_cast<const ATT_LAS bf16x8*>(Rs + RSWZ(r32, cb));
    const bf16x8 b1 = *reinterpret_cast<const ATT_LAS bf16x8*>(Rs + RSWZ(32 + r32, cb));
    p0 = __builtin_amdgcn_mfma_f32_32x32x16_bf16(b0, qr[8 + d0], p0, 0, 0, 0);
    p1 = __builtin_amdgcn_mfma_f32_32x32x16_bf16(b1, qr[8 + d0], p1, 0, 0, 0); }
}
__device__ __forceinline__ int v_st(int k, int c) { const int kk = (k & ~0xC) | ((k & 4) << 1) | ((k & 8) >> 1); return ((kk >> 3) * 4 + (c >> 5)) * 512 + ((kk & 7) * 32 + (c & 31)) * 2; }
__device__ __forceinline__ int v_rd_base(int lane) { return ((lane & 3) << 3) | (((lane >> 2) & 3) << 6) | (((lane >> 4) & 1) << 5) | (((lane >> 5) & 1) << 8); }
constexpr int v_rd_off(int d0, int ks, int half) { return d0 * 512 + ks * 4096 + half * 2048; }
template <int OFF> __device__ __forceinline__ s16x4 tr_read(int vb) {
  s16x4 r; asm volatile("ds_read_b64_tr_b16 %0, %1 offset:%2" : "=&v"(r) : "v"(vb), "i"(OFF) : "memory"); return r;
}
template <int D0> __device__ __forceinline__ void pv_one(f32x16& od, int vb, bf16x8 pa0, bf16x8 pa1, bf16x8 pa2, bf16x8 pa3) {
  const s16x4 l0 = tr_read<v_rd_off(D0, 0, 0)>(vb), h0 = tr_read<v_rd_off(D0, 0, 1)>(vb), l1 = tr_read<v_rd_off(D0, 1, 0)>(vb), h1 = tr_read<v_rd_off(D0, 1, 1)>(vb);
  const s16x4 l2 = tr_read<v_rd_off(D0, 2, 0)>(vb), h2 = tr_read<v_rd_off(D0, 2, 1)>(vb), l3 = tr_read<v_rd_off(D0, 3, 0)>(vb), h3 = tr_read<v_rd_off(D0, 3, 1)>(vb);
  asm volatile("s_waitcnt lgkmcnt(0)" ::: "memory"); SBAR();
#define PK(L, H) (bf16x8){L[0], L[1], L[2], L[3], H[0], H[1], H[2], H[3]}
  od = __builtin_amdgcn_mfma_f32_32x32x16_bf16(pa0, PK(l0, h0), od, 0, 0, 0);
  od = __builtin_amdgcn_mfma_f32_32x32x16_bf16(pa1, PK(l1, h1), od, 0, 0, 0);
  od = __builtin_amdgcn_mfma_f32_32x32x16_bf16(pa2, PK(l2, h2), od, 0, 0, 0);
  od = __builtin_amdgcn_mfma_f32_32x32x16_bf16(pa3, PK(l3, h3), od, 0, 0, 0);
#undef PK
}
__device__ __forceinline__ void pv_d0(f32x16* o, int vb, bf16x8 pa0, bf16x8 pa1, bf16x8 pa2, bf16x8 pa3) {
  pv_one<0>(o[0], vb, pa0, pa1, pa2, pa3); pv_one<1>(o[1], vb, pa0, pa1, pa2, pa3); pv_one<2>(o[2], vb, pa0, pa1, pa2, pa3); pv_one<3>(o[3], vb, pa0, pa1, pa2, pa3);
}
__device__ __forceinline__ unsigned short f2bf(float f) { unsigned u = __builtin_bit_cast(unsigned, f); return (unsigned short)((u + 0x7fffu + ((u >> 16) & 1u)) >> 16); }
__device__ __forceinline__ void attn_unit(const bf16* __restrict__ Q, const bf16* __restrict__ KV, const bf16* __restrict__ PROJ, bf16* __restrict__ CAT, int b, int h, int qb, ATT_LAS char* lds) {
  int tid_ = threadIdx.x; asm volatile("" : "+v"(tid_));
  const int tid = tid_, wid = __builtin_amdgcn_readfirstlane(tid >> 6), lane = tid & 63, r32 = lane & 31, hi = lane >> 5;
  ATT_LAS char* V_lds = lds + OFF_V; ATT_LAS char* K_lds = lds + OFF_K; ATT_LAS char* R_lds = lds + OFF_R;
  ATT_LAS float* wsp = (ATT_LAS float*)(lds + OFF_WS) + wid * 64; ATT_LAS float* li_l = wsp; ATT_LAS float* al_l = wsp + 32;
  float m_reg = -1e30f, l_reg = 0; f32x16 o[4] = {}; bf16x8 qr[12];
  const size_t tok0 = (size_t)b * 4096;
  const bf16* Qw = Q + (tok0 + (size_t)qb * 256 + wid * 32 + r32) * 3072 + h * 192 + hi * 8;
#pragma unroll
  for (int d0 = 0; d0 < 12; ++d0) qr[d0] = *reinterpret_cast<const bf16x8*>(Qw + d0 * 16);
  const int cw = qb * 4 + (wid >> 1), NT = qb * 4 + 4;
  const int sr = tid >> 4, sc = (tid & 15) * 8, vst0 = v_st(sr, sc), vst1 = v_st(32 + sr, sc), kst0 = KSWZ(sr, sc * 2), kst1 = KSWZ(32 + sr, sc * 2);
  const int rr = tid >> 3, rc = (tid & 7) * 8, rst = RSWZ(rr, rc * 2);
  const bf16* Kg = KV + tok0 * 4096 + h * 256;
  const bf16* Rg = PROJ + tok0 * 6912 + 3584;
  const int vb0 = (int)(uintptr_t)V_lds + v_rd_base(lane);
  bf16x8 sv0, sv1, sk0, sk1, srp;
#define ATT_SLOAD(k0) do { sv0 = *reinterpret_cast<const bf16x8*>(Kg + (size_t)((k0) + sr) * 4096 + 128 + sc); sv1 = *reinterpret_cast<const bf16x8*>(Kg + (size_t)((k0) + 32 + sr) * 4096 + 128 + sc); \
    sk0 = *reinterpret_cast<const bf16x8*>(Kg + (size_t)((k0) + sr) * 4096 + sc); sk1 = *reinterpret_cast<const bf16x8*>(Kg + (size_t)((k0) + 32 + sr) * 4096 + sc); \
    srp = *reinterpret_cast<const bf16x8*>(Rg + (size_t)((k0) + rr) * 6912 + rc); } while (0)
#define ATT_SWRITE(bf) do { *reinterpret_cast<ATT_LAS bf16x8*>(V_lds + (bf) * SHM_V + vst0) = sv0; *reinterpret_cast<ATT_LAS bf16x8*>(V_lds + (bf) * SHM_V + vst1) = sv1; \
    *reinterpret_cast<ATT_LAS bf16x8*>(K_lds + (bf) * SHM_K + kst0) = sk0; *reinterpret_cast<ATT_LAS bf16x8*>(K_lds + (bf) * SHM_K + kst1) = sk1; \
    *reinterpret_cast<ATT_LAS bf16x8*>(R_lds + (bf) * SHM_R + rst) = srp; } while (0)
#define ATT_RESC(a) do { if (__any((a) < 1.f)) { if (hi == 0) al_l[r32] = (a); asm volatile("s_waitcnt lgkmcnt(0)" ::: "memory"); \
    _Pragma("unroll") for (int d = 0; d < 4; ++d) _Pragma("unroll") for (int r = 0; r < 16; ++r) o[d][r] *= al_l[crow(r, hi)]; } } while (0)
  ATT_SLOAD(0); asm volatile("s_waitcnt vmcnt(0)" ::: "memory"); ATT_SWRITE(0); __syncthreads();
  for (int t = 0; t < NT; ++t) {
    const int bf = t & 1;
    if (t + 1 < NT) ATT_SLOAD((t + 1) * 64);
    if (t <= cw) {
      f32x16 p0, p1; float mn, al; bf16x8 pa0, pa1, pa2, pa3;
      qkt(p0, p1, K_lds + bf * SHM_K, R_lds + bf * SHM_R, qr, r32, hi);
      partialSM(p0, p1, m_reg, mn, al);
      ATT_RESC(al);
      finishSM(p0, p1, al, l_reg, pa0, pa1, pa2, pa3); SBAR();
      pv_d0(o, vb0 + bf * SHM_V, pa0, pa1, pa2, pa3);
    }
    if (t + 1 < NT) { asm volatile("s_waitcnt vmcnt(0)" ::: "memory"); ATT_SWRITE(bf ^ 1); }
    __syncthreads();
  }
  if (hi == 0) li_l[r32] = l_reg; asm volatile("s_waitcnt lgkmcnt(0)" ::: "memory");
  float rli[16];
#pragma unroll
  for (int r = 0; r < 16; ++r) rli[r] = __builtin_amdgcn_rcpf(li_l[crow(r, hi)]);
  bf16* Ow = CAT + (tok0 + (size_t)qb * 256 + wid * 32) * 4096 + 1024 + h * 128;
#pragma unroll
  for (int r = 0; r < 16; ++r) { const int orow = crow(r, hi);
#pragma unroll
    for (int d0 = 0; d0 < 4; ++d0) Ow[(size_t)orow * 4096 + d0 * 32 + r32] = f2bf(o[d0][r] * rli[r]); }
#undef ATT_SLOAD
#undef ATT_SWRITE
#undef ATT_RESC
}
}
constexpr int NWAVES = 8;
constexpr int BATCH = 2, SEQ = 4096, DM = 4096, M = BATCH * SEQ, DEPTH = 2, FF = 16384;
constexpr int INW = 6720, INP = 6912;
constexpr int C_U = 0, C_V = 1024, C_CQ = 2048, C_CKV = 3072, C_KR = 3584, C_RQ = 3648, C_RK = 4160, C_RV = 4672, C_RG = 5696;
constexpr int QW = 3072, KVW = 4096;
constexpr float EPS = 1e-6f;
constexpr size_t MiB = 1u << 20;
constexpr size_t WS_CTL = 0, CTL_ZERO_BYTES = 1 * MiB;
constexpr size_t WS_ROPE = 1 * MiB;
constexpr size_t WS_SSQ = 2 * MiB;
constexpr size_t WS_W = 4 * MiB, LW = 353 * MiB;
constexpr size_t W_IN = 0, W_Q = 54 * MiB, W_KV = 60 * MiB, W_OUT = 64 * MiB, W_UP = 96 * MiB, W_DOWN = 224 * MiB, W_SGU = 352 * MiB;
constexpr size_t WS_H = WS_W + 2 * LW;
constexpr size_t WS_PROJ = WS_H + 64 * MiB;
constexpr size_t WS_Q = WS_PROJ + 108 * MiB;
constexpr size_t WS_KV = WS_Q + 48 * MiB;
constexpr size_t WS_CAT = WS_KV + 64 * MiB;
constexpr size_t WS_MIX = WS_CAT + 64 * MiB;
constexpr size_t WS_ACT = WS_MIX + 64 * MiB;
constexpr size_t WS_KVS = WS_ACT + 256 * MiB;
constexpr size_t WS_SB = WS_KVS + 32 * MiB;
constexpr size_t WS_END = WS_SB + 16 * MiB;
static_assert((size_t)INP * DM * 2 == 54 * MiB && (size_t)M * INP * 2 == 108 * MiB, "map");
constexpr int CW_BAR = 4096;
constexpr int RING_OFF = 0, RING_BYTES = 131072;
constexpr int LDSCTL_OFF = RING_BYTES, MISC_OFF = LDSCTL_OFF + 320;
constexpr int LDS_BYTES = 147456;
#define GAS __attribute__((address_space(1)))
#define LAS __attribute__((address_space(3)))
typedef unsigned short bf16;
typedef unsigned v4u __attribute__((ext_vector_type(4)));
typedef float f32x4 __attribute__((ext_vector_type(4)));
typedef short bf16x8 __attribute__((ext_vector_type(8)));
typedef GAS unsigned gu32;
typedef GAS unsigned long long gu64;
#define RLX_AGENT __ATOMIC_RELAXED, __HIP_MEMORY_SCOPE_AGENT
#define LDS_WAIT() asm volatile("s_waitcnt lgkmcnt(0)" ::: "memory")
#define VM_WAIT() asm volatile("s_waitcnt vmcnt(0)" ::: "memory")
__device__ __forceinline__ unsigned long long rt() { return __builtin_amdgcn_s_memrealtime(); }
__device__ __forceinline__ unsigned f2bf(float f) { unsigned u = __builtin_bit_cast(unsigned, f); return (u + 0x7fffu + ((u >> 16) & 1u)) >> 16; }
__device__ __forceinline__ unsigned pk2(float lo, float hi) { return f2bf(lo) | (f2bf(hi) << 16); }

#define XB_TMO      128
#define XB_XCNT(j)  (256  + 64 * (j))
#define XB_XSUB(j)  (1280 + 64 * (j))
#define XB_XGEN(j)  (2304 + 64 * (j))
#define XB_TOP      3328
#define XB_TOPGEN   3392
#define XCD_BAR_WORDS 3456
#define XB_SPIN_CAP (1u << 18)

__device__ __forceinline__ unsigned xb_ld(unsigned* p)              { return __hip_atomic_load(p, __ATOMIC_RELAXED, __HIP_MEMORY_SCOPE_AGENT); }
__device__ __forceinline__ unsigned xb_add(unsigned* p, unsigned v) { return __hip_atomic_fetch_add(p, v, __ATOMIC_RELAXED, __HIP_MEMORY_SCOPE_AGENT); }
__device__ __forceinline__ unsigned xb_xcc_id() { return (unsigned)__builtin_amdgcn_s_getreg((3 << 11) | 20) & 0xFu; }
#define XB_SPIN(cond, bar) do { unsigned _sp = 0; while (cond) { __builtin_amdgcn_s_sleep(1); \
    if ((++_sp & 255u) == 0u) { if (xb_ld(&(bar)[XB_TMO])) break; if (_sp > XB_SPIN_CAP) { atomicAdd(&(bar)[XB_TMO], 1u); break; } } } } while (0)

struct XcdBarrier {
    unsigned* bar; unsigned x;
    volatile LAS unsigned* st;
};

__device__ __forceinline__ XcdBarrier xcd_barrier_post(unsigned* bar, volatile LAS unsigned* st) {
    XcdBarrier b; b.bar = bar; b.x = xb_xcc_id(); b.st = st;
    if (threadIdx.x == 0) (void)xb_add(&bar[XB_XCNT(b.x)], 1u);
    return b;
}
__device__ __forceinline__ void xcd_barrier_complete(unsigned* bar, unsigned x, unsigned& nloc, unsigned& nx) {
    const unsigned G = gridDim.x * gridDim.y * gridDim.z;
    unsigned sum, cnt, mine, sp = 0u;
    for (;;) {
        sum = 0u; cnt = 0u; mine = 0u;
#pragma unroll
        for (unsigned j = 0; j < 16; ++j) { const unsigned c = xb_ld(&bar[XB_XCNT(j)]); sum += c; cnt += (c > 0u) ? 1u : 0u; mine = (j == x) ? c : mine; }
        if (sum == G) break;
        __builtin_amdgcn_s_sleep(1);
        if ((++sp & 255u) == 0u) { if (xb_ld(&bar[XB_TMO])) break; if (sp > XB_SPIN_CAP) { atomicAdd(&bar[XB_TMO], 1u); break; } }
    }
    nloc = mine > 0u ? mine : 1u; nx = cnt > 0u ? cnt : 1u;
}

__device__ __forceinline__ void xcd_barrier(const XcdBarrier& b) {
    asm volatile("s_waitcnt vmcnt(0)" ::: "memory");
    __syncthreads();
    if (threadIdx.x == 0) {
        unsigned* bar = b.bar;
        __builtin_amdgcn_s_waitcnt(0);
        unsigned nloc = b.st[0], nx = b.st[1];
        if (nloc == 0u) { xcd_barrier_complete(bar, b.x, nloc, nx); b.st[0] = nloc; b.st[1] = nx; }
        const unsigned old = xb_add(&bar[XB_XSUB(b.x)], 1u);
        const unsigned gen = old / nloc;
        if (old + 1u == (gen + 1u) * nloc) {
            __builtin_amdgcn_fence(__ATOMIC_RELEASE, "agent");
            asm volatile("s_waitcnt vmcnt(0)" ::: "memory");
            const unsigned og = xb_add(&bar[XB_TOP], 1u);
            const unsigned tg = og / nx;
            if (og + 1u == (tg + 1u) * nx) xb_add(&bar[XB_TOPGEN], 1u);
            else XB_SPIN(xb_ld(&bar[XB_TOPGEN]) == tg, bar);
            __builtin_amdgcn_fence(__ATOMIC_ACQUIRE, "agent");
            xb_add(&bar[XB_XGEN(b.x)], 1u);
            asm volatile("s_waitcnt vmcnt(0)" ::: "memory");
        } else {
            XB_SPIN(xb_ld(&bar[XB_XGEN(b.x)]) == gen, bar);
            __builtin_amdgcn_fence(__ATOMIC_ACQUIRE, "agent");
            asm volatile("s_waitcnt vmcnt(0)" ::: "memory");
        }
    }
    __syncthreads();
}
typedef float f32x16 __attribute__((ext_vector_type(16)));
struct Frame {
    LAS unsigned char* lds; int tid, lane, wave, vcu, G;
};
__device__ __forceinline__ Frame make_frame(LAS unsigned char* lds) {
    Frame F; F.lds = lds; int t = threadIdx.x; asm volatile("" : "+v"(t)); int bx = blockIdx.x; asm volatile("" : "+s"(bx));
    F.tid = t; F.lane = t & 63; F.wave = __builtin_amdgcn_readfirstlane(t >> 6); F.G = gridDim.x;
    F.vcu = (F.G % 8 == 0) ? (bx % 8) * (F.G / 8) + bx / 8 : bx; return F;
}
__device__ __forceinline__ float bf2f(unsigned short h) { return __builtin_bit_cast(float, (unsigned)h << 16); }
__device__ __forceinline__ unsigned short f2bf16(float f) { return (unsigned short)f2bf(f); }
__device__ __forceinline__ float wave_sum(float v) {
#pragma unroll
    for (int o = 1; o < 64; o <<= 1) v += __shfl_xor(v, o);
    return v;
}
__device__ __forceinline__ int crow32(int r, int hi) { return (r & 3) + 8 * (r >> 2) + 4 * hi; }
template <int KSTEPS> __device__ __forceinline__ void mfma_lds(f32x16& acc, const LAS bf16* A, int pa, const LAS bf16* Bt, int pb, int r32, int hi) {
#pragma unroll
    for (int s = 0; s < KSTEPS; ++s) {
        const bf16x8 a = *(const LAS bf16x8*)(A + r32 * pa + s * 16 + hi * 8);
        const bf16x8 b = *(const LAS bf16x8*)(Bt + r32 * pb + s * 16 + hi * 8);
        acc = __builtin_amdgcn_mfma_f32_32x32x16_bf16(a, b, acc, 0, 0, 0);
    }
}
struct MapId  { __device__ __forceinline__ bool valid(int) const { return true; } __device__ __forceinline__ int src(int n) const { return n; } __device__ __forceinline__ float scale(int) const { return 1.f; } };
struct MapIn  { __device__ __forceinline__ bool valid(int n) const { return n < INW; }
                __device__ __forceinline__ int src(int n) const { return (n >= C_KR && n < C_RV) ? (n & ~63) + ((n & 63) >> 1) + 32 * (n & 1) : n; }
                __device__ __forceinline__ float scale(int n) const { return (n >= C_RQ && n < C_RK) ? 0.125f : 1.f; } };
struct MapQ   { __device__ __forceinline__ bool valid(int) const { return true; }
                __device__ __forceinline__ int src(int n) const { return ((n % 192) >= 128) ? (n & ~63) + ((n & 63) >> 1) + 32 * (n & 1) : n; }
                __device__ __forceinline__ float scale(int) const { return 1.f; } };
template <class Map> __device__ __forceinline__ void cvt_item(const float* __restrict__ W, int K, int N, bf16* __restrict__ WT, const float* __restrict__ kgain, const Map mp, LAS float* scr, int item, int nblk, int lane) {
    const int kb = item / nblk, nb = item % nblk, k0 = 64 * kb, n0 = 32 * nb;
    const int nd = n0 + (lane & 31); const bool ok = mp.valid(nd); const int sc = ok ? mp.src(nd) : 0; const float cs = mp.scale(nd);
#pragma unroll 8
    for (int i = 0; i < 32; ++i) { const int kk = 2 * i + (lane >> 5); float v = ok ? W[(size_t)(k0 + kk) * N + sc] : 0.f; if (kgain) v *= kgain[k0 + kk]; scr[kk * 33 + (lane & 31)] = v * cs; }
    LDS_WAIT(); asm volatile("" ::: "memory");
    const int c = lane & 7;
#pragma unroll
    for (int j = 0; j < 4; ++j) { const int n = (lane >> 3) + 8 * j; const LAS float* s = scr + (8 * c) * 33 + n;
        v4u o; o.x = pk2(s[0 * 33], s[1 * 33]); o.y = pk2(s[2 * 33], s[3 * 33]); o.z = pk2(s[4 * 33], s[5 * 33]); o.w = pk2(s[6 * 33], s[7 * 33]);
        *(GAS v4u*)(WT + (size_t)(n0 + n) * K + k0 + 8 * c) = o; }
    LDS_WAIT(); asm volatile("" ::: "memory");
}
__device__ __forceinline__ void rms_row_to_bf16(const float* __restrict__ xrow, const float* __restrict__ g, bf16* __restrict__ orow, int lane) {
    f32x4 v[16]; float s = 0.f;
#pragma unroll
    for (int j = 0; j < 8; ++j) { const f32x4* p = (const f32x4*)(xrow + 8 * (lane + 64 * j)); v[2 * j] = p[0]; v[2 * j + 1] = p[1]; }
#pragma unroll
    for (int j = 0; j < 16; ++j) s += (v[j][0] * v[j][0] + v[j][1] * v[j][1]) + (v[j][2] * v[j][2] + v[j][3] * v[j][3]);
    const float r = 1.0f / sqrtf(wave_sum(s) * (1.0f / 4096.0f) + EPS);
#pragma unroll
    for (int j = 0; j < 8; ++j) { const f32x4* gp = (const f32x4*)(g + 8 * (lane + 64 * j)); const f32x4 g0 = gp[0], g1 = gp[1]; const f32x4 a = v[2 * j] * r * g0, b = v[2 * j + 1] * r * g1;
        v4u o; o.x = pk2(a[0], a[1]); o.y = pk2(a[2], a[3]); o.z = pk2(b[0], b[1]); o.w = pk2(b[2], b[3]);
        *(v4u*)(orow + 8 * (lane + 64 * j)) = o; }
}
__device__ __forceinline__ void residual_row(const float* xin, const bf16* __restrict__ yrow, const float* __restrict__ gpost, float* xout, const float* __restrict__ gnext, bf16* __restrict__ hrow, int lane) {
    f32x4 v[16]; float y[64]; float s = 0.f;
#pragma unroll
    for (int j = 0; j < 8; ++j) { const f32x4* p = (const f32x4*)(xin + 8 * (lane + 64 * j)); v[2 * j] = p[0]; v[2 * j + 1] = p[1];
        const v4u q = *(const v4u*)(yrow + 8 * (lane + 64 * j));
        y[8 * j + 0] = __builtin_bit_cast(float, q.x << 16); y[8 * j + 1] = __builtin_bit_cast(float, q.x & 0xffff0000u); y[8 * j + 2] = __builtin_bit_cast(float, q.y << 16); y[8 * j + 3] = __builtin_bit_cast(float, q.y & 0xffff0000u);
        y[8 * j + 4] = __builtin_bit_cast(float, q.z << 16); y[8 * j + 5] = __builtin_bit_cast(float, q.z & 0xffff0000u); y[8 * j + 6] = __builtin_bit_cast(float, q.w << 16); y[8 * j + 7] = __builtin_bit_cast(float, q.w & 0xffff0000u); }
#pragma unroll
    for (int i = 0; i < 64; ++i) s += y[i] * y[i];
    const float r = 1.0f / sqrtf(wave_sum(s) * (1.0f / 4096.0f) + EPS);
    float s2 = 0.f;
#pragma unroll
    for (int j = 0; j < 8; ++j) { const f32x4* gp = (const f32x4*)(gpost + 8 * (lane + 64 * j)); const f32x4 g0 = gp[0], g1 = gp[1];
        f32x4 a = v[2 * j], b = v[2 * j + 1];
#pragma unroll
        for (int e = 0; e < 4; ++e) { a[e] += y[8 * j + e] * r * g0[e]; b[e] += y[8 * j + 4 + e] * r * g1[e]; }
        v[2 * j] = a; v[2 * j + 1] = b;
        f32x4* op = (f32x4*)(xout + 8 * (lane + 64 * j)); op[0] = a; op[1] = b;
        s2 += (a[0] * a[0] + a[1] * a[1]) + (a[2] * a[2] + a[3] * a[3]) + (b[0] * b[0] + b[1] * b[1]) + (b[2] * b[2] + b[3] * b[3]); }
    if (gnext) {
        const float r2 = 1.0f / sqrtf(wave_sum(s2) * (1.0f / 4096.0f) + EPS);
#pragma unroll
        for (int j = 0; j < 8; ++j) { const f32x4* gp = (const f32x4*)(gnext + 8 * (lane + 64 * j)); const f32x4 g0 = gp[0], g1 = gp[1]; const f32x4 a = v[2 * j] * r2 * g0, b = v[2 * j + 1] * r2 * g1;
            v4u o; o.x = pk2(a[0], a[1]); o.y = pk2(a[2], a[3]); o.z = pk2(b[0], b[1]); o.w = pk2(b[2], b[3]);
            *(v4u*)(hrow + 8 * (lane + 64 * j)) = o; }
    }
}
__device__ __forceinline__ float ret_lg(int h) { return log1pf(-exp2f(-5.0f - (float)h)); }
__device__ __forceinline__ void sgu_phase(LAS unsigned char* lds_, const bf16* __restrict__ PROJ, bf16* __restrict__ CAT, const bf16* __restrict__ SGW, const float* __restrict__ lng, const float* __restrict__ lnb, const float* __restrict__ bs) {
    const Frame F = make_frame(lds_);
    LAS bf16* Wm = (LAS bf16*)(F.lds + RING_OFF);
    LAS bf16* VT = Wm + 128 * 136;
    const int r32 = F.lane & 31, hi = F.lane >> 5;
    for (int unit = F.vcu; unit < 512; unit += F.G) {
        const int b = unit >> 8, n = (unit >> 3) & 31, g = unit & 7;
        const size_t R0 = (size_t)b * SEQ + (size_t)n * 128; const int cb = g * 128;
        for (int q = F.tid; q < 128 * 16; q += NWAVES * 64) { const int i = q >> 4, ch = q & 15;
            *(LAS bf16x8*)(Wm + i * 136 + ch * 8) = *(const bf16x8*)(SGW + ((size_t)g * 128 + i) * 128 + ch * 8); }
        const float g0 = lng[cb + 2 * F.lane], g1 = lng[cb + 2 * F.lane + 1], b0 = lnb[cb + 2 * F.lane], b1 = lnb[cb + 2 * F.lane + 1];
        for (int jj = 0; jj < 16; ++jj) { const int j = F.wave * 16 + jj;
            const unsigned pv = *(const unsigned*)(PROJ + (R0 + j) * INP + C_V + cb + 2 * F.lane);
            const float x0 = __builtin_bit_cast(float, pv << 16), x1 = __builtin_bit_cast(float, pv & 0xffff0000u);
            const float mu = wave_sum(x0 + x1) * (1.0f / 128.0f), d0 = x0 - mu, d1 = x1 - mu;
            const float rstd = 1.0f / sqrtf(wave_sum(d0 * d0 + d1 * d1) * (1.0f / 128.0f) + EPS);
            VT[(2 * F.lane) * 136 + j] = f2bf16(d0 * rstd * g0 + b0); VT[(2 * F.lane + 1) * 136 + j] = f2bf16(d1 * rstd * g1 + b1); }
        __syncthreads();
        const int ib = F.wave >> 1, cb0 = (F.wave & 1) * 2;
        f32x16 acc0 = {}, acc1 = {};
        mfma_lds<8>(acc0, Wm + ib * 32 * 136, 136, VT + (cb0 * 32) * 136, 136, r32, hi);
        mfma_lds<8>(acc1, Wm + ib * 32 * 136, 136, VT + ((cb0 + 1) * 32) * 136, 136, r32, hi);
#pragma unroll
        for (int r = 0; r < 16; ++r) { const int i = ib * 32 + crow32(r, hi); const float bias = bs[g * 128 + i]; const size_t row = R0 + i; const int c = cb0 * 32 + r32;
            const float u0 = bf2f(PROJ[row * INP + C_U + cb + c]), u1 = bf2f(PROJ[row * INP + C_U + cb + c + 32]);
            CAT[row * DM + cb + c] = f2bf16(u0 * (acc0[r] + bias)); CAT[row * DM + cb + c + 32] = f2bf16(u1 * (acc1[r] + bias)); }
        __syncthreads();
    }
}
__device__ __forceinline__ void ret1_phase(LAS unsigned char* lds_, const bf16* __restrict__ PROJ, float* __restrict__ KVS) {
    const Frame F = make_frame(lds_);
    LAS bf16* KT = (LAS bf16*)(F.lds + RING_OFF);
    LAS bf16* VT = KT + 64 * 72;
    const int r32 = F.lane & 31, hi = F.lane >> 5;
    for (int unit = F.vcu; unit < 1024; unit += F.G) {
        const int bh = unit >> 6, c = unit & 63, b = bh >> 3, h = bh & 7; const float lg = ret_lg(h);
        const size_t R0 = (size_t)b * SEQ + (size_t)c * 64;
        const int m = F.tid >> 3, d0 = (F.tid & 7) * 8, e0 = (F.tid & 7) * 16; const float kd = expf(lg * (float)(63 - m));
        const bf16x8 kv = *(const bf16x8*)(PROJ + (R0 + m) * INP + C_RK + h * 64 + d0);
        const bf16x8 va = *(const bf16x8*)(PROJ + (R0 + m) * INP + C_RV + h * 128 + e0), vb = *(const bf16x8*)(PROJ + (R0 + m) * INP + C_RV + h * 128 + e0 + 8);
#pragma unroll
        for (int i = 0; i < 8; ++i) KT[(d0 + i) * 72 + m] = f2bf16(bf2f((unsigned short)kv[i]) * kd);
#pragma unroll
        for (int i = 0; i < 8; ++i) { VT[(e0 + i) * 72 + m] = (unsigned short)va[i]; VT[(e0 + 8 + i) * 72 + m] = (unsigned short)vb[i]; }
        __syncthreads();
        const int eb = F.wave >> 1, db = F.wave & 1;
        f32x16 acc = {};
        mfma_lds<4>(acc, VT + eb * 32 * 72, 72, KT + db * 32 * 72, 72, r32, hi);
#pragma unroll
        for (int r = 0; r < 16; ++r) KVS[((size_t)unit * 128 + eb * 32 + crow32(r, hi)) * 64 + db * 32 + r32] = acc[r];
        __syncthreads();
    }
}
__device__ __forceinline__ void ret2_phase(LAS unsigned char* lds_, const float* __restrict__ KVS, bf16* __restrict__ SB) {
    const Frame F = make_frame(lds_);
    for (int gid = F.vcu * (NWAVES * 64) + F.tid; gid < 16 * 8192; gid += F.G * NWAVES * 64) {
        const int bh = gid >> 13, idx = gid & 8191; const float cd = expf(ret_lg(bh & 7) * 64.0f);
        float S = 0.f;
#pragma unroll 8
        for (int c = 0; c < 64; ++c) { const size_t o = ((size_t)bh * 64 + c) * 8192 + idx; SB[o] = f2bf16(S); S = cd * S + KVS[o]; }
    }
}
__device__ __forceinline__ void ret3_phase(LAS unsigned char* lds_, const bf16* __restrict__ PROJ, const bf16* __restrict__ SB, bf16* __restrict__ CAT) {
    const Frame F = make_frame(lds_);
    LAS bf16* Qs = (LAS bf16*)(F.lds + RING_OFF);
    LAS bf16* Ks = Qs + 64 * 72;
    LAS bf16* VT = Ks + 64 * 72;
    LAS bf16* Ss = VT + 128 * 72;
    LAS bf16* Ps = Ss + 128 * 72;
    LAS float* red = (LAS float*)(Ps + 64 * 72);
    const int r32 = F.lane & 31, hi = F.lane >> 5;
    for (int unit = F.vcu; unit < 1024; unit += F.G) {
        const int bh = unit >> 6, c = unit & 63, b = bh >> 3, h = bh & 7; const float lg = ret_lg(h);
        const size_t R0 = (size_t)b * SEQ + (size_t)c * 64;
        { const int m = F.tid >> 3, d0 = (F.tid & 7) * 8, e0 = (F.tid & 7) * 16;
          *(LAS bf16x8*)(Qs + m * 72 + d0) = *(const bf16x8*)(PROJ + (R0 + m) * INP + C_RQ + h * 64 + d0);
          *(LAS bf16x8*)(Ks + m * 72 + d0) = *(const bf16x8*)(PROJ + (R0 + m) * INP + C_RK + h * 64 + d0);
          const bf16x8 va = *(const bf16x8*)(PROJ + (R0 + m) * INP + C_RV + h * 128 + e0), vb = *(const bf16x8*)(PROJ + (R0 + m) * INP + C_RV + h * 128 + e0 + 8);
#pragma unroll
          for (int i = 0; i < 8; ++i) { VT[(e0 + i) * 72 + m] = (unsigned short)va[i]; VT[(e0 + 8 + i) * 72 + m] = (unsigned short)vb[i]; }
#pragma unroll
          for (int k = 0; k < 2; ++k) { const int q = F.tid + k * 512, e = q >> 3, dd = (q & 7) * 8; *(LAS bf16x8*)(Ss + e * 72 + dd) = *(const bf16x8*)(SB + (size_t)unit * 8192 + e * 64 + dd); } }
        __syncthreads();
        const int lb = F.wave & 1, eb = F.wave >> 1;
        f32x16 cross = {};
        mfma_lds<4>(cross, Qs + lb * 32 * 72, 72, Ss + eb * 32 * 72, 72, r32, hi);
        if (F.wave < 4) { const int mb = F.wave >> 1; f32x16 sc = {};
            mfma_lds<4>(sc, Qs + lb * 32 * 72, 72, Ks + mb * 32 * 72, 72, r32, hi);
#pragma unroll
            for (int r = 0; r < 16; ++r) { const int l = lb * 32 + crow32(r, hi), mm = mb * 32 + r32; const int ad = l > mm ? l - mm : mm - l;
                Ps[l * 72 + mm] = f2bf16(sc[r] * expf(lg * (float)ad)); } }
        __syncthreads();
        f32x16 o = {};
        mfma_lds<4>(o, Ps + lb * 32 * 72, 72, VT + eb * 32 * 72, 72, r32, hi);
#pragma unroll
        for (int r = 0; r < 16; ++r) { const int l = lb * 32 + crow32(r, hi); o[r] += cross[r] * expf(lg * (float)(l + 1));
            float s = o[r] * o[r];
#pragma unroll
            for (int x = 1; x < 32; x <<= 1) s += __shfl_xor(s, x);
            if (r32 == 0) red[l * 4 + eb] = s; }
        __syncthreads();
#pragma unroll
        for (int r = 0; r < 16; ++r) { const int l = lb * 32 + crow32(r, hi); const f32x4 t = *(const LAS f32x4*)(red + l * 4);
            const float rn = 1.0f / sqrtf(((t[0] + t[1]) + (t[2] + t[3])) * (1.0f / 128.0f) + EPS); const int e = eb * 32 + r32;
            const float gt = bf2f(PROJ[(R0 + l) * INP + C_RG + h * 128 + e]); const float sg = gt / (1.0f + expf(-gt));
            CAT[(R0 + l) * DM + 3072 + h * 128 + e] = f2bf16(sg * (o[r] * rn)); }
        __syncthreads();
    }
}
struct Args { const float* in[17]; float* out; unsigned char* ws; };
typedef const Args __attribute__((address_space(4))) CArgs;
__device__ __forceinline__ CArgs* fresh_args() { CArgs* p = (CArgs*)__builtin_amdgcn_kernarg_segment_ptr(); asm volatile("" : "+s"(p)); return p; }
__device__ __forceinline__ void prologue_phase(LAS unsigned char* lds_) {
    const Frame F = make_frame(lds_); CArgs* A = fresh_args(); unsigned char* ws = A->ws; float* rope = (float*)(ws + WS_ROPE); bf16* H = (bf16*)(ws + WS_H);
    const int gw = F.vcu * NWAVES + F.wave, NGW = F.G * NWAVES;
        LAS float* scr = (LAS float*)(F.lds + RING_OFF + F.wave * 16384);
        constexpr int I_IN = (DM / 64) * (INP / 32), I_Q = (1024 / 64) * (QW / 32), I_KV = (512 / 64) * (KVW / 32), I_OUT = (DM / 64) * (DM / 32), I_UP = (DM / 64) * (FF / 32), I_DN = (FF / 64) * (DM / 32);
        constexpr int I_L = I_IN + I_Q + I_KV + I_OUT + I_UP + I_DN;
        for (int it = gw; it < DEPTH * I_L; it += NGW) {
            const int l = it / I_L; int r = it % I_L; unsigned char* wl = ws + WS_W + (size_t)l * LW;
            if (r < I_IN) { cvt_item(A->in[5] + (size_t)l * DM * INW, DM, INW, (bf16*)(wl + W_IN), nullptr, MapIn{}, scr, r, INP / 32, F.lane); continue; } r -= I_IN;
            if (r < I_Q) { cvt_item(A->in[11] + (size_t)l * 1024 * QW, 1024, QW, (bf16*)(wl + W_Q), A->in[10] + l * 1024, MapQ{}, scr, r, QW / 32, F.lane); continue; } r -= I_Q;
            if (r < I_KV) { cvt_item(A->in[13] + (size_t)l * 512 * KVW, 512, KVW, (bf16*)(wl + W_KV), A->in[12] + l * 512, MapId{}, scr, r, KVW / 32, F.lane); continue; } r -= I_KV;
            if (r < I_OUT) { cvt_item(A->in[14] + (size_t)l * DM * DM, DM, DM, (bf16*)(wl + W_OUT), nullptr, MapId{}, scr, r, DM / 32, F.lane); continue; } r -= I_OUT;
            if (r < I_UP) { cvt_item(A->in[15] + (size_t)l * DM * FF, DM, FF, (bf16*)(wl + W_UP), nullptr, MapId{}, scr, r, FF / 32, F.lane); continue; } r -= I_UP;
            cvt_item(A->in[16] + (size_t)l * FF * DM, FF, DM, (bf16*)(wl + W_DOWN), nullptr, MapId{}, scr, r, DM / 32, F.lane);
        }
        for (int i = F.vcu * (NWAVES * 64) + F.tid; i < DEPTH * 8 * 128 * 128; i += F.G * NWAVES * 64) {
            const int l = i >> 17, r = i & 131071, ii = (r >> 7) & 127, jj = r & 127;
            ((bf16*)(ws + WS_W + (size_t)l * LW + W_SGU))[r] = ((jj >> 6) <= (ii >> 6)) ? f2bf16(A->in[8][i]) : (bf16)0; }
        for (int i = F.vcu * (NWAVES * 64) + F.tid; i < SEQ * 32; i += F.G * NWAVES * 64) {
            const int pos = i >> 5, j = i & 31; const float inv = (float)pow(10000.0, -(double)j / 32.0); const float ang = (float)pos * inv;
            float sn, cs; sincosf(ang, &sn, &cs); rope[2 * i] = cs; rope[2 * i + 1] = sn; }
        for (int m = gw; m < M; m += NGW) rms_row_to_bf16(A->in[0] + (size_t)m * DM, A->in[1], H + (size_t)m * DM, F.lane);
}
__device__ __forceinline__ void residual_phase(LAS unsigned char* lds_, int l, int which) {
    const Frame F = make_frame(lds_); CArgs* A = fresh_args(); unsigned char* ws = A->ws; const int gw = F.vcu * NWAVES + F.wave, NGW = F.G * NWAVES;
    const float* xin = (which == 0 && l == 0) ? A->in[0] : A->out; float* xout = A->out; const bf16* Y = (const bf16*)(ws + WS_MIX); bf16* Hn = (bf16*)(ws + WS_H);
    const float* gpost = (which == 0 ? A->in[2] : A->in[4]) + l * DM;
    const float* gnext = which == 0 ? A->in[3] + l * DM : ((l + 1 < DEPTH) ? A->in[1] + (l + 1) * DM : nullptr);
    for (int m = gw; m < M; m += NGW) residual_row(xin + (size_t)m * DM, Y + (size_t)m * DM, gpost, xout + (size_t)m * DM, gnext, Hn + (size_t)m * DM, F.lane);
}
__device__ __forceinline__ void attn_phase(LAS unsigned char* lds_) {
    const Frame F = make_frame(lds_); CArgs* A = fresh_args(); unsigned char* ws = A->ws;
    const bf16* QB = (const bf16*)(ws + WS_Q); const bf16* KVB = (const bf16*)(ws + WS_KV); const bf16* PROJ = (const bf16*)(ws + WS_PROJ); bf16* CAT = (bf16*)(ws + WS_CAT);
    for (int p2 = 2 * F.vcu; p2 < 512; p2 += 2 * F.G)
        for (int k = 0; k < 2; ++k) { const int p = p2 >> 1, bh = p >> 3, s = p & 7;
            att::attn_unit(QB, KVB, PROJ, CAT, bh >> 4, bh & 15, k ? 15 - s : s, (ATT_LAS char*)(F.lds + RING_OFF)); }
}
template <int WHICH> __device__ __forceinline__ void gemm_call(LAS unsigned char* lds_, int l) {
    CArgs* A = fresh_args(); unsigned char* ws = A->ws; unsigned char* wl = ws + WS_W + (size_t)l * LW; int bx = blockIdx.x; asm volatile("" : "+s"(bx)); const int G = gridDim.x;
    float* rope = (float*)(ws + WS_ROPE); float* ssq = (float*)(ws + WS_SSQ);
    bf16* H = (bf16*)(ws + WS_H); bf16* PROJ = (bf16*)(ws + WS_PROJ); bf16* QB = (bf16*)(ws + WS_Q); bf16* KVB = (bf16*)(ws + WS_KV);
    bf16* CAT = (bf16*)(ws + WS_CAT); bf16* MIX = (bf16*)(ws + WS_MIX); bf16* ACT = (bf16*)(ws + WS_ACT);
    pg8::StaticOrder S;
    if constexpr (WHICH == 0) { pg8::Gemm g{H, (const bf16*)(wl + W_IN), M, INP, DM, DM}; S.init(M, INP, G, bx); pg8::Epi<2> E{PROJ, INP, rope, ssq};
        pg8::gemm_phase<pg8::Epi<2>, pg8::StaticOrder, true, true>(lds_ + RING_OFF, g, S, E); }
    if constexpr (WHICH == 1) { pg8::Gemm g{PROJ + C_CQ, (const bf16*)(wl + W_Q), M, QW, 1024, INP}; S.init(M, QW, G, bx); pg8::Epi<3> E{QB, QW, rope, ssq};
        pg8::gemm_phase<pg8::Epi<3>, pg8::StaticOrder, true, true>(lds_ + RING_OFF, g, S, E); }
    if constexpr (WHICH == 2) { pg8::Gemm g{PROJ + C_CKV, (const bf16*)(wl + W_KV), M, KVW, 512, INP}; S.init(M, KVW, G, bx); pg8::Epi<4> E{KVB, KVW, rope, ssq};
        pg8::gemm_phase<pg8::Epi<4>, pg8::StaticOrder, true, true>(lds_ + RING_OFF, g, S, E); }
    if constexpr (WHICH == 3) { pg8::Gemm g{CAT, (const bf16*)(wl + W_OUT), M, DM, DM, DM}; S.init(M, DM, G, bx); pg8::Epi<0> E{MIX, DM, rope, ssq};
        pg8::gemm_phase<pg8::Epi<0>, pg8::StaticOrder, true, true>(lds_ + RING_OFF, g, S, E); }
    if constexpr (WHICH == 4) { pg8::Gemm g{H, (const bf16*)(wl + W_UP), M, FF, DM, DM}; S.init(M, FF, G, bx); pg8::Epi<1> E{ACT, FF, rope, ssq};
        pg8::gemm_phase<pg8::Epi<1>, pg8::StaticOrder, true, true>(lds_ + RING_OFF, g, S, E); }
    if constexpr (WHICH == 5) { pg8::Gemm g{ACT, (const bf16*)(wl + W_DOWN), M, DM, FF, FF}; S.init(M, DM, G, bx); pg8::Epi<0> E{MIX, DM, rope, ssq};
        pg8::gemm_phase<pg8::Epi<0>, pg8::StaticOrder, true, true>(lds_ + RING_OFF, g, S, E); }
}
__device__ __forceinline__ void mixer_small_phases(LAS unsigned char* lds_, int l) {
    CArgs* A = fresh_args(); unsigned char* ws = A->ws;
    sgu_phase(lds_, (const bf16*)(ws + WS_PROJ), (bf16*)(ws + WS_CAT), (const bf16*)(ws + WS_W + (size_t)l * LW + W_SGU), A->in[6] + l * 1024, A->in[7] + l * 1024, A->in[9] + l * 1024);
    CArgs* A2 = fresh_args(); unsigned char* ws2 = A2->ws;
    ret1_phase(lds_, (const bf16*)(ws2 + WS_PROJ), (float*)(ws2 + WS_KVS));
}
__global__ void __launch_bounds__(NWAVES * 64, 2) mega_fwd(Args args) {
    extern __shared__ __attribute__((aligned(16))) unsigned char lds[];
    LAS unsigned char* L = (LAS unsigned char*)lds;
    volatile LAS unsigned* MISC = (volatile LAS unsigned*)(L + MISC_OFF);
    for (int u = threadIdx.x; u < (LDS_BYTES - LDSCTL_OFF) / 4; u += NWAVES * 64) ((LAS unsigned*)(L + LDSCTL_OFF))[u] = 0u;
    __syncthreads();
    XcdBarrier bar = xcd_barrier_post((unsigned*)(args.ws + WS_CTL) + CW_BAR, MISC + 8);
#define GRID_BAR() do { XcdBarrier b_ = bar; asm volatile("" : "+s"(b_.bar), "+s"(b_.x)); xcd_barrier(b_); } while (0)
    prologue_phase(L);
    GRID_BAR();
    for (int l = 0; l < DEPTH; ++l) {
        gemm_call<0>(L, l);
        GRID_BAR();
        gemm_call<1>(L, l); gemm_call<2>(L, l);
        mixer_small_phases(L, l);
        GRID_BAR();
        { CArgs* A = fresh_args(); unsigned char* ws = A->ws; ret2_phase(L, (const float*)(ws + WS_KVS), (bf16*)(ws + WS_SB)); }
        attn_phase(L);
        GRID_BAR();
        { CArgs* A = fresh_args(); unsigned char* ws = A->ws; ret3_phase(L, (const bf16*)(ws + WS_PROJ), (const bf16*)(ws + WS_SB), (bf16*)(ws + WS_CAT)); }
        GRID_BAR();
        gemm_call<3>(L, l);
        GRID_BAR();
        residual_phase(L, l, 0);
        GRID_BAR();
        gemm_call<4>(L, l);
        GRID_BAR();
        gemm_call<5>(L, l);
        GRID_BAR();
        residual_phase(L, l, 1);
        if (l + 1 < DEPTH) GRID_BAR();
    }
}

extern "C" void kernel_launch(void* const* d_in, const int* in_sizes, int n_in, void* d_out, int out_size, void* d_ws, size_t ws_size, hipStream_t stream) {
    static int grid = 0;
    if (grid == 0) {
        if (n_in != 17 || in_sizes[0] != M * DM || out_size != M * DM || ws_size < WS_END) { fprintf(stderr, "kernel_launch: shape mismatch (n_in %d, in0 %d, out %d, ws %zu < %zu)\n", n_in, n_in > 0 ? in_sizes[0] : -1, out_size, ws_size, (size_t)WS_END); grid = -1; return; }
        int dev = 0, cus = 0, per_cu = 0;
        if (hipGetDevice(&dev) != hipSuccess || hipDeviceGetAttribute(&cus, hipDeviceAttributeMultiprocessorCount, dev) != hipSuccess) { grid = -1; return; }
        if (hipFuncSetAttribute((const void*)mega_fwd, hipFuncAttributeMaxDynamicSharedMemorySize, LDS_BYTES) != hipSuccess) { fprintf(stderr, "kernel_launch: hipFuncSetAttribute failed\n"); grid = -1; return; }
        if (hipOccupancyMaxActiveBlocksPerMultiprocessor(&per_cu, (const void*)mega_fwd, NWAVES * 64, LDS_BYTES) != hipSuccess || per_cu < 1)
            fprintf(stderr, "kernel_launch: note: occupancy query reports %d workgroups per CU\n", per_cu);
        (void)hipGetLastError();
        grid = cus;
    }
    if (grid < 0) return;
    if (hipMemsetAsync((char*)d_ws + WS_CTL, 0, CTL_ZERO_BYTES, stream) != hipSuccess) { fprintf(stderr, "kernel_launch: memset failed\n"); return; }
    Args a{};
    for (int i = 0; i < 17; ++i) a.in[i] = (const float*)d_in[i];
    a.out = (float*)d_out; a.ws = (unsigned char*)d_ws;
    hipLaunchKernelGGL(mega_fwd, dim3(grid), dim3(NWAVES * 64), LDS_BYTES, stream, a);
    const hipError_t le = hipPeekAtLastError();
    if (le != hipSuccess) fprintf(stderr, "kernel_launch: launch failed: %s\n", hipGetErrorName(le));
}
```

```cpp
#include <hip/hip_runtime.h>
#include <cstdio>
#include <cstdint>
namespace pg8 {
#define PG8_LAS __attribute__((address_space(3)))
typedef unsigned short bf16_t;
typedef short bf16x8 __attribute__((ext_vector_type(8)));
typedef float f32x4 __attribute__((ext_vector_type(4)));
typedef unsigned u32x4 __attribute__((ext_vector_type(4)));
constexpr int BM = 256, BK = 64, HALF = 128, HTB = HALF * BK * 2  , STAGE_BYTES = 8 * HTB, NXCD = 8, WGM = 8;

__host__ __device__ __forceinline__ int lds_byte(int r, int c) { const int st = (r >> 4) * 2 + (c >> 5), rr = r & 15, cc = c & 31, ob = rr * 64 + cc * 2; return st * 1024 + (ob ^ (((ob >> 9) & 1) << 5)); }
__host__ __device__ __forceinline__ void stage_rc(int b, int& R, int& C) { const int st = b / 1024, sb = b % 1024, swz = sb ^ (((sb >> 9) & 1) << 5); R = (st >> 1) * 16 + swz / 64; C = (st & 1) * 32 + (swz % 64) / 2; }
__host__ __device__ __forceinline__ int perm32(int rho) { const int n = rho >> 4, i = rho & 15; return 8 * (i >> 2) + 4 * n + (i & 3); }

struct Unit { int pm, pn; };
struct Gemm { const bf16_t* A; const bf16_t* Bt; int M, N, K, lda; };

struct StaticOrder {
    int nM, nN, nwg, G, c;
    __host__ __device__ void init(int M, int N, int G_, int c_) { nM = M / BM; nN = N / BM; nwg = nM * nN; G = G_; c = c_; }
    __host__ __device__ bool next(int i, Unit& u) const {
        const long L = (long)i * G + c; if (L >= nwg) return false;
        int wgid = (int)L; { const int q = nwg / NXCD, r = nwg % NXCD, xcd = wgid % NXCD, off = wgid / NXCD; wgid = (xcd < r ? xcd * (q + 1) : r * (q + 1) + (xcd - r) * q) + off; }
        const int nig = WGM * nN, gid = wgid / nig, fm = gid * WGM, gsz = (nM - fm) < WGM ? (nM - fm) : WGM;
        u.pm = fm + ((wgid % nig) % gsz); u.pn = (wgid % nig) / gsz; return true;
    }
    __device__ __forceinline__ void a_ready(const Unit&) const {}
    __device__ __forceinline__ void done(const Unit&) const {}
};
__device__ __forceinline__ unsigned cvt_pk_bf16(float lo, float hi) { unsigned r; asm volatile("v_cvt_pk_bf16_f32 %0, %1, %2" : "=v"(r) : "v"(lo), "v"(hi)); return r; }
__device__ __forceinline__ void rope8(f32x4& v0, f32x4& v1, const float* tab) {
    const f32x4 t0 = *(const f32x4*)tab, t1 = *(const f32x4*)(tab + 4);
    f32x4 a, b;
    a[0] = v0[0] * t0[0] - v0[1] * t0[1]; a[1] = v0[0] * t0[1] + v0[1] * t0[0];
    a[2] = v0[2] * t0[2] - v0[3] * t0[3]; a[3] = v0[2] * t0[3] + v0[3] * t0[2];
    b[0] = v1[0] * t1[0] - v1[1] * t1[1]; b[1] = v1[0] * t1[1] + v1[1] * t1[0];
    b[2] = v1[2] * t1[2] - v1[3] * t1[3]; b[3] = v1[2] * t1[3] + v1[3] * t1[2];
    v0 = a; v1 = b;
}
template <int MODE> struct Epi {
    static constexpr bool PERM = true, AFTER_DRAIN = false;
    bf16_t* O; int ldc; const float* rope; float* ssq;
    __device__ __forceinline__ void operator()(const f32x4 (&acc)[2][2][4][2], const Unit& u, int wr, int wc, int fr, int fq) const {
        const int row0 = u.pm * BM + wr * 64 + fr, colt = u.pn * BM + wc * 32 + 8 * fq;
        const bool want_ss = (MODE == 2) && u.pn >= 8 && u.pn < 14;
#pragma unroll
        for (int ai = 0; ai < 2; ++ai)
#pragma unroll
            for (int m = 0; m < 4; ++m) {
                const int row = row0 + ai * HALF + m * 16;
                float rs = 1.f;
                if (MODE == 3) { const f32x4* s = (const f32x4*)(ssq + (size_t)row * 24); const f32x4 a = s[0], b = s[1], c = s[2], d = s[3];
                    const float t = ((a[0] + a[1]) + (a[2] + a[3])) + ((b[0] + b[1]) + (b[2] + b[3])) + ((c[0] + c[1]) + (c[2] + c[3])) + ((d[0] + d[1]) + (d[2] + d[3]));
                    rs = 1.0f / sqrtf(t * (1.0f / 1024.0f) + 1e-6f); }
                if (MODE == 4) { const f32x4* s = (const f32x4*)(ssq + (size_t)row * 24); const f32x4 a = s[4], b = s[5];
                    const float t = ((a[0] + a[1]) + (a[2] + a[3])) + ((b[0] + b[1]) + (b[2] + b[3]));
                    rs = 1.0f / sqrtf(t * (1.0f / 512.0f) + 1e-6f); }
                float part = 0.f;
#pragma unroll
                for (int bj = 0; bj < 2; ++bj) {
                    const int col = colt + bj * HALF;
                    f32x4 v0 = acc[ai][bj][m][0], v1 = acc[ai][bj][m][1];
                    if (MODE == 1) {
#pragma unroll
                        for (int j = 0; j < 4; ++j) { const float p = fmaxf(v0[j], 0.f), q = fmaxf(v1[j], 0.f); v0[j] = p * p; v1[j] = q * q; } }
                    if (MODE == 2) {
                        if (want_ss) part += ((v0[0] * v0[0] + v0[1] * v0[1]) + (v0[2] * v0[2] + v0[3] * v0[3])) + ((v1[0] * v1[0] + v1[1] * v1[1]) + (v1[2] * v1[2] + v1[3] * v1[3]));
                        if (col >= 3584 && col < 4672) rope8(v0, v1, rope + ((size_t)(row & 4095) * 32 + ((col & 63) >> 1)) * 2); }
                    if (MODE == 3) { v0 = v0 * rs; v1 = v1 * rs; if ((col % 192) >= 128) rope8(v0, v1, rope + ((size_t)(row & 4095) * 32 + ((col & 63) >> 1)) * 2); }
                    if (MODE == 4) { v0 = v0 * rs; v1 = v1 * rs; }
                    u32x4 w; w.x = cvt_pk_bf16(v0[0], v0[1]); w.y = cvt_pk_bf16(v0[2], v0[3]); w.z = cvt_pk_bf16(v1[0], v1[1]); w.w = cvt_pk_bf16(v1[2], v1[3]);
                    *(u32x4*)(O + (size_t)row * ldc + col) = w;
                }
                if (want_ss) { part += __shfl_xor(part, 16); part += __shfl_xor(part, 32); if (fq == 0) ssq[(size_t)row * 24 + (u.pn - 8) * 4 + wc] = part; }
            }
    }
};
template <class Epi, class Sched, bool ALIGN_EPI = false, bool SP2 = false>
__device__ __forceinline__ void gemm_phase(PG8_LAS unsigned char* lds, const Gemm g, const Sched& S, const Epi& E) {
    int tid_ = threadIdx.x; asm volatile("" : "+v"(tid_));
    const int tid = tid_, wid = __builtin_amdgcn_readfirstlane(tid >> 6), lane = tid & 63, wr = wid >> 2, wc = wid & 3, fr = lane & 15, fq = lane >> 4;
    const int K = g.K, nt = K / BK;
    unsigned voffA[2], voffB[2];
#pragma unroll
    for (int i = 0; i < 2; ++i) { int R, C; stage_rc(tid * 16 + i * 8192, R, C); const int Rb = Epi::PERM ? ((R & ~31) + perm32(R & 31)) : R;
        voffA[i] = (unsigned)(R * g.lda + C) * 2u; voffB[i] = (unsigned)(Rb * K + C) * 2u; }
    const size_t kstep = (size_t)(BK * 2);
    const size_t hstep = (size_t)HALF * K * 2;
    const size_t tstep = 2 * hstep; const size_t hstepA = (size_t)HALF * g.lda * 2, tstepA = 2 * hstepA;
    const unsigned ldsw = (unsigned)wid * 1024u;
    const int aoff = lds_byte(wr * 64 + fr, fq * 8), boff = lds_byte(wc * 32 + fr, fq * 8);
#define PG8_SA(b, h) (((b) * 2 + (h)) * HTB)
#define PG8_SB(b, h) ((4 + (b) * 2 + (h)) * HTB)
#define PG8_STAGE(bufoff, gbase, voff) do { _Pragma("unroll") for (int _i = 0; _i < 2; ++_i) \
        __builtin_amdgcn_global_load_lds((const unsigned*)((const char*)(gbase) + (voff)[_i]), (PG8_LAS unsigned*)(lds + (bufoff) + ldsw + _i * 8192), 16, 0, 0); } while (0)
#define PG8_LDA(dst, b, h) do { _Pragma("unroll") for (int m = 0; m < 4; ++m) _Pragma("unroll") for (int k = 0; k < 2; ++k) dst[m][k] = *(const PG8_LAS bf16x8*)(lds + PG8_SA(b, h) + aoff + m * 2048 + k * 1024); } while (0)
#define PG8_LDB(dst, b, h) do { _Pragma("unroll") for (int n = 0; n < 2; ++n) _Pragma("unroll") for (int k = 0; k < 2; ++k) dst[n][k] = *(const PG8_LAS bf16x8*)(lds + PG8_SB(b, h) + boff + n * 2048 + k * 1024); } while (0)
#define PG8_MMA(ai, bj, At, Bt) do { __builtin_amdgcn_s_setprio(1); _Pragma("unroll") for (int m = 0; m < 4; ++m) _Pragma("unroll") for (int n = 0; n < 2; ++n) _Pragma("unroll") for (int k = 0; k < 2; ++k) \
        acc[ai][bj][m][n] = __builtin_amdgcn_mfma_f32_16x16x32_bf16(Bt[n][k], At[m][k], acc[ai][bj][m][n], 0, 0, 0); __builtin_amdgcn_s_setprio(0); } while (0)
#define PG8_WAIT_V(n) asm volatile("s_waitcnt vmcnt(" #n ")" ::: "memory")
#define PG8_WAIT_L(n) asm volatile("s_waitcnt lgkmcnt(" #n ")" ::: "memory")
#define PG8_BAR __builtin_amdgcn_s_barrier()
#define PG8_SCHED __builtin_amdgcn_sched_barrier(0)
    Unit cur, nxt; int ui = 0;
    if (!S.next(0, cur)) return;
    f32x4 acc[2][2][4][2];
#pragma unroll
    for (int a = 0; a < 2; ++a)
#pragma unroll
        for (int b = 0; b < 2; ++b)
#pragma unroll
            for (int m = 0; m < 4; ++m)
#pragma unroll
                for (int n = 0; n < 2; ++n) acc[a][b][m][n] = (f32x4){0.f, 0.f, 0.f, 0.f};
    bf16x8 At[4][2], B0[2][2], B1[2][2];
    const char* cA = (const char*)g.A + (size_t)cur.pm * tstepA; const char* cB = (const char*)g.Bt + (size_t)cur.pn * tstep;
    S.a_ready(cur);
    if constexpr (SP2) {
        PG8_STAGE(PG8_SB(0, 0), cB, voffB); PG8_STAGE(PG8_SB(0, 1), cB + hstep, voffB); PG8_STAGE(PG8_SA(0, 0), cA, voffA); PG8_STAGE(PG8_SA(0, 1), cA + hstepA, voffA);
        if (wr == 1) PG8_BAR;
        PG8_WAIT_V(2); PG8_BAR;
        PG8_STAGE(PG8_SB(1, 0), cB + kstep, voffB); PG8_STAGE(PG8_SA(1, 0), cA + kstep, voffA); PG8_STAGE(PG8_SB(1, 1), cB + hstep + kstep, voffB);
        PG8_WAIT_V(6); PG8_BAR;
    } else {
        PG8_STAGE(PG8_SB(0, 0), cB, voffB); PG8_STAGE(PG8_SA(0, 0), cA, voffA); PG8_STAGE(PG8_SB(0, 1), cB + hstep, voffB); PG8_STAGE(PG8_SA(0, 1), cA + hstepA, voffA);
        if (wr == 1) PG8_BAR;
        PG8_WAIT_V(4); PG8_BAR;
        PG8_STAGE(PG8_SB(1, 0), cB + kstep, voffB); PG8_STAGE(PG8_SA(1, 0), cA + kstep, voffA); PG8_STAGE(PG8_SB(1, 1), cB + hstep + kstep, voffB);
        PG8_WAIT_V(6); PG8_BAR;
    }
    for (;;) {
        const bool has_next = S.next(ui + 1, nxt);
        const char* nA = has_next ? (const char*)g.A + (size_t)nxt.pm * tstepA : cA; const char* nB = has_next ? (const char*)g.Bt + (size_t)nxt.pn * tstep : cB;
        for (int t = 0; t < nt; t += 2) {
            const bool last = (t == nt - 2);
            const char* a1 = cA + (size_t)(t + 1) * kstep;
            const char* a2 = last ? nA : cA + (size_t)(t + 2) * kstep; const char* b2 = last ? nB : cB + (size_t)(t + 2) * kstep;
            const char* a3 = a2 + kstep; const char* b3 = b2 + kstep;
            if (last && has_next) S.a_ready(nxt);
            if constexpr (SP2) {
            PG8_LDB(B0, 0, 0); PG8_LDB(B1, 0, 1); PG8_SCHED; PG8_LDA(At, 0, 0); PG8_STAGE(PG8_SA(1, 1), a1 + hstepA, voffA);
            PG8_WAIT_V(8); PG8_WAIT_L(0); PG8_BAR; PG8_MMA(0, 0, At, B0); PG8_MMA(0, 1, At, B1); PG8_BAR; PG8_SCHED;
            PG8_LDA(At, 0, 1); PG8_STAGE(PG8_SB(0, 0), b2, voffB); PG8_STAGE(PG8_SB(0, 1), b2 + hstep, voffB); PG8_STAGE(PG8_SA(0, 0), a2, voffA);
            PG8_WAIT_V(8); PG8_WAIT_L(0); PG8_BAR; PG8_MMA(1, 0, At, B0); PG8_MMA(1, 1, At, B1); PG8_BAR; PG8_SCHED;
            PG8_LDB(B0, 1, 0); PG8_LDB(B1, 1, 1); PG8_SCHED; PG8_LDA(At, 1, 0); PG8_STAGE(PG8_SA(0, 1), a2 + hstepA, voffA);
            PG8_WAIT_V(8); PG8_WAIT_L(0); PG8_BAR; PG8_MMA(0, 0, At, B0); PG8_MMA(0, 1, At, B1); PG8_BAR; PG8_SCHED;
            PG8_LDA(At, 1, 1); PG8_STAGE(PG8_SB(1, 0), b3, voffB); PG8_STAGE(PG8_SB(1, 1), b3 + hstep, voffB); PG8_STAGE(PG8_SA(1, 0), a3, voffA);
            PG8_WAIT_V(8); PG8_WAIT_L(0); PG8_BAR; PG8_MMA(1, 0, At, B0); PG8_MMA(1, 1, At, B1); PG8_BAR; PG8_SCHED;
            } else {
            PG8_LDB(B0, 0, 0); PG8_SCHED; PG8_LDA(At, 0, 0); PG8_STAGE(PG8_SA(1, 1), a1 + hstepA, voffA);
            PG8_WAIT_L(8); PG8_BAR; PG8_WAIT_L(0); PG8_MMA(0, 0, At, B0); PG8_BAR; PG8_SCHED;
            PG8_LDB(B1, 0, 1); PG8_STAGE(PG8_SB(0, 0), b2, voffB);
            PG8_BAR; PG8_WAIT_L(0); PG8_MMA(0, 1, At, B1); PG8_BAR;
            PG8_LDA(At, 0, 1); PG8_STAGE(PG8_SA(0, 0), a2, voffA);
            PG8_BAR; PG8_WAIT_L(0); PG8_MMA(1, 0, At, B0); PG8_BAR; PG8_SCHED;
            PG8_STAGE(PG8_SB(0, 1), b2 + hstep, voffB);
            PG8_WAIT_V(6); PG8_BAR; PG8_MMA(1, 1, At, B1); PG8_BAR;
            PG8_LDB(B0, 1, 0); PG8_SCHED; PG8_LDA(At, 1, 0); PG8_STAGE(PG8_SA(0, 1), a2 + hstepA, voffA);
            PG8_WAIT_L(8); PG8_BAR; PG8_WAIT_L(0); PG8_MMA(0, 0, At, B0); PG8_BAR; PG8_SCHED;
            PG8_LDB(B1, 1, 1); PG8_STAGE(PG8_SB(1, 0), b3, voffB);
            PG8_BAR; PG8_WAIT_L(0); PG8_MMA(0, 1, At, B1); PG8_BAR;
            PG8_LDA(At, 1, 1); PG8_STAGE(PG8_SA(1, 0), a3, voffA);
            PG8_BAR; PG8_WAIT_L(0); PG8_MMA(1, 0, At, B0); PG8_BAR; PG8_SCHED;
            PG8_STAGE(PG8_SB(1, 1), b3 + hstep, voffB);
            PG8_WAIT_V(6); PG8_BAR; PG8_MMA(1, 1, At, B1); PG8_BAR;
            }
        }
        if constexpr (ALIGN_EPI) { if (wr == 0) PG8_BAR; }
        if constexpr (!Epi::AFTER_DRAIN) { E(acc, cur, wr, wc, fr, fq); S.done(cur); }
        if (!has_next) break;
#pragma unroll
        for (int a = 0; a < 2; ++a)
#pragma unroll
            for (int b = 0; b < 2; ++b)
#pragma unroll
                for (int m = 0; m < 4; ++m)
#pragma unroll
                    for (int n = 0; n < 2; ++n) acc[a][b][m][n] = (f32x4){0.f, 0.f, 0.f, 0.f};
        cur = nxt; cA = nA; cB = nB; ++ui;
        if constexpr (ALIGN_EPI) { if (wr == 1) PG8_BAR; }
    }
    PG8_WAIT_V(0);
    if constexpr (!ALIGN_EPI) { if (wr == 0) PG8_BAR; }
    PG8_BAR;
    if constexpr (Epi::AFTER_DRAIN) { E.fused(acc, cur, wr, wc, fr, fq, lds, wid, lane); S.done(cur); }
#undef PG8_SA
#undef PG8_SB
#undef PG8_STAGE
#undef PG8_LDA
#undef PG8_LDB
#undef PG8_MMA
#undef PG8_WAIT_V
#undef PG8_WAIT_L
#undef PG8_BAR
#undef PG8_SCHED
}
}
namespace att {
#define ATT_LAS __attribute__((address_space(3)))
typedef unsigned short bf16;
using bf16x8 = __attribute__((ext_vector_type(8))) short;
using s16x4  = __attribute__((ext_vector_type(4))) short;
using f32x16 = __attribute__((ext_vector_type(16))) float;
using u32x4  = __attribute__((ext_vector_type(4))) unsigned;
constexpr float SCALE = 0.07216878364870322f;
constexpr float THR = 8.f;
constexpr int SHM_V = 16384, SHM_K = 16384, SHM_R = 8192;
constexpr int OFF_V = 0, OFF_K = 2 * SHM_V, OFF_R = OFF_K + 2 * SHM_K, OFF_WS = OFF_R + 2 * SHM_R, ATT_LDS_BYTES = OFF_WS + 8 * 64 * 4;
#define KSWZ(row, colB) ((row) * 256 + ((colB) ^ (((row) & 7) << 4)))
#define RSWZ(row, colB) ((row) * 128 + ((colB) ^ (((row) & 7) << 4)))
#define SBAR() __builtin_amdgcn_sched_barrier(0)
__device__ __forceinline__ int crow(int r, int hi) { return (r & 3) + 8 * (r >> 2) + 4 * hi; }
__device__ __forceinline__ unsigned cvtpk(float lo, float hi) { unsigned r; asm volatile("v_cvt_pk_bf16_f32 %0, %1, %2" : "=v"(r) : "v"(lo), "v"(hi)); return r; }
__device__ __forceinline__ void partialSM(f32x16& p0, f32x16& p1, float& m_reg, float& mn, float& alpha) {
  constexpr float C = SCALE * 1.4426950408889634f;
  float pmax = p0[0];
#pragma unroll
  for (int r = 1; r < 16; ++r) pmax = fmaxf(pmax, p0[r]);
#pragma unroll
  for (int r = 0; r < 16; ++r) pmax = fmaxf(pmax, p1[r]);
  { auto rr = __builtin_amdgcn_permlane32_swap(__float_as_uint(pmax), __float_as_uint(pmax), false, false);
    pmax = fmaxf(__uint_as_float(rr[0]), __uint_as_float(rr[1])); }
  if (__builtin_expect(__all(pmax - m_reg <= THR / SCALE), 1)) { mn = m_reg; alpha = 1.f; }
  else { mn = fmaxf(m_reg, pmax); alpha = __builtin_amdgcn_exp2f((m_reg - mn) * C); m_reg = mn; }
  float mnC = -mn * C;
#pragma unroll
  for (int r = 0; r < 16; ++r) p0[r] = fmaf(p0[r], C, mnC);
#pragma unroll
  for (int r = 0; r < 16; ++r) p1[r] = fmaf(p1[r], C, mnC);
#pragma unroll
  for (int r = 0; r < 16; ++r) p0[r] = __builtin_amdgcn_exp2f(p0[r]);
}
__device__ __forceinline__ void finishSM(f32x16& p0, f32x16& p1, float alpha, float& l_reg, bf16x8& pa0, bf16x8& pa1, bf16x8& pa2, bf16x8& pa3) {
#pragma unroll
  for (int r = 0; r < 16; ++r) p1[r] = __builtin_amdgcn_exp2f(p1[r]);
  float ps = 0;
#pragma unroll
  for (int r = 0; r < 16; ++r) ps += p0[r];
#pragma unroll
  for (int r = 0; r < 16; ++r) ps += p1[r];
  { auto rr = __builtin_amdgcn_permlane32_swap(__float_as_uint(ps), __float_as_uint(ps), false, false);
    ps = __uint_as_float(rr[0]) + __uint_as_float(rr[1]); }
  l_reg = l_reg * alpha + ps;
#define PK4(P, BASE, OUT) do { unsigned a0 = cvtpk(P[BASE + 0], P[BASE + 1]), a1 = cvtpk(P[BASE + 2], P[BASE + 3]);   \
    unsigned b0 = cvtpk(P[BASE + 4], P[BASE + 5]), b1 = cvtpk(P[BASE + 6], P[BASE + 7]);                              \
    auto r0 = __builtin_amdgcn_permlane32_swap(a0, b0, false, false); auto r1 = __builtin_amdgcn_permlane32_swap(a1, b1, false, false); \
    u32x4 w = {r0[0], r1[0], r0[1], r1[1]}; OUT = *reinterpret_cast<bf16x8*>(&w); } while (0)
  PK4(p0, 0, pa0); PK4(p0, 8, pa1); PK4(p1, 0, pa2); PK4(p1, 8, pa3);
#undef PK4
}
__device__ __forceinline__ void qkt(f32x16& p0, f32x16& p1, const ATT_LAS char* Ks, const ATT_LAS char* Rs, const bf16x8* qr, int r32, int hi) {
  p0 = f32x16{}; p1 = f32x16{};
#pragma unroll
  for (int d0 = 0; d0 < 8; ++d0) { const int cb = (d0 * 16 + hi * 8) * 2;
    const bf16x8 b0 = *reinterpret_cast<const ATT_LAS bf16x8*>(Ks + KSWZ(r32, cb));
    const bf16x8 b1 = *reinterpret_cast<const ATT_LAS bf16x8*>(Ks + KSWZ(32 + r32, cb));
    p0 = __builtin_amdgcn_mfma_f32_32x32x16_bf16(b0, qr[d0], p0, 0, 0, 0);
    p1 = __builtin_amdgcn_mfma_f32_32x32x16_bf16(b1, qr[d0], p1, 0, 0, 0); }
#pragma unroll
  for (int d0 = 0; d0 < 4; ++d0) { const int cb = (d0 * 16 + hi * 8) * 2;
    const bf16x8 b0 = *reinterpret_cast<const ATT_LAS bf16x8*>(Rs + RSWZ(r32, cb));
    const bf16x8 b1 = *reinterpret_cast<const ATT_LAS bf16x8*>(Rs + RSWZ(32 + r32, cb));
    p0 = __builtin_amdgcn_mfma_f32_32x32x16_bf16(b0, qr[8 + d0], p0, 0, 0, 0);
    p1 = __builtin_amdgcn_mfma_f32_32x32x16_bf16(b1, qr[8 + d0], p1, 0, 0, 0); }
}
__device__ __forceinline__ int v_st(int k, int c) { const int kk = (k & ~0xC) | ((k & 4) << 1) | ((k & 8) >> 1); return ((kk >> 3) * 4 + (c >> 5)) * 512 + ((kk & 7) * 32 + (c & 31)) * 2; }
__device__ __forceinline__ int v_rd_base(int lane) { return ((lane & 3) << 3) | (((lane >> 2) & 3) << 6) | (((lane >> 4) & 1) << 5) | (((lane >> 5) & 1) << 8); }
constexpr int v_rd_off(int d0, int ks, int half) { return d0 * 512 + ks * 4096 + half * 2048; }
template <int OFF> __device__ __forceinline__ s16x4 tr_read(int vb) {
  s16x4 r; asm volatile("ds_read_b64_tr_b16 %0, %1 offset:%2" : "=&v"(r) : "v"(vb), "i"(OFF) : "memory"); return r;
}
template <int D0> __device__ __forceinline__ void pv_one(f32x16& od, int vb, bf16x8 pa0, bf16x8 pa1, bf16x8 pa2, bf16x8 pa3) {
  const s16x4 l0 = tr_read<v_rd_off(D0, 0, 0)>(vb), h0 = tr_read<v_rd_off(D0, 0, 1)>(vb), l1 = tr_read<v_rd_off(D0, 1, 0)>(vb), h1 = tr_read<v_rd_off(D0, 1, 1)>(vb);
  const s16x4 l2 = tr_read<v_rd_off(D0, 2, 0)>(vb), h2 = tr_read<v_rd_off(D0, 2, 1)>(vb), l3 = tr_read<v_rd_off(D0, 3, 0)>(vb), h3 = tr_read<v_rd_off(D0, 3, 1)>(vb);
  asm volatile("s_waitcnt lgkmcnt(0)" ::: "memory"); SBAR();
#define PK(L, H) (bf16x8){L[0], L[1], L[2], L[3], H[0], H[1], H[2], H[3]}
  od = __builtin_amdgcn_mfma_f32_32x32x16_bf16(pa0, PK(l0, h0), od, 0, 0, 0);
  od = __builtin_amdgcn_mfma_f32_32x32x16_bf16(pa1, PK(l1, h1), od, 0, 0, 0);
  od = __builtin_amdgcn_mfma_f32_32x32x16_bf16(pa2, PK(l2, h2), od, 0, 0, 0);
  od = __builtin_amdgcn_mfma_f32_32x32x16_bf16(pa3, PK(l3, h3), od, 0, 0, 0);
#undef PK
}
__device__ __forceinline__ void pv_d0(f32x16* o, int vb, bf16x8 pa0, bf16x8 pa1, bf16x8 pa2, bf16x8 pa3) {
  pv_one<0>(o[0], vb, pa0, pa1, pa2, pa3); pv_one<1>(o[1], vb, pa0, pa1, pa2, pa3); pv_one<2>(o[2], vb, pa0, pa1, pa2, pa3); pv_one<3>(o[3], vb, pa0, pa1, pa2, pa3);
}
__device__ __forceinline__ unsigned short f2bf(float f) { unsigned u = __builtin_bit_cast(unsigned, f); return (unsigned short)((u + 0x7fffu + ((u >> 16) & 1u)) >> 16); }
__device__ __forceinline__ void attn_unit(const bf16* __restrict__ Q, const bf16* __restrict__ KV, const bf16* __restrict__ PROJ, bf16* __restrict__ CAT, int b, int h, int qb, ATT_LAS char* lds) {
  int tid_ = threadIdx.x; asm volatile("" : "+v"(tid_));
  const int tid = tid_, wid = __builtin_amdgcn_readfirstlane(tid >> 6), lane = tid & 63, r32 = lane & 31, hi = lane >> 5;
  ATT_LAS char* V_lds = lds + OFF_V; ATT_LAS char* K_lds = lds + OFF_K; ATT_LAS char* R_lds = lds + OFF_R;
  ATT_LAS float* wsp = (ATT_LAS float*)(lds + OFF_WS) + wid * 64; ATT_LAS float* li_l = wsp; ATT_LAS float* al_l = wsp + 32;
  float m_reg = -1e30f, l_reg = 0; f32x16 o[4] = {}; bf16x8 qr[12];
  const size_t tok0 = (size_t)b * 4096;
  const bf16* Qw = Q + (tok0 + (size_t)qb * 256 + wid * 32 + r32) * 3072 + h * 192 + hi * 8;
#pragma unroll
  for (int d0 = 0; d0 < 12; ++d0) qr[d0] = *reinterpret_cast<const bf16x8*>(Qw + d0 * 16);
  const int cw = qb * 4 + (wid >> 1), NT = qb * 4 + 4;
  const int sr = tid >> 4, sc = (tid & 15) * 8, vst0 = v_st(sr, sc), vst1 = v_st(32 + sr, sc), kst0 = KSWZ(sr, sc * 2), kst1 = KSWZ(32 + sr, sc * 2);
  const int rr = tid >> 3, rc = (tid & 7) * 8, rst = RSWZ(rr, rc * 2);
  const bf16* Kg = KV + tok0 * 4096 + h * 256;
  const bf16* Rg = PROJ + tok0 * 6912 + 3584;
  const int vb0 = (int)(uintptr_t)V_lds + v_rd_base(lane);
  bf16x8 sv0, sv1, sk0, sk1, srp;
#define ATT_SLOAD(k0) do { sv0 = *reinterpret_cast<const bf16x8*>(Kg + (size_t)((k0) + sr) * 4096 + 128 + sc); sv1 = *reinterpret_cast<const bf16x8*>(Kg + (size_t)((k0) + 32 + sr) * 4096 + 128 + sc); \
    sk0 = *reinterpret_cast<const bf16x8*>(Kg + (size_t)((k0) + sr) * 4096 + sc); sk1 = *reinterpret_cast<const bf16x8*>(Kg + (size_t)((k0) + 32 + sr) * 4096 + sc); \
    srp = *reinterpret_cast<const bf16x8*>(Rg + (size_t)((k0) + rr) * 6912 + rc); } while (0)
#define ATT_SWRITE(bf) do { *reinterpret_cast<ATT_LAS bf16x8*>(V_lds + (bf) * SHM_V + vst0) = sv0; *reinterpret_cast<ATT_LAS bf16x8*>(V_lds + (bf) * SHM_V + vst1) = sv1; \
    *reinterpret_cast<ATT_LAS bf16x8*>(K_lds + (bf) * SHM_K + kst0) = sk0; *reinterpret_cast<ATT_LAS bf16x8*>(K_lds + (bf) * SHM_K + kst1) = sk1; \
    *reinterpret_cast<ATT_LAS bf16x8*>(R_lds + (bf) * SHM_R + rst) = srp; } while (0)
#define ATT_RESC(a) do { if (__any((a) < 1.f)) { if (hi == 0) al_l[r32] = (a); asm volatile("s_waitcnt lgkmcnt(0)" ::: "memory"); \
    _Pragma("unroll") for (int d = 0; d < 4; ++d) _Pragma("unroll") for (int r = 0; r < 16; ++r) o[d][r] *= al_l[crow(r, hi)]; } } while (0)
  ATT_SLOAD(0); asm volatile("s_waitcnt vmcnt(0)" ::: "memory"); ATT_SWRITE(0); __syncthreads();
  for (int t = 0; t < NT; ++t) {
    const int bf = t & 1;
    if (t + 1 < NT) ATT_SLOAD((t + 1) * 64);
    if (t <= cw) {
      f32x16 p0, p1; float mn, al; bf16x8 pa0, pa1, pa2, pa3;
      qkt(p0, p1, K_lds + bf * SHM_K, R_lds + bf * SHM_R, qr, r32, hi);
      partialSM(p0, p1, m_reg, mn, al);
      ATT_RESC(al);
      finishSM(p0, p1, al, l_reg, pa0, pa1, pa2, pa3); SBAR();
      pv_d0(o, vb0 + bf * SHM_V, pa0, pa1, pa2, pa3);
    }
    if (t + 1 < NT) { asm volatile("s_waitcnt vmcnt(0)" ::: "memory"); ATT_SWRITE(bf ^ 1); }
    __syncthreads();
  }
  if (hi == 0) li_l[r32] = l_reg; asm volatile("s_waitcnt lgkmcnt(0)" ::: "memory");
  float rli[16];
#pragma unroll
  for (int r = 0; r < 16; ++r) rli[r] = __builtin_amdgcn_rcpf(li_l[crow(r, hi)]);
  bf16* Ow = CAT + (tok0 + (size_t)qb * 256 + wid * 32) * 4096 + 1024 + h * 128;
#pragma unroll
  for (int r = 0; r < 16; ++r) { const int orow = crow(r, hi);
#pragma unroll
    for (int d0 = 0; d0 < 4; ++d0) Ow[(size_t)orow * 4096 + d0 * 32 + r32] = f2bf(o[d0][r] * rli[r]); }
#undef ATT_SLOAD
#undef ATT_SWRITE
#undef ATT_RESC
}
}
constexpr int NWAVES = 8;
constexpr int BATCH = 2, SEQ = 4096, DM = 4096, M = BATCH * SEQ, DEPTH = 2, FF = 16384;
constexpr int INW = 6720, INP = 6912;
constexpr int C_U = 0, C_V = 1024, C_CQ = 2048, C_CKV = 3072, C_KR = 3584, C_RQ = 3648, C_RK = 4160, C_RV = 4672, C_RG = 5696;
constexpr int QW = 3072, KVW = 4096;
constexpr float EPS = 1e-6f;
constexpr size_t MiB = 1u << 20;
constexpr size_t WS_CTL = 0, CTL_ZERO_BYTES = 1 * MiB;
constexpr size_t WS_ROPE = 1 * MiB;
constexpr size_t WS_SSQ = 2 * MiB;
constexpr size_t WS_W = 4 * MiB, LW = 353 * MiB;
constexpr size_t W_IN = 0, W_Q = 54 * MiB, W_KV = 60 * MiB, W_OUT = 64 * MiB, W_UP = 96 * MiB, W_DOWN = 224 * MiB, W_SGU = 352 * MiB;
constexpr size_t WS_H = WS_W + 2 * LW;
constexpr size_t WS_PROJ = WS_H + 64 * MiB;
constexpr size_t WS_Q = WS_PROJ + 108 * MiB;
constexpr size_t WS_KV = WS_Q + 48 * MiB;
constexpr size_t WS_CAT = WS_KV + 64 * MiB;
constexpr size_t WS_MIX = WS_CAT + 64 * MiB;
constexpr size_t WS_ACT = WS_MIX + 64 * MiB;
constexpr size_t WS_KVS = WS_ACT + 256 * MiB;
constexpr size_t WS_SB = WS_KVS + 32 * MiB;
constexpr size_t WS_END = WS_SB + 16 * MiB;
static_assert((size_t)INP * DM * 2 == 54 * MiB && (size_t)M * INP * 2 == 108 * MiB, "map");
constexpr int CW_BAR = 4096;
constexpr int RING_OFF = 0, RING_BYTES = 131072;
constexpr int LDSCTL_OFF = RING_BYTES, MISC_OFF = LDSCTL_OFF + 320;
constexpr int LDS_BYTES = 147456;
#define GAS __attribute__((address_space(1)))
#define LAS __attribute__((address_space(3)))
typedef unsigned short bf16;
typedef unsigned v4u __attribute__((ext_vector_type(4)));
typedef float f32x4 __attribute__((ext_vector_type(4)));
typedef short bf16x8 __attribute__((ext_vector_type(8)));
typedef GAS unsigned gu32;
typedef GAS unsigned long long gu64;
#define RLX_AGENT __ATOMIC_RELAXED, __HIP_MEMORY_SCOPE_AGENT
#define LDS_WAIT() asm volatile("s_waitcnt lgkmcnt(0)" ::: "memory")
#define VM_WAIT() asm volatile("s_waitcnt vmcnt(0)" ::: "memory")
__device__ __forceinline__ unsigned long long rt() { return __builtin_amdgcn_s_memrealtime(); }
__device__ __forceinline__ unsigned f2bf(float f) { unsigned u = __builtin_bit_cast(unsigned, f); return (u + 0x7fffu + ((u >> 16) & 1u)) >> 16; }
__device__ __forceinline__ unsigned pk2(float lo, float hi) { return f2bf(lo) | (f2bf(hi) << 16); }

#define XB_TMO      128
#define XB_XCNT(j)  (256  + 64 * (j))
#define XB_XSUB(j)  (1280 + 64 * (j))
#define XB_XGEN(j)  (2304 + 64 * (j))
#define XB_TOP      3328
#define XB_TOPGEN   3392
#define XCD_BAR_WORDS 3456
#define XB_SPIN_CAP (1u << 18)

__device__ __forceinline__ unsigned xb_ld(unsigned* p)              { return __hip_atomic_load(p, __ATOMIC_RELAXED, __HIP_MEMORY_SCOPE_AGENT); }
__device__ __forceinline__ unsigned xb_add(unsigned* p, unsigned v) { return __hip_atomic_fetch_add(p, v, __ATOMIC_RELAXED, __HIP_MEMORY_SCOPE_AGENT); }
__device__ __forceinline__ unsigned xb_xcc_id() { return (unsigned)__builtin_amdgcn_s_getreg((3 << 11) | 20) & 0xFu; }
#define XB_SPIN(cond, bar) do { unsigned _sp = 0; while (cond) { __builtin_amdgcn_s_sleep(1); \
    if ((++_sp & 255u) == 0u) { if (xb_ld(&(bar)[XB_TMO])) break; if (_sp > XB_SPIN_CAP) { atomicAdd(&(bar)[XB_TMO], 1u); break; } } } } while (0)

struct XcdBarrier {
    unsigned* bar; unsigned x;
    volatile LAS unsigned* st;
};

__device__ __forceinline__ XcdBarrier xcd_barrier_post(unsigned* bar, volatile LAS unsigned* st) {
    XcdBarrier b; b.bar = bar; b.x = xb_xcc_id(); b.st = st;
    if (threadIdx.x == 0) (void)xb_add(&bar[XB_XCNT(b.x)], 1u);
    return b;
}
__device__ __forceinline__ void xcd_barrier_complete(unsigned* bar, unsigned x, unsigned& nloc, unsigned& nx) {
    const unsigned G = gridDim.x * gridDim.y * gridDim.z;
    unsigned sum, cnt, mine, sp = 0u;
    for (;;) {
        sum = 0u; cnt = 0u; mine = 0u;
#pragma unroll
        for (unsigned j = 0; j < 16; ++j) { const unsigned c = xb_ld(&bar[XB_XCNT(j)]); sum += c; cnt += (c > 0u) ? 1u : 0u; mine = (j == x) ? c : mine; }
        if (sum == G) break;
        __builtin_amdgcn_s_sleep(1);
        if ((++sp & 255u) == 0u) { if (xb_ld(&bar[XB_TMO])) break; if (sp > XB_SPIN_CAP) { atomicAdd(&bar[XB_TMO], 1u); break; } }
    }
    nloc = mine > 0u ? mine : 1u; nx = cnt > 0u ? cnt : 1u;
}

__device__ __forceinline__ void xcd_barrier(const XcdBarrier& b) {
    asm volatile("s_waitcnt vmcnt(0)" ::: "memory");
    __syncthreads();
    if (threadIdx.x == 0) {
        unsigned* bar = b.bar;
        __builtin_amdgcn_s_waitcnt(0);
        unsigned nloc = b.st[0], nx = b.st[1];
        if (nloc == 0u) { xcd_barrier_complete(bar, b.x, nloc, nx); b.st[0] = nloc; b.st[1] = nx; }
        const unsigned old = xb_add(&bar[XB_XSUB(b.x)], 1u);
        const unsigned gen = old / nloc;
        if (old + 1u == (gen + 1u) * nloc) {
            __builtin_amdgcn_fence(__ATOMIC_RELEASE, "agent");
            asm volatile("s_waitcnt vmcnt(0)" ::: "memory");
            const unsigned og = xb_add(&bar[XB_TOP], 1u);
            const unsigned tg = og / nx;
            if (og + 1u == (tg + 1u) * nx) xb_add(&bar[XB_TOPGEN], 1u);
            else XB_SPIN(xb_ld(&bar[XB_TOPGEN]) == tg, bar);
            __builtin_amdgcn_fence(__ATOMIC_ACQUIRE, "agent");
            xb_add(&bar[XB_XGEN(b.x)], 1u);
            asm volatile("s_waitcnt vmcnt(0)" ::: "memory");
        } else {
            XB_SPIN(xb_ld(&bar[XB_XGEN(b.x)]) == gen, bar);
            __builtin_amdgcn_fence(__ATOMIC_ACQUIRE, "agent");
            asm volatile("s_waitcnt vmcnt(0)" ::: "memory");
        }
    }
    __syncthreads();
}
typedef float f32x16 __attribute__((ext_vector_type(16)));
struct Frame {
    LAS unsigned char* lds; int tid, lane, wave, vcu, G;
};
__device__ __forceinline__ Frame make_frame(LAS unsigned char* lds) {
    Frame F; F.lds = lds; int t = threadIdx.x; asm volatile("" : "+v"(t)); int bx = blockIdx.x; asm volatile("" : "+s"(bx));
    F.tid = t; F.lane = t & 63; F.wave = __builtin_amdgcn_readfirstlane(t >> 6); F.G = gridDim.x;
    F.vcu = (F.G % 8 == 0) ? (bx % 8) * (F.G / 8) + bx / 8 : bx; return F;
}
__device__ __forceinline__ float bf2f(unsigned short h) { return __builtin_bit_cast(float, (unsigned)h << 16); }
__device__ __forceinline__ unsigned short f2bf16(float f) { return (unsigned short)f2bf(f); }
__device__ __forceinline__ float wave_sum(float v) {
#pragma unroll
    for (int o = 1; o < 64; o <<= 1) v += __shfl_xor(v, o);
    return v;
}
__device__ __forceinline__ int crow32(int r, int hi) { return (r & 3) + 8 * (r >> 2) + 4 * hi; }
template <int KSTEPS> __device__ __forceinline__ void mfma_lds(f32x16& acc, const LAS bf16* A, int pa, const LAS bf16* Bt, int pb, int r32, int hi) {
#pragma unroll
    for (int s = 0; s < KSTEPS; ++s) {
        const bf16x8 a = *(const LAS bf16x8*)(A + r32 * pa + s * 16 + hi * 8);
        const bf16x8 b = *(const LAS bf16x8*)(Bt + r32 * pb + s * 16 + hi * 8);
        acc = __builtin_amdgcn_mfma_f32_32x32x16_bf16(a, b, acc, 0, 0, 0);
    }
}
struct CvtDesc { const float* W; bf16* WT; const float* kgain; int K, N, k0, n0, kind; };
__device__ __forceinline__ void cvt_load(const CvtDesc& d, float (&v)[32], int lane) {
    const int nd = d.n0 + (lane & 31); bool ok = true; int sc = nd; float cs = 1.f;
    if (d.kind == 1) { ok = nd < INW; sc = (nd >= C_KR && nd < C_RV) ? (nd & ~63) + ((nd & 63) >> 1) + 32 * (nd & 1) : nd; cs = (nd >= C_RQ && nd < C_RK) ? 0.125f : 1.f; if (!ok) sc = 0; }
    if (d.kind == 2) { sc = ((nd % 192) >= 128) ? (nd & ~63) + ((nd & 63) >> 1) + 32 * (nd & 1) : nd; }
    const float* src = d.W + (size_t)(d.k0 + (lane >> 5)) * d.N + sc;
#pragma unroll
    for (int i = 0; i < 32; ++i) v[i] = __builtin_nontemporal_load(src + (size_t)(2 * i) * d.N);
    if (d.kgain) {
#pragma unroll
        for (int i = 0; i < 32; ++i) v[i] *= d.kgain[d.k0 + 2 * i + (lane >> 5)]; }
    if (d.kind == 1) {
#pragma unroll
        for (int i = 0; i < 32; ++i) v[i] = ok ? v[i] * cs : 0.f; }
}
__device__ __forceinline__ void cvt_finish(const CvtDesc& d, const float (&v)[32], LAS float* scr, int lane) {
#pragma unroll
    for (int i = 0; i < 32; ++i) scr[(2 * i + (lane >> 5)) * 33 + (lane & 31)] = v[i];
    LDS_WAIT(); asm volatile("" ::: "memory");
    const int c = lane & 7;
#pragma unroll
    for (int j = 0; j < 4; ++j) { const int n = (lane >> 3) + 8 * j; const LAS float* s = scr + (8 * c) * 33 + n;
        v4u o; o.x = pk2(s[0 * 33], s[1 * 33]); o.y = pk2(s[2 * 33], s[3 * 33]); o.z = pk2(s[4 * 33], s[5 * 33]); o.w = pk2(s[6 * 33], s[7 * 33]);
        *(GAS v4u*)(d.WT + (size_t)(d.n0 + n) * d.K + d.k0 + 8 * c) = o; }
    LDS_WAIT(); asm volatile("" ::: "memory");
}
__device__ __forceinline__ void rms_row_to_bf16(const float* __restrict__ xrow, const float* __restrict__ g, bf16* __restrict__ orow, int lane) {
    f32x4 v[16]; float s = 0.f;
#pragma unroll
    for (int j = 0; j < 8; ++j) { const f32x4* p = (const f32x4*)(xrow + 8 * (lane + 64 * j)); v[2 * j] = p[0]; v[2 * j + 1] = p[1]; }
#pragma unroll
    for (int j = 0; j < 16; ++j) s += (v[j][0] * v[j][0] + v[j][1] * v[j][1]) + (v[j][2] * v[j][2] + v[j][3] * v[j][3]);
    const float r = 1.0f / sqrtf(wave_sum(s) * (1.0f / 4096.0f) + EPS);
#pragma unroll
    for (int j = 0; j < 8; ++j) { const f32x4* gp = (const f32x4*)(g + 8 * (lane + 64 * j)); const f32x4 g0 = gp[0], g1 = gp[1]; const f32x4 a = v[2 * j] * r * g0, b = v[2 * j + 1] * r * g1;
        v4u o; o.x = pk2(a[0], a[1]); o.y = pk2(a[2], a[3]); o.z = pk2(b[0], b[1]); o.w = pk2(b[2], b[3]);
        *(v4u*)(orow + 8 * (lane + 64 * j)) = o; }
}
__device__ __forceinline__ void residual_row(const float* xin, const bf16* __restrict__ yrow, const float* __restrict__ gpost, float* xout, const float* __restrict__ gnext, bf16* __restrict__ hrow, int lane) {
    f32x4 v[16]; float y[64]; float s = 0.f;
#pragma unroll
    for (int j = 0; j < 8; ++j) { const f32x4* p = (const f32x4*)(xin + 8 * (lane + 64 * j)); v[2 * j] = p[0]; v[2 * j + 1] = p[1];
        const v4u q = *(const v4u*)(yrow + 8 * (lane + 64 * j));
        y[8 * j + 0] = __builtin_bit_cast(float, q.x << 16); y[8 * j + 1] = __builtin_bit_cast(float, q.x & 0xffff0000u); y[8 * j + 2] = __builtin_bit_cast(float, q.y << 16); y[8 * j + 3] = __builtin_bit_cast(float, q.y & 0xffff0000u);
        y[8 * j + 4] = __builtin_bit_cast(float, q.z << 16); y[8 * j + 5] = __builtin_bit_cast(float, q.z & 0xffff0000u); y[8 * j + 6] = __builtin_bit_cast(float, q.w << 16); y[8 * j + 7] = __builtin_bit_cast(float, q.w & 0xffff0000u); }
#pragma unroll
    for (int i = 0; i < 64; ++i) s += y[i] * y[i];
    const float r = 1.0f / sqrtf(wave_sum(s) * (1.0f / 4096.0f) + EPS);
    float s2 = 0.f;
#pragma unroll
    for (int j = 0; j < 8; ++j) { const f32x4* gp = (const f32x4*)(gpost + 8 * (lane + 64 * j)); const f32x4 g0 = gp[0], g1 = gp[1];
        f32x4 a = v[2 * j], b = v[2 * j + 1];
#pragma unroll
        for (int e = 0; e < 4; ++e) { a[e] += y[8 * j + e] * r * g0[e]; b[e] += y[8 * j + 4 + e] * r * g1[e]; }
        v[2 * j] = a; v[2 * j + 1] = b;
        f32x4* op = (f32x4*)(xout + 8 * (lane + 64 * j)); op[0] = a; op[1] = b;
        s2 += (a[0] * a[0] + a[1] * a[1]) + (a[2] * a[2] + a[3] * a[3]) + (b[0] * b[0] + b[1] * b[1]) + (b[2] * b[2] + b[3] * b[3]); }
    if (gnext) {
        const float r2 = 1.0f / sqrtf(wave_sum(s2) * (1.0f / 4096.0f) + EPS);
#pragma unroll
        for (int j = 0; j < 8; ++j) { const f32x4* gp = (const f32x4*)(gnext + 8 * (lane + 64 * j)); const f32x4 g0 = gp[0], g1 = gp[1]; const f32x4 a = v[2 * j] * r2 * g0, b = v[2 * j + 1] * r2 * g1;
            v4u o; o.x = pk2(a[0], a[1]); o.y = pk2(a[2], a[3]); o.z = pk2(b[0], b[1]); o.w = pk2(b[2], b[3]);
            *(v4u*)(hrow + 8 * (lane + 64 * j)) = o; }
    }
}
__device__ __forceinline__ float ret_lg(int h) { return log1pf(-exp2f(-5.0f - (float)h)); }
__device__ __forceinline__ void sgu_phase(LAS unsigned char* lds_, const bf16* __restrict__ PROJ, bf16* __restrict__ CAT, const bf16* __restrict__ SGW, const float* __restrict__ lng, const float* __restrict__ lnb, const float* __restrict__ bs) {
    const Frame F = make_frame(lds_);
    LAS bf16* Wm = (LAS bf16*)(F.lds + RING_OFF);
    LAS bf16* VT = Wm + 128 * 136;
    const int r32 = F.lane & 31, hi = F.lane >> 5;
    for (int unit = F.vcu; unit < 512; unit += F.G) {
        const int b = unit >> 8, n = (unit >> 3) & 31, g = unit & 7;
        const size_t R0 = (size_t)b * SEQ + (size_t)n * 128; const int cb = g * 128;
        for (int q = F.tid; q < 128 * 16; q += NWAVES * 64) { const int i = q >> 4, ch = q & 15;
            *(LAS bf16x8*)(Wm + i * 136 + ch * 8) = *(const bf16x8*)(SGW + ((size_t)g * 128 + i) * 128 + ch * 8); }
        const float g0 = lng[cb + 2 * F.lane], g1 = lng[cb + 2 * F.lane + 1], b0 = lnb[cb + 2 * F.lane], b1 = lnb[cb + 2 * F.lane + 1];
        for (int jj = 0; jj < 16; ++jj) { const int j = F.wave * 16 + jj;
            const unsigned pv = *(const unsigned*)(PROJ + (R0 + j) * INP + C_V + cb + 2 * F.lane);
            const float x0 = __builtin_bit_cast(float, pv << 16), x1 = __builtin_bit_cast(float, pv & 0xffff0000u);
            const float mu = wave_sum(x0 + x1) * (1.0f / 128.0f), d0 = x0 - mu, d1 = x1 - mu;
            const float rstd = 1.0f / sqrtf(wave_sum(d0 * d0 + d1 * d1) * (1.0f / 128.0f) + EPS);
            VT[(2 * F.lane) * 136 + j] = f2bf16(d0 * rstd * g0 + b0); VT[(2 * F.lane + 1) * 136 + j] = f2bf16(d1 * rstd * g1 + b1); }
        __syncthreads();
        const int ib = F.wave >> 1, cb0 = (F.wave & 1) * 2;
        f32x16 acc0 = {}, acc1 = {};
        mfma_lds<8>(acc0, Wm + ib * 32 * 136, 136, VT + (cb0 * 32) * 136, 136, r32, hi);
        mfma_lds<8>(acc1, Wm + ib * 32 * 136, 136, VT + ((cb0 + 1) * 32) * 136, 136, r32, hi);
#pragma unroll
        for (int r = 0; r < 16; ++r) { const int i = ib * 32 + crow32(r, hi); const float bias = bs[g * 128 + i]; const size_t row = R0 + i; const int c = cb0 * 32 + r32;
            const float u0 = bf2f(PROJ[row * INP + C_U + cb + c]), u1 = bf2f(PROJ[row * INP + C_U + cb + c + 32]);
            CAT[row * DM + cb + c] = f2bf16(u0 * (acc0[r] + bias)); CAT[row * DM + cb + c + 32] = f2bf16(u1 * (acc1[r] + bias)); }
        __syncthreads();
    }
}
__device__ __forceinline__ void ret1_phase(LAS unsigned char* lds_, const bf16* __restrict__ PROJ, float* __restrict__ KVS) {
    const Frame F = make_frame(lds_);
    LAS bf16* KT = (LAS bf16*)(F.lds + RING_OFF);
    LAS bf16* VT = KT + 64 * 72;
    const int r32 = F.lane & 31, hi = F.lane >> 5;
    for (int unit = F.vcu; unit < 1024; unit += F.G) {
        const int bh = unit >> 6, c = unit & 63, b = bh >> 3, h = bh & 7; const float lg = ret_lg(h);
        const size_t R0 = (size_t)b * SEQ + (size_t)c * 64;
        const int m = F.tid >> 3, d0 = (F.tid & 7) * 8, e0 = (F.tid & 7) * 16; const float kd = expf(lg * (float)(63 - m));
        const bf16x8 kv = *(const bf16x8*)(PROJ + (R0 + m) * INP + C_RK + h * 64 + d0);
        const bf16x8 va = *(const bf16x8*)(PROJ + (R0 + m) * INP + C_RV + h * 128 + e0), vb = *(const bf16x8*)(PROJ + (R0 + m) * INP + C_RV + h * 128 + e0 + 8);
#pragma unroll
        for (int i = 0; i < 8; ++i) KT[(d0 + i) * 72 + m] = f2bf16(bf2f((unsigned short)kv[i]) * kd);
#pragma unroll
        for (int i = 0; i < 8; ++i) { VT[(e0 + i) * 72 + m] = (unsigned short)va[i]; VT[(e0 + 8 + i) * 72 + m] = (unsigned short)vb[i]; }
        __syncthreads();
        const int eb = F.wave >> 1, db = F.wave & 1;
        f32x16 acc = {};
        mfma_lds<4>(acc, VT + eb * 32 * 72, 72, KT + db * 32 * 72, 72, r32, hi);
#pragma unroll
        for (int r = 0; r < 16; ++r) KVS[((size_t)unit * 128 + eb * 32 + crow32(r, hi)) * 64 + db * 32 + r32] = acc[r];
        __syncthreads();
    }
}
__device__ __forceinline__ void ret2_phase(LAS unsigned char* lds_, const float* __restrict__ KVS, bf16* __restrict__ SB) {
    const Frame F = make_frame(lds_);
    for (int gid = F.vcu * (NWAVES * 64) + F.tid; gid < 16 * 8192; gid += F.G * NWAVES * 64) {
        const int bh = gid >> 13, idx = gid & 8191; const float cd = expf(ret_lg(bh & 7) * 64.0f);
        float S = 0.f;
#pragma unroll 8
        for (int c = 0; c < 64; ++c) { const size_t o = ((size_t)bh * 64 + c) * 8192 + idx; SB[o] = f2bf16(S); S = cd * S + KVS[o]; }
    }
}
__device__ __forceinline__ void ret3_phase(LAS unsigned char* lds_, const bf16* __restrict__ PROJ, const bf16* __restrict__ SB, bf16* __restrict__ CAT) {
    const Frame F = make_frame(lds_);
    LAS bf16* Qs = (LAS bf16*)(F.lds + RING_OFF);
    LAS bf16* Ks = Qs + 64 * 72;
    LAS bf16* VT = Ks + 64 * 72;
    LAS bf16* Ss = VT + 128 * 72;
    LAS bf16* Ps = Ss + 128 * 72;
    LAS float* red = (LAS float*)(Ps + 64 * 72);
    const int r32 = F.lane & 31, hi = F.lane >> 5;
    for (int unit = F.vcu; unit < 1024; unit += F.G) {
        const int bh = unit >> 6, c = unit & 63, b = bh >> 3, h = bh & 7; const float lg = ret_lg(h);
        const size_t R0 = (size_t)b * SEQ + (size_t)c * 64;
        { const int m = F.tid >> 3, d0 = (F.tid & 7) * 8, e0 = (F.tid & 7) * 16;
          *(LAS bf16x8*)(Qs + m * 72 + d0) = *(const bf16x8*)(PROJ + (R0 + m) * INP + C_RQ + h * 64 + d0);
          *(LAS bf16x8*)(Ks + m * 72 + d0) = *(const bf16x8*)(PROJ + (R0 + m) * INP + C_RK + h * 64 + d0);
          const bf16x8 va = *(const bf16x8*)(PROJ + (R0 + m) * INP + C_RV + h * 128 + e0), vb = *(const bf16x8*)(PROJ + (R0 + m) * INP + C_RV + h * 128 + e0 + 8);
#pragma unroll
          for (int i = 0; i < 8; ++i) { VT[(e0 + i) * 72 + m] = (unsigned short)va[i]; VT[(e0 + 8 + i) * 72 + m] = (unsigned short)vb[i]; }
#pragma unroll
          for (int k = 0; k < 2; ++k) { const int q = F.tid + k * 512, e = q >> 3, dd = (q & 7) * 8; *(LAS bf16x8*)(Ss + e * 72 + dd) = *(const bf16x8*)(SB + (size_t)unit * 8192 + e * 64 + dd); } }
        __syncthreads();
        const int lb = F.wave & 1, eb = F.wave >> 1;
        f32x16 cross = {};
        mfma_lds<4>(cross, Qs + lb * 32 * 72, 72, Ss + eb * 32 * 72, 72, r32, hi);
        if (F.wave < 4) { const int mb = F.wave >> 1; f32x16 sc = {};
            mfma_lds<4>(sc, Qs + lb * 32 * 72, 72, Ks + mb * 32 * 72, 72, r32, hi);
#pragma unroll
            for (int r = 0; r < 16; ++r) { const int l = lb * 32 + crow32(r, hi), mm = mb * 32 + r32; const int ad = l > mm ? l - mm : mm - l;
                Ps[l * 72 + mm] = f2bf16(sc[r] * expf(lg * (float)ad)); } }
        __syncthreads();
        f32x16 o = {};
        mfma_lds<4>(o, Ps + lb * 32 * 72, 72, VT + eb * 32 * 72, 72, r32, hi);
#pragma unroll
        for (int r = 0; r < 16; ++r) { const int l = lb * 32 + crow32(r, hi); o[r] += cross[r] * expf(lg * (float)(l + 1));
            float s = o[r] * o[r];
#pragma unroll
            for (int x = 1; x < 32; x <<= 1) s += __shfl_xor(s, x);
            if (r32 == 0) red[l * 4 + eb] = s; }
        __syncthreads();
#pragma unroll
        for (int r = 0; r < 16; ++r) { const int l = lb * 32 + crow32(r, hi); const f32x4 t = *(const LAS f32x4*)(red + l * 4);
            const float rn = 1.0f / sqrtf(((t[0] + t[1]) + (t[2] + t[3])) * (1.0f / 128.0f) + EPS); const int e = eb * 32 + r32;
            const float gt = bf2f(PROJ[(R0 + l) * INP + C_RG + h * 128 + e]); const float sg = gt / (1.0f + expf(-gt));
            CAT[(R0 + l) * DM + 3072 + h * 128 + e] = f2bf16(sg * (o[r] * rn)); }
        __syncthreads();
    }
}
#ifndef REP_PRO
#define REP_PRO 1
#endif
#ifndef REP_ATTN
#define REP_ATTN 1
#endif
#ifndef REP_UP
#define REP_UP 1
#endif
#ifndef REP_IN
#define REP_IN 1
#endif
#ifndef REP_QKV
#define REP_QKV 1
#endif
#ifndef REP_RET3
#define REP_RET3 1
#endif
#ifndef BAR_DUP
#define BAR_DUP 1
#endif
#ifndef REP_OUT
#define REP_OUT 1
#endif
#ifndef REP_DOWN
#define REP_DOWN 1
#endif
#ifndef REP_RES
#define REP_RES 1
#endif
#ifndef REP_SMALL
#define REP_SMALL 1
#endif
struct Args { const float* in[17]; float* out; unsigned char* ws; };
typedef const Args __attribute__((address_space(4))) CArgs;
__device__ __forceinline__ CArgs* fresh_args() { CArgs* p = (CArgs*)__builtin_amdgcn_kernarg_segment_ptr(); asm volatile("" : "+s"(p)); return p; }
__device__ __forceinline__ void prologue_phase(LAS unsigned char* lds_) {
    const Frame F = make_frame(lds_); CArgs* A = fresh_args(); unsigned char* ws = A->ws; float* rope = (float*)(ws + WS_ROPE); bf16* H = (bf16*)(ws + WS_H);
    const int gw = F.vcu * NWAVES + F.wave, NGW = F.G * NWAVES;
        LAS float* scr = (LAS float*)(F.lds + RING_OFF + F.wave * 16384);
        constexpr int I_IN = (DM / 64) * (INP / 32), I_Q = (1024 / 64) * (QW / 32), I_KV = (512 / 64) * (KVW / 32), I_OUT = (DM / 64) * (DM / 32), I_UP = (DM / 64) * (FF / 32), I_DN = (FF / 64) * (DM / 32);
        constexpr int I_L = I_IN + I_Q + I_KV + I_OUT + I_UP + I_DN;
        auto desc_of = [&](int it) -> CvtDesc {
            const int l = it / I_L; int r = it % I_L; unsigned char* wl = ws + WS_W + (size_t)l * LW; CvtDesc d; int nblk;
            if (r < I_IN) { d.W = A->in[5] + (size_t)l * DM * INW; d.WT = (bf16*)(wl + W_IN); d.kgain = nullptr; d.K = DM; d.N = INW; nblk = INP / 32; d.kind = 1; }
            else if ((r -= I_IN) < I_Q) { d.W = A->in[11] + (size_t)l * 1024 * QW; d.WT = (bf16*)(wl + W_Q); d.kgain = A->in[10] + l * 1024; d.K = 1024; d.N = QW; nblk = QW / 32; d.kind = 2; }
            else if ((r -= I_Q) < I_KV) { d.W = A->in[13] + (size_t)l * 512 * KVW; d.WT = (bf16*)(wl + W_KV); d.kgain = A->in[12] + l * 512; d.K = 512; d.N = KVW; nblk = KVW / 32; d.kind = 0; }
            else if ((r -= I_KV) < I_OUT) { d.W = A->in[14] + (size_t)l * DM * DM; d.WT = (bf16*)(wl + W_OUT); d.kgain = nullptr; d.K = DM; d.N = DM; nblk = DM / 32; d.kind = 0; }
            else if ((r -= I_OUT) < I_UP) { d.W = A->in[15] + (size_t)l * DM * FF; d.WT = (bf16*)(wl + W_UP); d.kgain = nullptr; d.K = DM; d.N = FF; nblk = FF / 32; d.kind = 0; }
            else { r -= I_UP; d.W = A->in[16] + (size_t)l * FF * DM; d.WT = (bf16*)(wl + W_DOWN); d.kgain = nullptr; d.K = FF; d.N = DM; nblk = DM / 32; d.kind = 0; }
            d.k0 = 64 * (r / nblk); d.n0 = 32 * (r % nblk); return d; };
        for (int it = gw; it < DEPTH * I_L; it += 2 * NGW) {
            const bool two = it + NGW < DEPTH * I_L;
            float va[32], vb[32];
            const CvtDesc da = desc_of(it); const CvtDesc db = desc_of(two ? it + NGW : it);
            cvt_load(da, va, F.lane); if (two) cvt_load(db, vb, F.lane);
            cvt_finish(da, va, scr, F.lane); if (two) cvt_finish(db, vb, scr, F.lane);
        }
        for (int i = F.vcu * (NWAVES * 64) + F.tid; i < DEPTH * 8 * 128 * 128; i += F.G * NWAVES * 64) {
            const int l = i >> 17, r = i & 131071, ii = (r >> 7) & 127, jj = r & 127;
            ((bf16*)(ws + WS_W + (size_t)l * LW + W_SGU))[r] = ((jj >> 6) <= (ii >> 6)) ? f2bf16(A->in[8][i]) : (bf16)0; }
        for (int i = F.vcu * (NWAVES * 64) + F.tid; i < SEQ * 32; i += F.G * NWAVES * 64) {
            const int pos = i >> 5, j = i & 31; const float inv = (float)pow(10000.0, -(double)j / 32.0); const float ang = (float)pos * inv;
            float sn, cs; sincosf(ang, &sn, &cs); rope[2 * i] = cs; rope[2 * i + 1] = sn; }
        for (int m = gw; m < M; m += NGW) rms_row_to_bf16(A->in[0] + (size_t)m * DM, A->in[1], H + (size_t)m * DM, F.lane);
}
__device__ __forceinline__ void residual_phase(LAS unsigned char* lds_, int l, int which, bool dry = false) {
    const Frame F = make_frame(lds_); CArgs* A = fresh_args(); unsigned char* ws = A->ws; const int gw = F.vcu * NWAVES + F.wave, NGW = F.G * NWAVES;
    const float* xin = (which == 0 && l == 0) ? A->in[0] : A->out; float* xout = dry ? (float*)(ws + WS_ACT) : A->out; const bf16* Y = (const bf16*)(ws + WS_MIX); bf16* Hn = dry ? (bf16*)(ws + WS_ACT + 134 * MiB) : (bf16*)(ws + WS_H);
    const float* gpost = (which == 0 ? A->in[2] : A->in[4]) + l * DM;
    const float* gnext = which == 0 ? A->in[3] + l * DM : ((l + 1 < DEPTH) ? A->in[1] + (l + 1) * DM : nullptr);
    for (int m = gw; m < M; m += NGW) residual_row(xin + (size_t)m * DM, Y + (size_t)m * DM, gpost, xout + (size_t)m * DM, gnext, Hn + (size_t)m * DM, F.lane);
}
__device__ __forceinline__ void attn_phase(LAS unsigned char* lds_) {
    const Frame F = make_frame(lds_); CArgs* A = fresh_args(); unsigned char* ws = A->ws;
    const bf16* QB = (const bf16*)(ws + WS_Q); const bf16* KVB = (const bf16*)(ws + WS_KV); const bf16* PROJ = (const bf16*)(ws + WS_PROJ); bf16* CAT = (bf16*)(ws + WS_CAT);
    for (int p2 = 2 * F.vcu; p2 < 512; p2 += 2 * F.G)
        for (int k = 0; k < 2; ++k) { const int p = p2 >> 1, bh = p >> 3, s = p & 7;
            att::attn_unit(QB, KVB, PROJ, CAT, bh >> 4, bh & 15, k ? 15 - s : s, (ATT_LAS char*)(F.lds + RING_OFF)); }
}
template <int WHICH> __device__ __forceinline__ void gemm_call(LAS unsigned char* lds_, int l) {
    CArgs* A = fresh_args(); unsigned char* ws = A->ws; unsigned char* wl = ws + WS_W + (size_t)l * LW; int bx = blockIdx.x; asm volatile("" : "+s"(bx)); const int G = gridDim.x;
    float* rope = (float*)(ws + WS_ROPE); float* ssq = (float*)(ws + WS_SSQ);
    bf16* H = (bf16*)(ws + WS_H); bf16* PROJ = (bf16*)(ws + WS_PROJ); bf16* QB = (bf16*)(ws + WS_Q); bf16* KVB = (bf16*)(ws + WS_KV);
    bf16* CAT = (bf16*)(ws + WS_CAT); bf16* MIX = (bf16*)(ws + WS_MIX); bf16* ACT = (bf16*)(ws + WS_ACT);
    pg8::StaticOrder S;
    if constexpr (WHICH == 0) { pg8::Gemm g{H, (const bf16*)(wl + W_IN), M, INP, DM, DM}; S.init(M, INP, G, bx); pg8::Epi<2> E{PROJ, INP, rope, ssq};
        pg8::gemm_phase<pg8::Epi<2>, pg8::StaticOrder, true, true>(lds_ + RING_OFF, g, S, E); }
    if constexpr (WHICH == 1) { pg8::Gemm g{PROJ + C_CQ, (const bf16*)(wl + W_Q), M, QW, 1024, INP}; S.init(M, QW, G, bx); pg8::Epi<3> E{QB, QW, rope, ssq};
        pg8::gemm_phase<pg8::Epi<3>, pg8::StaticOrder, true, true>(lds_ + RING_OFF, g, S, E); }
    if constexpr (WHICH == 2) { pg8::Gemm g{PROJ + C_CKV, (const bf16*)(wl + W_KV), M, KVW, 512, INP}; S.init(M, KVW, G, bx); pg8::Epi<4> E{KVB, KVW, rope, ssq};
        pg8::gemm_phase<pg8::Epi<4>, pg8::StaticOrder, true, true>(lds_ + RING_OFF, g, S, E); }
    if constexpr (WHICH == 3) { pg8::Gemm g{CAT, (const bf16*)(wl + W_OUT), M, DM, DM, DM}; S.init(M, DM, G, bx); pg8::Epi<0> E{MIX, DM, rope, ssq};
        pg8::gemm_phase<pg8::Epi<0>, pg8::StaticOrder, true, true>(lds_ + RING_OFF, g, S, E); }
    if constexpr (WHICH == 4) { pg8::Gemm g{H, (const bf16*)(wl + W_UP), M, FF, DM, DM}; S.init(M, FF, G, bx); pg8::Epi<1> E{ACT, FF, rope, ssq};
        pg8::gemm_phase<pg8::Epi<1>, pg8::StaticOrder, true, true>(lds_ + RING_OFF, g, S, E); }
    if constexpr (WHICH == 5) { pg8::Gemm g{ACT, (const bf16*)(wl + W_DOWN), M, DM, FF, FF}; S.init(M, DM, G, bx); pg8::Epi<0> E{MIX, DM, rope, ssq};
        pg8::gemm_phase<pg8::Epi<0>, pg8::StaticOrder, true, true>(lds_ + RING_OFF, g, S, E); }
}
__device__ __forceinline__ void mixer_small_phases(LAS unsigned char* lds_, int l) {
    CArgs* A = fresh_args(); unsigned char* ws = A->ws;
    sgu_phase(lds_, (const bf16*)(ws + WS_PROJ), (bf16*)(ws + WS_CAT), (const bf16*)(ws + WS_W + (size_t)l * LW + W_SGU), A->in[6] + l * 1024, A->in[7] + l * 1024, A->in[9] + l * 1024);
    CArgs* A2 = fresh_args(); unsigned char* ws2 = A2->ws;
    ret1_phase(lds_, (const bf16*)(ws2 + WS_PROJ), (float*)(ws2 + WS_KVS));
}
__global__ void __launch_bounds__(NWAVES * 64, 2) mega_fwd(Args args) {
    extern __shared__ __attribute__((aligned(16))) unsigned char lds[];
    LAS unsigned char* L = (LAS unsigned char*)lds;
    volatile LAS unsigned* MISC = (volatile LAS unsigned*)(L + MISC_OFF);
    for (int u = threadIdx.x; u < (LDS_BYTES - LDSCTL_OFF) / 4; u += NWAVES * 64) ((LAS unsigned*)(L + LDSCTL_OFF))[u] = 0u;
    __syncthreads();
    XcdBarrier bar = xcd_barrier_post((unsigned*)(args.ws + WS_CTL) + CW_BAR, MISC + 8);
#define GRID_BAR() do { for (int bd_ = 0; bd_ < BAR_DUP; ++bd_) { XcdBarrier b_ = bar; asm volatile("" : "+s"(b_.bar), "+s"(b_.x)); xcd_barrier(b_); } } while (0)
    for (int rep_ = 0; rep_ < REP_PRO; ++rep_) prologue_phase(L);
    GRID_BAR();
    for (int l = 0; l < DEPTH; ++l) {
        for (int rep_ = 0; rep_ < REP_IN; ++rep_) gemm_call<0>(L, l);
        GRID_BAR();
        for (int rep_ = 0; rep_ < REP_QKV; ++rep_) { gemm_call<1>(L, l); gemm_call<2>(L, l); }
        for (int rep_ = 0; rep_ < REP_SMALL; ++rep_) mixer_small_phases(L, l);
        GRID_BAR();
        { CArgs* A = fresh_args(); unsigned char* ws = A->ws; ret2_phase(L, (const float*)(ws + WS_KVS), (bf16*)(ws + WS_SB)); }
        for (int rep_ = 0; rep_ < REP_ATTN; ++rep_) attn_phase(L);
        GRID_BAR();
        for (int rep_ = 0; rep_ < REP_RET3; ++rep_) { CArgs* A = fresh_args(); unsigned char* ws = A->ws; ret3_phase(L, (const bf16*)(ws + WS_PROJ), (const bf16*)(ws + WS_SB), (bf16*)(ws + WS_CAT)); }
        GRID_BAR();
        for (int rep_ = 0; rep_ < REP_OUT; ++rep_) gemm_call<3>(L, l);
        GRID_BAR();
        for (int rep_ = 0; rep_ < REP_RES; ++rep_) residual_phase(L, l, 0, rep_ + 1 < REP_RES);
        GRID_BAR();
        for (int rep_ = 0; rep_ < REP_UP; ++rep_) gemm_call<4>(L, l);
        GRID_BAR();
        for (int rep_ = 0; rep_ < REP_DOWN; ++rep_) gemm_call<5>(L, l);
        GRID_BAR();
        for (int rep_ = 0; rep_ < REP_RES; ++rep_) residual_phase(L, l, 1, rep_ + 1 < REP_RES);
        if (l + 1 < DEPTH) GRID_BAR();
    }
}

extern "C" void kernel_launch(void* const* d_in, const int* in_sizes, int n_in, void* d_out, int out_size, void* d_ws, size_t ws_size, hipStream_t stream) {
    static int grid = 0;
    if (grid == 0) {
        if (n_in != 17 || in_sizes[0] != M * DM || out_size != M * DM || ws_size < WS_END) { fprintf(stderr, "kernel_launch: shape mismatch (n_in %d, in0 %d, out %d, ws %zu < %zu)\n", n_in, n_in > 0 ? in_sizes[0] : -1, out_size, ws_size, (size_t)WS_END); grid = -1; return; }
        int dev = 0, cus = 0, per_cu = 0;
        if (hipGetDevice(&dev) != hipSuccess || hipDeviceGetAttribute(&cus, hipDeviceAttributeMultiprocessorCount, dev) != hipSuccess) { grid = -1; return; }
        if (hipFuncSetAttribute((const void*)mega_fwd, hipFuncAttributeMaxDynamicSharedMemorySize, LDS_BYTES) != hipSuccess) { fprintf(stderr, "kernel_launch: hipFuncSetAttribute failed\n"); grid = -1; return; }
        if (hipOccupancyMaxActiveBlocksPerMultiprocessor(&per_cu, (const void*)mega_fwd, NWAVES * 64, LDS_BYTES) != hipSuccess || per_cu < 1)
            fprintf(stderr, "kernel_launch: note: occupancy query reports %d workgroups per CU\n", per_cu);
        (void)hipGetLastError();
        grid = cus;
    }
    if (grid < 0) return;
    if (hipMemsetAsync((char*)d_ws + WS_CTL, 0, CTL_ZERO_BYTES, stream) != hipSuccess) { fprintf(stderr, "kernel_launch: memset failed\n"); return; }
    Args a{};
    for (int i = 0; i < 17; ++i) a.in[i] = (const float*)d_in[i];
    a.out = (float*)d_out; a.ws = (unsigned char*)d_ws;
    hipLaunchKernelGGL(mega_fwd, dim3(grid), dim3(NWAVES * 64), LDS_BYTES, stream, a);
    const hipError_t le = hipPeekAtLastError();
    if (le != hipSuccess) fprintf(stderr, "kernel_launch: launch failed: %s\n", hipGetErrorName(le));
}
```

```cpp
#include <hip/hip_runtime.h>
#include <cstdio>
#include <cstdint>
namespace pg8 {
#define PG8_LAS __attribute__((address_space(3)))
typedef unsigned short bf16_t;
typedef short bf16x8 __attribute__((ext_vector_type(8)));
typedef float f32x4 __attribute__((ext_vector_type(4)));
typedef unsigned u32x4 __attribute__((ext_vector_type(4)));
constexpr int BM = 256, BK = 64, HALF = 128, HTB = HALF * BK * 2  , STAGE_BYTES = 8 * HTB, NXCD = 8, WGM = 8;

__host__ __device__ __forceinline__ int lds_byte(int r, int c) { const int st = (r >> 4) * 2 + (c >> 5), rr = r & 15, cc = c & 31, ob = rr * 64 + cc * 2; return st * 1024 + (ob ^ (((ob >> 9) & 1) << 5)); }
__host__ __device__ __forceinline__ void stage_rc(int b, int& R, int& C) { const int st = b / 1024, sb = b % 1024, swz = sb ^ (((sb >> 9) & 1) << 5); R = (st >> 1) * 16 + swz / 64; C = (st & 1) * 32 + (swz % 64) / 2; }
__host__ __device__ __forceinline__ int perm32(int rho) { const int n = rho >> 4, i = rho & 15; return 8 * (i >> 2) + 4 * n + (i & 3); }

struct Unit { int pm, pn; };
struct Gemm { const bf16_t* A; const bf16_t* Bt; int M, N, K, lda; };

struct StaticOrder {
    int nM, nN, nwg, G, c;
    __host__ __device__ void init(int M, int N, int G_, int c_) { nM = M / BM; nN = N / BM; nwg = nM * nN; G = G_; c = c_; }
    __host__ __device__ bool next(int i, Unit& u) const {
        const long L = (long)i * G + c; if (L >= nwg) return false;
        int wgid = (int)L; { const int q = nwg / NXCD, r = nwg % NXCD, xcd = wgid % NXCD, off = wgid / NXCD; wgid = (xcd < r ? xcd * (q + 1) : r * (q + 1) + (xcd - r) * q) + off; }
        const int nig = WGM * nN, gid = wgid / nig, fm = gid * WGM, gsz = (nM - fm) < WGM ? (nM - fm) : WGM;
        u.pm = fm + ((wgid % nig) % gsz); u.pn = (wgid % nig) / gsz; return true;
    }
    __device__ __forceinline__ void a_ready(const Unit&) const {}
    __device__ __forceinline__ void done(const Unit&) const {}
};
__device__ __forceinline__ unsigned cvt_pk_bf16(float lo, float hi) { unsigned r; asm volatile("v_cvt_pk_bf16_f32 %0, %1, %2" : "=v"(r) : "v"(lo), "v"(hi)); return r; }
__device__ __forceinline__ void rope8(f32x4& v0, f32x4& v1, const float* tab) {
    const f32x4 t0 = *(const f32x4*)tab, t1 = *(const f32x4*)(tab + 4);
    f32x4 a, b;
    a[0] = v0[0] * t0[0] - v0[1] * t0[1]; a[1] = v0[0] * t0[1] + v0[1] * t0[0];
    a[2] = v0[2] * t0[2] - v0[3] * t0[3]; a[3] = v0[2] * t0[3] + v0[3] * t0[2];
    b[0] = v1[0] * t1[0] - v1[1] * t1[1]; b[1] = v1[0] * t1[1] + v1[1] * t1[0];
    b[2] = v1[2] * t1[2] - v1[3] * t1[3]; b[3] = v1[2] * t1[3] + v1[3] * t1[2];
    v0 = a; v1 = b;
}
template <int MODE> struct Epi {
    static constexpr bool PERM = true, AFTER_DRAIN = false;
    bf16_t* O; int ldc; const float* rope; float* ssq;
    __device__ __forceinline__ void operator()(const f32x4 (&acc)[2][2][4][2], const Unit& u, int wr, int wc, int fr, int fq) const {
        const int row0 = u.pm * BM + wr * 64 + fr, colt = u.pn * BM + wc * 32 + 8 * fq;
        const bool want_ss = (MODE == 2) && u.pn >= 8 && u.pn < 14;
#pragma unroll
        for (int ai = 0; ai < 2; ++ai)
#pragma unroll
            for (int m = 0; m < 4; ++m) {
                const int row = row0 + ai * HALF + m * 16;
                float rs = 1.f;
                if (MODE == 3) { const f32x4* s = (const f32x4*)(ssq + (size_t)row * 24); const f32x4 a = s[0], b = s[1], c = s[2], d = s[3];
                    const float t = ((a[0] + a[1]) + (a[2] + a[3])) + ((b[0] + b[1]) + (b[2] + b[3])) + ((c[0] + c[1]) + (c[2] + c[3])) + ((d[0] + d[1]) + (d[2] + d[3]));
                    rs = 1.0f / sqrtf(t * (1.0f / 1024.0f) + 1e-6f); }
                if (MODE == 4) { const f32x4* s = (const f32x4*)(ssq + (size_t)row * 24); const f32x4 a = s[4], b = s[5];
                    const float t = ((a[0] + a[1]) + (a[2] + a[3])) + ((b[0] + b[1]) + (b[2] + b[3]));
                    rs = 1.0f / sqrtf(t * (1.0f / 512.0f) + 1e-6f); }
                float part = 0.f;
#pragma unroll
                for (int bj = 0; bj < 2; ++bj) {
                    const int col = colt + bj * HALF;
                    f32x4 v0 = acc[ai][bj][m][0], v1 = acc[ai][bj][m][1];
                    if (MODE == 1) {
#pragma unroll
                        for (int j = 0; j < 4; ++j) { const float p = fmaxf(v0[j], 0.f), q = fmaxf(v1[j], 0.f); v0[j] = p * p; v1[j] = q * q; } }
                    if (MODE == 2) {
                        if (want_ss) part += ((v0[0] * v0[0] + v0[1] * v0[1]) + (v0[2] * v0[2] + v0[3] * v0[3])) + ((v1[0] * v1[0] + v1[1] * v1[1]) + (v1[2] * v1[2] + v1[3] * v1[3]));
                        if (col >= 3584 && col < 4672) rope8(v0, v1, rope + ((size_t)(row & 4095) * 32 + ((col & 63) >> 1)) * 2); }
                    if (MODE == 3) { v0 = v0 * rs; v1 = v1 * rs; if ((col % 192) >= 128) rope8(v0, v1, rope + ((size_t)(row & 4095) * 32 + ((col & 63) >> 1)) * 2); }
                    if (MODE == 4) { v0 = v0 * rs; v1 = v1 * rs; }
                    u32x4 w; w.x = cvt_pk_bf16(v0[0], v0[1]); w.y = cvt_pk_bf16(v0[2], v0[3]); w.z = cvt_pk_bf16(v1[0], v1[1]); w.w = cvt_pk_bf16(v1[2], v1[3]);
                    *(u32x4*)(O + (size_t)row * ldc + col) = w;
                }
                if (want_ss) { part += __shfl_xor(part, 16); part += __shfl_xor(part, 32); if (fq == 0) ssq[(size_t)row * 24 + (u.pn - 8) * 4 + wc] = part; }
            }
    }
};
template <class Epi, class Sched, bool ALIGN_EPI = false, bool SP2 = false>
__device__ __forceinline__ void gemm_phase(PG8_LAS unsigned char* lds, const Gemm g, const Sched& S, const Epi& E) {
    int tid_ = threadIdx.x; asm volatile("" : "+v"(tid_));
    const int tid = tid_, wid = __builtin_amdgcn_readfirstlane(tid >> 6), lane = tid & 63, wr = wid >> 2, wc = wid & 3, fr = lane & 15, fq = lane >> 4;
    const int K = g.K, nt = K / BK;
    unsigned voffA[2], voffB[2];
#pragma unroll
    for (int i = 0; i < 2; ++i) { int R, C; stage_rc(tid * 16 + i * 8192, R, C); const int Rb = Epi::PERM ? ((R & ~31) + perm32(R & 31)) : R;
        voffA[i] = (unsigned)(R * g.lda + C) * 2u; voffB[i] = (unsigned)(Rb * K + C) * 2u; }
    const size_t kstep = (size_t)(BK * 2);
    const size_t hstep = (size_t)HALF * K * 2;
    const size_t tstep = 2 * hstep; const size_t hstepA = (size_t)HALF * g.lda * 2, tstepA = 2 * hstepA;
    const unsigned ldsw = (unsigned)wid * 1024u;
    const int aoff = lds_byte(wr * 64 + fr, fq * 8), boff = lds_byte(wc * 32 + fr, fq * 8);
#define PG8_SA(b, h) (((b) * 2 + (h)) * HTB)
#define PG8_SB(b, h) ((4 + (b) * 2 + (h)) * HTB)
#define PG8_STAGE(bufoff, gbase, voff) do { _Pragma("unroll") for (int _i = 0; _i < 2; ++_i) \
        __builtin_amdgcn_global_load_lds((const unsigned*)((const char*)(gbase) + (voff)[_i]), (PG8_LAS unsigned*)(lds + (bufoff) + ldsw + _i * 8192), 16, 0, 0); } while (0)
#define PG8_LDA(dst, b, h) do { _Pragma("unroll") for (int m = 0; m < 4; ++m) _Pragma("unroll") for (int k = 0; k < 2; ++k) dst[m][k] = *(const PG8_LAS bf16x8*)(lds + PG8_SA(b, h) + aoff + m * 2048 + k * 1024); } while (0)
#define PG8_LDB(dst, b, h) do { _Pragma("unroll") for (int n = 0; n < 2; ++n) _Pragma("unroll") for (int k = 0; k < 2; ++k) dst[n][k] = *(const PG8_LAS bf16x8*)(lds + PG8_SB(b, h) + boff + n * 2048 + k * 1024); } while (0)
#define PG8_MMA(ai, bj, At, Bt) do { __builtin_amdgcn_s_setprio(1); _Pragma("unroll") for (int m = 0; m < 4; ++m) _Pragma("unroll") for (int n = 0; n < 2; ++n) _Pragma("unroll") for (int k = 0; k < 2; ++k) \
        acc[ai][bj][m][n] = __builtin_amdgcn_mfma_f32_16x16x32_bf16(Bt[n][k], At[m][k], acc[ai][bj][m][n], 0, 0, 0); __builtin_amdgcn_s_setprio(0); } while (0)
#define PG8_WAIT_V(n) asm volatile("s_waitcnt vmcnt(" #n ")" ::: "memory")
#define PG8_WAIT_L(n) asm volatile("s_waitcnt lgkmcnt(" #n ")" ::: "memory")
#define PG8_BAR __builtin_amdgcn_s_barrier()
#define PG8_SCHED __builtin_amdgcn_sched_barrier(0)
    Unit cur, nxt; int ui = 0;
    if (!S.next(0, cur)) return;
    f32x4 acc[2][2][4][2];
#pragma unroll
    for (int a = 0; a < 2; ++a)
#pragma unroll
        for (int b = 0; b < 2; ++b)
#pragma unroll
            for (int m = 0; m < 4; ++m)
#pragma unroll
                for (int n = 0; n < 2; ++n) acc[a][b][m][n] = (f32x4){0.f, 0.f, 0.f, 0.f};
    bf16x8 At[4][2], B0[2][2], B1[2][2];
    const char* cA = (const char*)g.A + (size_t)cur.pm * tstepA; const char* cB = (const char*)g.Bt + (size_t)cur.pn * tstep;
    S.a_ready(cur);
    if constexpr (SP2) {
        PG8_STAGE(PG8_SB(0, 0), cB, voffB); PG8_STAGE(PG8_SB(0, 1), cB + hstep, voffB); PG8_STAGE(PG8_SA(0, 0), cA, voffA); PG8_STAGE(PG8_SA(0, 1), cA + hstepA, voffA);
        if (wr == 1) PG8_BAR;
        PG8_WAIT_V(2); PG8_BAR;
        PG8_STAGE(PG8_SB(1, 0), cB + kstep, voffB); PG8_STAGE(PG8_SA(1, 0), cA + kstep, voffA); PG8_STAGE(PG8_SB(1, 1), cB + hstep + kstep, voffB);
        PG8_WAIT_V(6); PG8_BAR;
    } else {
        PG8_STAGE(PG8_SB(0, 0), cB, voffB); PG8_STAGE(PG8_SA(0, 0), cA, voffA); PG8_STAGE(PG8_SB(0, 1), cB + hstep, voffB); PG8_STAGE(PG8_SA(0, 1), cA + hstepA, voffA);
        if (wr == 1) PG8_BAR;
        PG8_WAIT_V(4); PG8_BAR;
        PG8_STAGE(PG8_SB(1, 0), cB + kstep, voffB); PG8_STAGE(PG8_SA(1, 0), cA + kstep, voffA); PG8_STAGE(PG8_SB(1, 1), cB + hstep + kstep, voffB);
        PG8_WAIT_V(6); PG8_BAR;
    }
    for (;;) {
        const bool has_next = S.next(ui + 1, nxt);
        const char* nA = has_next ? (const char*)g.A + (size_t)nxt.pm * tstepA : cA; const char* nB = has_next ? (const char*)g.Bt + (size_t)nxt.pn * tstep : cB;
        for (int t = 0; t < nt; t += 2) {
            const bool last = (t == nt - 2);
            const char* a1 = cA + (size_t)(t + 1) * kstep;
            const char* a2 = last ? nA : cA + (size_t)(t + 2) * kstep; const char* b2 = last ? nB : cB + (size_t)(t + 2) * kstep;
            const char* a3 = a2 + kstep; const char* b3 = b2 + kstep;
            if (last && has_next) S.a_ready(nxt);
            if constexpr (SP2) {
            PG8_LDB(B0, 0, 0); PG8_LDB(B1, 0, 1); PG8_SCHED; PG8_LDA(At, 0, 0); PG8_STAGE(PG8_SA(1, 1), a1 + hstepA, voffA);
            PG8_WAIT_V(8); PG8_WAIT_L(0); PG8_BAR; PG8_MMA(0, 0, At, B0); PG8_MMA(0, 1, At, B1); PG8_BAR; PG8_SCHED;
            PG8_LDA(At, 0, 1); PG8_STAGE(PG8_SB(0, 0), b2, voffB); PG8_STAGE(PG8_SB(0, 1), b2 + hstep, voffB); PG8_STAGE(PG8_SA(0, 0), a2, voffA);
            PG8_WAIT_V(8); PG8_WAIT_L(0); PG8_BAR; PG8_MMA(1, 0, At, B0); PG8_MMA(1, 1, At, B1); PG8_BAR; PG8_SCHED;
            PG8_LDB(B0, 1, 0); PG8_LDB(B1, 1, 1); PG8_SCHED; PG8_LDA(At, 1, 0); PG8_STAGE(PG8_SA(0, 1), a2 + hstepA, voffA);
            PG8_WAIT_V(8); PG8_WAIT_L(0); PG8_BAR; PG8_MMA(0, 0, At, B0); PG8_MMA(0, 1, At, B1); PG8_BAR; PG8_SCHED;
            PG8_LDA(At, 1, 1); PG8_STAGE(PG8_SB(1, 0), b3, voffB); PG8_STAGE(PG8_SB(1, 1), b3 + hstep, voffB); PG8_STAGE(PG8_SA(1, 0), a3, voffA);
            PG8_WAIT_V(8); PG8_WAIT_L(0); PG8_BAR; PG8_MMA(1, 0, At, B0); PG8_MMA(1, 1, At, B1); PG8_BAR; PG8_SCHED;
            } else {
            PG8_LDB(B0, 0, 0); PG8_SCHED; PG8_LDA(At, 0, 0); PG8_STAGE(PG8_SA(1, 1), a1 + hstepA, voffA);
            PG8_WAIT_L(8); PG8_BAR; PG8_WAIT_L(0); PG8_MMA(0, 0, At, B0); PG8_BAR; PG8_SCHED;
            PG8_LDB(B1, 0, 1); PG8_STAGE(PG8_SB(0, 0), b2, voffB);
            PG8_BAR; PG8_WAIT_L(0); PG8_MMA(0, 1, At, B1); PG8_BAR;
            PG8_LDA(At, 0, 1); PG8_STAGE(PG8_SA(0, 0), a2, voffA);
            PG8_BAR; PG8_WAIT_L(0); PG8_MMA(1, 0, At, B0); PG8_BAR; PG8_SCHED;
            PG8_STAGE(PG8_SB(0, 1), b2 + hstep, voffB);
            PG8_WAIT_V(6); PG8_BAR; PG8_MMA(1, 1, At, B1); PG8_BAR;
            PG8_LDB(B0, 1, 0); PG8_SCHED; PG8_LDA(At, 1, 0); PG8_STAGE(PG8_SA(0, 1), a2 + hstepA, voffA);
            PG8_WAIT_L(8); PG8_BAR; PG8_WAIT_L(0); PG8_MMA(0, 0, At, B0); PG8_BAR; PG8_SCHED;
            PG8_LDB(B1, 1, 1); PG8_STAGE(PG8_SB(1, 0), b3, voffB);
            PG8_BAR; PG8_WAIT_L(0); PG8_MMA(0, 1, At, B1); PG8_BAR;
            PG8_LDA(At, 1, 1); PG8_STAGE(PG8_SA(1, 0), a3, voffA);
            PG8_BAR; PG8_WAIT_L(0); PG8_MMA(1, 0, At, B0); PG8_BAR; PG8_SCHED;
            PG8_STAGE(PG8_SB(1, 1), b3 + hstep, voffB);
            PG8_WAIT_V(6); PG8_BAR; PG8_MMA(1, 1, At, B1); PG8_BAR;
            }
        }
        if constexpr (ALIGN_EPI) { if (wr == 0) PG8_BAR; }
        if constexpr (!Epi::AFTER_DRAIN) { E(acc, cur, wr, wc, fr, fq); S.done(cur); }
        if (!has_next) break;
#pragma unroll
        for (int a = 0; a < 2; ++a)
#pragma unroll
            for (int b = 0; b < 2; ++b)
#pragma unroll
                for (int m = 0; m < 4; ++m)
#pragma unroll
                    for (int n = 0; n < 2; ++n) acc[a][b][m][n] = (f32x4){0.f, 0.f, 0.f, 0.f};
        cur = nxt; cA = nA; cB = nB; ++ui;
        if constexpr (ALIGN_EPI) { if (wr == 1) PG8_BAR; }
    }
    PG8_WAIT_V(0);
    if constexpr (!ALIGN_EPI) { if (wr == 0) PG8_BAR; }
    PG8_BAR;
    if constexpr (Epi::AFTER_DRAIN) { E.fused(acc, cur, wr, wc, fr, fq, lds, wid, lane); S.done(cur); }
#undef PG8_SA
#undef PG8_SB
#undef PG8_STAGE
#undef PG8_LDA
#undef PG8_LDB
#undef PG8_MMA
#undef PG8_WAIT_V
#undef PG8_WAIT_L
#undef PG8_BAR
#undef PG8_SCHED
}
}
namespace att {
#define ATT_LAS __attribute__((address_space(3)))
typedef unsigned short bf16;
using bf16x8 = __attribute__((ext_vector_type(8))) short;
using s16x4  = __attribute__((ext_vector_type(4))) short;
using f32x16 = __attribute__((ext_vector_type(16))) float;
using u32x4  = __attribute__((ext_vector_type(4))) unsigned;
constexpr float SCALE = 0.07216878364870322f;
constexpr float THR = 8.f;
constexpr int SHM_V = 16384, SHM_K = 16384, SHM_R = 8192;
constexpr int OFF_V = 0, OFF_K = 2 * SHM_V, OFF_R = OFF_K + 2 * SHM_K, OFF_WS = OFF_R + 2 * SHM_R, ATT_LDS_BYTES = OFF_WS + 8 * 64 * 4;
#define KSWZ(row, colB) ((row) * 256 + ((colB) ^ (((row) & 7) << 4)))
#define RSWZ(row, colB) ((row) * 128 + ((colB) ^ (((row) & 7) << 4)))
#define SBAR() __builtin_amdgcn_sched_barrier(0)
__device__ __forceinline__ int crow(int r, int hi) { return (r & 3) + 8 * (r >> 2) + 4 * hi; }
__device__ __forceinline__ unsigned cvtpk(float lo, float hi) { unsigned r; asm volatile("v_cvt_pk_bf16_f32 %0, %1, %2" : "=v"(r) : "v"(lo), "v"(hi)); return r; }
__device__ __forceinline__ void partialSM(f32x16& p0, f32x16& p1, float& m_reg, float& mn, float& alpha) {
  constexpr float C = SCALE * 1.4426950408889634f;
  float pmax = p0[0];
#pragma unroll
  for (int r = 1; r < 16; ++r) pmax = fmaxf(pmax, p0[r]);
#pragma unroll
  for (int r = 0; r < 16; ++r) pmax = fmaxf(pmax, p1[r]);
  { auto rr = __builtin_amdgcn_permlane32_swap(__float_as_uint(pmax), __float_as_uint(pmax), false, false);
    pmax = fmaxf(__uint_as_float(rr[0]), __uint_as_float(rr[1])); }
  if (__builtin_expect(__all(pmax - m_reg <= THR / SCALE), 1)) { mn = m_reg; alpha = 1.f; }
  else { mn = fmaxf(m_reg, pmax); alpha = __builtin_amdgcn_exp2f((m_reg - mn) * C); m_reg = mn; }
  float mnC = -mn * C;
#pragma unroll
  for (int r = 0; r < 16; ++r) p0[r] = fmaf(p0[r], C, mnC);
#pragma unroll
  for (int r = 0; r < 16; ++r) p1[r] = fmaf(p1[r], C, mnC);
#pragma unroll
  for (int r = 0; r < 16; ++r) p0[r] = __builtin_amdgcn_exp2f(p0[r]);
}
__device__ __forceinline__ void finishSM(f32x16& p0, f32x16& p1, float alpha, float& l_reg, bf16x8& pa0, bf16x8& pa1, bf16x8& pa2, bf16x8& pa3) {
#pragma unroll
  for (int r = 0; r < 16; ++r) p1[r] = __builtin_amdgcn_exp2f(p1[r]);
  float ps = 0;
#pragma unroll
  for (int r = 0; r < 16; ++r) ps += p0[r];
#pragma unroll
  for (int r = 0; r < 16; ++r) ps += p1[r];
  { auto rr = __builtin_amdgcn_permlane32_swap(__float_as_uint(ps), __float_as_uint(ps), false, false);
    ps = __uint_as_float(rr[0]) + __uint_as_float(rr[1]); }
  l_reg = l_reg * alpha + ps;
#define PK4(P, BASE, OUT) do { unsigned a0 = cvtpk(P[BASE + 0], P[BASE + 1]), a1 = cvtpk(P[BASE + 2], P[BASE + 3]);   \
    unsigned b0 = cvtpk(P[BASE + 4], P[BASE + 5]), b1 = cvtpk(P[BASE + 6], P[BASE + 7]);                              \
    auto r0 = __builtin_amdgcn_permlane32_swap(a0, b0, false, false); auto r1 = __builtin_amdgcn_permlane32_swap(a1, b1, false, false); \
    u32x4 w = {r0[0], r1[0], r0[1], r1[1]}; OUT = *reinterpret_cast<bf16x8*>(&w); } while (0)
  PK4(p0, 0, pa0); PK4(p0, 8, pa1); PK4(p1, 0, pa2); PK4(p1, 8, pa3);
#undef PK4
}
__device__ __forceinline__ void qkt(f32x16& p0, f32x16& p1, const ATT_LAS char* Ks, const ATT_LAS char* Rs, const bf16x8* qr, int r32, int hi) {
  p0 = f32x16{}; p1 = f32x16{};
#pragma unroll
  for (int d0 = 0; d0 < 8; ++d0) { const int cb = (d0 * 16 + hi * 8) * 2;
    const bf16x8 b0 = *reinterpret_cast<const ATT_LAS bf16x8*>(Ks + KSWZ(r32, cb));
    const bf16x8 b1 = *reinterpret_cast<const ATT_LAS bf16x8*>(Ks + KSWZ(32 + r32, cb));
    p0 = __builtin_amdgcn_mfma_f32_32x32x16_bf16(b0, qr[d0], p0, 0, 0, 0);
    p1 = __builtin_amdgcn_mfma_f32_32x32x16_bf16(b1, qr[d0], p1, 0, 0, 0); }
#pragma unroll
  for (int d0 = 0; d0 < 4; ++d0) { const int cb = (d0 * 16 + hi * 8) * 2;
    const bf16x8 b0 = *reinterpret_cast<const ATT_LAS bf16x8*>(Rs + RSWZ(r32, cb));
    const bf16x8 b1 = *reinterpret_cast<const ATT_LAS bf16x8*>(Rs + RSWZ(32 + r32, cb));
    p0 = __builtin_amdgcn_mfma_f32_32x32x16_bf16(b0, qr[8 + d0], p0, 0, 0, 0);
    p1 = __builtin_amdgcn_mfma_f32_32x32x16_bf16(b1, qr[8 + d0], p1, 0, 0, 0); }
}
__device__ __forceinline__ int v_st(int k, int c) { const int kk = (k & ~0xC) | ((k & 4) << 1) | ((k & 8) >> 1); return ((kk >> 3) * 4 + (c >> 5)) * 512 + ((kk & 7) * 32 + (c & 31)) * 2; }
__device__ __forceinline__ int v_rd_base(int lane) { return ((lane & 3) << 3) | (((lane >> 2) & 3) << 6) | (((lane >> 4) & 1) << 5) | (((lane >> 5) & 1) << 8); }
constexpr int v_rd_off(int d0, int ks, int half) { return d0 * 512 + ks * 4096 + half * 2048; }
template <int OFF> __device__ __forceinline__ s16x4 tr_read(int vb) {
  s16x4 r; asm volatile("ds_read_b64_tr_b16 %0, %1 offset:%2" : "=&v"(r) : "v"(vb), "i"(OFF) : "memory"); return r;
}
template <int D0> __device__ __forceinline__ void pv_one(f32x16& od, int vb, bf16x8 pa0, bf16x8 pa1, bf16x8 pa2, bf16x8 pa3) {
  const s16x4 l0 = tr_read<v_rd_off(D0, 0, 0)>(vb), h0 = tr_read<v_rd_off(D0, 0, 1)>(vb), l1 = tr_read<v_rd_off(D0, 1, 0)>(vb), h1 = tr_read<v_rd_off(D0, 1, 1)>(vb);
  const s16x4 l2 = tr_read<v_rd_off(D0, 2, 0)>(vb), h2 = tr_read<v_rd_off(D0, 2, 1)>(vb), l3 = tr_read<v_rd_off(D0, 3, 0)>(vb), h3 = tr_read<v_rd_off(D0, 3, 1)>(vb);
  asm volatile("s_waitcnt lgkmcnt(0)" ::: "memory"); SBAR();
#define PK(L, H) (bf16x8){L[0], L[1], L[2], L[3], H[0], H[1], H[2], H[3]}
  od = __builtin_amdgcn_mfma_f32_32x32x16_bf16(pa0, PK(l0, h0), od, 0, 0, 0);
  od = __builtin_amdgcn_mfma_f32_32x32x16_bf16(pa1, PK(l1, h1), od, 0, 0, 0);
  od = __builtin_amdgcn_mfma_f32_32x32x16_bf16(pa2, PK(l2, h2), od, 0, 0, 0);
  od = __builtin_amdgcn_mfma_f32_32x32x16_bf16(pa3, PK(l3, h3), od, 0, 0, 0);
#undef PK
}
__device__ __forceinline__ void pv_d0(f32x16* o, int vb, bf16x8 pa0, bf16x8 pa1, bf16x8 pa2, bf16x8 pa3) {
  pv_one<0>(o[0], vb, pa0, pa1, pa2, pa3); pv_one<1>(o[1], vb, pa0, pa1, pa2, pa3); pv_one<2>(o[2], vb, pa0, pa1, pa2, pa3); pv_one<3>(o[3], vb, pa0, pa1, pa2, pa3);
}
__device__ __forceinline__ unsigned short f2bf(float f) { unsigned u = __builtin_bit_cast(unsigned, f); return (unsigned short)((u + 0x7fffu + ((u >> 16) & 1u)) >> 16); }
__device__ __forceinline__ void attn_unit(const bf16* __restrict__ Q, const bf16* __restrict__ KV, const bf16* __restrict__ PROJ, bf16* __restrict__ CAT, int b, int h, int qb, ATT_LAS char* lds) {
  int tid_ = threadIdx.x; asm volatile("" : "+v"(tid_));
  const int tid = tid_, wid = __builtin_amdgcn_readfirstlane(tid >> 6), lane = tid & 63, r32 = lane & 31, hi = lane >> 5;
  ATT_LAS char* V_lds = lds + OFF_V; ATT_LAS char* K_lds = lds + OFF_K; ATT_LAS char* R_lds = lds + OFF_R;
  ATT_LAS float* wsp = (ATT_LAS float*)(lds + OFF_WS) + wid * 64; ATT_LAS float* li_l = wsp; ATT_LAS float* al_l = wsp + 32;
  float m_reg = -1e30f, l_reg = 0; f32x16 o[4] = {}; bf16x8 qr[12];
  const size_t tok0 = (size_t)b * 4096;
  const bf16* Qw = Q + (tok0 + (size_t)qb * 256 + wid * 32 + r32) * 3072 + h * 192 + hi * 8;
#pragma unroll
  for (int d0 = 0; d0 < 12; ++d0) qr[d0] = *reinterpret_cast<const bf16x8*>(Qw + d0 * 16);
  const int cw = qb * 4 + (wid >> 1), NT = qb * 4 + 4;
  const int sr = tid >> 4, sc = (tid & 15) * 8, vst0 = v_st(sr, sc), vst1 = v_st(32 + sr, sc), kst0 = KSWZ(sr, sc * 2), kst1 = KSWZ(32 + sr, sc * 2);
  const int rr = tid >> 3, rc = (tid & 7) * 8, rst = RSWZ(rr, rc * 2);
  const bf16* Kg = KV + tok0 * 4096 + h * 256;
  const bf16* Rg = PROJ + tok0 * 6912 + 3584;
  const int vb0 = (int)(uintptr_t)V_lds + v_rd_base(lane);
  bf16x8 sv0, sv1, sk0, sk1, srp;
#define ATT_SLOAD(k0) do { sv0 = *reinterpret_cast<const bf16x8*>(Kg + (size_t)((k0) + sr) * 4096 + 128 + sc); sv1 = *reinterpret_cast<const bf16x8*>(Kg + (size_t)((k0) + 32 + sr) * 4096 + 128 + sc); \
    sk0 = *reinterpret_cast<const bf16x8*>(Kg + (size_t)((k0) + sr) * 4096 + sc); sk1 = *reinterpret_cast<const bf16x8*>(Kg + (size_t)((k0) + 32 + sr) * 4096 + sc); \
    srp = *reinterpret_cast<const bf16x8*>(Rg + (size_t)((k0) + rr) * 6912 + rc); } while (0)
#define ATT_SWRITE(bf) do { *reinterpret_cast<ATT_LAS bf16x8*>(V_lds + (bf) * SHM_V + vst0) = sv0; *reinterpret_cast<ATT_LAS bf16x8*>(V_lds + (bf) * SHM_V + vst1) = sv1; \
    *reinterpret_cast<ATT_LAS bf16x8*>(K_lds + (bf) * SHM_K + kst0) = sk0; *reinterpret_cast<ATT_LAS bf16x8*>(K_lds + (bf) * SHM_K + kst1) = sk1; \
    *reinterpret_cast<ATT_LAS bf16x8*>(R_lds + (bf) * SHM_R + rst) = srp; } while (0)
#define ATT_RESC(a) do { if (__any((a) < 1.f)) { if (hi == 0) al_l[r32] = (a); asm volatile("s_waitcnt lgkmcnt(0)" ::: "memory"); \
    _Pragma("unroll") for (int d = 0; d < 4; ++d) _Pragma("unroll") for (int r = 0; r < 16; ++r) o[d][r] *= al_l[crow(r, hi)]; } } while (0)
  ATT_SLOAD(0); asm volatile("s_waitcnt vmcnt(0)" ::: "memory"); ATT_SWRITE(0); __syncthreads();
  for (int t = 0; t < NT; ++t) {
    const int bf = t & 1;
    if (t + 1 < NT) ATT_SLOAD((t + 1) * 64);
    if (t <= cw) {
      f32x16 p0, p1; float mn, al; bf16x8 pa0, pa1, pa2, pa3;
      qkt(p0, p1, K_lds + bf * SHM_K, R_lds + bf * SHM_R, qr, r32, hi);
      partialSM(p0, p1, m_reg, mn, al);
      ATT_RESC(al);
      finishSM(p0, p1, al, l_reg, pa0, pa1, pa2, pa3); SBAR();
      pv_d0(o, vb0 + bf * SHM_V, pa0, pa1, pa2, pa3);
    }
    if (t + 1 < NT) { asm volatile("s_waitcnt vmcnt(0)" ::: "memory"); ATT_SWRITE(bf ^ 1); }
    __syncthreads();
  }
  if (hi == 0) li_l[r32] = l_reg; asm volatile("s_waitcnt lgkmcnt(0)" ::: "memory");
  float rli[16];
#pragma unroll
  for (int r = 0; r < 16; ++r) rli[r] = __builtin_amdgcn_rcpf(li_l[crow(r, hi)]);
  bf16* Ow = CAT + (tok0 + (size_t)qb * 256 + wid * 32) * 4096 + 1024 + h * 128;
#pragma unroll
  for (int r = 0; r < 16; ++r) { const int orow = crow(r, hi);
#pragma unroll
    for (int d0 = 0; d0 < 4; ++d0) Ow[(size_t)orow * 4096 + d0 * 32 + r32] = f2bf(o[d0][r] * rli[r]); }
#undef ATT_SLOAD
#undef ATT_SWRITE
#undef ATT_RESC
}
}
constexpr int NWAVES = 8;
constexpr int BATCH = 2, SEQ = 4096, DM = 4096, M = BATCH * SEQ, DEPTH = 2, FF = 16384;
constexpr int INW = 6720, INP = 6912;
constexpr int C_U = 0, C_V = 1024, C_CQ = 2048, C_CKV = 3072, C_KR = 3584, C_RQ = 3648, C_RK = 4160, C_RV = 4672, C_RG = 5696;
constexpr int QW = 3072, KVW = 4096;
constexpr float EPS = 1e-6f;
constexpr size_t MiB = 1u << 20;
constexpr size_t WS_CTL = 0, CTL_ZERO_BYTES = 1 * MiB;
constexpr size_t WS_ROPE = 1 * MiB;
constexpr size_t WS_SSQ = 2 * MiB;
constexpr size_t WS_W = 4 * MiB, LW = 353 * MiB;
constexpr size_t W_IN = 0, W_Q = 54 * MiB, W_KV = 60 * MiB, W_OUT = 64 * MiB, W_UP = 96 * MiB, W_DOWN = 224 * MiB, W_SGU = 352 * MiB;
constexpr size_t WS_H = WS_W + 2 * LW;
constexpr size_t WS_PROJ = WS_H + 64 * MiB;
constexpr size_t WS_Q = WS_PROJ + 108 * MiB;
constexpr size_t WS_KV = WS_Q + 48 * MiB;
constexpr size_t WS_CAT = WS_KV + 64 * MiB;
constexpr size_t WS_MIX = WS_CAT + 64 * MiB;
constexpr size_t WS_ACT = WS_MIX + 64 * MiB;
constexpr size_t WS_KVS = WS_ACT + 256 * MiB;
constexpr size_t WS_SB = WS_KVS + 32 * MiB;
constexpr size_t WS_END = WS_SB + 16 * MiB;
static_assert((size_t)INP * DM * 2 == 54 * MiB && (size_t)M * INP * 2 == 108 * MiB, "map");
constexpr int CW_BAR = 4096;
constexpr int RING_OFF = 0, RING_BYTES = 131072;
constexpr int LDSCTL_OFF = RING_BYTES, MISC_OFF = LDSCTL_OFF + 320;
constexpr int LDS_BYTES = 147456;
#define GAS __attribute__((address_space(1)))
#define LAS __attribute__((address_space(3)))
typedef unsigned short bf16;
typedef unsigned v4u __attribute__((ext_vector_type(4)));
typedef float f32x4 __attribute__((ext_vector_type(4)));
typedef short bf16x8 __attribute__((ext_vector_type(8)));
typedef GAS unsigned gu32;
typedef GAS unsigned long long gu64;
#define RLX_AGENT __ATOMIC_RELAXED, __HIP_MEMORY_SCOPE_AGENT
#define LDS_WAIT() asm volatile("s_waitcnt lgkmcnt(0)" ::: "memory")
#define VM_WAIT() asm volatile("s_waitcnt vmcnt(0)" ::: "memory")
__device__ __forceinline__ unsigned long long rt() { return __builtin_amdgcn_s_memrealtime(); }
__device__ __forceinline__ unsigned f2bf(float f) { unsigned u = __builtin_bit_cast(unsigned, f); return (u + 0x7fffu + ((u >> 16) & 1u)) >> 16; }
__device__ __forceinline__ unsigned pk2(float lo, float hi) { return f2bf(lo) | (f2bf(hi) << 16); }

#define XB_TMO      128
#define XB_XCNT(j)  (256  + 64 * (j))
#define XB_XSUB(j)  (1280 + 64 * (j))
#define XB_XGEN(j)  (2304 + 64 * (j))
#define XB_TOP      3328
#define XB_TOPGEN   3392
#define XCD_BAR_WORDS 3456
#define XB_SPIN_CAP (1u << 18)

__device__ __forceinline__ unsigned xb_ld(unsigned* p)              { return __hip_atomic_load(p, __ATOMIC_RELAXED, __HIP_MEMORY_SCOPE_AGENT); }
__device__ __forceinline__ unsigned xb_add(unsigned* p, unsigned v) { return __hip_atomic_fetch_add(p, v, __ATOMIC_RELAXED, __HIP_MEMORY_SCOPE_AGENT); }
__device__ __forceinline__ unsigned xb_xcc_id() { return (unsigned)__builtin_amdgcn_s_getreg((3 << 11) | 20) & 0xFu; }
#define XB_SPIN(cond, bar) do { unsigned _sp = 0; while (cond) { __builtin_amdgcn_s_sleep(1); \
    if ((++_sp & 255u) == 0u) { if (xb_ld(&(bar)[XB_TMO])) break; if (_sp > XB_SPIN_CAP) { atomicAdd(&(bar)[XB_TMO], 1u); break; } } } } while (0)

struct XcdBarrier {
    unsigned* bar; unsigned x;
    volatile LAS unsigned* st;
};

__device__ __forceinline__ XcdBarrier xcd_barrier_post(unsigned* bar, volatile LAS unsigned* st) {
    XcdBarrier b; b.bar = bar; b.x = xb_xcc_id(); b.st = st;
    if (threadIdx.x == 0) (void)xb_add(&bar[XB_XCNT(b.x)], 1u);
    return b;
}
__device__ __forceinline__ void xcd_barrier_complete(unsigned* bar, unsigned x, unsigned& nloc, unsigned& nx) {
    const unsigned G = gridDim.x * gridDim.y * gridDim.z;
    unsigned sum, cnt, mine, sp = 0u;
    for (;;) {
        sum = 0u; cnt = 0u; mine = 0u;
#pragma unroll
        for (unsigned j = 0; j < 16; ++j) { const unsigned c = xb_ld(&bar[XB_XCNT(j)]); sum += c; cnt += (c > 0u) ? 1u : 0u; mine = (j == x) ? c : mine; }
        if (sum == G) break;
        __builtin_amdgcn_s_sleep(1);
        if ((++sp & 255u) == 0u) { if (xb_ld(&bar[XB_TMO])) break; if (sp > XB_SPIN_CAP) { atomicAdd(&bar[XB_TMO], 1u); break; } }
    }
    nloc = mine > 0u ? mine : 1u; nx = cnt > 0u ? cnt : 1u;
}

__device__ __forceinline__ void xcd_barrier(const XcdBarrier& b) {
    asm volatile("s_waitcnt vmcnt(0)" ::: "memory");
    __syncthreads();
    if (threadIdx.x == 0) {
        unsigned* bar = b.bar;
        __builtin_amdgcn_s_waitcnt(0);
        unsigned nloc = b.st[0], nx = b.st[1];
        if (nloc == 0u) { xcd_barrier_complete(bar, b.x, nloc, nx); b.st[0] = nloc; b.st[1] = nx; }
        const unsigned old = xb_add(&bar[XB_XSUB(b.x)], 1u);
        const unsigned gen = old / nloc;
        if (old + 1u == (gen + 1u) * nloc) {
            __builtin_amdgcn_fence(__ATOMIC_RELEASE, "agent");
            asm volatile("s_waitcnt vmcnt(0)" ::: "memory");
            const unsigned og = xb_add(&bar[XB_TOP], 1u);
            const unsigned tg = og / nx;
            if (og + 1u == (tg + 1u) * nx) xb_add(&bar[XB_TOPGEN], 1u);
            else XB_SPIN(xb_ld(&bar[XB_TOPGEN]) == tg, bar);
            __builtin_amdgcn_fence(__ATOMIC_ACQUIRE, "agent");
            xb_add(&bar[XB_XGEN(b.x)], 1u);
            asm volatile("s_waitcnt vmcnt(0)" ::: "memory");
        } else {
            XB_SPIN(xb_ld(&bar[XB_XGEN(b.x)]) == gen, bar);
            __builtin_amdgcn_fence(__ATOMIC_ACQUIRE, "agent");
            asm volatile("s_waitcnt vmcnt(0)" ::: "memory");
        }
    }
    __syncthreads();
}
typedef float f32x16 __attribute__((ext_vector_type(16)));
struct Frame {
    LAS unsigned char* lds; int tid, lane, wave, vcu, G;
};
__device__ __forceinline__ Frame make_frame(LAS unsigned char* lds) {
    Frame F; F.lds = lds; int t = threadIdx.x; asm volatile("" : "+v"(t)); int bx = blockIdx.x; asm volatile("" : "+s"(bx));
    F.tid = t; F.lane = t & 63; F.wave = __builtin_amdgcn_readfirstlane(t >> 6); F.G = gridDim.x;
    F.vcu = (F.G % 8 == 0) ? (bx % 8) * (F.G / 8) + bx / 8 : bx; return F;
}
__device__ __forceinline__ float bf2f(unsigned short h) { return __builtin_bit_cast(float, (unsigned)h << 16); }
__device__ __forceinline__ unsigned short f2bf16(float f) { return (unsigned short)f2bf(f); }
__device__ __forceinline__ float wave_sum(float v) {
#pragma unroll
    for (int o = 1; o < 64; o <<= 1) v += __shfl_xor(v, o);
    return v;
}
__device__ __forceinline__ int crow32(int r, int hi) { return (r & 3) + 8 * (r >> 2) + 4 * hi; }
template <int KSTEPS> __device__ __forceinline__ void mfma_lds(f32x16& acc, const LAS bf16* A, int pa, const LAS bf16* Bt, int pb, int r32, int hi) {
#pragma unroll
    for (int s = 0; s < KSTEPS; ++s) {
        const bf16x8 a = *(const LAS bf16x8*)(A + r32 * pa + s * 16 + hi * 8);
        const bf16x8 b = *(const LAS bf16x8*)(Bt + r32 * pb + s * 16 + hi * 8);
        acc = __builtin_amdgcn_mfma_f32_32x32x16_bf16(a, b, acc, 0, 0, 0);
    }
}
struct CvtDesc { const float* W; bf16* WT; const float* kgain; int K, N, k0, n0, kind; };
__device__ __forceinline__ void cvt_load(const CvtDesc& d, float (&v)[32], int lane) {
    const int nd = d.n0 + (lane & 31); bool ok = true; int sc = nd; float cs = 1.f;
    if (d.kind == 1) { ok = nd < INW; sc = (nd >= C_KR && nd < C_RV) ? (nd & ~63) + ((nd & 63) >> 1) + 32 * (nd & 1) : nd; cs = (nd >= C_RQ && nd < C_RK) ? 0.125f : 1.f; if (!ok) sc = 0; }
    if (d.kind == 2) { sc = ((nd % 192) >= 128) ? (nd & ~63) + ((nd & 63) >> 1) + 32 * (nd & 1) : nd; }
    const float* src = d.W + (size_t)(d.k0 + (lane >> 5)) * d.N + sc;
#pragma unroll
    for (int i = 0; i < 32; ++i) v[i] = __builtin_nontemporal_load(src + (size_t)(2 * i) * d.N);
    if (d.kgain) {
#pragma unroll
        for (int i = 0; i < 32; ++i) v[i] *= d.kgain[d.k0 + 2 * i + (lane >> 5)]; }
    if (d.kind == 1) {
#pragma unroll
        for (int i = 0; i < 32; ++i) v[i] = ok ? v[i] * cs : 0.f; }
}
__device__ __forceinline__ void cvt_finish(const CvtDesc& d, const float (&v)[32], LAS float* scr, int lane) {
#pragma unroll
    for (int i = 0; i < 32; ++i) scr[(2 * i + (lane >> 5)) * 33 + (lane & 31)] = v[i];
    LDS_WAIT(); asm volatile("" ::: "memory");
    const int c = lane & 7;
#pragma unroll
    for (int j = 0; j < 4; ++j) { const int n = (lane >> 3) + 8 * j; const LAS float* s = scr + (8 * c) * 33 + n;
        v4u o; o.x = pk2(s[0 * 33], s[1 * 33]); o.y = pk2(s[2 * 33], s[3 * 33]); o.z = pk2(s[4 * 33], s[5 * 33]); o.w = pk2(s[6 * 33], s[7 * 33]);
        *(GAS v4u*)(d.WT + (size_t)(d.n0 + n) * d.K + d.k0 + 8 * c) = o; }
    LDS_WAIT(); asm volatile("" ::: "memory");
}
__device__ __forceinline__ void rms_row_to_bf16(const float* __restrict__ xrow, const float* __restrict__ g, bf16* __restrict__ orow, int lane) {
    f32x4 v[16]; float s = 0.f;
#pragma unroll
    for (int j = 0; j < 8; ++j) { const f32x4* p = (const f32x4*)(xrow + 8 * (lane + 64 * j)); v[2 * j] = p[0]; v[2 * j + 1] = p[1]; }
#pragma unroll
    for (int j = 0; j < 16; ++j) s += (v[j][0] * v[j][0] + v[j][1] * v[j][1]) + (v[j][2] * v[j][2] + v[j][3] * v[j][3]);
    const float r = 1.0f / sqrtf(wave_sum(s) * (1.0f / 4096.0f) + EPS);
#pragma unroll
    for (int j = 0; j < 8; ++j) { const f32x4* gp = (const f32x4*)(g + 8 * (lane + 64 * j)); const f32x4 g0 = gp[0], g1 = gp[1]; const f32x4 a = v[2 * j] * r * g0, b = v[2 * j + 1] * r * g1;
        v4u o; o.x = pk2(a[0], a[1]); o.y = pk2(a[2], a[3]); o.z = pk2(b[0], b[1]); o.w = pk2(b[2], b[3]);
        *(v4u*)(orow + 8 * (lane + 64 * j)) = o; }
}
__device__ __forceinline__ void residual_row(const float* xin, const bf16* __restrict__ yrow, const float* __restrict__ gpost, float* xout, const float* __restrict__ gnext, bf16* __restrict__ hrow, int lane) {
    f32x4 v[16]; float y[64]; float s = 0.f;
#pragma unroll
    for (int j = 0; j < 8; ++j) { const f32x4* p = (const f32x4*)(xin + 8 * (lane + 64 * j)); v[2 * j] = p[0]; v[2 * j + 1] = p[1];
        const v4u q = *(const v4u*)(yrow + 8 * (lane + 64 * j));
        y[8 * j + 0] = __builtin_bit_cast(float, q.x << 16); y[8 * j + 1] = __builtin_bit_cast(float, q.x & 0xffff0000u); y[8 * j + 2] = __builtin_bit_cast(float, q.y << 16); y[8 * j + 3] = __builtin_bit_cast(float, q.y & 0xffff0000u);
        y[8 * j + 4] = __builtin_bit_cast(float, q.z << 16); y[8 * j + 5] = __builtin_bit_cast(float, q.z & 0xffff0000u); y[8 * j + 6] = __builtin_bit_cast(float, q.w << 16); y[8 * j + 7] = __builtin_bit_cast(float, q.w & 0xffff0000u); }
#pragma unroll
    for (int i = 0; i < 64; ++i) s += y[i] * y[i];
    const float r = 1.0f / sqrtf(wave_sum(s) * (1.0f / 4096.0f) + EPS);
    float s2 = 0.f;
#pragma unroll
    for (int j = 0; j < 8; ++j) { const f32x4* gp = (const f32x4*)(gpost + 8 * (lane + 64 * j)); const f32x4 g0 = gp[0], g1 = gp[1];
        f32x4 a = v[2 * j], b = v[2 * j + 1];
#pragma unroll
        for (int e = 0; e < 4; ++e) { a[e] += y[8 * j + e] * r * g0[e]; b[e] += y[8 * j + 4 + e] * r * g1[e]; }
        v[2 * j] = a; v[2 * j + 1] = b;
        f32x4* op = (f32x4*)(xout + 8 * (lane + 64 * j)); op[0] = a; op[1] = b;
        s2 += (a[0] * a[0] + a[1] * a[1]) + (a[2] * a[2] + a[3] * a[3]) + (b[0] * b[0] + b[1] * b[1]) + (b[2] * b[2] + b[3] * b[3]); }
    if (gnext) {
        const float r2 = 1.0f / sqrtf(wave_sum(s2) * (1.0f / 4096.0f) + EPS);
#pragma unroll
        for (int j = 0; j < 8; ++j) { const f32x4* gp = (const f32x4*)(gnext + 8 * (lane + 64 * j)); const f32x4 g0 = gp[0], g1 = gp[1]; const f32x4 a = v[2 * j] * r2 * g0, b = v[2 * j + 1] * r2 * g1;
            v4u o; o.x = pk2(a[0], a[1]); o.y = pk2(a[2], a[3]); o.z = pk2(b[0], b[1]); o.w = pk2(b[2], b[3]);
            *(v4u*)(hrow + 8 * (lane + 64 * j)) = o; }
    }
}
__device__ __forceinline__ float ret_lg(int h) { return log1pf(-exp2f(-5.0f - (float)h)); }
__device__ __forceinline__ void sgu_phase(LAS unsigned char* lds_, const bf16* __restrict__ PROJ, bf16* __restrict__ CAT, const bf16* __restrict__ SGW, const float* __restrict__ lng, const float* __restrict__ lnb, const float* __restrict__ bs) {
    const Frame F = make_frame(lds_);
    LAS bf16* Wm = (LAS bf16*)(F.lds + RING_OFF);
    LAS bf16* VT = Wm + 128 * 136;
    const int r32 = F.lane & 31, hi = F.lane >> 5;
    for (int unit = F.vcu; unit < 512; unit += F.G) {
        const int b = unit >> 8, n = (unit >> 3) & 31, g = unit & 7;
        const size_t R0 = (size_t)b * SEQ + (size_t)n * 128; const int cb = g * 128;
        for (int q = F.tid; q < 128 * 16; q += NWAVES * 64) { const int i = q >> 4, ch = q & 15;
            *(LAS bf16x8*)(Wm + i * 136 + ch * 8) = *(const bf16x8*)(SGW + ((size_t)g * 128 + i) * 128 + ch * 8); }
        const float g0 = lng[cb + 2 * F.lane], g1 = lng[cb + 2 * F.lane + 1], b0 = lnb[cb + 2 * F.lane], b1 = lnb[cb + 2 * F.lane + 1];
        for (int jj = 0; jj < 16; ++jj) { const int j = F.wave * 16 + jj;
            const unsigned pv = *(const unsigned*)(PROJ + (R0 + j) * INP + C_V + cb + 2 * F.lane);
            const float x0 = __builtin_bit_cast(float, pv << 16), x1 = __builtin_bit_cast(float, pv & 0xffff0000u);
            const float mu = wave_sum(x0 + x1) * (1.0f / 128.0f), d0 = x0 - mu, d1 = x1 - mu;
            const float rstd = 1.0f / sqrtf(wave_sum(d0 * d0 + d1 * d1) * (1.0f / 128.0f) + EPS);
            VT[(2 * F.lane) * 136 + j] = f2bf16(d0 * rstd * g0 + b0); VT[(2 * F.lane + 1) * 136 + j] = f2bf16(d1 * rstd * g1 + b1); }
        __syncthreads();
        const int ib = F.wave >> 1, cb0 = (F.wave & 1) * 2;
        f32x16 acc0 = {}, acc1 = {};
        mfma_lds<8>(acc0, Wm + ib * 32 * 136, 136, VT + (cb0 * 32) * 136, 136, r32, hi);
        mfma_lds<8>(acc1, Wm + ib * 32 * 136, 136, VT + ((cb0 + 1) * 32) * 136, 136, r32, hi);
#pragma unroll
        for (int r = 0; r < 16; ++r) { const int i = ib * 32 + crow32(r, hi); const float bias = bs[g * 128 + i]; const size_t row = R0 + i; const int c = cb0 * 32 + r32;
            const float u0 = bf2f(PROJ[row * INP + C_U + cb + c]), u1 = bf2f(PROJ[row * INP + C_U + cb + c + 32]);
            CAT[row * DM + cb + c] = f2bf16(u0 * (acc0[r] + bias)); CAT[row * DM + cb + c + 32] = f2bf16(u1 * (acc1[r] + bias)); }
        __syncthreads();
    }
}
__device__ __forceinline__ void ret1_phase(LAS unsigned char* lds_, const bf16* __restrict__ PROJ, float* __restrict__ KVS) {
    const Frame F = make_frame(lds_);
    LAS bf16* KT = (LAS bf16*)(F.lds + RING_OFF);
    LAS bf16* VT = KT + 64 * 72;
    const int r32 = F.lane & 31, hi = F.lane >> 5;
    for (int unit = F.vcu; unit < 1024; unit += F.G) {
        const int bh = unit >> 6, c = unit & 63, b = bh >> 3, h = bh & 7; const float lg = ret_lg(h);
        const size_t R0 = (size_t)b * SEQ + (size_t)c * 64;
        const int m = F.tid >> 3, d0 = (F.tid & 7) * 8, e0 = (F.tid & 7) * 16; const float kd = expf(lg * (float)(63 - m));
        const bf16x8 kv = *(const bf16x8*)(PROJ + (R0 + m) * INP + C_RK + h * 64 + d0);
        const bf16x8 va = *(const bf16x8*)(PROJ + (R0 + m) * INP + C_RV + h * 128 + e0), vb = *(const bf16x8*)(PROJ + (R0 + m) * INP + C_RV + h * 128 + e0 + 8);
#pragma unroll
        for (int i = 0; i < 8; ++i) KT[(d0 + i) * 72 + m] = f2bf16(bf2f((unsigned short)kv[i]) * kd);
#pragma unroll
        for (int i = 0; i < 8; ++i) { VT[(e0 + i) * 72 + m] = (unsigned short)va[i]; VT[(e0 + 8 + i) * 72 + m] = (unsigned short)vb[i]; }
        __syncthreads();
        const int eb = F.wave >> 1, db = F.wave & 1;
        f32x16 acc = {};
        mfma_lds<4>(acc, VT + eb * 32 * 72, 72, KT + db * 32 * 72, 72, r32, hi);
#pragma unroll
        for (int r = 0; r < 16; ++r) KVS[((size_t)unit * 128 + eb * 32 + crow32(r, hi)) * 64 + db * 32 + r32] = acc[r];
        __syncthreads();
    }
}
__device__ __forceinline__ void ret2_phase(LAS unsigned char* lds_, const float* __restrict__ KVS, bf16* __restrict__ SB) {
    const Frame F = make_frame(lds_);
    for (int gid = F.vcu * (NWAVES * 64) + F.tid; gid < 16 * 8192; gid += F.G * NWAVES * 64) {
        const int bh = gid >> 13, idx = gid & 8191; const float cd = expf(ret_lg(bh & 7) * 64.0f);
        float S = 0.f;
#pragma unroll 8
        for (int c = 0; c < 64; ++c) { const size_t o = ((size_t)bh * 64 + c) * 8192 + idx; SB[o] = f2bf16(S); S = cd * S + KVS[o]; }
    }
}
__device__ __forceinline__ void ret3_phase(LAS unsigned char* lds_, const bf16* __restrict__ PROJ, const bf16* __restrict__ SB, bf16* __restrict__ CAT) {
    const Frame F = make_frame(lds_);
    LAS bf16* Qs = (LAS bf16*)(F.lds + RING_OFF);
    LAS bf16* Ks = Qs + 64 * 72;
    LAS bf16* VT = Ks + 64 * 72;
    LAS bf16* Ss = VT + 128 * 72;
    LAS bf16* Ps = Ss + 128 * 72;
    LAS float* red = (LAS float*)(Ps + 64 * 72);
    const int r32 = F.lane & 31, hi = F.lane >> 5;
    for (int unit = F.vcu; unit < 1024; unit += F.G) {
        const int bh = unit >> 6, c = unit & 63, b = bh >> 3, h = bh & 7; const float lg = ret_lg(h);
        const size_t R0 = (size_t)b * SEQ + (size_t)c * 64;
        { const int m = F.tid >> 3, d0 = (F.tid & 7) * 8, e0 = (F.tid & 7) * 16;
          *(LAS bf16x8*)(Qs + m * 72 + d0) = *(const bf16x8*)(PROJ + (R0 + m) * INP + C_RQ + h * 64 + d0);
          *(LAS bf16x8*)(Ks + m * 72 + d0) = *(const bf16x8*)(PROJ + (R0 + m) * INP + C_RK + h * 64 + d0);
          const bf16x8 va = *(const bf16x8*)(PROJ + (R0 + m) * INP + C_RV + h * 128 + e0), vb = *(const bf16x8*)(PROJ + (R0 + m) * INP + C_RV + h * 128 + e0 + 8);
#pragma unroll
          for (int i = 0; i < 8; ++i) { VT[(e0 + i) * 72 + m] = (unsigned short)va[i]; VT[(e0 + 8 + i) * 72 + m] = (unsigned short)vb[i]; }
#pragma unroll
          for (int k = 0; k < 2; ++k) { const int q = F.tid + k * 512, e = q >> 3, dd = (q & 7) * 8; *(LAS bf16x8*)(Ss + e * 72 + dd) = *(const bf16x8*)(SB + (size_t)unit * 8192 + e * 64 + dd); } }
        __syncthreads();
        const int lb = F.wave & 1, eb = F.wave >> 1;
        f32x16 cross = {};
        mfma_lds<4>(cross, Qs + lb * 32 * 72, 72, Ss + eb * 32 * 72, 72, r32, hi);
        if (F.wave < 4) { const int mb = F.wave >> 1; f32x16 sc = {};
            mfma_lds<4>(sc, Qs + lb * 32 * 72, 72, Ks + mb * 32 * 72, 72, r32, hi);
#pragma unroll
            for (int r = 0; r < 16; ++r) { const int l = lb * 32 + crow32(r, hi), mm = mb * 32 + r32; const int ad = l > mm ? l - mm : mm - l;
                Ps[l * 72 + mm] = f2bf16(sc[r] * expf(lg * (float)ad)); } }
        __syncthreads();
        f32x16 o = {};
        mfma_lds<4>(o, Ps + lb * 32 * 72, 72, VT + eb * 32 * 72, 72, r32, hi);
#pragma unroll
        for (int r = 0; r < 16; ++r) { const int l = lb * 32 + crow32(r, hi); o[r] += cross[r] * expf(lg * (float)(l + 1));
            float s = o[r] * o[r];
#pragma unroll
            for (int x = 1; x < 32; x <<= 1) s += __shfl_xor(s, x);
            if (r32 == 0) red[l * 4 + eb] = s; }
        __syncthreads();
#pragma unroll
        for (int r = 0; r < 16; ++r) { const int l = lb * 32 + crow32(r, hi); const f32x4 t = *(const LAS f32x4*)(red + l * 4);
            const float rn = 1.0f / sqrtf(((t[0] + t[1]) + (t[2] + t[3])) * (1.0f / 128.0f) + EPS); const int e = eb * 32 + r32;
            const float gt = bf2f(PROJ[(R0 + l) * INP + C_RG + h * 128 + e]); const float sg = gt / (1.0f + expf(-gt));
            CAT[(R0 + l) * DM + 3072 + h * 128 + e] = f2bf16(sg * (o[r] * rn)); }
        __syncthreads();
    }
}
#define CVT_LOOP(NITEMS, NIF) do { for (int it = gw; it < (NITEMS); it += (NIF) * NGW) { float vv[NIF][32]; \
    _Pragma("unroll") for (int j = 0; j < (NIF); ++j) if (it + j * NGW < (NITEMS)) { const CvtDesc d = desc_of(it + j * NGW); cvt_load(d, vv[j], F.lane); } \
    _Pragma("unroll") for (int j = 0; j < (NIF); ++j) if (it + j * NGW < (NITEMS)) { const CvtDesc d = desc_of(it + j * NGW); cvt_finish(d, vv[j], scr, F.lane); } } } while (0)
#ifndef PRO_NIF
#define PRO_NIF 2
#endif
#ifndef DEF_NIF
#define DEF_NIF 4
#endif
#ifndef DN_DEFER
#define DN_DEFER 24576
#endif
#ifndef GEMM_ALIGN
#define GEMM_ALIGN true
#endif
#ifndef GEMM_SP2
#define GEMM_SP2 true
#endif
#ifndef REP_PRO
#define REP_PRO 1
#endif
#ifndef REP_ATTN
#define REP_ATTN 1
#endif
#ifndef REP_UP
#define REP_UP 1
#endif
#ifndef REP_IN
#define REP_IN 1
#endif
#ifndef REP_QKV
#define REP_QKV 1
#endif
#ifndef REP_RET3
#define REP_RET3 1
#endif
#ifndef BAR_DUP
#define BAR_DUP 1
#endif
#ifndef REP_OUT
#define REP_OUT 1
#endif
#ifndef REP_DOWN
#define REP_DOWN 1
#endif
#ifndef REP_RES
#define REP_RES 1
#endif
#ifndef REP_SMALL
#define REP_SMALL 1
#endif
struct Args { const float* in[17]; float* out; unsigned char* ws; };
typedef const Args __attribute__((address_space(4))) CArgs;
__device__ __forceinline__ CArgs* fresh_args() { CArgs* p = (CArgs*)__builtin_amdgcn_kernarg_segment_ptr(); asm volatile("" : "+s"(p)); return p; }
__device__ __forceinline__ void prologue_phase(LAS unsigned char* lds_) {
    const Frame F = make_frame(lds_); CArgs* A = fresh_args(); unsigned char* ws = A->ws; float* rope = (float*)(ws + WS_ROPE); bf16* H = (bf16*)(ws + WS_H);
    const int gw = F.vcu * NWAVES + F.wave, NGW = F.G * NWAVES;
        LAS float* scr = (LAS float*)(F.lds + RING_OFF + F.wave * 16384);
        constexpr int I_IN = (DM / 64) * (INP / 32), I_Q = (1024 / 64) * (QW / 32), I_KV = (512 / 64) * (KVW / 32), I_OUT = (DM / 64) * (DM / 32), I_UP = (DM / 64) * (FF / 32);
        constexpr int I_DNP = (FF / 64) * (DM / 32) - DN_DEFER;
        constexpr int I_L = I_IN + I_Q + I_KV + I_OUT + I_UP + I_DNP;
        auto desc_of = [&](int it) -> CvtDesc {
            const int l = it / I_L; int r = it % I_L; unsigned char* wl = ws + WS_W + (size_t)l * LW; CvtDesc d; int nblk;
            if (r < I_IN) { d.W = A->in[5] + (size_t)l * DM * INW; d.WT = (bf16*)(wl + W_IN); d.kgain = nullptr; d.K = DM; d.N = INW; nblk = INP / 32; d.kind = 1; }
            else if ((r -= I_IN) < I_Q) { d.W = A->in[11] + (size_t)l * 1024 * QW; d.WT = (bf16*)(wl + W_Q); d.kgain = A->in[10] + l * 1024; d.K = 1024; d.N = QW; nblk = QW / 32; d.kind = 2; }
            else if ((r -= I_Q) < I_KV) { d.W = A->in[13] + (size_t)l * 512 * KVW; d.WT = (bf16*)(wl + W_KV); d.kgain = A->in[12] + l * 512; d.K = 512; d.N = KVW; nblk = KVW / 32; d.kind = 0; }
            else if ((r -= I_KV) < I_OUT) { d.W = A->in[14] + (size_t)l * DM * DM; d.WT = (bf16*)(wl + W_OUT); d.kgain = nullptr; d.K = DM; d.N = DM; nblk = DM / 32; d.kind = 0; }
            else if ((r -= I_OUT) < I_UP) { d.W = A->in[15] + (size_t)l * DM * FF; d.WT = (bf16*)(wl + W_UP); d.kgain = nullptr; d.K = DM; d.N = FF; nblk = FF / 32; d.kind = 0; }
            else { r -= I_UP; r += DN_DEFER; d.W = A->in[16] + (size_t)l * FF * DM; d.WT = (bf16*)(wl + W_DOWN); d.kgain = nullptr; d.K = FF; d.N = DM; nblk = DM / 32; d.kind = 0; }
            d.k0 = 64 * (r / nblk); d.n0 = 32 * (r % nblk); return d; };
        CVT_LOOP(DEPTH * I_L, PRO_NIF);
        for (int i = F.vcu * (NWAVES * 64) + F.tid; i < DEPTH * 8 * 128 * 128; i += F.G * NWAVES * 64) {
            const int l = i >> 17, r = i & 131071, ii = (r >> 7) & 127, jj = r & 127;
            ((bf16*)(ws + WS_W + (size_t)l * LW + W_SGU))[r] = ((jj >> 6) <= (ii >> 6)) ? f2bf16(A->in[8][i]) : (bf16)0; }
        for (int i = F.vcu * (NWAVES * 64) + F.tid; i < SEQ * 32; i += F.G * NWAVES * 64) {
            const int pos = i >> 5, j = i & 31; const float inv = (float)pow(10000.0, -(double)j / 32.0); const float ang = (float)pos * inv;
            float sn, cs; sincosf(ang, &sn, &cs); rope[2 * i] = cs; rope[2 * i + 1] = sn; }
        for (int m = gw; m < M; m += NGW) rms_row_to_bf16(A->in[0] + (size_t)m * DM, A->in[1], H + (size_t)m * DM, F.lane);
}
__device__ __forceinline__ void convert_down_phase(LAS unsigned char* lds_, int l, int idx, int n) {
    const Frame F = make_frame(lds_); CArgs* A = fresh_args(); unsigned char* ws = A->ws;
    LAS float* scr = (LAS float*)(F.lds + RING_OFF + F.wave * 16384);
    constexpr int I_DN = (FF / 64) * (DM / 32), NB = DM / 32;
    const int gw = idx * NWAVES + F.wave, NGW = n * NWAVES;
    auto desc_of = [&](int r) -> CvtDesc { CvtDesc d; d.W = A->in[16] + (size_t)l * FF * DM; d.WT = (bf16*)(ws + WS_W + (size_t)l * LW + W_DOWN); d.kgain = nullptr; d.K = FF; d.N = DM; d.kind = 0;
        d.k0 = 64 * (r / NB); d.n0 = 32 * (r % NB); return d; };
    CVT_LOOP(DN_DEFER, DEF_NIF);
}
__device__ __forceinline__ void residual_phase(LAS unsigned char* lds_, int l, int which, bool dry = false) {
    const Frame F = make_frame(lds_); CArgs* A = fresh_args(); unsigned char* ws = A->ws; const int gw = F.vcu * NWAVES + F.wave, NGW = F.G * NWAVES;
    const float* xin = (which == 0 && l == 0) ? A->in[0] : A->out; float* xout = dry ? (float*)(ws + WS_ACT) : A->out; const bf16* Y = (const bf16*)(ws + WS_MIX); bf16* Hn = dry ? (bf16*)(ws + WS_ACT + 134 * MiB) : (bf16*)(ws + WS_H);
    const float* gpost = (which == 0 ? A->in[2] : A->in[4]) + l * DM;
    const float* gnext = which == 0 ? A->in[3] + l * DM : ((l + 1 < DEPTH) ? A->in[1] + (l + 1) * DM : nullptr);
    for (int m = gw; m < M; m += NGW) residual_row(xin + (size_t)m * DM, Y + (size_t)m * DM, gpost, xout + (size_t)m * DM, gnext, Hn + (size_t)m * DM, F.lane);
}
__device__ __forceinline__ void attn_phase(LAS unsigned char* lds_) {
    const Frame F = make_frame(lds_); CArgs* A = fresh_args(); unsigned char* ws = A->ws;
    const bf16* QB = (const bf16*)(ws + WS_Q); const bf16* KVB = (const bf16*)(ws + WS_KV); const bf16* PROJ = (const bf16*)(ws + WS_PROJ); bf16* CAT = (bf16*)(ws + WS_CAT);
    for (int p2 = 2 * F.vcu; p2 < 512; p2 += 2 * F.G)
        for (int k = 0; k < 2; ++k) { const int p = p2 >> 1, bh = p >> 3, s = p & 7;
            att::attn_unit(QB, KVB, PROJ, CAT, bh >> 4, bh & 15, k ? 15 - s : s, (ATT_LAS char*)(F.lds + RING_OFF)); }
}
template <int WHICH> __device__ __forceinline__ void gemm_call(LAS unsigned char* lds_, int l) {
    CArgs* A = fresh_args(); unsigned char* ws = A->ws; unsigned char* wl = ws + WS_W + (size_t)l * LW; int bx = blockIdx.x; asm volatile("" : "+s"(bx)); const int G = gridDim.x;
    float* rope = (float*)(ws + WS_ROPE); float* ssq = (float*)(ws + WS_SSQ);
    bf16* H = (bf16*)(ws + WS_H); bf16* PROJ = (bf16*)(ws + WS_PROJ); bf16* QB = (bf16*)(ws + WS_Q); bf16* KVB = (bf16*)(ws + WS_KV);
    bf16* CAT = (bf16*)(ws + WS_CAT); bf16* MIX = (bf16*)(ws + WS_MIX); bf16* ACT = (bf16*)(ws + WS_ACT);
    pg8::StaticOrder S;
    if constexpr (WHICH == 0) { pg8::Gemm g{H, (const bf16*)(wl + W_IN), M, INP, DM, DM}; S.init(M, INP, G, bx); pg8::Epi<2> E{PROJ, INP, rope, ssq};
        pg8::gemm_phase<pg8::Epi<2>, pg8::StaticOrder, GEMM_ALIGN, GEMM_SP2>(lds_ + RING_OFF, g, S, E); }
    if constexpr (WHICH == 1) { pg8::Gemm g{PROJ + C_CQ, (const bf16*)(wl + W_Q), M, QW, 1024, INP}; S.init(M, QW, G, bx); pg8::Epi<3> E{QB, QW, rope, ssq};
        pg8::gemm_phase<pg8::Epi<3>, pg8::StaticOrder, GEMM_ALIGN, GEMM_SP2>(lds_ + RING_OFF, g, S, E); }
    if constexpr (WHICH == 2) { pg8::Gemm g{PROJ + C_CKV, (const bf16*)(wl + W_KV), M, KVW, 512, INP}; S.init(M, KVW, G, bx); pg8::Epi<4> E{KVB, KVW, rope, ssq};
        pg8::gemm_phase<pg8::Epi<4>, pg8::StaticOrder, GEMM_ALIGN, GEMM_SP2>(lds_ + RING_OFF, g, S, E); }
    if constexpr (WHICH == 3) { pg8::Gemm g{CAT, (const bf16*)(wl + W_OUT), M, DM, DM, DM}; S.init(M, DM, G, bx); pg8::Epi<0> E{MIX, DM, rope, ssq};
        pg8::gemm_phase<pg8::Epi<0>, pg8::StaticOrder, GEMM_ALIGN, GEMM_SP2>(lds_ + RING_OFF, g, S, E); }
    if constexpr (WHICH == 4) { pg8::Gemm g{H, (const bf16*)(wl + W_UP), M, FF, DM, DM}; S.init(M, FF, G, bx); pg8::Epi<1> E{ACT, FF, rope, ssq};
        pg8::gemm_phase<pg8::Epi<1>, pg8::StaticOrder, GEMM_ALIGN, GEMM_SP2>(lds_ + RING_OFF, g, S, E); }
    if constexpr (WHICH == 5) { pg8::Gemm g{ACT, (const bf16*)(wl + W_DOWN), M, DM, FF, FF}; S.init(M, DM, G, bx); pg8::Epi<0> E{MIX, DM, rope, ssq};
        pg8::gemm_phase<pg8::Epi<0>, pg8::StaticOrder, GEMM_ALIGN, GEMM_SP2>(lds_ + RING_OFF, g, S, E); }
}
__device__ __forceinline__ void mixer_small_phases(LAS unsigned char* lds_, int l) {
    CArgs* A = fresh_args(); unsigned char* ws = A->ws;
    sgu_phase(lds_, (const bf16*)(ws + WS_PROJ), (bf16*)(ws + WS_CAT), (const bf16*)(ws + WS_W + (size_t)l * LW + W_SGU), A->in[6] + l * 1024, A->in[7] + l * 1024, A->in[9] + l * 1024);
    CArgs* A2 = fresh_args(); unsigned char* ws2 = A2->ws;
    ret1_phase(lds_, (const bf16*)(ws2 + WS_PROJ), (float*)(ws2 + WS_KVS));
}
__global__ void __launch_bounds__(NWAVES * 64, 2) mega_fwd(Args args) {
    extern __shared__ __attribute__((aligned(16))) unsigned char lds[];
    LAS unsigned char* L = (LAS unsigned char*)lds;
    volatile LAS unsigned* MISC = (volatile LAS unsigned*)(L + MISC_OFF);
    for (int u = threadIdx.x; u < (LDS_BYTES - LDSCTL_OFF) / 4; u += NWAVES * 64) ((LAS unsigned*)(L + LDSCTL_OFF))[u] = 0u;
    __syncthreads();
    XcdBarrier bar = xcd_barrier_post((unsigned*)(args.ws + WS_CTL) + CW_BAR, MISC + 8);
#define GRID_BAR() do { for (int bd_ = 0; bd_ < BAR_DUP; ++bd_) { XcdBarrier b_ = bar; asm volatile("" : "+s"(b_.bar), "+s"(b_.x)); xcd_barrier(b_); } } while (0)
    for (int rep_ = 0; rep_ < REP_PRO; ++rep_) prologue_phase(L);
    GRID_BAR();
    for (int l = 0; l < DEPTH; ++l) {
        for (int rep_ = 0; rep_ < REP_IN; ++rep_) gemm_call<0>(L, l);
        { int bx = blockIdx.x; asm volatile("" : "+s"(bx)); const int G = gridDim.x, NT_IN = (M / 256) * (INP / 256), nfull = NT_IN % G;
          if (nfull == 0) convert_down_phase(L, l, bx, G); else if (bx >= nfull) convert_down_phase(L, l, bx - nfull, G - nfull); }
        GRID_BAR();
        for (int rep_ = 0; rep_ < REP_QKV; ++rep_) { gemm_call<1>(L, l); gemm_call<2>(L, l); }
        for (int rep_ = 0; rep_ < REP_SMALL; ++rep_) mixer_small_phases(L, l);
        GRID_BAR();
        { CArgs* A = fresh_args(); unsigned char* ws = A->ws; ret2_phase(L, (const float*)(ws + WS_KVS), (bf16*)(ws + WS_SB)); }
        for (int rep_ = 0; rep_ < REP_ATTN; ++rep_) attn_phase(L);
        GRID_BAR();
        for (int rep_ = 0; rep_ < REP_RET3; ++rep_) { CArgs* A = fresh_args(); unsigned char* ws = A->ws; ret3_phase(L, (const bf16*)(ws + WS_PROJ), (const bf16*)(ws + WS_SB), (bf16*)(ws + WS_CAT)); }
        GRID_BAR();
        for (int rep_ = 0; rep_ < REP_OUT; ++rep_) gemm_call<3>(L, l);
        GRID_BAR();
        for (int rep_ = 0; rep_ < REP_RES; ++rep_) residual_phase(L, l, 0, rep_ + 1 < REP_RES);
        GRID_BAR();
        for (int rep_ = 0; rep_ < REP_UP; ++rep_) gemm_call<4>(L, l);
        GRID_BAR();
        for (int rep_ = 0; rep_ < REP_DOWN; ++rep_) gemm_call<5>(L, l);
        GRID_BAR();
        for (int rep_ = 0; rep_ < REP_RES; ++rep_) residual_phase(L, l, 1, rep_ + 1 < REP_RES);
        if (l + 1 < DEPTH) GRID_BAR();
    }
}

extern "C" void kernel_launch(void* const* d_in, const int* in_sizes, int n_in, void* d_out, int out_size, void* d_ws, size_t ws_size, hipStream_t stream) {
    static int grid = 0;
    if (grid == 0) {
        if (n_in != 17 || in_sizes[0] != M * DM || out_size != M * DM || ws_size < WS_END) { fprintf(stderr, "kernel_launch: shape mismatch (n_in %d, in0 %d, out %d, ws %zu < %zu)\n", n_in, n_in > 0 ? in_sizes[0] : -1, out_size, ws_size, (size_t)WS_END); grid = -1; return; }
        int dev = 0, cus = 0, per_cu = 0;
        if (hipGetDevice(&dev) != hipSuccess || hipDeviceGetAttribute(&cus, hipDeviceAttributeMultiprocessorCount, dev) != hipSuccess) { grid = -1; return; }
        if (hipFuncSetAttribute((const void*)mega_fwd, hipFuncAttributeMaxDynamicSharedMemorySize, LDS_BYTES) != hipSuccess) { fprintf(stderr, "kernel_launch: hipFuncSetAttribute failed\n"); grid = -1; return; }
        if (hipOccupancyMaxActiveBlocksPerMultiprocessor(&per_cu, (const void*)mega_fwd, NWAVES * 64, LDS_BYTES) != hipSuccess || per_cu < 1)
            fprintf(stderr, "kernel_launch: note: occupancy query reports %d workgroups per CU\n", per_cu);
        (void)hipGetLastError();
        grid = cus;
    }
    if (grid < 0) return;
    if (hipMemsetAsync((char*)d_ws + WS_CTL, 0, CTL_ZERO_BYTES, stream) != hipSuccess) { fprintf(stderr, "kernel_launch: memset failed\n"); return; }
    Args a{};
    for (int i = 0; i < 17; ++i) a.in[i] = (const float*)d_in[i];
    a.out = (float*)d_out; a.ws = (unsigned char*)d_ws;
    hipLaunchKernelGGL(mega_fwd, dim3(grid), dim3(NWAVES * 64), LDS_BYTES, stream, a);
    const hipError_t le = hipPeekAtLastError();
    if (le != hipSuccess) fprintf(stderr, "kernel_launch: launch failed: %s\n", hipGetErrorName(le));
}
```

```cpp
#include <hip/hip_runtime.h>
#include <cstdio>
#include <cstdint>
namespace pg8 {
#define PG8_LAS __attribute__((address_space(3)))
typedef unsigned short bf16_t;
typedef short bf16x8 __attribute__((ext_vector_type(8)));
typedef float f32x4 __attribute__((ext_vector_type(4)));
typedef unsigned u32x4 __attribute__((ext_vector_type(4)));
constexpr int BM = 256, BK = 64, HALF = 128, HTB = HALF * BK * 2  , STAGE_BYTES = 8 * HTB, NXCD = 8, WGM = 8;

__host__ __device__ __forceinline__ int lds_byte(int r, int c) { const int st = (r >> 4) * 2 + (c >> 5), rr = r & 15, cc = c & 31, ob = rr * 64 + cc * 2; return st * 1024 + (ob ^ (((ob >> 9) & 1) << 5)); }
__host__ __device__ __forceinline__ void stage_rc(int b, int& R, int& C) { const int st = b / 1024, sb = b % 1024, swz = sb ^ (((sb >> 9) & 1) << 5); R = (st >> 1) * 16 + swz / 64; C = (st & 1) * 32 + (swz % 64) / 2; }
__host__ __device__ __forceinline__ int perm32(int rho) { const int n = rho >> 4, i = rho & 15; return 8 * (i >> 2) + 4 * n + (i & 3); }

struct Unit { int pm, pn; };
struct Gemm { const bf16_t* A; const bf16_t* Bt; int M, N, K, lda; };

struct StaticOrder {
    int nM, nN, nwg, G, c;
    __host__ __device__ void init(int M, int N, int G_, int c_) { nM = M / BM; nN = N / BM; nwg = nM * nN; G = G_; c = c_; }
    __host__ __device__ bool next(int i, Unit& u) const {
        const long L = (long)i * G + c; if (L >= nwg) return false;
        int wgid = (int)L; { const int q = nwg / NXCD, r = nwg % NXCD, xcd = wgid % NXCD, off = wgid / NXCD; wgid = (xcd < r ? xcd * (q + 1) : r * (q + 1) + (xcd - r) * q) + off; }
        const int nig = WGM * nN, gid = wgid / nig, fm = gid * WGM, gsz = (nM - fm) < WGM ? (nM - fm) : WGM;
        u.pm = fm + ((wgid % nig) % gsz); u.pn = (wgid % nig) / gsz; return true;
    }
    __device__ __forceinline__ void a_ready(const Unit&) const {}
    __device__ __forceinline__ void done(const Unit&) const {}
};
__device__ __forceinline__ unsigned cvt_pk_bf16(float lo, float hi) { unsigned r; asm volatile("v_cvt_pk_bf16_f32 %0, %1, %2" : "=v"(r) : "v"(lo), "v"(hi)); return r; }
__device__ __forceinline__ void rope8(f32x4& v0, f32x4& v1, const float* tab) {
    const f32x4 t0 = *(const f32x4*)tab, t1 = *(const f32x4*)(tab + 4);
    f32x4 a, b;
    a[0] = v0[0] * t0[0] - v0[1] * t0[1]; a[1] = v0[0] * t0[1] + v0[1] * t0[0];
    a[2] = v0[2] * t0[2] - v0[3] * t0[3]; a[3] = v0[2] * t0[3] + v0[3] * t0[2];
    b[0] = v1[0] * t1[0] - v1[1] * t1[1]; b[1] = v1[0] * t1[1] + v1[1] * t1[0];
    b[2] = v1[2] * t1[2] - v1[3] * t1[3]; b[3] = v1[2] * t1[3] + v1[3] * t1[2];
    v0 = a; v1 = b;
}
template <int MODE> struct Epi {
    static constexpr bool PERM = true, AFTER_DRAIN = false;
    bf16_t* O; int ldc; const float* rope; float* ssq; const float* rsc;
    __device__ __forceinline__ void operator()(const f32x4 (&acc)[2][2][4][2], const Unit& u, int wr, int wc, int fr, int fq) const {
        const int row0 = u.pm * BM + wr * 64 + fr, colt = u.pn * BM + wc * 32 + 8 * fq;
        const bool want_ss = (MODE == 2) && u.pn >= 8 && u.pn < 14;
#pragma unroll
        for (int ai = 0; ai < 2; ++ai)
#pragma unroll
            for (int m = 0; m < 4; ++m) {
                const int row = row0 + ai * HALF + m * 16;
                float rs = 1.f;
                if (MODE == 1 || MODE == 2) rs = rsc[row];
                if (MODE == 3) { const f32x4* s = (const f32x4*)(ssq + (size_t)row * 24); const f32x4 a = s[0], b = s[1], c = s[2], d = s[3];
                    const float t = ((a[0] + a[1]) + (a[2] + a[3])) + ((b[0] + b[1]) + (b[2] + b[3])) + ((c[0] + c[1]) + (c[2] + c[3])) + ((d[0] + d[1]) + (d[2] + d[3]));
                    rs = 1.0f / sqrtf(t * (1.0f / 1024.0f) + 1e-6f); }
                if (MODE == 4) { const f32x4* s = (const f32x4*)(ssq + (size_t)row * 24); const f32x4 a = s[4], b = s[5];
                    const float t = ((a[0] + a[1]) + (a[2] + a[3])) + ((b[0] + b[1]) + (b[2] + b[3]));
                    rs = 1.0f / sqrtf(t * (1.0f / 512.0f) + 1e-6f); }
                float part = 0.f;
#pragma unroll
                for (int bj = 0; bj < 2; ++bj) {
                    const int col = colt + bj * HALF;
                    f32x4 v0 = acc[ai][bj][m][0], v1 = acc[ai][bj][m][1];
                    if (MODE == 1) {
#pragma unroll
                        for (int j = 0; j < 4; ++j) { const float p = fmaxf(v0[j] * rs, 0.f), q = fmaxf(v1[j] * rs, 0.f); v0[j] = p * p; v1[j] = q * q; } }
                    if (MODE == 2) { v0 = v0 * rs; v1 = v1 * rs;
                        if (want_ss) part += ((v0[0] * v0[0] + v0[1] * v0[1]) + (v0[2] * v0[2] + v0[3] * v0[3])) + ((v1[0] * v1[0] + v1[1] * v1[1]) + (v1[2] * v1[2] + v1[3] * v1[3]));
                        if (col >= 3584 && col < 4672) rope8(v0, v1, rope + ((size_t)(row & 4095) * 32 + ((col & 63) >> 1)) * 2); }
                    if (MODE == 3) { v0 = v0 * rs; v1 = v1 * rs; if ((col % 192) >= 128) rope8(v0, v1, rope + ((size_t)(row & 4095) * 32 + ((col & 63) >> 1)) * 2); }
                    if (MODE == 4) { v0 = v0 * rs; v1 = v1 * rs; }
                    u32x4 w; w.x = cvt_pk_bf16(v0[0], v0[1]); w.y = cvt_pk_bf16(v0[2], v0[3]); w.z = cvt_pk_bf16(v1[0], v1[1]); w.w = cvt_pk_bf16(v1[2], v1[3]);
                    *(u32x4*)(O + (size_t)row * ldc + col) = w;
                }
                if (want_ss) { part += __shfl_xor(part, 16); part += __shfl_xor(part, 32); if (fq == 0) ssq[(size_t)row * 24 + (u.pn - 8) * 4 + wc] = part; }
            }
    }
};
template <class Epi, class Sched, bool ALIGN_EPI = false, bool SP2 = false>
__device__ __forceinline__ void gemm_phase(PG8_LAS unsigned char* lds, const Gemm g, const Sched& S, const Epi& E) {
    int tid_ = threadIdx.x; asm volatile("" : "+v"(tid_));
    const int tid = tid_, wid = __builtin_amdgcn_readfirstlane(tid >> 6), lane = tid & 63, wr = wid >> 2, wc = wid & 3, fr = lane & 15, fq = lane >> 4;
    const int K = g.K, nt = K / BK;
    unsigned voffA[2], voffB[2];
#pragma unroll
    for (int i = 0; i < 2; ++i) { int R, C; stage_rc(tid * 16 + i * 8192, R, C); const int Rb = Epi::PERM ? ((R & ~31) + perm32(R & 31)) : R;
        voffA[i] = (unsigned)(R * g.lda + C) * 2u; voffB[i] = (unsigned)(Rb * K + C) * 2u; }
    const size_t kstep = (size_t)(BK * 2);
    const size_t hstep = (size_t)HALF * K * 2;
    const size_t tstep = 2 * hstep; const size_t hstepA = (size_t)HALF * g.lda * 2, tstepA = 2 * hstepA;
    const unsigned ldsw = (unsigned)wid * 1024u;
    const int aoff = lds_byte(wr * 64 + fr, fq * 8), boff = lds_byte(wc * 32 + fr, fq * 8);
#define PG8_SA(b, h) (((b) * 2 + (h)) * HTB)
#define PG8_SB(b, h) ((4 + (b) * 2 + (h)) * HTB)
#define PG8_STAGE(bufoff, gbase, voff) do { _Pragma("unroll") for (int _i = 0; _i < 2; ++_i) \
        __builtin_amdgcn_global_load_lds((const unsigned*)((const char*)(gbase) + (voff)[_i]), (PG8_LAS unsigned*)(lds + (bufoff) + ldsw + _i * 8192), 16, 0, 0); } while (0)
#define PG8_LDA(dst, b, h) do { _Pragma("unroll") for (int m = 0; m < 4; ++m) _Pragma("unroll") for (int k = 0; k < 2; ++k) dst[m][k] = *(const PG8_LAS bf16x8*)(lds + PG8_SA(b, h) + aoff + m * 2048 + k * 1024); } while (0)
#define PG8_LDB(dst, b, h) do { _Pragma("unroll") for (int n = 0; n < 2; ++n) _Pragma("unroll") for (int k = 0; k < 2; ++k) dst[n][k] = *(const PG8_LAS bf16x8*)(lds + PG8_SB(b, h) + boff + n * 2048 + k * 1024); } while (0)
#define PG8_MMA(ai, bj, At, Bt) do { __builtin_amdgcn_s_setprio(1); _Pragma("unroll") for (int m = 0; m < 4; ++m) _Pragma("unroll") for (int n = 0; n < 2; ++n) _Pragma("unroll") for (int k = 0; k < 2; ++k) \
        acc[ai][bj][m][n] = __builtin_amdgcn_mfma_f32_16x16x32_bf16(Bt[n][k], At[m][k], acc[ai][bj][m][n], 0, 0, 0); __builtin_amdgcn_s_setprio(0); } while (0)
#define PG8_WAIT_V(n) asm volatile("s_waitcnt vmcnt(" #n ")" ::: "memory")
#define PG8_WAIT_L(n) asm volatile("s_waitcnt lgkmcnt(" #n ")" ::: "memory")
#define PG8_BAR __builtin_amdgcn_s_barrier()
#define PG8_SCHED __builtin_amdgcn_sched_barrier(0)
    Unit cur, nxt; int ui = 0;
    if (!S.next(0, cur)) return;
    f32x4 acc[2][2][4][2];
#pragma unroll
    for (int a = 0; a < 2; ++a)
#pragma unroll
        for (int b = 0; b < 2; ++b)
#pragma unroll
            for (int m = 0; m < 4; ++m)
#pragma unroll
                for (int n = 0; n < 2; ++n) acc[a][b][m][n] = (f32x4){0.f, 0.f, 0.f, 0.f};
    bf16x8 At[4][2], B0[2][2], B1[2][2];
    const char* cA = (const char*)g.A + (size_t)cur.pm * tstepA; const char* cB = (const char*)g.Bt + (size_t)cur.pn * tstep;
    S.a_ready(cur);
    if constexpr (SP2) {
        PG8_STAGE(PG8_SB(0, 0), cB, voffB); PG8_STAGE(PG8_SB(0, 1), cB + hstep, voffB); PG8_STAGE(PG8_SA(0, 0), cA, voffA); PG8_STAGE(PG8_SA(0, 1), cA + hstepA, voffA);
        if (wr == 1) PG8_BAR;
        PG8_WAIT_V(2); PG8_BAR;
        PG8_STAGE(PG8_SB(1, 0), cB + kstep, voffB); PG8_STAGE(PG8_SA(1, 0), cA + kstep, voffA); PG8_STAGE(PG8_SB(1, 1), cB + hstep + kstep, voffB);
        PG8_WAIT_V(6); PG8_BAR;
    } else {
        PG8_STAGE(PG8_SB(0, 0), cB, voffB); PG8_STAGE(PG8_SA(0, 0), cA, voffA); PG8_STAGE(PG8_SB(0, 1), cB + hstep, voffB); PG8_STAGE(PG8_SA(0, 1), cA + hstepA, voffA);
        if (wr == 1) PG8_BAR;
        PG8_WAIT_V(4); PG8_BAR;
        PG8_STAGE(PG8_SB(1, 0), cB + kstep, voffB); PG8_STAGE(PG8_SA(1, 0), cA + kstep, voffA); PG8_STAGE(PG8_SB(1, 1), cB + hstep + kstep, voffB);
        PG8_WAIT_V(6); PG8_BAR;
    }
    for (;;) {
        const bool has_next = S.next(ui + 1, nxt);
        const char* nA = has_next ? (const char*)g.A + (size_t)nxt.pm * tstepA : cA; const char* nB = has_next ? (const char*)g.Bt + (size_t)nxt.pn * tstep : cB;
        for (int t = 0; t < nt; t += 2) {
            const bool last = (t == nt - 2);
            const char* a1 = cA + (size_t)(t + 1) * kstep;
            const char* a2 = last ? nA : cA + (size_t)(t + 2) * kstep; const char* b2 = last ? nB : cB + (size_t)(t + 2) * kstep;
            const char* a3 = a2 + kstep; const char* b3 = b2 + kstep;
            if (last && has_next) S.a_ready(nxt);
            if constexpr (SP2) {
            PG8_LDB(B0, 0, 0); PG8_LDB(B1, 0, 1); PG8_SCHED; PG8_LDA(At, 0, 0); PG8_STAGE(PG8_SA(1, 1), a1 + hstepA, voffA);
            PG8_WAIT_V(8); PG8_WAIT_L(0); PG8_BAR; PG8_MMA(0, 0, At, B0); PG8_MMA(0, 1, At, B1); PG8_BAR; PG8_SCHED;
            PG8_LDA(At, 0, 1); PG8_STAGE(PG8_SB(0, 0), b2, voffB); PG8_STAGE(PG8_SB(0, 1), b2 + hstep, voffB); PG8_STAGE(PG8_SA(0, 0), a2, voffA);
            PG8_WAIT_V(8); PG8_WAIT_L(0); PG8_BAR; PG8_MMA(1, 0, At, B0); PG8_MMA(1, 1, At, B1); PG8_BAR; PG8_SCHED;
            PG8_LDB(B0, 1, 0); PG8_LDB(B1, 1, 1); PG8_SCHED; PG8_LDA(At, 1, 0); PG8_STAGE(PG8_SA(0, 1), a2 + hstepA, voffA);
            PG8_WAIT_V(8); PG8_WAIT_L(0); PG8_BAR; PG8_MMA(0, 0, At, B0); PG8_MMA(0, 1, At, B1); PG8_BAR; PG8_SCHED;
            PG8_LDA(At, 1, 1); PG8_STAGE(PG8_SB(1, 0), b3, voffB); PG8_STAGE(PG8_SB(1, 1), b3 + hstep, voffB); PG8_STAGE(PG8_SA(1, 0), a3, voffA);
            PG8_WAIT_V(8); PG8_WAIT_L(0); PG8_BAR; PG8_MMA(1, 0, At, B0); PG8_MMA(1, 1, At, B1); PG8_BAR; PG8_SCHED;
            } else {
            PG8_LDB(B0, 0, 0); PG8_SCHED; PG8_LDA(At, 0, 0); PG8_STAGE(PG8_SA(1, 1), a1 + hstepA, voffA);
            PG8_WAIT_L(8); PG8_BAR; PG8_WAIT_L(0); PG8_MMA(0, 0, At, B0); PG8_BAR; PG8_SCHED;
            PG8_LDB(B1, 0, 1); PG8_STAGE(PG8_SB(0, 0), b2, voffB);
            PG8_BAR; PG8_WAIT_L(0); PG8_MMA(0, 1, At, B1); PG8_BAR;
            PG8_LDA(At, 0, 1); PG8_STAGE(PG8_SA(0, 0), a2, voffA);
            PG8_BAR; PG8_WAIT_L(0); PG8_MMA(1, 0, At, B0); PG8_BAR; PG8_SCHED;
            PG8_STAGE(PG8_SB(0, 1), b2 + hstep, voffB);
            PG8_WAIT_V(6); PG8_BAR; PG8_MMA(1, 1, At, B1); PG8_BAR;
            PG8_LDB(B0, 1, 0); PG8_SCHED; PG8_LDA(At, 1, 0); PG8_STAGE(PG8_SA(0, 1), a2 + hstepA, voffA);
            PG8_WAIT_L(8); PG8_BAR; PG8_WAIT_L(0); PG8_MMA(0, 0, At, B0); PG8_BAR; PG8_SCHED;
            PG8_LDB(B1, 1, 1); PG8_STAGE(PG8_SB(1, 0), b3, voffB);
            PG8_BAR; PG8_WAIT_L(0); PG8_MMA(0, 1, At, B1); PG8_BAR;
            PG8_LDA(At, 1, 1); PG8_STAGE(PG8_SA(1, 0), a3, voffA);
            PG8_BAR; PG8_WAIT_L(0); PG8_MMA(1, 0, At, B0); PG8_BAR; PG8_SCHED;
            PG8_STAGE(PG8_SB(1, 1), b3 + hstep, voffB);
            PG8_WAIT_V(6); PG8_BAR; PG8_MMA(1, 1, At, B1); PG8_BAR;
            }
        }
        if constexpr (ALIGN_EPI) { if (wr == 0) PG8_BAR; }
        if constexpr (!Epi::AFTER_DRAIN) { E(acc, cur, wr, wc, fr, fq); S.done(cur); }
        if (!has_next) break;
#pragma unroll
        for (int a = 0; a < 2; ++a)
#pragma unroll
            for (int b = 0; b < 2; ++b)
#pragma unroll
                for (int m = 0; m < 4; ++m)
#pragma unroll
                    for (int n = 0; n < 2; ++n) acc[a][b][m][n] = (f32x4){0.f, 0.f, 0.f, 0.f};
        cur = nxt; cA = nA; cB = nB; ++ui;
        if constexpr (ALIGN_EPI) { if (wr == 1) PG8_BAR; }
    }
    PG8_WAIT_V(0);
    if constexpr (!ALIGN_EPI) { if (wr == 0) PG8_BAR; }
    PG8_BAR;
    if constexpr (Epi::AFTER_DRAIN) { E.fused(acc, cur, wr, wc, fr, fq, lds, wid, lane); S.done(cur); }
#undef PG8_SA
#undef PG8_SB
#undef PG8_STAGE
#undef PG8_LDA
#undef PG8_LDB
#undef PG8_MMA
#undef PG8_WAIT_V
#undef PG8_WAIT_L
#undef PG8_BAR
#undef PG8_SCHED
}
}
namespace att {
#define ATT_LAS __attribute__((address_space(3)))
typedef unsigned short bf16;
using bf16x8 = __attribute__((ext_vector_type(8))) short;
using s16x4  = __attribute__((ext_vector_type(4))) short;
using f32x16 = __attribute__((ext_vector_type(16))) float;
using u32x4  = __attribute__((ext_vector_type(4))) unsigned;
constexpr float SCALE = 0.07216878364870322f;
constexpr float THR = 8.f;
constexpr int SHM_V = 16384, SHM_K = 16384, SHM_R = 8192;
constexpr int OFF_V = 0, OFF_K = 2 * SHM_V, OFF_R = OFF_K + 2 * SHM_K, OFF_WS = OFF_R + 2 * SHM_R, ATT_LDS_BYTES = OFF_WS + 8 * 64 * 4;
#define KSWZ(row, colB) ((row) * 256 + ((colB) ^ (((row) & 7) << 4)))
#define RSWZ(row, colB) ((row) * 128 + ((colB) ^ (((row) & 7) << 4)))
#define SBAR() __builtin_amdgcn_sched_barrier(0)
__device__ __forceinline__ int crow(int r, int hi) { return (r & 3) + 8 * (r >> 2) + 4 * hi; }
__device__ __forceinline__ unsigned cvtpk(float lo, float hi) { unsigned r; asm volatile("v_cvt_pk_bf16_f32 %0, %1, %2" : "=v"(r) : "v"(lo), "v"(hi)); return r; }
__device__ __forceinline__ void partialSM(f32x16& p0, f32x16& p1, float& m_reg, float& mn, float& alpha) {
  constexpr float C = SCALE * 1.4426950408889634f;
  float pmax = p0[0];
#pragma unroll
  for (int r = 1; r < 16; ++r) pmax = fmaxf(pmax, p0[r]);
#pragma unroll
  for (int r = 0; r < 16; ++r) pmax = fmaxf(pmax, p1[r]);
  { auto rr = __builtin_amdgcn_permlane32_swap(__float_as_uint(pmax), __float_as_uint(pmax), false, false);
    pmax = fmaxf(__uint_as_float(rr[0]), __uint_as_float(rr[1])); }
  if (__builtin_expect(__all(pmax - m_reg <= THR / SCALE), 1)) { mn = m_reg; alpha = 1.f; }
  else { mn = fmaxf(m_reg, pmax); alpha = __builtin_amdgcn_exp2f((m_reg - mn) * C); m_reg = mn; }
  float mnC = -mn * C;
#pragma unroll
  for (int r = 0; r < 16; ++r) p0[r] = fmaf(p0[r], C, mnC);
#pragma unroll
  for (int r = 0; r < 16; ++r) p1[r] = fmaf(p1[r], C, mnC);
#pragma unroll
  for (int r = 0; r < 16; ++r) p0[r] = __builtin_amdgcn_exp2f(p0[r]);
}
__device__ __forceinline__ void finishSM(f32x16& p0, f32x16& p1, float alpha, float& l_reg, bf16x8& pa0, bf16x8& pa1, bf16x8& pa2, bf16x8& pa3) {
#pragma unroll
  for (int r = 0; r < 16; ++r) p1[r] = __builtin_amdgcn_exp2f(p1[r]);
  float ps = 0;
#pragma unroll
  for (int r = 0; r < 16; ++r) ps += p0[r];
#pragma unroll
  for (int r = 0; r < 16; ++r) ps += p1[r];
  { auto rr = __builtin_amdgcn_permlane32_swap(__float_as_uint(ps), __float_as_uint(ps), false, false);
    ps = __uint_as_float(rr[0]) + __uint_as_float(rr[1]); }
  l_reg = l_reg * alpha + ps;
#define PK4(P, BASE, OUT) do { unsigned a0 = cvtpk(P[BASE + 0], P[BASE + 1]), a1 = cvtpk(P[BASE + 2], P[BASE + 3]);   \
    unsigned b0 = cvtpk(P[BASE + 4], P[BASE + 5]), b1 = cvtpk(P[BASE + 6], P[BASE + 7]);                              \
    auto r0 = __builtin_amdgcn_permlane32_swap(a0, b0, false, false); auto r1 = __builtin_amdgcn_permlane32_swap(a1, b1, false, false); \
    u32x4 w = {r0[0], r1[0], r0[1], r1[1]}; OUT = *reinterpret_cast<bf16x8*>(&w); } while (0)
  PK4(p0, 0, pa0); PK4(p0, 8, pa1); PK4(p1, 0, pa2); PK4(p1, 8, pa3);
#undef PK4
}
__device__ __forceinline__ void qkt(f32x16& p0, f32x16& p1, const ATT_LAS char* Ks, const ATT_LAS char* Rs, const bf16x8* qr, int r32, int hi) {
  p0 = f32x16{}; p1 = f32x16{};
#pragma unroll
  for (int d0 = 0; d0 < 8; ++d0) { const int cb = (d0 * 16 + hi * 8) * 2;
    const bf16x8 b0 = *reinterpret_cast<const ATT_LAS bf16x8*>(Ks + KSWZ(r32, cb));
    const bf16x8 b1 = *reinterpret_cast<const ATT_LAS bf16x8*>(Ks + KSWZ(32 + r32, cb));
    p0 = __builtin_amdgcn_mfma_f32_32x32x16_bf16(b0, qr[d0], p0, 0, 0, 0);
    p1 = __builtin_amdgcn_mfma_f32_32x32x16_bf16(b1, qr[d0], p1, 0, 0, 0); }
#pragma unroll
  for (int d0 = 0; d0 < 4; ++d0) { const int cb = (d0 * 16 + hi * 8) * 2;
    const bf16x8 b0 = *reinterpret_cast<const ATT_LAS bf16x8*>(Rs + RSWZ(r32, cb));
    const bf16x8 b1 = *reinterpret_cast<const ATT_LAS bf16x8*>(Rs + RSWZ(32 + r32, cb));
    p0 = __builtin_amdgcn_mfma_f32_32x32x16_bf16(b0, qr[8 + d0], p0, 0, 0, 0);
    p1 = __builtin_amdgcn_mfma_f32_32x32x16_bf16(b1, qr[8 + d0], p1, 0, 0, 0); }
}
__device__ __forceinline__ int v_st(int k, int c) { const int kk = (k & ~0xC) | ((k & 4) << 1) | ((k & 8) >> 1); return ((kk >> 3) * 4 + (c >> 5)) * 512 + ((kk & 7) * 32 + (c & 31)) * 2; }
__device__ __forceinline__ int v_rd_base(int lane) { return ((lane & 3) << 3) | (((lane >> 2) & 3) << 6) | (((lane >> 4) & 1) << 5) | (((lane >> 5) & 1) << 8); }
constexpr int v_rd_off(int d0, int ks, int half) { return d0 * 512 + ks * 4096 + half * 2048; }
template <int OFF> __device__ __forceinline__ s16x4 tr_read(int vb) {
  s16x4 r; asm volatile("ds_read_b64_tr_b16 %0, %1 offset:%2" : "=&v"(r) : "v"(vb), "i"(OFF) : "memory"); return r;
}
template <int D0> __device__ __forceinline__ void pv_one(f32x16& od, int vb, bf16x8 pa0, bf16x8 pa1, bf16x8 pa2, bf16x8 pa3) {
  const s16x4 l0 = tr_read<v_rd_off(D0, 0, 0)>(vb), h0 = tr_read<v_rd_off(D0, 0, 1)>(vb), l1 = tr_read<v_rd_off(D0, 1, 0)>(vb), h1 = tr_read<v_rd_off(D0, 1, 1)>(vb);
  const s16x4 l2 = tr_read<v_rd_off(D0, 2, 0)>(vb), h2 = tr_read<v_rd_off(D0, 2, 1)>(vb), l3 = tr_read<v_rd_off(D0, 3, 0)>(vb), h3 = tr_read<v_rd_off(D0, 3, 1)>(vb);
  asm volatile("s_waitcnt lgkmcnt(0)" ::: "memory"); SBAR();
#define PK(L, H) (bf16x8){L[0], L[1], L[2], L[3], H[0], H[1], H[2], H[3]}
  od = __builtin_amdgcn_mfma_f32_32x32x16_bf16(pa0, PK(l0, h0), od, 0, 0, 0);
  od = __builtin_amdgcn_mfma_f32_32x32x16_bf16(pa1, PK(l1, h1), od, 0, 0, 0);
  od = __builtin_amdgcn_mfma_f32_32x32x16_bf16(pa2, PK(l2, h2), od, 0, 0, 0);
  od = __builtin_amdgcn_mfma_f32_32x32x16_bf16(pa3, PK(l3, h3), od, 0, 0, 0);
#undef PK
}
__device__ __forceinline__ void pv_d0(f32x16* o, int vb, bf16x8 pa0, bf16x8 pa1, bf16x8 pa2, bf16x8 pa3) {
  pv_one<0>(o[0], vb, pa0, pa1, pa2, pa3); pv_one<1>(o[1], vb, pa0, pa1, pa2, pa3); pv_one<2>(o[2], vb, pa0, pa1, pa2, pa3); pv_one<3>(o[3], vb, pa0, pa1, pa2, pa3);
}
__device__ __forceinline__ unsigned short f2bf(float f) { unsigned u = __builtin_bit_cast(unsigned, f); return (unsigned short)((u + 0x7fffu + ((u >> 16) & 1u)) >> 16); }
__device__ __forceinline__ void attn_unit(const bf16* __restrict__ Q, const bf16* __restrict__ KV, const bf16* __restrict__ PROJ, bf16* __restrict__ CAT, int b, int h, int qb, ATT_LAS char* lds) {
  int tid_ = threadIdx.x; asm volatile("" : "+v"(tid_));
  const int tid = tid_, wid = __builtin_amdgcn_readfirstlane(tid >> 6), lane = tid & 63, r32 = lane & 31, hi = lane >> 5;
  ATT_LAS char* V_lds = lds + OFF_V; ATT_LAS char* K_lds = lds + OFF_K; ATT_LAS char* R_lds = lds + OFF_R;
  ATT_LAS float* wsp = (ATT_LAS float*)(lds + OFF_WS) + wid * 64; ATT_LAS float* li_l = wsp; ATT_LAS float* al_l = wsp + 32;
  float m_reg = -1e30f, l_reg = 0; f32x16 o[4] = {}; bf16x8 qr[12];
  const size_t tok0 = (size_t)b * 4096;
  const bf16* Qw = Q + (tok0 + (size_t)qb * 256 + wid * 32 + r32) * 3072 + h * 192 + hi * 8;
#pragma unroll
  for (int d0 = 0; d0 < 12; ++d0) qr[d0] = *reinterpret_cast<const bf16x8*>(Qw + d0 * 16);
  const int cw = qb * 4 + (wid >> 1), NT = qb * 4 + 4;
  const int sr = tid >> 4, sc = (tid & 15) * 8, vst0 = v_st(sr, sc), vst1 = v_st(32 + sr, sc), kst0 = KSWZ(sr, sc * 2), kst1 = KSWZ(32 + sr, sc * 2);
  const int rr = tid >> 3, rc = (tid & 7) * 8, rst = RSWZ(rr, rc * 2);
  const bf16* Kg = KV + tok0 * 4096 + h * 256;
  const bf16* Rg = PROJ + tok0 * 6912 + 3584;
  const int vb0 = (int)(uintptr_t)V_lds + v_rd_base(lane);
  bf16x8 sv0, sv1, sk0, sk1, srp;
#define ATT_SLOAD(k0) do { sv0 = *reinterpret_cast<const bf16x8*>(Kg + (size_t)((k0) + sr) * 4096 + 128 + sc); sv1 = *reinterpret_cast<const bf16x8*>(Kg + (size_t)((k0) + 32 + sr) * 4096 + 128 + sc); \
    sk0 = *reinterpret_cast<const bf16x8*>(Kg + (size_t)((k0) + sr) * 4096 + sc); sk1 = *reinterpret_cast<const bf16x8*>(Kg + (size_t)((k0) + 32 + sr) * 4096 + sc); \
    srp = *reinterpret_cast<const bf16x8*>(Rg + (size_t)((k0) + rr) * 6912 + rc); } while (0)
#define ATT_SWRITE(bf) do { *reinterpret_cast<ATT_LAS bf16x8*>(V_lds + (bf) * SHM_V + vst0) = sv0; *reinterpret_cast<ATT_LAS bf16x8*>(V_lds + (bf) * SHM_V + vst1) = sv1; \
    *reinterpret_cast<ATT_LAS bf16x8*>(K_lds + (bf) * SHM_K + kst0) = sk0; *reinterpret_cast<ATT_LAS bf16x8*>(K_lds + (bf) * SHM_K + kst1) = sk1; \
    *reinterpret_cast<ATT_LAS bf16x8*>(R_lds + (bf) * SHM_R + rst) = srp; } while (0)
#define ATT_RESC(a) do { if (__any((a) < 1.f)) { if (hi == 0) al_l[r32] = (a); asm volatile("s_waitcnt lgkmcnt(0)" ::: "memory"); \
    _Pragma("unroll") for (int d = 0; d < 4; ++d) _Pragma("unroll") for (int r = 0; r < 16; ++r) o[d][r] *= al_l[crow(r, hi)]; } } while (0)
  ATT_SLOAD(0); asm volatile("s_waitcnt vmcnt(0)" ::: "memory"); ATT_SWRITE(0); __syncthreads();
  for (int t = 0; t < NT; ++t) {
    const int bf = t & 1;
    if (t + 1 < NT) ATT_SLOAD((t + 1) * 64);
    if (t <= cw) {
      f32x16 p0, p1; float mn, al; bf16x8 pa0, pa1, pa2, pa3;
      qkt(p0, p1, K_lds + bf * SHM_K, R_lds + bf * SHM_R, qr, r32, hi);
      partialSM(p0, p1, m_reg, mn, al);
      ATT_RESC(al);
      finishSM(p0, p1, al, l_reg, pa0, pa1, pa2, pa3); SBAR();
      pv_d0(o, vb0 + bf * SHM_V, pa0, pa1, pa2, pa3);
    }
    if (t + 1 < NT) { asm volatile("s_waitcnt vmcnt(0)" ::: "memory"); ATT_SWRITE(bf ^ 1); }
    __syncthreads();
  }
  if (hi == 0) li_l[r32] = l_reg; asm volatile("s_waitcnt lgkmcnt(0)" ::: "memory");
  float rli[16];
#pragma unroll
  for (int r = 0; r < 16; ++r) rli[r] = __builtin_amdgcn_rcpf(li_l[crow(r, hi)]);
  bf16* Ow = CAT + (tok0 + (size_t)qb * 256 + wid * 32) * 4096 + 1024 + h * 128;
#pragma unroll
  for (int r = 0; r < 16; ++r) { const int orow = crow(r, hi);
#pragma unroll
    for (int d0 = 0; d0 < 4; ++d0) Ow[(size_t)orow * 4096 + d0 * 32 + r32] = f2bf(o[d0][r] * rli[r]); }
#undef ATT_SLOAD
#undef ATT_SWRITE
#undef ATT_RESC
}
}
constexpr int NWAVES = 8;
constexpr int BATCH = 2, SEQ = 4096, DM = 4096, M = BATCH * SEQ, DEPTH = 2, FF = 16384;
constexpr int INW = 6720, INP = 6912;
constexpr int C_U = 0, C_V = 1024, C_CQ = 2048, C_CKV = 3072, C_KR = 3584, C_RQ = 3648, C_RK = 4160, C_RV = 4672, C_RG = 5696;
constexpr int QW = 3072, KVW = 4096;
constexpr float EPS = 1e-6f;
constexpr size_t MiB = 1u << 20;
constexpr size_t WS_CTL = 0, CTL_ZERO_BYTES = 1 * MiB;
constexpr size_t WS_ROPE = 1 * MiB;
constexpr size_t WS_SSQ = 2 * MiB;
constexpr size_t WS_RS = 3 * MiB;
constexpr size_t WS_W = 4 * MiB, LW = 353 * MiB;
constexpr size_t W_IN = 0, W_Q = 54 * MiB, W_KV = 60 * MiB, W_OUT = 64 * MiB, W_UP = 96 * MiB, W_DOWN = 224 * MiB, W_SGU = 352 * MiB;
constexpr size_t WS_H = WS_W + 2 * LW;
constexpr size_t WS_PROJ = WS_H + 64 * MiB;
constexpr size_t WS_Q = WS_PROJ + 108 * MiB;
constexpr size_t WS_KV = WS_Q + 48 * MiB;
constexpr size_t WS_CAT = WS_KV + 64 * MiB;
constexpr size_t WS_MIX = WS_CAT + 64 * MiB;
constexpr size_t WS_ACT = WS_MIX + 64 * MiB;
constexpr size_t WS_KVS = WS_ACT + 256 * MiB;
constexpr size_t WS_SB = WS_KVS + 32 * MiB;
constexpr size_t WS_END = WS_SB + 16 * MiB;
static_assert((size_t)INP * DM * 2 == 54 * MiB && (size_t)M * INP * 2 == 108 * MiB, "map");
constexpr int CW_BAR = 4096;
constexpr int RING_OFF = 0, RING_BYTES = 131072;
constexpr int LDSCTL_OFF = RING_BYTES, MISC_OFF = LDSCTL_OFF + 320;
constexpr int LDS_BYTES = 147456;
#define GAS __attribute__((address_space(1)))
#define LAS __attribute__((address_space(3)))
typedef unsigned short bf16;
typedef unsigned v4u __attribute__((ext_vector_type(4)));
typedef float f32x4 __attribute__((ext_vector_type(4)));
typedef short bf16x8 __attribute__((ext_vector_type(8)));
typedef GAS unsigned gu32;
typedef GAS unsigned long long gu64;
#define RLX_AGENT __ATOMIC_RELAXED, __HIP_MEMORY_SCOPE_AGENT
#define LDS_WAIT() asm volatile("s_waitcnt lgkmcnt(0)" ::: "memory")
#define VM_WAIT() asm volatile("s_waitcnt vmcnt(0)" ::: "memory")
__device__ __forceinline__ unsigned long long rt() { return __builtin_amdgcn_s_memrealtime(); }
__device__ __forceinline__ unsigned f2bf(float f) { unsigned u = __builtin_bit_cast(unsigned, f); return (u + 0x7fffu + ((u >> 16) & 1u)) >> 16; }
__device__ __forceinline__ unsigned pk2(float lo, float hi) { return f2bf(lo) | (f2bf(hi) << 16); }

#define XB_TMO      128
#define XB_XCNT(j)  (256  + 64 * (j))
#define XB_XSUB(j)  (1280 + 64 * (j))
#define XB_XGEN(j)  (2304 + 64 * (j))
#define XB_TOP      3328
#define XB_TOPGEN   3392
#define XCD_BAR_WORDS 3456
#define XB_SPIN_CAP (1u << 18)

__device__ __forceinline__ unsigned xb_ld(unsigned* p)              { return __hip_atomic_load(p, __ATOMIC_RELAXED, __HIP_MEMORY_SCOPE_AGENT); }
__device__ __forceinline__ unsigned xb_add(unsigned* p, unsigned v) { return __hip_atomic_fetch_add(p, v, __ATOMIC_RELAXED, __HIP_MEMORY_SCOPE_AGENT); }
__device__ __forceinline__ unsigned xb_xcc_id() { return (unsigned)__builtin_amdgcn_s_getreg((3 << 11) | 20) & 0xFu; }
#define XB_SPIN(cond, bar) do { unsigned _sp = 0; while (cond) { __builtin_amdgcn_s_sleep(1); \
    if ((++_sp & 255u) == 0u) { if (xb_ld(&(bar)[XB_TMO])) break; if (_sp > XB_SPIN_CAP) { atomicAdd(&(bar)[XB_TMO], 1u); break; } } } } while (0)

struct XcdBarrier {
    unsigned* bar; unsigned x;
    volatile LAS unsigned* st;
};

__device__ __forceinline__ XcdBarrier xcd_barrier_post(unsigned* bar, volatile LAS unsigned* st) {
    XcdBarrier b; b.bar = bar; b.x = xb_xcc_id(); b.st = st;
    if (threadIdx.x == 0) (void)xb_add(&bar[XB_XCNT(b.x)], 1u);
    return b;
}
__device__ __forceinline__ void xcd_barrier_complete(unsigned* bar, unsigned x, unsigned& nloc, unsigned& nx) {
    const unsigned G = gridDim.x * gridDim.y * gridDim.z;
    unsigned sum, cnt, mine, sp = 0u;
    for (;;) {
        sum = 0u; cnt = 0u; mine = 0u;
#pragma unroll
        for (unsigned j = 0; j < 16; ++j) { const unsigned c = xb_ld(&bar[XB_XCNT(j)]); sum += c; cnt += (c > 0u) ? 1u : 0u; mine = (j == x) ? c : mine; }
        if (sum == G) break;
        __builtin_amdgcn_s_sleep(1);
        if ((++sp & 255u) == 0u) { if (xb_ld(&bar[XB_TMO])) break; if (sp > XB_SPIN_CAP) { atomicAdd(&bar[XB_TMO], 1u); break; } }
    }
    nloc = mine > 0u ? mine : 1u; nx = cnt > 0u ? cnt : 1u;
}

__device__ __forceinline__ void xcd_barrier(const XcdBarrier& b) {
    asm volatile("s_waitcnt vmcnt(0)" ::: "memory");
    __syncthreads();
    if (threadIdx.x == 0) {
        unsigned* bar = b.bar;
        __builtin_amdgcn_s_waitcnt(0);
        unsigned nloc = b.st[0], nx = b.st[1];
        if (nloc == 0u) { xcd_barrier_complete(bar, b.x, nloc, nx); b.st[0] = nloc; b.st[1] = nx; }
        const unsigned old = xb_add(&bar[XB_XSUB(b.x)], 1u);
        const unsigned gen = old / nloc;
        if (old + 1u == (gen + 1u) * nloc) {
            __builtin_amdgcn_fence(__ATOMIC_RELEASE, "agent");
            asm volatile("s_waitcnt vmcnt(0)" ::: "memory");
            const unsigned og = xb_add(&bar[XB_TOP], 1u);
            const unsigned tg = og / nx;
            if (og + 1u == (tg + 1u) * nx) xb_add(&bar[XB_TOPGEN], 1u);
            else XB_SPIN(xb_ld(&bar[XB_TOPGEN]) == tg, bar);
            __builtin_amdgcn_fence(__ATOMIC_ACQUIRE, "agent");
            xb_add(&bar[XB_XGEN(b.x)], 1u);
            asm volatile("s_waitcnt vmcnt(0)" ::: "memory");
        } else {
            XB_SPIN(xb_ld(&bar[XB_XGEN(b.x)]) == gen, bar);
            __builtin_amdgcn_fence(__ATOMIC_ACQUIRE, "agent");
            asm volatile("s_waitcnt vmcnt(0)" ::: "memory");
        }
    }
    __syncthreads();
}
typedef float f32x16 __attribute__((ext_vector_type(16)));
struct Frame {
    LAS unsigned char* lds; int tid, lane, wave, vcu, G;
};
__device__ __forceinline__ Frame make_frame(LAS unsigned char* lds) {
    Frame F; F.lds = lds; int t = threadIdx.x; asm volatile("" : "+v"(t)); int bx = blockIdx.x; asm volatile("" : "+s"(bx));
    F.tid = t; F.lane = t & 63; F.wave = __builtin_amdgcn_readfirstlane(t >> 6); F.G = gridDim.x;
    F.vcu = (F.G % 8 == 0) ? (bx % 8) * (F.G / 8) + bx / 8 : bx; return F;
}
__device__ __forceinline__ float bf2f(unsigned short h) { return __builtin_bit_cast(float, (unsigned)h << 16); }
__device__ __forceinline__ unsigned short f2bf16(float f) { return (unsigned short)f2bf(f); }
__device__ __forceinline__ float wave_sum(float v) {
#pragma unroll
    for (int o = 1; o < 64; o <<= 1) v += __shfl_xor(v, o);
    return v;
}
__device__ __forceinline__ int crow32(int r, int hi) { return (r & 3) + 8 * (r >> 2) + 4 * hi; }
template <int KSTEPS> __device__ __forceinline__ void mfma_lds(f32x16& acc, const LAS bf16* A, int pa, const LAS bf16* Bt, int pb, int r32, int hi) {
#pragma unroll
    for (int s = 0; s < KSTEPS; ++s) {
        const bf16x8 a = *(const LAS bf16x8*)(A + r32 * pa + s * 16 + hi * 8);
        const bf16x8 b = *(const LAS bf16x8*)(Bt + r32 * pb + s * 16 + hi * 8);
        acc = __builtin_amdgcn_mfma_f32_32x32x16_bf16(a, b, acc, 0, 0, 0);
    }
}
struct CvtDesc { const float* W; bf16* WT; const float* kgain; int K, N, k0, n0, kind; };
__device__ __forceinline__ void cvt_load(const CvtDesc& d, float (&v)[32], int lane) {
    const int nd = d.n0 + (lane & 31); bool ok = true; int sc = nd; float cs = 1.f;
    if (d.kind == 1) { ok = nd < INW; sc = (nd >= C_KR && nd < C_RV) ? (nd & ~63) + ((nd & 63) >> 1) + 32 * (nd & 1) : nd; cs = (nd >= C_RQ && nd < C_RK) ? 0.125f : 1.f; if (!ok) sc = 0; }
    if (d.kind == 2) { sc = ((nd % 192) >= 128) ? (nd & ~63) + ((nd & 63) >> 1) + 32 * (nd & 1) : nd; }
    const float* src = d.W + (size_t)(d.k0 + (lane >> 5)) * d.N + sc;
#pragma unroll
    for (int i = 0; i < 32; ++i) v[i] = __builtin_nontemporal_load(src + (size_t)(2 * i) * d.N);
    if (d.kgain) {
#pragma unroll
        for (int i = 0; i < 32; ++i) v[i] *= d.kgain[d.k0 + 2 * i + (lane >> 5)]; }
    if (d.kind == 1) {
#pragma unroll
        for (int i = 0; i < 32; ++i) v[i] = ok ? v[i] * cs : 0.f; }
}
__device__ __forceinline__ void cvt_finish(const CvtDesc& d, const float (&v)[32], LAS float* scr, int lane) {
#pragma unroll
    for (int i = 0; i < 32; ++i) scr[(2 * i + (lane >> 5)) * 33 + (lane & 31)] = v[i];
    LDS_WAIT(); asm volatile("" ::: "memory");
    const int c = lane & 7;
#pragma unroll
    for (int j = 0; j < 4; ++j) { const int n = (lane >> 3) + 8 * j; const LAS float* s = scr + (8 * c) * 33 + n;
        v4u o; o.x = pk2(s[0 * 33], s[1 * 33]); o.y = pk2(s[2 * 33], s[3 * 33]); o.z = pk2(s[4 * 33], s[5 * 33]); o.w = pk2(s[6 * 33], s[7 * 33]);
        *(GAS v4u*)(d.WT + (size_t)(d.n0 + n) * d.K + d.k0 + 8 * c) = o; }
    LDS_WAIT(); asm volatile("" ::: "memory");
}
__device__ __forceinline__ void x_row_to_bf16(const float* __restrict__ xrow, bf16* __restrict__ orow, float* __restrict__ rs, int lane) {
    f32x4 v[16]; float s = 0.f;
#pragma unroll
    for (int j = 0; j < 8; ++j) { const f32x4* p = (const f32x4*)(xrow + 8 * (lane + 64 * j)); v[2 * j] = p[0]; v[2 * j + 1] = p[1]; }
#pragma unroll
    for (int j = 0; j < 16; ++j) s += (v[j][0] * v[j][0] + v[j][1] * v[j][1]) + (v[j][2] * v[j][2] + v[j][3] * v[j][3]);
    const float r = 1.0f / sqrtf(wave_sum(s) * (1.0f / 4096.0f) + EPS);
    if (lane == 0) *rs = r;
#pragma unroll
    for (int j = 0; j < 8; ++j) { const f32x4 a = v[2 * j], b = v[2 * j + 1];
        v4u o; o.x = pk2(a[0], a[1]); o.y = pk2(a[2], a[3]); o.z = pk2(b[0], b[1]); o.w = pk2(b[2], b[3]);
        *(v4u*)(orow + 8 * (lane + 64 * j)) = o; }
}
__device__ __forceinline__ void unpack8(const v4u q, float* y) {
    y[0] = __builtin_bit_cast(float, q.x << 16); y[1] = __builtin_bit_cast(float, q.x & 0xffff0000u); y[2] = __builtin_bit_cast(float, q.y << 16); y[3] = __builtin_bit_cast(float, q.y & 0xffff0000u);
    y[4] = __builtin_bit_cast(float, q.z << 16); y[5] = __builtin_bit_cast(float, q.z & 0xffff0000u); y[6] = __builtin_bit_cast(float, q.w << 16); y[7] = __builtin_bit_cast(float, q.w & 0xffff0000u);
}
__device__ __forceinline__ void residual_row(const float* __restrict__ xin32, bf16* xb, const bf16* __restrict__ yrow, const float* __restrict__ gpost, float* __restrict__ out32, float* __restrict__ rs_next, bool last, int lane) {
    float x[64], y[64]; float s = 0.f;
#pragma unroll
    for (int j = 0; j < 8; ++j) { unpack8(*(const v4u*)(yrow + 8 * (lane + 64 * j)), y + 8 * j);
        if (xin32) { const f32x4* p = (const f32x4*)(xin32 + 8 * (lane + 64 * j)); const f32x4 a = p[0], b = p[1];
#pragma unroll
            for (int e = 0; e < 4; ++e) { x[8 * j + e] = a[e]; x[8 * j + 4 + e] = b[e]; } }
        else unpack8(*(const v4u*)(xb + 8 * (lane + 64 * j)), x + 8 * j); }
#pragma unroll
    for (int i = 0; i < 64; ++i) s += y[i] * y[i];
    const float r = 1.0f / sqrtf(wave_sum(s) * (1.0f / 4096.0f) + EPS);
    float s2 = 0.f;
#pragma unroll
    for (int j = 0; j < 8; ++j) { const f32x4* gp = (const f32x4*)(gpost + 8 * (lane + 64 * j)); const f32x4 g0 = gp[0], g1 = gp[1];
#pragma unroll
        for (int e = 0; e < 4; ++e) { x[8 * j + e] += y[8 * j + e] * r * g0[e]; x[8 * j + 4 + e] += y[8 * j + 4 + e] * r * g1[e]; }
#pragma unroll
        for (int e = 0; e < 8; ++e) s2 += x[8 * j + e] * x[8 * j + e];
        if (last) { f32x4* op = (f32x4*)(out32 + 8 * (lane + 64 * j)); op[0] = (f32x4){x[8 * j], x[8 * j + 1], x[8 * j + 2], x[8 * j + 3]}; op[1] = (f32x4){x[8 * j + 4], x[8 * j + 5], x[8 * j + 6], x[8 * j + 7]}; }
        else { v4u o; o.x = pk2(x[8 * j], x[8 * j + 1]); o.y = pk2(x[8 * j + 2], x[8 * j + 3]); o.z = pk2(x[8 * j + 4], x[8 * j + 5]); o.w = pk2(x[8 * j + 6], x[8 * j + 7]);
            *(v4u*)(xb + 8 * (lane + 64 * j)) = o; } }
    if (!last) { const float r2 = 1.0f / sqrtf(wave_sum(s2) * (1.0f / 4096.0f) + EPS); if (lane == 0) *rs_next = r2; }
}
__device__ __forceinline__ float ret_lg(int h) { return log1pf(-exp2f(-5.0f - (float)h)); }
__device__ __forceinline__ void sgu_phase(LAS unsigned char* lds_, const bf16* __restrict__ PROJ, bf16* __restrict__ CAT, const bf16* __restrict__ SGW, const float* __restrict__ lng, const float* __restrict__ lnb, const float* __restrict__ bs) {
    const Frame F = make_frame(lds_);
    LAS bf16* Wm = (LAS bf16*)(F.lds + RING_OFF);
    LAS bf16* VT = Wm + 128 * 136;
    const int r32 = F.lane & 31, hi = F.lane >> 5;
    for (int unit = F.vcu; unit < 512; unit += F.G) {
        const int b = unit >> 8, n = (unit >> 3) & 31, g = unit & 7;
        const size_t R0 = (size_t)b * SEQ + (size_t)n * 128; const int cb = g * 128;
        for (int q = F.tid; q < 128 * 16; q += NWAVES * 64) { const int i = q >> 4, ch = q & 15;
            *(LAS bf16x8*)(Wm + i * 136 + ch * 8) = *(const bf16x8*)(SGW + ((size_t)g * 128 + i) * 128 + ch * 8); }
        const float g0 = lng[cb + 2 * F.lane], g1 = lng[cb + 2 * F.lane + 1], b0 = lnb[cb + 2 * F.lane], b1 = lnb[cb + 2 * F.lane + 1];
        for (int jj = 0; jj < 16; ++jj) { const int j = F.wave * 16 + jj;
            const unsigned pv = *(const unsigned*)(PROJ + (R0 + j) * INP + C_V + cb + 2 * F.lane);
            const float x0 = __builtin_bit_cast(float, pv << 16), x1 = __builtin_bit_cast(float, pv & 0xffff0000u);
            const float mu = wave_sum(x0 + x1) * (1.0f / 128.0f), d0 = x0 - mu, d1 = x1 - mu;
            const float rstd = 1.0f / sqrtf(wave_sum(d0 * d0 + d1 * d1) * (1.0f / 128.0f) + EPS);
            VT[(2 * F.lane) * 136 + j] = f2bf16(d0 * rstd * g0 + b0); VT[(2 * F.lane + 1) * 136 + j] = f2bf16(d1 * rstd * g1 + b1); }
        __syncthreads();
        const int ib = F.wave >> 1, cb0 = (F.wave & 1) * 2;
        f32x16 acc0 = {}, acc1 = {};
        mfma_lds<8>(acc0, Wm + ib * 32 * 136, 136, VT + (cb0 * 32) * 136, 136, r32, hi);
        mfma_lds<8>(acc1, Wm + ib * 32 * 136, 136, VT + ((cb0 + 1) * 32) * 136, 136, r32, hi);
#pragma unroll
        for (int r = 0; r < 16; ++r) { const int i = ib * 32 + crow32(r, hi); const float bias = bs[g * 128 + i]; const size_t row = R0 + i; const int c = cb0 * 32 + r32;
            const float u0 = bf2f(PROJ[row * INP + C_U + cb + c]), u1 = bf2f(PROJ[row * INP + C_U + cb + c + 32]);
            CAT[row * DM + cb + c] = f2bf16(u0 * (acc0[r] + bias)); CAT[row * DM + cb + c + 32] = f2bf16(u1 * (acc1[r] + bias)); }
        __syncthreads();
    }
}
__device__ __forceinline__ void ret1_phase(LAS unsigned char* lds_, const bf16* __restrict__ PROJ, float* __restrict__ KVS) {
    const Frame F = make_frame(lds_);
    LAS bf16* KT = (LAS bf16*)(F.lds + RING_OFF);
    LAS bf16* VT = KT + 64 * 72;
    const int r32 = F.lane & 31, hi = F.lane >> 5;
    for (int unit = F.vcu; unit < 1024; unit += F.G) {
        const int bh = unit >> 6, c = unit & 63, b = bh >> 3, h = bh & 7; const float lg = ret_lg(h);
        const size_t R0 = (size_t)b * SEQ + (size_t)c * 64;
        const int m = F.tid >> 3, d0 = (F.tid & 7) * 8, e0 = (F.tid & 7) * 16; const float kd = expf(lg * (float)(63 - m));
        const bf16x8 kv = *(const bf16x8*)(PROJ + (R0 + m) * INP + C_RK + h * 64 + d0);
        const bf16x8 va = *(const bf16x8*)(PROJ + (R0 + m) * INP + C_RV + h * 128 + e0), vb = *(const bf16x8*)(PROJ + (R0 + m) * INP + C_RV + h * 128 + e0 + 8);
#pragma unroll
        for (int i = 0; i < 8; ++i) KT[(d0 + i) * 72 + m] = f2bf16(bf2f((unsigned short)kv[i]) * kd);
#pragma unroll
        for (int i = 0; i < 8; ++i) { VT[(e0 + i) * 72 + m] = (unsigned short)va[i]; VT[(e0 + 8 + i) * 72 + m] = (unsigned short)vb[i]; }
        __syncthreads();
        const int eb = F.wave >> 1, db = F.wave & 1;
        f32x16 acc = {};
        mfma_lds<4>(acc, VT + eb * 32 * 72, 72, KT + db * 32 * 72, 72, r32, hi);
#pragma unroll
        for (int r = 0; r < 16; ++r) KVS[((size_t)unit * 128 + eb * 32 + crow32(r, hi)) * 64 + db * 32 + r32] = acc[r];
        __syncthreads();
    }
}
__device__ __forceinline__ void ret2_phase(LAS unsigned char* lds_, const float* __restrict__ KVS, bf16* __restrict__ SB) {
    const Frame F = make_frame(lds_);
    for (int gid = F.vcu * (NWAVES * 64) + F.tid; gid < 16 * 8192; gid += F.G * NWAVES * 64) {
        const int bh = gid >> 13, idx = gid & 8191; const float cd = expf(ret_lg(bh & 7) * 64.0f);
        float S = 0.f;
#pragma unroll 8
        for (int c = 0; c < 64; ++c) { const size_t o = ((size_t)bh * 64 + c) * 8192 + idx; SB[o] = f2bf16(S); S = cd * S + KVS[o]; }
    }
}
__device__ __forceinline__ void ret3_phase(LAS unsigned char* lds_, const bf16* __restrict__ PROJ, const bf16* __restrict__ SB, bf16* __restrict__ CAT) {
    const Frame F = make_frame(lds_);
    LAS bf16* Qs = (LAS bf16*)(F.lds + RING_OFF);
    LAS bf16* Ks = Qs + 64 * 72;
    LAS bf16* VT = Ks + 64 * 72;
    LAS bf16* Ss = VT + 128 * 72;
    LAS bf16* Ps = Ss + 128 * 72;
    LAS float* red = (LAS float*)(Ps + 64 * 72);
    const int r32 = F.lane & 31, hi = F.lane >> 5;
    for (int unit = F.vcu; unit < 1024; unit += F.G) {
        const int bh = unit >> 6, c = unit & 63, b = bh >> 3, h = bh & 7; const float lg = ret_lg(h);
        const size_t R0 = (size_t)b * SEQ + (size_t)c * 64;
        { const int m = F.tid >> 3, d0 = (F.tid & 7) * 8, e0 = (F.tid & 7) * 16;
          *(LAS bf16x8*)(Qs + m * 72 + d0) = *(const bf16x8*)(PROJ + (R0 + m) * INP + C_RQ + h * 64 + d0);
          *(LAS bf16x8*)(Ks + m * 72 + d0) = *(const bf16x8*)(PROJ + (R0 + m) * INP + C_RK + h * 64 + d0);
          const bf16x8 va = *(const bf16x8*)(PROJ + (R0 + m) * INP + C_RV + h * 128 + e0), vb = *(const bf16x8*)(PROJ + (R0 + m) * INP + C_RV + h * 128 + e0 + 8);
#pragma unroll
          for (int i = 0; i < 8; ++i) { VT[(e0 + i) * 72 + m] = (unsigned short)va[i]; VT[(e0 + 8 + i) * 72 + m] = (unsigned short)vb[i]; }
#pragma unroll
          for (int k = 0; k < 2; ++k) { const int q = F.tid + k * 512, e = q >> 3, dd = (q & 7) * 8; *(LAS bf16x8*)(Ss + e * 72 + dd) = *(const bf16x8*)(SB + (size_t)unit * 8192 + e * 64 + dd); } }
        __syncthreads();
        const int lb = F.wave & 1, eb = F.wave >> 1;
        f32x16 cross = {};
        mfma_lds<4>(cross, Qs + lb * 32 * 72, 72, Ss + eb * 32 * 72, 72, r32, hi);
        if (F.wave < 4) { const int mb = F.wave >> 1; f32x16 sc = {};
            mfma_lds<4>(sc, Qs + lb * 32 * 72, 72, Ks + mb * 32 * 72, 72, r32, hi);
#pragma unroll
            for (int r = 0; r < 16; ++r) { const int l = lb * 32 + crow32(r, hi), mm = mb * 32 + r32; const int ad = l > mm ? l - mm : mm - l;
                Ps[l * 72 + mm] = f2bf16(sc[r] * expf(lg * (float)ad)); } }
        __syncthreads();
        f32x16 o = {};
        mfma_lds<4>(o, Ps + lb * 32 * 72, 72, VT + eb * 32 * 72, 72, r32, hi);
#pragma unroll
        for (int r = 0; r < 16; ++r) { const int l = lb * 32 + crow32(r, hi); o[r] += cross[r] * expf(lg * (float)(l + 1));
            float s = o[r] * o[r];
#pragma unroll
            for (int x = 1; x < 32; x <<= 1) s += __shfl_xor(s, x);
            if (r32 == 0) red[l * 4 + eb] = s; }
        __syncthreads();
#pragma unroll
        for (int r = 0; r < 16; ++r) { const int l = lb * 32 + crow32(r, hi); const f32x4 t = *(const LAS f32x4*)(red + l * 4);
            const float rn = 1.0f / sqrtf(((t[0] + t[1]) + (t[2] + t[3])) * (1.0f / 128.0f) + EPS); const int e = eb * 32 + r32;
            const float gt = bf2f(PROJ[(R0 + l) * INP + C_RG + h * 128 + e]); const float sg = gt / (1.0f + expf(-gt));
            CAT[(R0 + l) * DM + 3072 + h * 128 + e] = f2bf16(sg * (o[r] * rn)); }
        __syncthreads();
    }
}
#define CVT_LOOP(NITEMS, NIF) do { for (int it = gw; it < (NITEMS); it += (NIF) * NGW) { float vv[NIF][32]; \
    _Pragma("unroll") for (int j = 0; j < (NIF); ++j) if (it + j * NGW < (NITEMS)) { const CvtDesc d = desc_of(it + j * NGW); cvt_load(d, vv[j], F.lane); } \
    _Pragma("unroll") for (int j = 0; j < (NIF); ++j) if (it + j * NGW < (NITEMS)) { const CvtDesc d = desc_of(it + j * NGW); cvt_finish(d, vv[j], scr, F.lane); } } } while (0)
#ifndef PRO_NIF
#define PRO_NIF 2
#endif
#ifndef DEF_NIF
#define DEF_NIF 4
#endif
#ifndef DN_DEFER
#define DN_DEFER 24576
#endif
#ifndef GEMM_ALIGN
#define GEMM_ALIGN true
#endif
#ifndef GEMM_SP2
#define GEMM_SP2 true
#endif
#ifndef REP_PRO
#define REP_PRO 1
#endif
#ifndef REP_ATTN
#define REP_ATTN 1
#endif
#ifndef REP_UP
#define REP_UP 1
#endif
#ifndef REP_IN
#define REP_IN 1
#endif
#ifndef REP_QKV
#define REP_QKV 1
#endif
#ifndef REP_RET3
#define REP_RET3 1
#endif
#ifndef BAR_DUP
#define BAR_DUP 1
#endif
#ifndef REP_OUT
#define REP_OUT 1
#endif
#ifndef REP_DOWN
#define REP_DOWN 1
#endif
#ifndef REP_RES
#define REP_RES 1
#endif
#ifndef REP_SMALL
#define REP_SMALL 1
#endif
struct Args { const float* in[17]; float* out; unsigned char* ws; };
typedef const Args __attribute__((address_space(4))) CArgs;
__device__ __forceinline__ CArgs* fresh_args() { CArgs* p = (CArgs*)__builtin_amdgcn_kernarg_segment_ptr(); asm volatile("" : "+s"(p)); return p; }
__device__ __forceinline__ void prologue_phase(LAS unsigned char* lds_) {
    const Frame F = make_frame(lds_); CArgs* A = fresh_args(); unsigned char* ws = A->ws; float* rope = (float*)(ws + WS_ROPE); bf16* H = (bf16*)(ws + WS_H);
    const int gw = F.vcu * NWAVES + F.wave, NGW = F.G * NWAVES;
        LAS float* scr = (LAS float*)(F.lds + RING_OFF + F.wave * 16384);
        constexpr int I_IN = (DM / 64) * (INP / 32), I_Q = (1024 / 64) * (QW / 32), I_KV = (512 / 64) * (KVW / 32), I_OUT = (DM / 64) * (DM / 32), I_UP = (DM / 64) * (FF / 32);
        constexpr int I_DNP = (FF / 64) * (DM / 32) - DN_DEFER;
        constexpr int I_L = I_IN + I_Q + I_KV + I_OUT + I_UP + I_DNP;
        auto desc_of = [&](int it) -> CvtDesc {
            const int l = it / I_L; int r = it % I_L; unsigned char* wl = ws + WS_W + (size_t)l * LW; CvtDesc d; int nblk;
            if (r < I_IN) { d.W = A->in[5] + (size_t)l * DM * INW; d.WT = (bf16*)(wl + W_IN); d.kgain = A->in[1] + l * DM; d.K = DM; d.N = INW; nblk = INP / 32; d.kind = 1; }
            else if ((r -= I_IN) < I_Q) { d.W = A->in[11] + (size_t)l * 1024 * QW; d.WT = (bf16*)(wl + W_Q); d.kgain = A->in[10] + l * 1024; d.K = 1024; d.N = QW; nblk = QW / 32; d.kind = 2; }
            else if ((r -= I_Q) < I_KV) { d.W = A->in[13] + (size_t)l * 512 * KVW; d.WT = (bf16*)(wl + W_KV); d.kgain = A->in[12] + l * 512; d.K = 512; d.N = KVW; nblk = KVW / 32; d.kind = 0; }
            else if ((r -= I_KV) < I_OUT) { d.W = A->in[14] + (size_t)l * DM * DM; d.WT = (bf16*)(wl + W_OUT); d.kgain = nullptr; d.K = DM; d.N = DM; nblk = DM / 32; d.kind = 0; }
            else if ((r -= I_OUT) < I_UP) { d.W = A->in[15] + (size_t)l * DM * FF; d.WT = (bf16*)(wl + W_UP); d.kgain = A->in[3] + l * DM; d.K = DM; d.N = FF; nblk = FF / 32; d.kind = 0; }
            else { r -= I_UP; r += DN_DEFER; d.W = A->in[16] + (size_t)l * FF * DM; d.WT = (bf16*)(wl + W_DOWN); d.kgain = nullptr; d.K = FF; d.N = DM; nblk = DM / 32; d.kind = 0; }
            d.k0 = 64 * (r / nblk); d.n0 = 32 * (r % nblk); return d; };
        CVT_LOOP(DEPTH * I_L, PRO_NIF);
        for (int i = F.vcu * (NWAVES * 64) + F.tid; i < DEPTH * 8 * 128 * 128; i += F.G * NWAVES * 64) {
            const int l = i >> 17, r = i & 131071, ii = (r >> 7) & 127, jj = r & 127;
            ((bf16*)(ws + WS_W + (size_t)l * LW + W_SGU))[r] = ((jj >> 6) <= (ii >> 6)) ? f2bf16(A->in[8][i]) : (bf16)0; }
        for (int i = F.vcu * (NWAVES * 64) + F.tid; i < SEQ * 32; i += F.G * NWAVES * 64) {
            const int pos = i >> 5, j = i & 31; const float inv = (float)pow(10000.0, -(double)j / 32.0); const float ang = (float)pos * inv;
            float sn, cs; sincosf(ang, &sn, &cs); rope[2 * i] = cs; rope[2 * i + 1] = sn; }
        { float* rs0 = (float*)(ws + WS_RS); for (int m = gw; m < M; m += NGW) x_row_to_bf16(A->in[0] + (size_t)m * DM, H + (size_t)m * DM, rs0 + m, F.lane); }
}
__device__ __forceinline__ void convert_down_phase(LAS unsigned char* lds_, int l, int idx, int n) {
    const Frame F = make_frame(lds_); CArgs* A = fresh_args(); unsigned char* ws = A->ws;
    LAS float* scr = (LAS float*)(F.lds + RING_OFF + F.wave * 16384);
    constexpr int I_DN = (FF / 64) * (DM / 32), NB = DM / 32;
    const int gw = idx * NWAVES + F.wave, NGW = n * NWAVES;
    auto desc_of = [&](int r) -> CvtDesc { CvtDesc d; d.W = A->in[16] + (size_t)l * FF * DM; d.WT = (bf16*)(ws + WS_W + (size_t)l * LW + W_DOWN); d.kgain = nullptr; d.K = FF; d.N = DM; d.kind = 0;
        d.k0 = 64 * (r / NB); d.n0 = 32 * (r % NB); return d; };
    CVT_LOOP(DN_DEFER, DEF_NIF);
}
__device__ __forceinline__ void residual_phase(LAS unsigned char* lds_, int l, int which, bool dry = false) {
    const Frame F = make_frame(lds_); CArgs* A = fresh_args(); unsigned char* ws = A->ws; const int gw = F.vcu * NWAVES + F.wave, NGW = F.G * NWAVES;
    const float* xin32 = (which == 0 && l == 0) ? A->in[0] : nullptr; const bf16* Y = (const bf16*)(ws + WS_MIX); bf16* XB = (bf16*)(ws + WS_H);
    const bool last = (which == 1 && l + 1 == DEPTH);
    float* out32 = dry ? (float*)(ws + WS_ACT) : A->out; float* rs_next = (float*)(ws + WS_RS) + (which == 0 ? M : 0) + (dry ? 2 * M : 0);
    if (dry) XB = (bf16*)(ws + WS_ACT + 134 * MiB);
    const float* gpost = (which == 0 ? A->in[2] : A->in[4]) + l * DM;
    for (int m = gw; m < M; m += NGW) residual_row(xin32 ? xin32 + (size_t)m * DM : nullptr, XB + (size_t)m * DM, Y + (size_t)m * DM, gpost, out32 + (size_t)m * DM, rs_next + m, last, F.lane);
}
__device__ __forceinline__ void attn_phase(LAS unsigned char* lds_) {
    const Frame F = make_frame(lds_); CArgs* A = fresh_args(); unsigned char* ws = A->ws;
    const bf16* QB = (const bf16*)(ws + WS_Q); const bf16* KVB = (const bf16*)(ws + WS_KV); const bf16* PROJ = (const bf16*)(ws + WS_PROJ); bf16* CAT = (bf16*)(ws + WS_CAT);
    for (int p2 = 2 * F.vcu; p2 < 512; p2 += 2 * F.G)
        for (int k = 0; k < 2; ++k) { const int p = p2 >> 1, bh = p >> 3, s = p & 7;
            att::attn_unit(QB, KVB, PROJ, CAT, bh >> 4, bh & 15, k ? 15 - s : s, (ATT_LAS char*)(F.lds + RING_OFF)); }
}
template <int WHICH> __device__ __forceinline__ void gemm_call(LAS unsigned char* lds_, int l) {
    CArgs* A = fresh_args(); unsigned char* ws = A->ws; unsigned char* wl = ws + WS_W + (size_t)l * LW; int bx = blockIdx.x; asm volatile("" : "+s"(bx)); const int G = gridDim.x;
    float* rope = (float*)(ws + WS_ROPE); float* ssq = (float*)(ws + WS_SSQ); const float* rs = (const float*)(ws + WS_RS);
    bf16* H = (bf16*)(ws + WS_H); bf16* PROJ = (bf16*)(ws + WS_PROJ); bf16* QB = (bf16*)(ws + WS_Q); bf16* KVB = (bf16*)(ws + WS_KV);
    bf16* CAT = (bf16*)(ws + WS_CAT); bf16* MIX = (bf16*)(ws + WS_MIX); bf16* ACT = (bf16*)(ws + WS_ACT);
    pg8::StaticOrder S;
    if constexpr (WHICH == 0) { pg8::Gemm g{H, (const bf16*)(wl + W_IN), M, INP, DM, DM}; S.init(M, INP, G, bx); pg8::Epi<2> E{PROJ, INP, rope, ssq, rs};
        pg8::gemm_phase<pg8::Epi<2>, pg8::StaticOrder, GEMM_ALIGN, GEMM_SP2>(lds_ + RING_OFF, g, S, E); }
    if constexpr (WHICH == 1) { pg8::Gemm g{PROJ + C_CQ, (const bf16*)(wl + W_Q), M, QW, 1024, INP}; S.init(M, QW, G, bx); pg8::Epi<3> E{QB, QW, rope, ssq, nullptr};
        pg8::gemm_phase<pg8::Epi<3>, pg8::StaticOrder, GEMM_ALIGN, GEMM_SP2>(lds_ + RING_OFF, g, S, E); }
    if constexpr (WHICH == 2) { pg8::Gemm g{PROJ + C_CKV, (const bf16*)(wl + W_KV), M, KVW, 512, INP}; S.init(M, KVW, G, bx); pg8::Epi<4> E{KVB, KVW, rope, ssq, nullptr};
        pg8::gemm_phase<pg8::Epi<4>, pg8::StaticOrder, GEMM_ALIGN, GEMM_SP2>(lds_ + RING_OFF, g, S, E); }
    if constexpr (WHICH == 3) { pg8::Gemm g{CAT, (const bf16*)(wl + W_OUT), M, DM, DM, DM}; S.init(M, DM, G, bx); pg8::Epi<0> E{MIX, DM, rope, ssq, nullptr};
        pg8::gemm_phase<pg8::Epi<0>, pg8::StaticOrder, GEMM_ALIGN, GEMM_SP2>(lds_ + RING_OFF, g, S, E); }
    if constexpr (WHICH == 4) { pg8::Gemm g{H, (const bf16*)(wl + W_UP), M, FF, DM, DM}; S.init(M, FF, G, bx); pg8::Epi<1> E{ACT, FF, rope, ssq, rs + M};
        pg8::gemm_phase<pg8::Epi<1>, pg8::StaticOrder, GEMM_ALIGN, GEMM_SP2>(lds_ + RING_OFF, g, S, E); }
    if constexpr (WHICH == 5) { pg8::Gemm g{ACT, (const bf16*)(wl + W_DOWN), M, DM, FF, FF}; S.init(M, DM, G, bx); pg8::Epi<0> E{MIX, DM, rope, ssq, nullptr};
        pg8::gemm_phase<pg8::Epi<0>, pg8::StaticOrder, GEMM_ALIGN, GEMM_SP2>(lds_ + RING_OFF, g, S, E); }
}
__device__ __forceinline__ void mixer_small_phases(LAS unsigned char* lds_, int l) {
    CArgs* A = fresh_args(); unsigned char* ws = A->ws;
    sgu_phase(lds_, (const bf16*)(ws + WS_PROJ), (bf16*)(ws + WS_CAT), (const bf16*)(ws + WS_W + (size_t)l * LW + W_SGU), A->in[6] + l * 1024, A->in[7] + l * 1024, A->in[9] + l * 1024);
    CArgs* A2 = fresh_args(); unsigned char* ws2 = A2->ws;
    ret1_phase(lds_, (const bf16*)(ws2 + WS_PROJ), (float*)(ws2 + WS_KVS));
}
__global__ void __launch_bounds__(NWAVES * 64, 2) mega_fwd(Args args) {
    extern __shared__ __attribute__((aligned(16))) unsigned char lds[];
    LAS unsigned char* L = (LAS unsigned char*)lds;
    volatile LAS unsigned* MISC = (volatile LAS unsigned*)(L + MISC_OFF);
    for (int u = threadIdx.x; u < (LDS_BYTES - LDSCTL_OFF) / 4; u += NWAVES * 64) ((LAS unsigned*)(L + LDSCTL_OFF))[u] = 0u;
    __syncthreads();
    XcdBarrier bar = xcd_barrier_post((unsigned*)(args.ws + WS_CTL) + CW_BAR, MISC + 8);
#define GRID_BAR() do { for (int bd_ = 0; bd_ < BAR_DUP; ++bd_) { XcdBarrier b_ = bar; asm volatile("" : "+s"(b_.bar), "+s"(b_.x)); xcd_barrier(b_); } } while (0)
    for (int rep_ = 0; rep_ < REP_PRO; ++rep_) prologue_phase(L);
    GRID_BAR();
    for (int l = 0; l < DEPTH; ++l) {
        for (int rep_ = 0; rep_ < REP_IN; ++rep_) gemm_call<0>(L, l);
        { int bx = blockIdx.x; asm volatile("" : "+s"(bx)); const int G = gridDim.x, NT_IN = (M / 256) * (INP / 256), nfull = NT_IN % G;
          if (nfull == 0) convert_down_phase(L, l, bx, G); else if (bx >= nfull) convert_down_phase(L, l, bx - nfull, G - nfull); }
        GRID_BAR();
        for (int rep_ = 0; rep_ < REP_QKV; ++rep_) { gemm_call<1>(L, l); gemm_call<2>(L, l); }
        for (int rep_ = 0; rep_ < REP_SMALL; ++rep_) mixer_small_phases(L, l);
        GRID_BAR();
        { CArgs* A = fresh_args(); unsigned char* ws = A->ws; ret2_phase(L, (const float*)(ws + WS_KVS), (bf16*)(ws + WS_SB)); }
        for (int rep_ = 0; rep_ < REP_ATTN; ++rep_) attn_phase(L);
        GRID_BAR();
        for (int rep_ = 0; rep_ < REP_RET3; ++rep_) { CArgs* A = fresh_args(); unsigned char* ws = A->ws; ret3_phase(L, (const bf16*)(ws + WS_PROJ), (const bf16*)(ws + WS_SB), (bf16*)(ws + WS_CAT)); }
        GRID_BAR();
        for (int rep_ = 0; rep_ < REP_OUT; ++rep_) gemm_call<3>(L, l);
        GRID_BAR();
        for (int rep_ = 0; rep_ < REP_RES; ++rep_) residual_phase(L, l, 0, rep_ + 1 < REP_RES);
        GRID_BAR();
        for (int rep_ = 0; rep_ < REP_UP; ++rep_) gemm_call<4>(L, l);
        GRID_BAR();
        for (int rep_ = 0; rep_ < REP_DOWN; ++rep_) gemm_call<5>(L, l);
        GRID_BAR();
        for (int rep_ = 0; rep_ < REP_RES; ++rep_) residual_phase(L, l, 1, rep_ + 1 < REP_RES);
        if (l + 1 < DEPTH) GRID_BAR();
    }
}

extern "C" void kernel_launch(void* const* d_in, const int* in_sizes, int n_in, void* d_out, int out_size, void* d_ws, size_t ws_size, hipStream_t stream) {
    static int grid = 0;
    if (grid == 0) {
        if (n_in != 17 || in_sizes[0] != M * DM || out_size != M * DM || ws_size < WS_END) { fprintf(stderr, "kernel_launch: shape mismatch (n_in %d, in0 %d, out %d, ws %zu < %zu)\n", n_in, n_in > 0 ? in_sizes[0] : -1, out_size, ws_size, (size_t)WS_END); grid = -1; return; }
        int dev = 0, cus = 0, per_cu = 0;
        if (hipGetDevice(&dev) != hipSuccess || hipDeviceGetAttribute(&cus, hipDeviceAttributeMultiprocessorCount, dev) != hipSuccess) { grid = -1; return; }
        if (hipFuncSetAttribute((const void*)mega_fwd, hipFuncAttributeMaxDynamicSharedMemorySize, LDS_BYTES) != hipSuccess) { fprintf(stderr, "kernel_launch: hipFuncSetAttribute failed\n"); grid = -1; return; }
        if (hipOccupancyMaxActiveBlocksPerMultiprocessor(&per_cu, (const void*)mega_fwd, NWAVES * 64, LDS_BYTES) != hipSuccess || per_cu < 1)
            fprintf(stderr, "kernel_launch: note: occupancy query reports %d workgroups per CU\n", per_cu);
        (void)hipGetLastError();
        grid = cus;
    }
    if (grid < 0) return;
    if (hipMemsetAsync((char*)d_ws + WS_CTL, 0, CTL_ZERO_BYTES, stream) != hipSuccess) { fprintf(stderr, "kernel_launch: memset failed\n"); return; }
    Args a{};
    for (int i = 0; i < 17; ++i) a.in[i] = (const float*)d_in[i];
    a.out = (float*)d_out; a.ws = (unsigned char*)d_ws;
    hipLaunchKernelGGL(mega_fwd, dim3(grid), dim3(NWAVES * 64), LDS_BYTES, stream, a);
    const hipError_t le = hipPeekAtLastError();
    if (le != hipSuccess) fprintf(stderr, "kernel_launch: launch failed: %s\n", hipGetErrorName(le));
}
```

```cpp
#include <hip/hip_runtime.h>
#include <cstdio>
#include <cstdint>
namespace pg8 {
#define PG8_LAS __attribute__((address_space(3)))
typedef unsigned short bf16_t;
typedef short bf16x8 __attribute__((ext_vector_type(8)));
typedef float f32x4 __attribute__((ext_vector_type(4)));
typedef unsigned u32x4 __attribute__((ext_vector_type(4)));
constexpr int BM = 256, BK = 64, HALF = 128, HTB = HALF * BK * 2  , STAGE_BYTES = 8 * HTB, NXCD = 8, WGM = 8;

__host__ __device__ __forceinline__ int lds_byte(int r, int c) { const int st = (r >> 4) * 2 + (c >> 5), rr = r & 15, cc = c & 31, ob = rr * 64 + cc * 2; return st * 1024 + (ob ^ (((ob >> 9) & 1) << 5)); }
__host__ __device__ __forceinline__ void stage_rc(int b, int& R, int& C) { const int st = b / 1024, sb = b % 1024, swz = sb ^ (((sb >> 9) & 1) << 5); R = (st >> 1) * 16 + swz / 64; C = (st & 1) * 32 + (swz % 64) / 2; }
__host__ __device__ __forceinline__ int perm32(int rho) { const int n = rho >> 4, i = rho & 15; return 8 * (i >> 2) + 4 * n + (i & 3); }

struct Unit { int pm, pn; };
struct Gemm { const bf16_t* A; const bf16_t* Bt; int M, N, K, lda, krev; };

struct StaticOrder {
    int nM, nN, nwg, G, c;
    __host__ __device__ void init(int M, int N, int G_, int c_) { nM = M / BM; nN = N / BM; nwg = nM * nN; G = G_; c = c_; }
    __host__ __device__ bool next(int i, Unit& u) const {
        const long L = (long)i * G + c; if (L >= nwg) return false;
        int wgid = (int)L; { const int q = nwg / NXCD, r = nwg % NXCD, xcd = wgid % NXCD, off = wgid / NXCD; wgid = (xcd < r ? xcd * (q + 1) : r * (q + 1) + (xcd - r) * q) + off; }
        const int nig = WGM * nN, gid = wgid / nig, fm = gid * WGM, gsz = (nM - fm) < WGM ? (nM - fm) : WGM;
        u.pm = fm + ((wgid % nig) % gsz); u.pn = (wgid % nig) / gsz; return true;
    }
    __device__ __forceinline__ void a_ready(const Unit&) const {}
    __device__ __forceinline__ void done(const Unit&) const {}
};
__device__ __forceinline__ unsigned cvt_pk_bf16(float lo, float hi) { unsigned r; asm volatile("v_cvt_pk_bf16_f32 %0, %1, %2" : "=v"(r) : "v"(lo), "v"(hi)); return r; }
__device__ __forceinline__ void rope8(f32x4& v0, f32x4& v1, const float* tab) {
    const f32x4 t0 = *(const f32x4*)tab, t1 = *(const f32x4*)(tab + 4);
    f32x4 a, b;
    a[0] = v0[0] * t0[0] - v0[1] * t0[1]; a[1] = v0[0] * t0[1] + v0[1] * t0[0];
    a[2] = v0[2] * t0[2] - v0[3] * t0[3]; a[3] = v0[2] * t0[3] + v0[3] * t0[2];
    b[0] = v1[0] * t1[0] - v1[1] * t1[1]; b[1] = v1[0] * t1[1] + v1[1] * t1[0];
    b[2] = v1[2] * t1[2] - v1[3] * t1[3]; b[3] = v1[2] * t1[3] + v1[3] * t1[2];
    v0 = a; v1 = b;
}
template <int MODE> struct Epi {
    static constexpr bool PERM = true, AFTER_DRAIN = false;
    bf16_t* O; int ldc; const float* rope; float* ssq; const float* rsc;
    __device__ __forceinline__ void operator()(const f32x4 (&acc)[2][2][4][2], const Unit& u, int wr, int wc, int fr, int fq) const {
        const int row0 = u.pm * BM + wr * 64 + fr, colt = u.pn * BM + wc * 32 + 8 * fq;
        const bool want_ss = (MODE == 2) && u.pn >= 8 && u.pn < 14;
#pragma unroll
        for (int ai = 0; ai < 2; ++ai)
#pragma unroll
            for (int m = 0; m < 4; ++m) {
                const int row = row0 + ai * HALF + m * 16;
                float rs = 1.f;
                if (MODE == 1 || MODE == 2) rs = rsc[row];
                if (MODE == 3) { const f32x4* s = (const f32x4*)(ssq + (size_t)row * 24); const f32x4 a = s[0], b = s[1], c = s[2], d = s[3];
                    const float t = ((a[0] + a[1]) + (a[2] + a[3])) + ((b[0] + b[1]) + (b[2] + b[3])) + ((c[0] + c[1]) + (c[2] + c[3])) + ((d[0] + d[1]) + (d[2] + d[3]));
                    rs = 1.0f / sqrtf(t * (1.0f / 1024.0f) + 1e-6f); }
                if (MODE == 4) { const f32x4* s = (const f32x4*)(ssq + (size_t)row * 24); const f32x4 a = s[4], b = s[5];
                    const float t = ((a[0] + a[1]) + (a[2] + a[3])) + ((b[0] + b[1]) + (b[2] + b[3]));
                    rs = 1.0f / sqrtf(t * (1.0f / 512.0f) + 1e-6f); }
                float part = 0.f;
#pragma unroll
                for (int bj = 0; bj < 2; ++bj) {
                    const int col = colt + bj * HALF;
                    f32x4 v0 = acc[ai][bj][m][0], v1 = acc[ai][bj][m][1];
                    if (MODE == 1) {
#pragma unroll
                        for (int j = 0; j < 4; ++j) { const float p = fmaxf(v0[j] * rs, 0.f), q = fmaxf(v1[j] * rs, 0.f); v0[j] = p * p; v1[j] = q * q; } }
                    if (MODE == 2) { v0 = v0 * rs; v1 = v1 * rs;
                        if (want_ss) part += ((v0[0] * v0[0] + v0[1] * v0[1]) + (v0[2] * v0[2] + v0[3] * v0[3])) + ((v1[0] * v1[0] + v1[1] * v1[1]) + (v1[2] * v1[2] + v1[3] * v1[3]));
                        if (col >= 3584 && col < 4672) rope8(v0, v1, rope + ((size_t)(row & 4095) * 32 + ((col & 63) >> 1)) * 2); }
                    if (MODE == 3) { v0 = v0 * rs; v1 = v1 * rs; if ((col % 192) >= 128) rope8(v0, v1, rope + ((size_t)(row & 4095) * 32 + ((col & 63) >> 1)) * 2); }
                    if (MODE == 4) { v0 = v0 * rs; v1 = v1 * rs; }
                    u32x4 w; w.x = cvt_pk_bf16(v0[0], v0[1]); w.y = cvt_pk_bf16(v0[2], v0[3]); w.z = cvt_pk_bf16(v1[0], v1[1]); w.w = cvt_pk_bf16(v1[2], v1[3]);
                    *(u32x4*)(O + (size_t)row * ldc + col) = w;
                }
                if (want_ss) { part += __shfl_xor(part, 16); part += __shfl_xor(part, 32); if (fq == 0) ssq[(size_t)row * 24 + (u.pn - 8) * 4 + wc] = part; }
            }
    }
};
template <class Epi, class Sched, bool ALIGN_EPI = false, bool SP2 = false>
__device__ __forceinline__ void gemm_phase(PG8_LAS unsigned char* lds, const Gemm g, const Sched& S, const Epi& E) {
    int tid_ = threadIdx.x; asm volatile("" : "+v"(tid_));
    const int tid = tid_, wid = __builtin_amdgcn_readfirstlane(tid >> 6), lane = tid & 63, wr = wid >> 2, wc = wid & 3, fr = lane & 15, fq = lane >> 4;
    const int K = g.K, nt = K / BK;
    unsigned voffA[2], voffB[2];
#pragma unroll
    for (int i = 0; i < 2; ++i) { int R, C; stage_rc(tid * 16 + i * 8192, R, C); const int Rb = Epi::PERM ? ((R & ~31) + perm32(R & 31)) : R;
        voffA[i] = (unsigned)(R * g.lda + C) * 2u; voffB[i] = (unsigned)(Rb * K + C) * 2u; }
    const long kstep = g.krev ? -(long)(BK * 2) : (long)(BK * 2);
    const size_t hstep = (size_t)HALF * K * 2;
    const size_t tstep = 2 * hstep; const size_t hstepA = (size_t)HALF * g.lda * 2, tstepA = 2 * hstepA;
    const unsigned ldsw = (unsigned)wid * 1024u;
    const int aoff = lds_byte(wr * 64 + fr, fq * 8), boff = lds_byte(wc * 32 + fr, fq * 8);
#define PG8_SA(b, h) (((b) * 2 + (h)) * HTB)
#define PG8_SB(b, h) ((4 + (b) * 2 + (h)) * HTB)
#define PG8_STAGE(bufoff, gbase, voff) do { _Pragma("unroll") for (int _i = 0; _i < 2; ++_i) \
        __builtin_amdgcn_global_load_lds((const unsigned*)((const char*)(gbase) + (voff)[_i]), (PG8_LAS unsigned*)(lds + (bufoff) + ldsw + _i * 8192), 16, 0, 0); } while (0)
#define PG8_LDA(dst, b, h) do { _Pragma("unroll") for (int m = 0; m < 4; ++m) _Pragma("unroll") for (int k = 0; k < 2; ++k) dst[m][k] = *(const PG8_LAS bf16x8*)(lds + PG8_SA(b, h) + aoff + m * 2048 + k * 1024); } while (0)
#define PG8_LDB(dst, b, h) do { _Pragma("unroll") for (int n = 0; n < 2; ++n) _Pragma("unroll") for (int k = 0; k < 2; ++k) dst[n][k] = *(const PG8_LAS bf16x8*)(lds + PG8_SB(b, h) + boff + n * 2048 + k * 1024); } while (0)
#define PG8_MMA(ai, bj, At, Bt) do { __builtin_amdgcn_s_setprio(1); _Pragma("unroll") for (int m = 0; m < 4; ++m) _Pragma("unroll") for (int n = 0; n < 2; ++n) _Pragma("unroll") for (int k = 0; k < 2; ++k) \
        acc[ai][bj][m][n] = __builtin_amdgcn_mfma_f32_16x16x32_bf16(Bt[n][k], At[m][k], acc[ai][bj][m][n], 0, 0, 0); __builtin_amdgcn_s_setprio(0); } while (0)
#define PG8_WAIT_V(n) asm volatile("s_waitcnt vmcnt(" #n ")" ::: "memory")
#define PG8_WAIT_L(n) asm volatile("s_waitcnt lgkmcnt(" #n ")" ::: "memory")
#define PG8_BAR __builtin_amdgcn_s_barrier()
#define PG8_SCHED __builtin_amdgcn_sched_barrier(0)
    Unit cur, nxt; int ui = 0;
    if (!S.next(0, cur)) return;
    f32x4 acc[2][2][4][2];
#pragma unroll
    for (int a = 0; a < 2; ++a)
#pragma unroll
        for (int b = 0; b < 2; ++b)
#pragma unroll
            for (int m = 0; m < 4; ++m)
#pragma unroll
                for (int n = 0; n < 2; ++n) acc[a][b][m][n] = (f32x4){0.f, 0.f, 0.f, 0.f};
    bf16x8 At[4][2], B0[2][2], B1[2][2];
    const char* cA = (const char*)g.A + (size_t)cur.pm * tstepA; const char* cB = (const char*)g.Bt + (size_t)cur.pn * tstep;
    S.a_ready(cur);
    if constexpr (SP2) {
        PG8_STAGE(PG8_SB(0, 0), cB, voffB); PG8_STAGE(PG8_SB(0, 1), cB + hstep, voffB); PG8_STAGE(PG8_SA(0, 0), cA, voffA); PG8_STAGE(PG8_SA(0, 1), cA + hstepA, voffA);
        if (wr == 1) PG8_BAR;
        PG8_WAIT_V(2); PG8_BAR;
        PG8_STAGE(PG8_SB(1, 0), cB + kstep, voffB); PG8_STAGE(PG8_SA(1, 0), cA + kstep, voffA); PG8_STAGE(PG8_SB(1, 1), cB + hstep + kstep, voffB);
        PG8_WAIT_V(6); PG8_BAR;
    } else {
        PG8_STAGE(PG8_SB(0, 0), cB, voffB); PG8_STAGE(PG8_SA(0, 0), cA, voffA); PG8_STAGE(PG8_SB(0, 1), cB + hstep, voffB); PG8_STAGE(PG8_SA(0, 1), cA + hstepA, voffA);
        if (wr == 1) PG8_BAR;
        PG8_WAIT_V(4); PG8_BAR;
        PG8_STAGE(PG8_SB(1, 0), cB + kstep, voffB); PG8_STAGE(PG8_SA(1, 0), cA + kstep, voffA); PG8_STAGE(PG8_SB(1, 1), cB + hstep + kstep, voffB);
        PG8_WAIT_V(6); PG8_BAR;
    }
    for (;;) {
        const bool has_next = S.next(ui + 1, nxt);
        const char* nA = has_next ? (const char*)g.A + (size_t)nxt.pm * tstepA : cA; const char* nB = has_next ? (const char*)g.Bt + (size_t)nxt.pn * tstep : cB;
        for (int t = 0; t < nt; t += 2) {
            const bool last = (t == nt - 2);
            const char* a1 = cA + (long)(t + 1) * kstep;
            const char* a2 = last ? nA : cA + (long)(t + 2) * kstep; const char* b2 = last ? nB : cB + (long)(t + 2) * kstep;
            const char* a3 = a2 + kstep; const char* b3 = b2 + kstep;
            if (last && has_next) S.a_ready(nxt);
            if constexpr (SP2) {
            PG8_LDB(B0, 0, 0); PG8_LDB(B1, 0, 1); PG8_SCHED; PG8_LDA(At, 0, 0); PG8_STAGE(PG8_SA(1, 1), a1 + hstepA, voffA);
            PG8_WAIT_V(8); PG8_WAIT_L(0); PG8_BAR; PG8_MMA(0, 0, At, B0); PG8_MMA(0, 1, At, B1); PG8_BAR; PG8_SCHED;
            PG8_LDA(At, 0, 1); PG8_STAGE(PG8_SB(0, 0), b2, voffB); PG8_STAGE(PG8_SB(0, 1), b2 + hstep, voffB); PG8_STAGE(PG8_SA(0, 0), a2, voffA);
            PG8_WAIT_V(8); PG8_WAIT_L(0); PG8_BAR; PG8_MMA(1, 0, At, B0); PG8_MMA(1, 1, At, B1); PG8_BAR; PG8_SCHED;
            PG8_LDB(B0, 1, 0); PG8_LDB(B1, 1, 1); PG8_SCHED; PG8_LDA(At, 1, 0); PG8_STAGE(PG8_SA(0, 1), a2 + hstepA, voffA);
            PG8_WAIT_V(8); PG8_WAIT_L(0); PG8_BAR; PG8_MMA(0, 0, At, B0); PG8_MMA(0, 1, At, B1); PG8_BAR; PG8_SCHED;
            PG8_LDA(At, 1, 1); PG8_STAGE(PG8_SB(1, 0), b3, voffB); PG8_STAGE(PG8_SB(1, 1), b3 + hstep, voffB); PG8_STAGE(PG8_SA(1, 0), a3, voffA);
            PG8_WAIT_V(8); PG8_WAIT_L(0); PG8_BAR; PG8_MMA(1, 0, At, B0); PG8_MMA(1, 1, At, B1); PG8_BAR; PG8_SCHED;
            } else {
            PG8_LDB(B0, 0, 0); PG8_SCHED; PG8_LDA(At, 0, 0); PG8_STAGE(PG8_SA(1, 1), a1 + hstepA, voffA);
            PG8_WAIT_L(8); PG8_BAR; PG8_WAIT_L(0); PG8_MMA(0, 0, At, B0); PG8_BAR; PG8_SCHED;
            PG8_LDB(B1, 0, 1); PG8_STAGE(PG8_SB(0, 0), b2, voffB);
            PG8_BAR; PG8_WAIT_L(0); PG8_MMA(0, 1, At, B1); PG8_BAR;
            PG8_LDA(At, 0, 1); PG8_STAGE(PG8_SA(0, 0), a2, voffA);
            PG8_BAR; PG8_WAIT_L(0); PG8_MMA(1, 0, At, B0); PG8_BAR; PG8_SCHED;
            PG8_STAGE(PG8_SB(0, 1), b2 + hstep, voffB);
            PG8_WAIT_V(6); PG8_BAR; PG8_MMA(1, 1, At, B1); PG8_BAR;
            PG8_LDB(B0, 1, 0); PG8_SCHED; PG8_LDA(At, 1, 0); PG8_STAGE(PG8_SA(0, 1), a2 + hstepA, voffA);
            PG8_WAIT_L(8); PG8_BAR; PG8_WAIT_L(0); PG8_MMA(0, 0, At, B0); PG8_BAR; PG8_SCHED;
            PG8_LDB(B1, 1, 1); PG8_STAGE(PG8_SB(1, 0), b3, voffB);
            PG8_BAR; PG8_WAIT_L(0); PG8_MMA(0, 1, At, B1); PG8_BAR;
            PG8_LDA(At, 1, 1); PG8_STAGE(PG8_SA(1, 0), a3, voffA);
            PG8_BAR; PG8_WAIT_L(0); PG8_MMA(1, 0, At, B0); PG8_BAR; PG8_SCHED;
            PG8_STAGE(PG8_SB(1, 1), b3 + hstep, voffB);
            PG8_WAIT_V(6); PG8_BAR; PG8_MMA(1, 1, At, B1); PG8_BAR;
            }
        }
        if constexpr (ALIGN_EPI) { if (wr == 0) PG8_BAR; }
        if constexpr (!Epi::AFTER_DRAIN) { E(acc, cur, wr, wc, fr, fq); S.done(cur); }
        if (!has_next) break;
#pragma unroll
        for (int a = 0; a < 2; ++a)
#pragma unroll
            for (int b = 0; b < 2; ++b)
#pragma unroll
                for (int m = 0; m < 4; ++m)
#pragma unroll
                    for (int n = 0; n < 2; ++n) acc[a][b][m][n] = (f32x4){0.f, 0.f, 0.f, 0.f};
        cur = nxt; cA = nA; cB = nB; ++ui;
        if constexpr (ALIGN_EPI) { if (wr == 1) PG8_BAR; }
    }
    PG8_WAIT_V(0);
    if constexpr (!ALIGN_EPI) { if (wr == 0) PG8_BAR; }
    PG8_BAR;
    if constexpr (Epi::AFTER_DRAIN) { E.fused(acc, cur, wr, wc, fr, fq, lds, wid, lane); S.done(cur); }
#undef PG8_SA
#undef PG8_SB
#undef PG8_STAGE
#undef PG8_LDA
#undef PG8_LDB
#undef PG8_MMA
#undef PG8_WAIT_V
#undef PG8_WAIT_L
#undef PG8_BAR
#undef PG8_SCHED
}
}
namespace att {
#define ATT_LAS __attribute__((address_space(3)))
typedef unsigned short bf16;
using bf16x8 = __attribute__((ext_vector_type(8))) short;
using s16x4  = __attribute__((ext_vector_type(4))) short;
using f32x16 = __attribute__((ext_vector_type(16))) float;
using u32x4  = __attribute__((ext_vector_type(4))) unsigned;
constexpr float SCALE = 0.07216878364870322f;
constexpr float THR = 8.f;
constexpr int SHM_V = 16384, SHM_K = 16384, SHM_R = 8192;
constexpr int OFF_V = 0, OFF_K = 2 * SHM_V, OFF_R = OFF_K + 2 * SHM_K, OFF_WS = OFF_R + 2 * SHM_R, ATT_LDS_BYTES = OFF_WS + 8 * 64 * 4;
#define KSWZ(row, colB) ((row) * 256 + ((colB) ^ (((row) & 7) << 4)))
#define RSWZ(row, colB) ((row) * 128 + ((colB) ^ (((row) & 7) << 4)))
#define SBAR() __builtin_amdgcn_sched_barrier(0)
__device__ __forceinline__ int crow(int r, int hi) { return (r & 3) + 8 * (r >> 2) + 4 * hi; }
__device__ __forceinline__ unsigned cvtpk(float lo, float hi) { unsigned r; asm volatile("v_cvt_pk_bf16_f32 %0, %1, %2" : "=v"(r) : "v"(lo), "v"(hi)); return r; }
__device__ __forceinline__ void partialSM(f32x16& p0, f32x16& p1, float& m_reg, float& mn, float& alpha) {
  constexpr float C = SCALE * 1.4426950408889634f;
  float pmax = p0[0];
#pragma unroll
  for (int r = 1; r < 16; ++r) pmax = fmaxf(pmax, p0[r]);
#pragma unroll
  for (int r = 0; r < 16; ++r) pmax = fmaxf(pmax, p1[r]);
  { auto rr = __builtin_amdgcn_permlane32_swap(__float_as_uint(pmax), __float_as_uint(pmax), false, false);
    pmax = fmaxf(__uint_as_float(rr[0]), __uint_as_float(rr[1])); }
  if (__builtin_expect(__all(pmax - m_reg <= THR / SCALE), 1)) { mn = m_reg; alpha = 1.f; }
  else { mn = fmaxf(m_reg, pmax); alpha = __builtin_amdgcn_exp2f((m_reg - mn) * C); m_reg = mn; }
  float mnC = -mn * C;
#pragma unroll
  for (int r = 0; r < 16; ++r) p0[r] = fmaf(p0[r], C, mnC);
#pragma unroll
  for (int r = 0; r < 16; ++r) p1[r] = fmaf(p1[r], C, mnC);
#pragma unroll
  for (int r = 0; r < 16; ++r) p0[r] = __builtin_amdgcn_exp2f(p0[r]);
}
__device__ __forceinline__ void finishSM(f32x16& p0, f32x16& p1, float alpha, float& l_reg, bf16x8& pa0, bf16x8& pa1, bf16x8& pa2, bf16x8& pa3) {
#pragma unroll
  for (int r = 0; r < 16; ++r) p1[r] = __builtin_amdgcn_exp2f(p1[r]);
  float ps = 0;
#pragma unroll
  for (int r = 0; r < 16; ++r) ps += p0[r];
#pragma unroll
  for (int r = 0; r < 16; ++r) ps += p1[r];
  { auto rr = __builtin_amdgcn_permlane32_swap(__float_as_uint(ps), __float_as_uint(ps), false, false);
    ps = __uint_as_float(rr[0]) + __uint_as_float(rr[1]); }
  l_reg = l_reg * alpha + ps;
#define PK4(P, BASE, OUT) do { unsigned a0 = cvtpk(P[BASE + 0], P[BASE + 1]), a1 = cvtpk(P[BASE + 2], P[BASE + 3]);   \
    unsigned b0 = cvtpk(P[BASE + 4], P[BASE + 5]), b1 = cvtpk(P[BASE + 6], P[BASE + 7]);                              \
    auto r0 = __builtin_amdgcn_permlane32_swap(a0, b0, false, false); auto r1 = __builtin_amdgcn_permlane32_swap(a1, b1, false, false); \
    u32x4 w = {r0[0], r1[0], r0[1], r1[1]}; OUT = *reinterpret_cast<bf16x8*>(&w); } while (0)
  PK4(p0, 0, pa0); PK4(p0, 8, pa1); PK4(p1, 0, pa2); PK4(p1, 8, pa3);
#undef PK4
}
__device__ __forceinline__ void qkt(f32x16& p0, f32x16& p1, const ATT_LAS char* Ks, const ATT_LAS char* Rs, const bf16x8* qr, int r32, int hi) {
  p0 = f32x16{}; p1 = f32x16{};
#pragma unroll
  for (int d0 = 0; d0 < 8; ++d0) { const int cb = (d0 * 16 + hi * 8) * 2;
    const bf16x8 b0 = *reinterpret_cast<const ATT_LAS bf16x8*>(Ks + KSWZ(r32, cb));
    const bf16x8 b1 = *reinterpret_cast<const ATT_LAS bf16x8*>(Ks + KSWZ(32 + r32, cb));
    p0 = __builtin_amdgcn_mfma_f32_32x32x16_bf16(b0, qr[d0], p0, 0, 0, 0);
    p1 = __builtin_amdgcn_mfma_f32_32x32x16_bf16(b1, qr[d0], p1, 0, 0, 0); }
#pragma unroll
  for (int d0 = 0; d0 < 4; ++d0) { const int cb = (d0 * 16 + hi * 8) * 2;
    const bf16x8 b0 = *reinterpret_cast<const ATT_LAS bf16x8*>(Rs + RSWZ(r32, cb));
    const bf16x8 b1 = *reinterpret_cast<const ATT_LAS bf16x8*>(Rs + RSWZ(32 + r32, cb));
    p0 = __builtin_amdgcn_mfma_f32_32x32x16_bf16(b0, qr[8 + d0], p0, 0, 0, 0);
    p1 = __builtin_amdgcn_mfma_f32_32x32x16_bf16(b1, qr[8 + d0], p1, 0, 0, 0); }
}
__device__ __forceinline__ int v_st(int k, int c) { const int kk = (k & ~0xC) | ((k & 4) << 1) | ((k & 8) >> 1); return ((kk >> 3) * 4 + (c >> 5)) * 512 + ((kk & 7) * 32 + (c & 31)) * 2; }
__device__ __forceinline__ int v_rd_base(int lane) { return ((lane & 3) << 3) | (((lane >> 2) & 3) << 6) | (((lane >> 4) & 1) << 5) | (((lane >> 5) & 1) << 8); }
constexpr int v_rd_off(int d0, int ks, int half) { return d0 * 512 + ks * 4096 + half * 2048; }
template <int OFF> __device__ __forceinline__ s16x4 tr_read(int vb) {
  s16x4 r; asm volatile("ds_read_b64_tr_b16 %0, %1 offset:%2" : "=&v"(r) : "v"(vb), "i"(OFF) : "memory"); return r;
}
template <int D0> __device__ __forceinline__ void pv_one(f32x16& od, int vb, bf16x8 pa0, bf16x8 pa1, bf16x8 pa2, bf16x8 pa3) {
  const s16x4 l0 = tr_read<v_rd_off(D0, 0, 0)>(vb), h0 = tr_read<v_rd_off(D0, 0, 1)>(vb), l1 = tr_read<v_rd_off(D0, 1, 0)>(vb), h1 = tr_read<v_rd_off(D0, 1, 1)>(vb);
  const s16x4 l2 = tr_read<v_rd_off(D0, 2, 0)>(vb), h2 = tr_read<v_rd_off(D0, 2, 1)>(vb), l3 = tr_read<v_rd_off(D0, 3, 0)>(vb), h3 = tr_read<v_rd_off(D0, 3, 1)>(vb);
  asm volatile("s_waitcnt lgkmcnt(0)" ::: "memory"); SBAR();
#define PK(L, H) (bf16x8){L[0], L[1], L[2], L[3], H[0], H[1], H[2], H[3]}
  od = __builtin_amdgcn_mfma_f32_32x32x16_bf16(pa0, PK(l0, h0), od, 0, 0, 0);
  od = __builtin_amdgcn_mfma_f32_32x32x16_bf16(pa1, PK(l1, h1), od, 0, 0, 0);
  od = __builtin_amdgcn_mfma_f32_32x32x16_bf16(pa2, PK(l2, h2), od, 0, 0, 0);
  od = __builtin_amdgcn_mfma_f32_32x32x16_bf16(pa3, PK(l3, h3), od, 0, 0, 0);
#undef PK
}
__device__ __forceinline__ void pv_d0(f32x16* o, int vb, bf16x8 pa0, bf16x8 pa1, bf16x8 pa2, bf16x8 pa3) {
  pv_one<0>(o[0], vb, pa0, pa1, pa2, pa3); pv_one<1>(o[1], vb, pa0, pa1, pa2, pa3); pv_one<2>(o[2], vb, pa0, pa1, pa2, pa3); pv_one<3>(o[3], vb, pa0, pa1, pa2, pa3);
}
__device__ __forceinline__ unsigned short f2bf(float f) { unsigned u = __builtin_bit_cast(unsigned, f); return (unsigned short)((u + 0x7fffu + ((u >> 16) & 1u)) >> 16); }
__device__ __forceinline__ void attn_unit(const bf16* __restrict__ Q, const bf16* __restrict__ KV, const bf16* __restrict__ PROJ, bf16* __restrict__ CAT, int b, int h, int qb, ATT_LAS char* lds) {
  int tid_ = threadIdx.x; asm volatile("" : "+v"(tid_));
  const int tid = tid_, wid = __builtin_amdgcn_readfirstlane(tid >> 6), lane = tid & 63, r32 = lane & 31, hi = lane >> 5;
  ATT_LAS char* V_lds = lds + OFF_V; ATT_LAS char* K_lds = lds + OFF_K; ATT_LAS char* R_lds = lds + OFF_R;
  ATT_LAS float* wsp = (ATT_LAS float*)(lds + OFF_WS) + wid * 64; ATT_LAS float* li_l = wsp; ATT_LAS float* al_l = wsp + 32;
  float m_reg = -1e30f, l_reg = 0; f32x16 o[4] = {}; bf16x8 qr[12];
  const size_t tok0 = (size_t)b * 4096;
  const bf16* Qw = Q + (tok0 + (size_t)qb * 256 + wid * 32 + r32) * 3072 + h * 192 + hi * 8;
#pragma unroll
  for (int d0 = 0; d0 < 12; ++d0) qr[d0] = *reinterpret_cast<const bf16x8*>(Qw + d0 * 16);
  const int cw = qb * 4 + (wid >> 1), NT = qb * 4 + 4;
  const int sr = tid >> 4, sc = (tid & 15) * 8, vst0 = v_st(sr, sc), vst1 = v_st(32 + sr, sc), kst0 = KSWZ(sr, sc * 2), kst1 = KSWZ(32 + sr, sc * 2);
  const int rr = tid >> 3, rc = (tid & 7) * 8, rst = RSWZ(rr, rc * 2);
  const bf16* Kg = KV + tok0 * 4096 + h * 256;
  const bf16* Rg = PROJ + tok0 * 6912 + 3584;
  const int vb0 = (int)(uintptr_t)V_lds + v_rd_base(lane);
  bf16x8 sv0, sv1, sk0, sk1, srp;
#define ATT_SLOAD(k0) do { sv0 = *reinterpret_cast<const bf16x8*>(Kg + (size_t)((k0) + sr) * 4096 + 128 + sc); sv1 = *reinterpret_cast<const bf16x8*>(Kg + (size_t)((k0) + 32 + sr) * 4096 + 128 + sc); \
    sk0 = *reinterpret_cast<const bf16x8*>(Kg + (size_t)((k0) + sr) * 4096 + sc); sk1 = *reinterpret_cast<const bf16x8*>(Kg + (size_t)((k0) + 32 + sr) * 4096 + sc); \
    srp = *reinterpret_cast<const bf16x8*>(Rg + (size_t)((k0) + rr) * 6912 + rc); } while (0)
#define ATT_SWRITE(bf) do { *reinterpret_cast<ATT_LAS bf16x8*>(V_lds + (bf) * SHM_V + vst0) = sv0; *reinterpret_cast<ATT_LAS bf16x8*>(V_lds + (bf) * SHM_V + vst1) = sv1; \
    *reinterpret_cast<ATT_LAS bf16x8*>(K_lds + (bf) * SHM_K + kst0) = sk0; *reinterpret_cast<ATT_LAS bf16x8*>(K_lds + (bf) * SHM_K + kst1) = sk1; \
    *reinterpret_cast<ATT_LAS bf16x8*>(R_lds + (bf) * SHM_R + rst) = srp; } while (0)
#define ATT_RESC(a) do { if (__any((a) < 1.f)) { if (hi == 0) al_l[r32] = (a); asm volatile("s_waitcnt lgkmcnt(0)" ::: "memory"); \
    _Pragma("unroll") for (int d = 0; d < 4; ++d) _Pragma("unroll") for (int r = 0; r < 16; ++r) o[d][r] *= al_l[crow(r, hi)]; } } while (0)
  ATT_SLOAD(0); asm volatile("s_waitcnt vmcnt(0)" ::: "memory"); ATT_SWRITE(0); __syncthreads();
  for (int t = 0; t < NT; ++t) {
    const int bf = t & 1;
    if (t + 1 < NT) ATT_SLOAD((t + 1) * 64);
    if (t <= cw) {
      f32x16 p0, p1; float mn, al; bf16x8 pa0, pa1, pa2, pa3;
      qkt(p0, p1, K_lds + bf * SHM_K, R_lds + bf * SHM_R, qr, r32, hi);
      partialSM(p0, p1, m_reg, mn, al);
      ATT_RESC(al);
      finishSM(p0, p1, al, l_reg, pa0, pa1, pa2, pa3); SBAR();
      pv_d0(o, vb0 + bf * SHM_V, pa0, pa1, pa2, pa3);
    }
    if (t + 1 < NT) { asm volatile("s_waitcnt vmcnt(0)" ::: "memory"); ATT_SWRITE(bf ^ 1); }
    __syncthreads();
  }
  if (hi == 0) li_l[r32] = l_reg; asm volatile("s_waitcnt lgkmcnt(0)" ::: "memory");
  float rli[16];
#pragma unroll
  for (int r = 0; r < 16; ++r) rli[r] = __builtin_amdgcn_rcpf(li_l[crow(r, hi)]);
  bf16* Ow = CAT + (tok0 + (size_t)qb * 256 + wid * 32) * 4096 + 1024 + h * 128;
#pragma unroll
  for (int r = 0; r < 16; ++r) { const int orow = crow(r, hi);
#pragma unroll
    for (int d0 = 0; d0 < 4; ++d0) Ow[(size_t)orow * 4096 + d0 * 32 + r32] = f2bf(o[d0][r] * rli[r]); }
#undef ATT_SLOAD
#undef ATT_SWRITE
#undef ATT_RESC
}
}
constexpr int NWAVES = 8;
constexpr int BATCH = 2, SEQ = 4096, DM = 4096, M = BATCH * SEQ, DEPTH = 2, FF = 16384;
constexpr int INW = 6720, INP = 6912;
constexpr int C_U = 0, C_V = 1024, C_CQ = 2048, C_CKV = 3072, C_KR = 3584, C_RQ = 3648, C_RK = 4160, C_RV = 4672, C_RG = 5696;
constexpr int QW = 3072, KVW = 4096;
constexpr float EPS = 1e-6f;
constexpr size_t MiB = 1u << 20;
constexpr size_t WS_CTL = 0, CTL_ZERO_BYTES = 1 * MiB;
constexpr size_t WS_ROPE = 1 * MiB;
constexpr size_t WS_SSQ = 2 * MiB;
constexpr size_t WS_RS = 3 * MiB;
constexpr size_t WS_W = 4 * MiB, LW = 353 * MiB;
constexpr size_t W_IN = 0, W_Q = 54 * MiB, W_KV = 60 * MiB, W_OUT = 64 * MiB, W_UP = 96 * MiB, W_DOWN = 224 * MiB, W_SGU = 352 * MiB;
constexpr size_t WS_H = WS_W + 2 * LW;
constexpr size_t WS_PROJ = WS_H + 64 * MiB;
constexpr size_t WS_Q = WS_PROJ + 108 * MiB;
constexpr size_t WS_KV = WS_Q + 48 * MiB;
constexpr size_t WS_CAT = WS_KV + 64 * MiB;
constexpr size_t WS_MIX = WS_CAT + 64 * MiB;
constexpr size_t WS_ACT = WS_MIX + 64 * MiB;
constexpr size_t WS_KVS = WS_ACT + 256 * MiB;
constexpr size_t WS_SB = WS_KVS + 32 * MiB;
constexpr size_t WS_END = WS_SB + 16 * MiB;
static_assert((size_t)INP * DM * 2 == 54 * MiB && (size_t)M * INP * 2 == 108 * MiB, "map");
constexpr int CW_BAR = 4096;
constexpr int RING_OFF = 0, RING_BYTES = 131072;
constexpr int LDSCTL_OFF = RING_BYTES, MISC_OFF = LDSCTL_OFF + 320;
constexpr int LDS_BYTES = 147456;
#define GAS __attribute__((address_space(1)))
#define LAS __attribute__((address_space(3)))
typedef unsigned short bf16;
typedef unsigned v4u __attribute__((ext_vector_type(4)));
typedef float f32x4 __attribute__((ext_vector_type(4)));
typedef short bf16x8 __attribute__((ext_vector_type(8)));
typedef GAS unsigned gu32;
typedef GAS unsigned long long gu64;
#define RLX_AGENT __ATOMIC_RELAXED, __HIP_MEMORY_SCOPE_AGENT
#define LDS_WAIT() asm volatile("s_waitcnt lgkmcnt(0)" ::: "memory")
#define VM_WAIT() asm volatile("s_waitcnt vmcnt(0)" ::: "memory")
__device__ __forceinline__ unsigned long long rt() { return __builtin_amdgcn_s_memrealtime(); }
__device__ __forceinline__ unsigned f2bf(float f) { unsigned u = __builtin_bit_cast(unsigned, f); return (u + 0x7fffu + ((u >> 16) & 1u)) >> 16; }
__device__ __forceinline__ unsigned pk2(float lo, float hi) { return f2bf(lo) | (f2bf(hi) << 16); }

#define XB_TMO      128
#define XB_XCNT(j)  (256  + 64 * (j))
#define XB_XSUB(j)  (1280 + 64 * (j))
#define XB_XGEN(j)  (2304 + 64 * (j))
#define XB_TOP      3328
#define XB_TOPGEN   3392
#define XCD_BAR_WORDS 3456
#define XB_SPIN_CAP (1u << 18)

__device__ __forceinline__ unsigned xb_ld(unsigned* p)              { return __hip_atomic_load(p, __ATOMIC_RELAXED, __HIP_MEMORY_SCOPE_AGENT); }
__device__ __forceinline__ unsigned xb_add(unsigned* p, unsigned v) { return __hip_atomic_fetch_add(p, v, __ATOMIC_RELAXED, __HIP_MEMORY_SCOPE_AGENT); }
__device__ __forceinline__ unsigned xb_xcc_id() { return (unsigned)__builtin_amdgcn_s_getreg((3 << 11) | 20) & 0xFu; }
#define XB_SPIN(cond, bar) do { unsigned _sp = 0; while (cond) { __builtin_amdgcn_s_sleep(1); \
    if ((++_sp & 255u) == 0u) { if (xb_ld(&(bar)[XB_TMO])) break; if (_sp > XB_SPIN_CAP) { atomicAdd(&(bar)[XB_TMO], 1u); break; } } } } while (0)

struct XcdBarrier {
    unsigned* bar; unsigned x;
    volatile LAS unsigned* st;
};

__device__ __forceinline__ XcdBarrier xcd_barrier_post(unsigned* bar, volatile LAS unsigned* st) {
    XcdBarrier b; b.bar = bar; b.x = xb_xcc_id(); b.st = st;
    if (threadIdx.x == 0) (void)xb_add(&bar[XB_XCNT(b.x)], 1u);
    return b;
}
__device__ __forceinline__ void xcd_barrier_complete(unsigned* bar, unsigned x, unsigned& nloc, unsigned& nx) {
    const unsigned G = gridDim.x * gridDim.y * gridDim.z;
    unsigned sum, cnt, mine, sp = 0u;
    for (;;) {
        sum = 0u; cnt = 0u; mine = 0u;
#pragma unroll
        for (unsigned j = 0; j < 16; ++j) { const unsigned c = xb_ld(&bar[XB_XCNT(j)]); sum += c; cnt += (c > 0u) ? 1u : 0u; mine = (j == x) ? c : mine; }
        if (sum == G) break;
        __builtin_amdgcn_s_sleep(1);
        if ((++sp & 255u) == 0u) { if (xb_ld(&bar[XB_TMO])) break; if (sp > XB_SPIN_CAP) { atomicAdd(&bar[XB_TMO], 1u); break; } }
    }
    nloc = mine > 0u ? mine : 1u; nx = cnt > 0u ? cnt : 1u;
}

__device__ __forceinline__ void xcd_barrier(const XcdBarrier& b) {
    asm volatile("s_waitcnt vmcnt(0)" ::: "memory");
    __syncthreads();
    if (threadIdx.x == 0) {
        unsigned* bar = b.bar;
        __builtin_amdgcn_s_waitcnt(0);
        unsigned nloc = b.st[0], nx = b.st[1];
        if (nloc == 0u) { xcd_barrier_complete(bar, b.x, nloc, nx); b.st[0] = nloc; b.st[1] = nx; }
        const unsigned old = xb_add(&bar[XB_XSUB(b.x)], 1u);
        const unsigned gen = old / nloc;
        if (old + 1u == (gen + 1u) * nloc) {
            __builtin_amdgcn_fence(__ATOMIC_RELEASE, "agent");
            asm volatile("s_waitcnt vmcnt(0)" ::: "memory");
            const unsigned og = xb_add(&bar[XB_TOP], 1u);
            const unsigned tg = og / nx;
            if (og + 1u == (tg + 1u) * nx) xb_add(&bar[XB_TOPGEN], 1u);
            else XB_SPIN(xb_ld(&bar[XB_TOPGEN]) == tg, bar);
            __builtin_amdgcn_fence(__ATOMIC_ACQUIRE, "agent");
            xb_add(&bar[XB_XGEN(b.x)], 1u);
            asm volatile("s_waitcnt vmcnt(0)" ::: "memory");
        } else {
            XB_SPIN(xb_ld(&bar[XB_XGEN(b.x)]) == gen, bar);
            __builtin_amdgcn_fence(__ATOMIC_ACQUIRE, "agent");
            asm volatile("s_waitcnt vmcnt(0)" ::: "memory");
        }
    }
    __syncthreads();
}
typedef float f32x16 __attribute__((ext_vector_type(16)));
struct Frame {
    LAS unsigned char* lds; int tid, lane, wave, vcu, G;
};
__device__ __forceinline__ Frame make_frame(LAS unsigned char* lds) {
    Frame F; F.lds = lds; int t = threadIdx.x; asm volatile("" : "+v"(t)); int bx = blockIdx.x; asm volatile("" : "+s"(bx));
    F.tid = t; F.lane = t & 63; F.wave = __builtin_amdgcn_readfirstlane(t >> 6); F.G = gridDim.x;
    F.vcu = (F.G % 8 == 0) ? (bx % 8) * (F.G / 8) + bx / 8 : bx; return F;
}
__device__ __forceinline__ float bf2f(unsigned short h) { return __builtin_bit_cast(float, (unsigned)h << 16); }
__device__ __forceinline__ unsigned short f2bf16(float f) { return (unsigned short)f2bf(f); }
__device__ __forceinline__ float wave_sum(float v) {
#pragma unroll
    for (int o = 1; o < 64; o <<= 1) v += __shfl_xor(v, o);
    return v;
}
__device__ __forceinline__ int crow32(int r, int hi) { return (r & 3) + 8 * (r >> 2) + 4 * hi; }
template <int KSTEPS> __device__ __forceinline__ void mfma_lds(f32x16& acc, const LAS bf16* A, int pa, const LAS bf16* Bt, int pb, int r32, int hi) {
#pragma unroll
    for (int s = 0; s < KSTEPS; ++s) {
        const bf16x8 a = *(const LAS bf16x8*)(A + r32 * pa + s * 16 + hi * 8);
        const bf16x8 b = *(const LAS bf16x8*)(Bt + r32 * pb + s * 16 + hi * 8);
        acc = __builtin_amdgcn_mfma_f32_32x32x16_bf16(a, b, acc, 0, 0, 0);
    }
}
struct CvtDesc { const float* W; bf16* WT; const float* kgain; int K, N, k0, n0, kind; };
__device__ __forceinline__ void cvt_load(const CvtDesc& d, float (&v)[32], int lane) {
    const int nd = d.n0 + (lane & 31); bool ok = true; int sc = nd; float cs = 1.f;
    if (d.kind == 1) { ok = nd < INW; sc = (nd >= C_KR && nd < C_RV) ? (nd & ~63) + ((nd & 63) >> 1) + 32 * (nd & 1) : nd; cs = (nd >= C_RQ && nd < C_RK) ? 0.125f : 1.f; if (!ok) sc = 0; }
    if (d.kind == 2) { sc = ((nd % 192) >= 128) ? (nd & ~63) + ((nd & 63) >> 1) + 32 * (nd & 1) : nd; }
    const float* src = d.W + (size_t)(d.k0 + (lane >> 5)) * d.N + sc;
#pragma unroll
    for (int i = 0; i < 32; ++i) v[i] = __builtin_nontemporal_load(src + (size_t)(2 * i) * d.N);
    if (d.kgain) {
#pragma unroll
        for (int i = 0; i < 32; ++i) v[i] *= d.kgain[d.k0 + 2 * i + (lane >> 5)]; }
    if (d.kind == 1) {
#pragma unroll
        for (int i = 0; i < 32; ++i) v[i] = ok ? v[i] * cs : 0.f; }
}
template <bool NT = false> __device__ __forceinline__ void cvt_finish(const CvtDesc& d, const float (&v)[32], LAS float* scr, int lane) {
#pragma unroll
    for (int i = 0; i < 32; ++i) scr[(2 * i + (lane >> 5)) * 33 + (lane & 31)] = v[i];
    LDS_WAIT(); asm volatile("" ::: "memory");
    const int c = lane & 7;
#pragma unroll
    for (int j = 0; j < 4; ++j) { const int n = (lane >> 3) + 8 * j; const LAS float* s = scr + (8 * c) * 33 + n;
        v4u o; o.x = pk2(s[0 * 33], s[1 * 33]); o.y = pk2(s[2 * 33], s[3 * 33]); o.z = pk2(s[4 * 33], s[5 * 33]); o.w = pk2(s[6 * 33], s[7 * 33]);
        if (NT) __builtin_nontemporal_store(o, (GAS v4u*)(d.WT + (size_t)(d.n0 + n) * d.K + d.k0 + 8 * c)); else *(GAS v4u*)(d.WT + (size_t)(d.n0 + n) * d.K + d.k0 + 8 * c) = o; }
    LDS_WAIT(); asm volatile("" ::: "memory");
}
__device__ __forceinline__ void x_row_to_bf16(const float* __restrict__ xrow, bf16* __restrict__ orow, float* __restrict__ rs, int lane) {
    f32x4 v[16]; float s = 0.f;
#pragma unroll
    for (int j = 0; j < 8; ++j) { const f32x4* p = (const f32x4*)(xrow + 8 * (lane + 64 * j)); v[2 * j] = p[0]; v[2 * j + 1] = p[1]; }
#pragma unroll
    for (int j = 0; j < 16; ++j) s += (v[j][0] * v[j][0] + v[j][1] * v[j][1]) + (v[j][2] * v[j][2] + v[j][3] * v[j][3]);
    const float r = 1.0f / sqrtf(wave_sum(s) * (1.0f / 4096.0f) + EPS);
    if (lane == 0) *rs = r;
#pragma unroll
    for (int j = 0; j < 8; ++j) { const f32x4 a = v[2 * j], b = v[2 * j + 1];
        v4u o; o.x = pk2(a[0], a[1]); o.y = pk2(a[2], a[3]); o.z = pk2(b[0], b[1]); o.w = pk2(b[2], b[3]);
        *(v4u*)(orow + 8 * (lane + 64 * j)) = o; }
}
__device__ __forceinline__ void unpack8(const v4u q, float* y) {
    y[0] = __builtin_bit_cast(float, q.x << 16); y[1] = __builtin_bit_cast(float, q.x & 0xffff0000u); y[2] = __builtin_bit_cast(float, q.y << 16); y[3] = __builtin_bit_cast(float, q.y & 0xffff0000u);
    y[4] = __builtin_bit_cast(float, q.z << 16); y[5] = __builtin_bit_cast(float, q.z & 0xffff0000u); y[6] = __builtin_bit_cast(float, q.w << 16); y[7] = __builtin_bit_cast(float, q.w & 0xffff0000u);
}
__device__ __forceinline__ void residual_row(const float* __restrict__ xin32, bf16* xb, const bf16* __restrict__ yrow, const float* __restrict__ gpost, float* __restrict__ out32, float* __restrict__ rs_next, bool last, int lane) {
    float x[64], y[64]; float s = 0.f;
#pragma unroll
    for (int j = 0; j < 8; ++j) { unpack8(*(const v4u*)(yrow + 8 * (lane + 64 * j)), y + 8 * j);
        if (xin32) { const f32x4* p = (const f32x4*)(xin32 + 8 * (lane + 64 * j)); const f32x4 a = p[0], b = p[1];
#pragma unroll
            for (int e = 0; e < 4; ++e) { x[8 * j + e] = a[e]; x[8 * j + 4 + e] = b[e]; } }
        else unpack8(*(const v4u*)(xb + 8 * (lane + 64 * j)), x + 8 * j); }
#pragma unroll
    for (int i = 0; i < 64; ++i) s += y[i] * y[i];
    const float r = 1.0f / sqrtf(wave_sum(s) * (1.0f / 4096.0f) + EPS);
    float s2 = 0.f;
#pragma unroll
    for (int j = 0; j < 8; ++j) { const f32x4* gp = (const f32x4*)(gpost + 8 * (lane + 64 * j)); const f32x4 g0 = gp[0], g1 = gp[1];
#pragma unroll
        for (int e = 0; e < 4; ++e) { x[8 * j + e] += y[8 * j + e] * r * g0[e]; x[8 * j + 4 + e] += y[8 * j + 4 + e] * r * g1[e]; }
#pragma unroll
        for (int e = 0; e < 8; ++e) s2 += x[8 * j + e] * x[8 * j + e];
        if (last) { f32x4* op = (f32x4*)(out32 + 8 * (lane + 64 * j)); op[0] = (f32x4){x[8 * j], x[8 * j + 1], x[8 * j + 2], x[8 * j + 3]}; op[1] = (f32x4){x[8 * j + 4], x[8 * j + 5], x[8 * j + 6], x[8 * j + 7]}; }
        else { v4u o; o.x = pk2(x[8 * j], x[8 * j + 1]); o.y = pk2(x[8 * j + 2], x[8 * j + 3]); o.z = pk2(x[8 * j + 4], x[8 * j + 5]); o.w = pk2(x[8 * j + 6], x[8 * j + 7]);
            *(v4u*)(xb + 8 * (lane + 64 * j)) = o; } }
    if (!last) { const float r2 = 1.0f / sqrtf(wave_sum(s2) * (1.0f / 4096.0f) + EPS); if (lane == 0) *rs_next = r2; }
}
__device__ __forceinline__ float ret_lg(int h) { return log1pf(-exp2f(-5.0f - (float)h)); }
__device__ __forceinline__ void sgu_phase(LAS unsigned char* lds_, const bf16* __restrict__ PROJ, bf16* __restrict__ CAT, const bf16* __restrict__ SGW, const float* __restrict__ lng, const float* __restrict__ lnb, const float* __restrict__ bs) {
    const Frame F = make_frame(lds_);
    LAS bf16* Wm = (LAS bf16*)(F.lds + RING_OFF);
    LAS bf16* VT = Wm + 128 * 136;
    const int r32 = F.lane & 31, hi = F.lane >> 5;
    for (int unit = F.vcu; unit < 512; unit += F.G) {
        const int b = unit >> 8, n = (unit >> 3) & 31, g = unit & 7;
        const size_t R0 = (size_t)b * SEQ + (size_t)n * 128; const int cb = g * 128;
        for (int q = F.tid; q < 128 * 16; q += NWAVES * 64) { const int i = q >> 4, ch = q & 15;
            *(LAS bf16x8*)(Wm + i * 136 + ch * 8) = *(const bf16x8*)(SGW + ((size_t)g * 128 + i) * 128 + ch * 8); }
        const float g0 = lng[cb + 2 * F.lane], g1 = lng[cb + 2 * F.lane + 1], b0 = lnb[cb + 2 * F.lane], b1 = lnb[cb + 2 * F.lane + 1];
        for (int jj = 0; jj < 16; ++jj) { const int j = F.wave * 16 + jj;
            const unsigned pv = *(const unsigned*)(PROJ + (R0 + j) * INP + C_V + cb + 2 * F.lane);
            const float x0 = __builtin_bit_cast(float, pv << 16), x1 = __builtin_bit_cast(float, pv & 0xffff0000u);
            const float mu = wave_sum(x0 + x1) * (1.0f / 128.0f), d0 = x0 - mu, d1 = x1 - mu;
            const float rstd = 1.0f / sqrtf(wave_sum(d0 * d0 + d1 * d1) * (1.0f / 128.0f) + EPS);
            VT[(2 * F.lane) * 136 + j] = f2bf16(d0 * rstd * g0 + b0); VT[(2 * F.lane + 1) * 136 + j] = f2bf16(d1 * rstd * g1 + b1); }
        __syncthreads();
        const int ib = F.wave >> 1, cb0 = (F.wave & 1) * 2;
        f32x16 acc0 = {}, acc1 = {};
        mfma_lds<8>(acc0, Wm + ib * 32 * 136, 136, VT + (cb0 * 32) * 136, 136, r32, hi);
        mfma_lds<8>(acc1, Wm + ib * 32 * 136, 136, VT + ((cb0 + 1) * 32) * 136, 136, r32, hi);
#pragma unroll
        for (int r = 0; r < 16; ++r) { const int i = ib * 32 + crow32(r, hi); const float bias = bs[g * 128 + i]; const size_t row = R0 + i; const int c = cb0 * 32 + r32;
            const float u0 = bf2f(PROJ[row * INP + C_U + cb + c]), u1 = bf2f(PROJ[row * INP + C_U + cb + c + 32]);
            CAT[row * DM + cb + c] = f2bf16(u0 * (acc0[r] + bias)); CAT[row * DM + cb + c + 32] = f2bf16(u1 * (acc1[r] + bias)); }
        __syncthreads();
    }
}
__device__ __forceinline__ void ret1_phase(LAS unsigned char* lds_, const bf16* __restrict__ PROJ, float* __restrict__ KVS) {
    const Frame F = make_frame(lds_);
    LAS bf16* KT = (LAS bf16*)(F.lds + RING_OFF);
    LAS bf16* VT = KT + 64 * 72;
    const int r32 = F.lane & 31, hi = F.lane >> 5;
    for (int unit = F.vcu; unit < 1024; unit += F.G) {
        const int bh = unit >> 6, c = unit & 63, b = bh >> 3, h = bh & 7; const float lg = ret_lg(h);
        const size_t R0 = (size_t)b * SEQ + (size_t)c * 64;
        const int m = F.tid >> 3, d0 = (F.tid & 7) * 8, e0 = (F.tid & 7) * 16; const float kd = expf(lg * (float)(63 - m));
        const bf16x8 kv = *(const bf16x8*)(PROJ + (R0 + m) * INP + C_RK + h * 64 + d0);
        const bf16x8 va = *(const bf16x8*)(PROJ + (R0 + m) * INP + C_RV + h * 128 + e0), vb = *(const bf16x8*)(PROJ + (R0 + m) * INP + C_RV + h * 128 + e0 + 8);
#pragma unroll
        for (int i = 0; i < 8; ++i) KT[(d0 + i) * 72 + m] = f2bf16(bf2f((unsigned short)kv[i]) * kd);
#pragma unroll
        for (int i = 0; i < 8; ++i) { VT[(e0 + i) * 72 + m] = (unsigned short)va[i]; VT[(e0 + 8 + i) * 72 + m] = (unsigned short)vb[i]; }
        __syncthreads();
        const int eb = F.wave >> 1, db = F.wave & 1;
        f32x16 acc = {};
        mfma_lds<4>(acc, VT + eb * 32 * 72, 72, KT + db * 32 * 72, 72, r32, hi);
#pragma unroll
        for (int r = 0; r < 16; ++r) KVS[((size_t)unit * 128 + eb * 32 + crow32(r, hi)) * 64 + db * 32 + r32] = acc[r];
        __syncthreads();
    }
}
__device__ __forceinline__ void ret2_phase(LAS unsigned char* lds_, const float* __restrict__ KVS, bf16* __restrict__ SB) {
    const Frame F = make_frame(lds_);
    for (int gid = F.vcu * (NWAVES * 64) + F.tid; gid < 16 * 8192; gid += F.G * NWAVES * 64) {
        const int bh = gid >> 13, idx = gid & 8191; const float cd = expf(ret_lg(bh & 7) * 64.0f);
        float S = 0.f;
#pragma unroll 8
        for (int c = 0; c < 64; ++c) { const size_t o = ((size_t)bh * 64 + c) * 8192 + idx; SB[o] = f2bf16(S); S = cd * S + KVS[o]; }
    }
}
__device__ __forceinline__ void ret3_phase(LAS unsigned char* lds_, const bf16* __restrict__ PROJ, const bf16* __restrict__ SB, bf16* __restrict__ CAT) {
    const Frame F = make_frame(lds_);
    LAS bf16* Qs = (LAS bf16*)(F.lds + RING_OFF);
    LAS bf16* Ks = Qs + 64 * 72;
    LAS bf16* VT = Ks + 64 * 72;
    LAS bf16* Ss = VT + 128 * 72;
    LAS bf16* Ps = Ss + 128 * 72;
    LAS float* red = (LAS float*)(Ps + 64 * 72);
    const int r32 = F.lane & 31, hi = F.lane >> 5;
    for (int unit = F.vcu; unit < 1024; unit += F.G) {
        const int bh = unit >> 6, c = unit & 63, b = bh >> 3, h = bh & 7; const float lg = ret_lg(h);
        const size_t R0 = (size_t)b * SEQ + (size_t)c * 64;
        { const int m = F.tid >> 3, d0 = (F.tid & 7) * 8, e0 = (F.tid & 7) * 16;
          *(LAS bf16x8*)(Qs + m * 72 + d0) = *(const bf16x8*)(PROJ + (R0 + m) * INP + C_RQ + h * 64 + d0);
          *(LAS bf16x8*)(Ks + m * 72 + d0) = *(const bf16x8*)(PROJ + (R0 + m) * INP + C_RK + h * 64 + d0);
          const bf16x8 va = *(const bf16x8*)(PROJ + (R0 + m) * INP + C_RV + h * 128 + e0), vb = *(const bf16x8*)(PROJ + (R0 + m) * INP + C_RV + h * 128 + e0 + 8);
#pragma unroll
          for (int i = 0; i < 8; ++i) { VT[(e0 + i) * 72 + m] = (unsigned short)va[i]; VT[(e0 + 8 + i) * 72 + m] = (unsigned short)vb[i]; }
#pragma unroll
          for (int k = 0; k < 2; ++k) { const int q = F.tid + k * 512, e = q >> 3, dd = (q & 7) * 8; *(LAS bf16x8*)(Ss + e * 72 + dd) = *(const bf16x8*)(SB + (size_t)unit * 8192 + e * 64 + dd); } }
        __syncthreads();
        const int lb = F.wave & 1, eb = F.wave >> 1;
        f32x16 cross = {};
        mfma_lds<4>(cross, Qs + lb * 32 * 72, 72, Ss + eb * 32 * 72, 72, r32, hi);
        if (F.wave < 4) { const int mb = F.wave >> 1; f32x16 sc = {};
            mfma_lds<4>(sc, Qs + lb * 32 * 72, 72, Ks + mb * 32 * 72, 72, r32, hi);
#pragma unroll
            for (int r = 0; r < 16; ++r) { const int l = lb * 32 + crow32(r, hi), mm = mb * 32 + r32; const int ad = l > mm ? l - mm : mm - l;
                Ps[l * 72 + mm] = f2bf16(sc[r] * expf(lg * (float)ad)); } }
        __syncthreads();
        f32x16 o = {};
        mfma_lds<4>(o, Ps + lb * 32 * 72, 72, VT + eb * 32 * 72, 72, r32, hi);
#pragma unroll
        for (int r = 0; r < 16; ++r) { const int l = lb * 32 + crow32(r, hi); o[r] += cross[r] * expf(lg * (float)(l + 1));
            float s = o[r] * o[r];
#pragma unroll
            for (int x = 1; x < 32; x <<= 1) s += __shfl_xor(s, x);
            if (r32 == 0) red[l * 4 + eb] = s; }
        __syncthreads();
#pragma unroll
        for (int r = 0; r < 16; ++r) { const int l = lb * 32 + crow32(r, hi); const f32x4 t = *(const LAS f32x4*)(red + l * 4);
            const float rn = 1.0f / sqrtf(((t[0] + t[1]) + (t[2] + t[3])) * (1.0f / 128.0f) + EPS); const int e = eb * 32 + r32;
            const float gt = bf2f(PROJ[(R0 + l) * INP + C_RG + h * 128 + e]); const float sg = gt / (1.0f + expf(-gt));
            CAT[(R0 + l) * DM + 3072 + h * 128 + e] = f2bf16(sg * (o[r] * rn)); }
        __syncthreads();
    }
}
#define CVT_LOOP(NITEMS, NIF, NTS) do { for (int it = gw; it < (NITEMS); it += (NIF) * NGW) { float vv[NIF][32]; \
    _Pragma("unroll") for (int j = 0; j < (NIF); ++j) if (it + j * NGW < (NITEMS)) { const CvtDesc d = desc_of(it + j * NGW); cvt_load(d, vv[j], F.lane); } \
    _Pragma("unroll") for (int j = 0; j < (NIF); ++j) if (it + j * NGW < (NITEMS)) { const CvtDesc d = desc_of(it + j * NGW); cvt_finish<NTS>(d, vv[j], scr, F.lane); } } } while (0)
#ifndef PRO_NIF
#define PRO_NIF 2
#endif
#ifndef DEF_NIF
#define DEF_NIF 4
#endif
#ifndef DEF_NT
#define DEF_NT true
#endif
#ifndef DOWN_KREV
#define DOWN_KREV 1
#endif
#ifndef UP_DEFER
#define UP_DEFER 0
#endif
#ifndef DN_DEFER
#define DN_DEFER 32768
#endif
#ifndef GEMM_ALIGN
#define GEMM_ALIGN true
#endif
#ifndef GEMM_SP2
#define GEMM_SP2 true
#endif
#ifndef REP_PRO
#define REP_PRO 1
#endif
#ifndef REP_ATTN
#define REP_ATTN 1
#endif
#ifndef REP_UP
#define REP_UP 1
#endif
#ifndef REP_IN
#define REP_IN 1
#endif
#ifndef REP_QKV
#define REP_QKV 1
#endif
#ifndef REP_RET3
#define REP_RET3 1
#endif
#ifndef BAR_DUP
#define BAR_DUP 1
#endif
#ifndef REP_OUT
#define REP_OUT 1
#endif
#ifndef REP_DOWN
#define REP_DOWN 1
#endif
#ifndef REP_RES
#define REP_RES 1
#endif
#ifndef REP_BAR
#define REP_BAR 0
#endif
#ifndef REP_RET2
#define REP_RET2 1
#endif
#ifndef PROBE_IDX
#define PROBE_IDX -1
#endif
#ifndef PROBE_Q
#define PROBE_Q 20
#endif
#ifndef PROBE_L
#define PROBE_L 0
#endif
#ifndef REP_SMALL
#define REP_SMALL 1
#endif
struct Args { const float* in[17]; float* out; unsigned char* ws; };
typedef const Args __attribute__((address_space(4))) CArgs;
__device__ __forceinline__ CArgs* fresh_args() { CArgs* p = (CArgs*)__builtin_amdgcn_kernarg_segment_ptr(); asm volatile("" : "+s"(p)); return p; }
__device__ __forceinline__ void prologue_phase(LAS unsigned char* lds_) {
    const Frame F = make_frame(lds_); CArgs* A = fresh_args(); unsigned char* ws = A->ws; float* rope = (float*)(ws + WS_ROPE); bf16* H = (bf16*)(ws + WS_H);
    const int gw = F.vcu * NWAVES + F.wave, NGW = F.G * NWAVES;
        LAS float* scr = (LAS float*)(F.lds + RING_OFF + F.wave * 16384);
        constexpr int I_IN = (DM / 64) * (INP / 32), I_Q = (1024 / 64) * (QW / 32), I_KV = (512 / 64) * (KVW / 32), I_OUT = (DM / 64) * (DM / 32), I_UP = (DM / 64) * (FF / 32);
        constexpr int I_DNP = (FF / 64) * (DM / 32) - DN_DEFER;
        constexpr int I_UPP = I_UP - UP_DEFER;
        constexpr int I_L = I_IN + I_Q + I_KV + I_OUT + I_UPP + I_DNP;
        auto desc_of = [&](int it_) -> CvtDesc {
            const int it = DEPTH * I_L - 1 - it_; const int l = it / I_L; int r = it % I_L; unsigned char* wl = ws + WS_W + (size_t)l * LW; CvtDesc d; int nblk;
            if (r < I_IN) { d.W = A->in[5] + (size_t)l * DM * INW; d.WT = (bf16*)(wl + W_IN); d.kgain = A->in[1] + l * DM; d.K = DM; d.N = INW; nblk = INP / 32; d.kind = 1; }
            else if ((r -= I_IN) < I_Q) { d.W = A->in[11] + (size_t)l * 1024 * QW; d.WT = (bf16*)(wl + W_Q); d.kgain = A->in[10] + l * 1024; d.K = 1024; d.N = QW; nblk = QW / 32; d.kind = 2; }
            else if ((r -= I_Q) < I_KV) { d.W = A->in[13] + (size_t)l * 512 * KVW; d.WT = (bf16*)(wl + W_KV); d.kgain = A->in[12] + l * 512; d.K = 512; d.N = KVW; nblk = KVW / 32; d.kind = 0; }
            else if ((r -= I_KV) < I_OUT) { d.W = A->in[14] + (size_t)l * DM * DM; d.WT = (bf16*)(wl + W_OUT); d.kgain = nullptr; d.K = DM; d.N = DM; nblk = DM / 32; d.kind = 0; }
            else if ((r -= I_OUT) < I_UPP) { r += UP_DEFER; d.W = A->in[15] + (size_t)l * DM * FF; d.WT = (bf16*)(wl + W_UP); d.kgain = A->in[3] + l * DM; d.K = DM; d.N = FF; nblk = FF / 32; d.kind = 0; }
            else { r -= I_UPP; r += DN_DEFER; d.W = A->in[16] + (size_t)l * FF * DM; d.WT = (bf16*)(wl + W_DOWN); d.kgain = nullptr; d.K = FF; d.N = DM; nblk = DM / 32; d.kind = 0; }
            d.k0 = 64 * (r / nblk); d.n0 = 32 * (r % nblk); return d; };
        CVT_LOOP(DEPTH * I_L, PRO_NIF, false);
        for (int i = F.vcu * (NWAVES * 64) + F.tid; i < DEPTH * 8 * 128 * 128; i += F.G * NWAVES * 64) {
            const int l = i >> 17, r = i & 131071, ii = (r >> 7) & 127, jj = r & 127;
            ((bf16*)(ws + WS_W + (size_t)l * LW + W_SGU))[r] = ((jj >> 6) <= (ii >> 6)) ? f2bf16(A->in[8][i]) : (bf16)0; }
        for (int i = F.vcu * (NWAVES * 64) + F.tid; i < SEQ * 32; i += F.G * NWAVES * 64) {
            const int pos = i >> 5, j = i & 31; const float inv = (float)pow(10000.0, -(double)j / 32.0); const float ang = (float)pos * inv;
            float sn, cs; sincosf(ang, &sn, &cs); rope[2 * i] = cs; rope[2 * i + 1] = sn; }
        { float* rs0 = (float*)(ws + WS_RS); for (int m = gw; m < M; m += NGW) x_row_to_bf16(A->in[0] + (size_t)m * DM, H + (size_t)m * DM, rs0 + m, F.lane); }
}
__device__ __forceinline__ void convert_down_phase(LAS unsigned char* lds_, int l, int idx, int n) {
    const Frame F = make_frame(lds_); CArgs* A = fresh_args(); unsigned char* ws = A->ws;
    LAS float* scr = (LAS float*)(F.lds + RING_OFF + F.wave * 16384);
    constexpr int I_DN = (FF / 64) * (DM / 32), NB = DM / 32;
    const int gw = idx * NWAVES + F.wave, NGW = n * NWAVES;
    auto desc_of = [&](int r) -> CvtDesc { CvtDesc d; d.kind = 0;
        if (r < DN_DEFER) { d.W = A->in[16] + (size_t)l * FF * DM; d.WT = (bf16*)(ws + WS_W + (size_t)l * LW + W_DOWN); d.kgain = nullptr; d.K = FF; d.N = DM; d.k0 = 64 * (r / NB); d.n0 = 32 * (r % NB); }
        else { r -= DN_DEFER; d.W = A->in[15] + (size_t)l * DM * FF; d.WT = (bf16*)(ws + WS_W + (size_t)l * LW + W_UP); d.kgain = A->in[3] + l * DM; d.K = DM; d.N = FF; d.k0 = 64 * (r / (FF / 32)); d.n0 = 32 * (r % (FF / 32)); }
        return d; };
    CVT_LOOP(DN_DEFER + UP_DEFER, DEF_NIF, DEF_NT);
}
__device__ __forceinline__ void residual_phase(LAS unsigned char* lds_, int l, int which, bool dry = false) {
    const Frame F = make_frame(lds_); CArgs* A = fresh_args(); unsigned char* ws = A->ws; const int gw = F.vcu * NWAVES + F.wave, NGW = F.G * NWAVES;
    const float* xin32 = (which == 0 && l == 0) ? A->in[0] : nullptr; const bf16* Y = (const bf16*)(ws + WS_MIX); bf16* XB = (bf16*)(ws + WS_H);
    const bool last = (which == 1 && l + 1 == DEPTH);
    float* out32 = dry ? (float*)(ws + WS_ACT) : A->out; float* rs_next = (float*)(ws + WS_RS) + (which == 0 ? M : 0) + (dry ? 2 * M : 0);
    if (dry) XB = (bf16*)(ws + WS_ACT + 134 * MiB);
    const float* gpost = (which == 0 ? A->in[2] : A->in[4]) + l * DM;
    for (int m = gw; m < M; m += NGW) residual_row(xin32 ? xin32 + (size_t)m * DM : nullptr, XB + (size_t)m * DM, Y + (size_t)m * DM, gpost, out32 + (size_t)m * DM, rs_next + m, last, F.lane);
}
__device__ __forceinline__ void attn_phase(LAS unsigned char* lds_) {
    const Frame F = make_frame(lds_); CArgs* A = fresh_args(); unsigned char* ws = A->ws;
    const bf16* QB = (const bf16*)(ws + WS_Q); const bf16* KVB = (const bf16*)(ws + WS_KV); const bf16* PROJ = (const bf16*)(ws + WS_PROJ); bf16* CAT = (bf16*)(ws + WS_CAT);
    for (int p2 = 2 * F.vcu; p2 < 512; p2 += 2 * F.G)
        for (int k = 0; k < 2; ++k) { const int p = p2 >> 1, bh = p >> 3, s = p & 7;
            att::attn_unit(QB, KVB, PROJ, CAT, bh >> 4, bh & 15, k ? 15 - s : s, (ATT_LAS char*)(F.lds + RING_OFF)); }
}
template <int WHICH> __device__ __forceinline__ void gemm_call(LAS unsigned char* lds_, int l) {
    CArgs* A = fresh_args(); unsigned char* ws = A->ws; unsigned char* wl = ws + WS_W + (size_t)l * LW; int bx = blockIdx.x; asm volatile("" : "+s"(bx)); const int G = gridDim.x;
    float* rope = (float*)(ws + WS_ROPE); float* ssq = (float*)(ws + WS_SSQ); const float* rs = (const float*)(ws + WS_RS);
    bf16* H = (bf16*)(ws + WS_H); bf16* PROJ = (bf16*)(ws + WS_PROJ); bf16* QB = (bf16*)(ws + WS_Q); bf16* KVB = (bf16*)(ws + WS_KV);
    bf16* CAT = (bf16*)(ws + WS_CAT); bf16* MIX = (bf16*)(ws + WS_MIX); bf16* ACT = (bf16*)(ws + WS_ACT);
    pg8::StaticOrder S;
    if constexpr (WHICH == 0) { pg8::Gemm g{H, (const bf16*)(wl + W_IN), M, INP, DM, DM, 0}; S.init(M, INP, G, bx); pg8::Epi<2> E{PROJ, INP, rope, ssq, rs};
        pg8::gemm_phase<pg8::Epi<2>, pg8::StaticOrder, GEMM_ALIGN, GEMM_SP2>(lds_ + RING_OFF, g, S, E); }
    if constexpr (WHICH == 1) { pg8::Gemm g{PROJ + C_CQ, (const bf16*)(wl + W_Q), M, QW, 1024, INP, 0}; S.init(M, QW, G, bx); pg8::Epi<3> E{QB, QW, rope, ssq, nullptr};
        pg8::gemm_phase<pg8::Epi<3>, pg8::StaticOrder, GEMM_ALIGN, GEMM_SP2>(lds_ + RING_OFF, g, S, E); }
    if constexpr (WHICH == 2) { pg8::Gemm g{PROJ + C_CKV, (const bf16*)(wl + W_KV), M, KVW, 512, INP, 0}; S.init(M, KVW, G, bx); pg8::Epi<4> E{KVB, KVW, rope, ssq, nullptr};
        pg8::gemm_phase<pg8::Epi<4>, pg8::StaticOrder, GEMM_ALIGN, GEMM_SP2>(lds_ + RING_OFF, g, S, E); }
    if constexpr (WHICH == 3) { pg8::Gemm g{CAT, (const bf16*)(wl + W_OUT), M, DM, DM, DM, 0}; S.init(M, DM, G, bx); pg8::Epi<0> E{MIX, DM, rope, ssq, nullptr};
        pg8::gemm_phase<pg8::Epi<0>, pg8::StaticOrder, GEMM_ALIGN, GEMM_SP2>(lds_ + RING_OFF, g, S, E); }
    if constexpr (WHICH == 4) { pg8::Gemm g{H, (const bf16*)(wl + W_UP), M, FF, DM, DM, 0}; S.init(M, FF, G, bx); pg8::Epi<1> E{ACT, FF, rope, ssq, rs + M};
        pg8::gemm_phase<pg8::Epi<1>, pg8::StaticOrder, GEMM_ALIGN, GEMM_SP2>(lds_ + RING_OFF, g, S, E); }
    if constexpr (WHICH == 5) { pg8::Gemm g{ACT + (DOWN_KREV ? FF - 64 : 0), (const bf16*)(wl + W_DOWN) + (DOWN_KREV ? FF - 64 : 0), M, DM, FF, FF, DOWN_KREV};     S.init(M, DM, G, bx); pg8::Epi<0> E{MIX, DM, rope, ssq, nullptr};
        pg8::gemm_phase<pg8::Epi<0>, pg8::StaticOrder, GEMM_ALIGN, GEMM_SP2>(lds_ + RING_OFF, g, S, E); }
}
__device__ __forceinline__ void mixer_small_phases(LAS unsigned char* lds_, int l) {
    CArgs* A = fresh_args(); unsigned char* ws = A->ws;
    sgu_phase(lds_, (const bf16*)(ws + WS_PROJ), (bf16*)(ws + WS_CAT), (const bf16*)(ws + WS_W + (size_t)l * LW + W_SGU), A->in[6] + l * 1024, A->in[7] + l * 1024, A->in[9] + l * 1024);
    CArgs* A2 = fresh_args(); unsigned char* ws2 = A2->ws;
    ret1_phase(lds_, (const bf16*)(ws2 + WS_PROJ), (float*)(ws2 + WS_KVS));
}
__global__ void __launch_bounds__(NWAVES * 64, 2) mega_fwd(Args args) {
    extern __shared__ __attribute__((aligned(16))) unsigned char lds[];
    LAS unsigned char* L = (LAS unsigned char*)lds;
    volatile LAS unsigned* MISC = (volatile LAS unsigned*)(L + MISC_OFF);
    for (int u = threadIdx.x; u < (LDS_BYTES - LDSCTL_OFF) / 4; u += NWAVES * 64) ((LAS unsigned*)(L + LDSCTL_OFF))[u] = 0u;
    __syncthreads();
    XcdBarrier bar = xcd_barrier_post((unsigned*)(args.ws + WS_CTL) + CW_BAR, MISC + 8);
#define GRID_BAR() do { for (int bd_ = 0; bd_ < BAR_DUP; ++bd_) { XcdBarrier b_ = bar; asm volatile("" : "+s"(b_.bar), "+s"(b_.x)); xcd_barrier(b_); } } while (0)
    unsigned long long tp0 = 0, tp1 = 0;
#define STAMP(kk, cond) do { if (PROBE_IDX >= 0 && (cond)) { if (PROBE_IDX == (kk)) tp0 = __builtin_amdgcn_s_memrealtime(); if (PROBE_IDX + 1 == (kk)) tp1 = __builtin_amdgcn_s_memrealtime(); } } while (0)
    STAMP(0, true);
    for (int rep_ = 0; rep_ < REP_PRO; ++rep_) prologue_phase(L);
    GRID_BAR();
    for (int l = 0; l < DEPTH; ++l) {
        STAMP(1, l == PROBE_L);
        for (int rep_ = 0; rep_ < REP_IN; ++rep_) gemm_call<0>(L, l);
        { int bx = blockIdx.x; asm volatile("" : "+s"(bx)); const int G = gridDim.x, NT_IN = (M / 256) * (INP / 256), nfull = NT_IN % G;
          if (nfull == 0) convert_down_phase(L, l, bx, G); else if (bx >= nfull) convert_down_phase(L, l, bx - nfull, G - nfull); }
        GRID_BAR();
        STAMP(2, l == PROBE_L);
        for (int rep_ = 0; rep_ < REP_QKV; ++rep_) { gemm_call<1>(L, l); gemm_call<2>(L, l); }
        for (int rep_ = 0; rep_ < REP_SMALL; ++rep_) mixer_small_phases(L, l);
        GRID_BAR();
        STAMP(3, l == PROBE_L);
        for (int rep_ = 0; rep_ < REP_RET2; ++rep_) { CArgs* A = fresh_args(); unsigned char* ws = A->ws; ret2_phase(L, (const float*)(ws + WS_KVS), (bf16*)(ws + WS_SB)); }
        for (int rep_ = 0; rep_ < REP_ATTN; ++rep_) attn_phase(L);
        GRID_BAR();
        STAMP(4, l == PROBE_L);
        for (int rep_ = 0; rep_ < REP_RET3; ++rep_) { CArgs* A = fresh_args(); unsigned char* ws = A->ws; ret3_phase(L, (const bf16*)(ws + WS_PROJ), (const bf16*)(ws + WS_SB), (bf16*)(ws + WS_CAT)); }
        GRID_BAR();
        STAMP(5, l == PROBE_L);
        for (int rep_ = 0; rep_ < REP_OUT; ++rep_) gemm_call<3>(L, l);
        GRID_BAR();
        STAMP(6, l == PROBE_L);
        for (int rep_ = 0; rep_ < REP_RES; ++rep_) residual_phase(L, l, 0, rep_ + 1 < REP_RES);
        GRID_BAR();
        STAMP(7, l == PROBE_L);
        for (int rep_ = 0; rep_ < REP_UP; ++rep_) { if (rep_ && REP_BAR) GRID_BAR(); gemm_call<4>(L, l); }
        GRID_BAR();
        STAMP(8, l == PROBE_L);
        for (int rep_ = 0; rep_ < REP_DOWN; ++rep_) gemm_call<5>(L, l);
        GRID_BAR();
        STAMP(9, l == PROBE_L);
        for (int rep_ = 0; rep_ < REP_RES; ++rep_) residual_phase(L, l, 1, rep_ + 1 < REP_RES);
        STAMP(10, l == PROBE_L);
        if (l + 1 < DEPTH) GRID_BAR();
    }
    if (PROBE_IDX >= 0 && blockIdx.x == 0 && threadIdx.x == 0) { asm volatile("s_waitcnt vmcnt(0)" ::: "memory"); args.out[0] = (float)(((tp1 - tp0) + PROBE_Q * 50ull) / (PROBE_Q * 100ull)) * (float)(PROBE_Q * 10); }
}

extern "C" void kernel_launch(void* const* d_in, const int* in_sizes, int n_in, void* d_out, int out_size, void* d_ws, size_t ws_size, hipStream_t stream) {
    static int grid = 0;
    if (grid == 0) {
        if (n_in != 17 || in_sizes[0] != M * DM || out_size != M * DM || ws_size < WS_END) { fprintf(stderr, "kernel_launch: shape mismatch (n_in %d, in0 %d, out %d, ws %zu < %zu)\n", n_in, n_in > 0 ? in_sizes[0] : -1, out_size, ws_size, (size_t)WS_END); grid = -1; return; }
        int dev = 0, cus = 0, per_cu = 0;
        if (hipGetDevice(&dev) != hipSuccess || hipDeviceGetAttribute(&cus, hipDeviceAttributeMultiprocessorCount, dev) != hipSuccess) { grid = -1; return; }
        if (hipFuncSetAttribute((const void*)mega_fwd, hipFuncAttributeMaxDynamicSharedMemorySize, LDS_BYTES) != hipSuccess) { fprintf(stderr, "kernel_launch: hipFuncSetAttribute failed\n"); grid = -1; return; }
        if (hipOccupancyMaxActiveBlocksPerMultiprocessor(&per_cu, (const void*)mega_fwd, NWAVES * 64, LDS_BYTES) != hipSuccess || per_cu < 1)
            fprintf(stderr, "kernel_launch: note: occupancy query reports %d workgroups per CU\n", per_cu);
        (void)hipGetLastError();
        grid = cus;
    }
    if (grid < 0) return;
    if (hipMemsetAsync((char*)d_ws + WS_CTL, 0, CTL_ZERO_BYTES, stream) != hipSuccess) { fprintf(stderr, "kernel_launch: memset failed\n"); return; }
    Args a{};
    for (int i = 0; i < 17; ++i) a.in[i] = (const float*)d_in[i];
    a.out = (float*)d_out; a.ws = (unsigned char*)d_ws;
    hipLaunchKernelGGL(mega_fwd, dim3(grid), dim3(NWAVES * 64), LDS_BYTES, stream, a);
    const hipError_t le = hipPeekAtLastError();
    if (le != hipSuccess) fprintf(stderr, "kernel_launch: launch failed: %s\n", hipGetErrorName(le));
}
```

```cpp
#include <hip/hip_runtime.h>
#include <cstdio>
#include <cstdint>
namespace pg8 {
#define PG8_LAS __attribute__((address_space(3)))
typedef unsigned short bf16_t;
typedef short bf16x8 __attribute__((ext_vector_type(8)));
typedef float f32x4 __attribute__((ext_vector_type(4)));
typedef unsigned u32x4 __attribute__((ext_vector_type(4)));
constexpr int BM = 256, BK = 64, HALF = 128, HTB = HALF * BK * 2  , STAGE_BYTES = 8 * HTB, NXCD = 8, WGM = 8;

__host__ __device__ __forceinline__ int lds_byte(int r, int c) { const int st = (r >> 4) * 2 + (c >> 5), rr = r & 15, cc = c & 31, ob = rr * 64 + cc * 2; return st * 1024 + (ob ^ (((ob >> 9) & 1) << 5)); }
__host__ __device__ __forceinline__ void stage_rc(int b, int& R, int& C) { const int st = b / 1024, sb = b % 1024, swz = sb ^ (((sb >> 9) & 1) << 5); R = (st >> 1) * 16 + swz / 64; C = (st & 1) * 32 + (swz % 64) / 2; }
__host__ __device__ __forceinline__ int perm32(int rho) { const int n = rho >> 4, i = rho & 15; return 8 * (i >> 2) + 4 * n + (i & 3); }

struct Unit { int pm, pn; };
struct Gemm { const bf16_t* A; const bf16_t* Bt; int M, N, K, lda, krev; };

struct StaticOrder {
    int nM, nN, nwg, G, c;
    __host__ __device__ void init(int M, int N, int G_, int c_) { nM = M / BM; nN = N / BM; nwg = nM * nN; G = G_; c = c_; }
    __host__ __device__ bool next(int i, Unit& u) const {
        const long L = (long)i * G + c; if (L >= nwg) return false;
        int wgid = (int)L; { const int q = nwg / NXCD, r = nwg % NXCD, xcd = wgid % NXCD, off = wgid / NXCD; wgid = (xcd < r ? xcd * (q + 1) : r * (q + 1) + (xcd - r) * q) + off; }
        const int nig = WGM * nN, gid = wgid / nig, fm = gid * WGM, gsz = (nM - fm) < WGM ? (nM - fm) : WGM;
        u.pm = fm + ((wgid % nig) % gsz); u.pn = (wgid % nig) / gsz; return true;
    }
    __device__ __forceinline__ void a_ready(const Unit&) const {}
    __device__ __forceinline__ void done(const Unit&) const {}
};
__device__ __forceinline__ unsigned cvt_pk_bf16(float lo, float hi) { unsigned r; asm volatile("v_cvt_pk_bf16_f32 %0, %1, %2" : "=v"(r) : "v"(lo), "v"(hi)); return r; }
__device__ __forceinline__ void rope8(f32x4& v0, f32x4& v1, const float* tab) {
    const f32x4 t0 = *(const f32x4*)tab, t1 = *(const f32x4*)(tab + 4);
    f32x4 a, b;
    a[0] = v0[0] * t0[0] - v0[1] * t0[1]; a[1] = v0[0] * t0[1] + v0[1] * t0[0];
    a[2] = v0[2] * t0[2] - v0[3] * t0[3]; a[3] = v0[2] * t0[3] + v0[3] * t0[2];
    b[0] = v1[0] * t1[0] - v1[1] * t1[1]; b[1] = v1[0] * t1[1] + v1[1] * t1[0];
    b[2] = v1[2] * t1[2] - v1[3] * t1[3]; b[3] = v1[2] * t1[3] + v1[3] * t1[2];
    v0 = a; v1 = b;
}
template <int MODE> struct Epi {
    static constexpr bool PERM = true, AFTER_DRAIN = false;
    bf16_t* O; int ldc; const float* rope; float* ssq; const float* rsc;
    __device__ __forceinline__ void operator()(const f32x4 (&acc)[2][2][4][2], const Unit& u, int wr, int wc, int fr, int fq) const {
        const int row0 = u.pm * BM + wr * 64 + fr, colt = u.pn * BM + wc * 32 + 8 * fq;
        const bool want_ss = (MODE == 2) && u.pn >= 8 && u.pn < 14;
#pragma unroll
        for (int ai = 0; ai < 2; ++ai)
#pragma unroll
            for (int m = 0; m < 4; ++m) {
                const int row = row0 + ai * HALF + m * 16;
                float rs = 1.f;
                if (MODE == 1 || MODE == 2) rs = rsc[row];
                if (MODE == 3) { const f32x4* s = (const f32x4*)(ssq + (size_t)row * 24); const f32x4 a = s[0], b = s[1], c = s[2], d = s[3];
                    const float t = ((a[0] + a[1]) + (a[2] + a[3])) + ((b[0] + b[1]) + (b[2] + b[3])) + ((c[0] + c[1]) + (c[2] + c[3])) + ((d[0] + d[1]) + (d[2] + d[3]));
                    rs = 1.0f / sqrtf(t * (1.0f / 1024.0f) + 1e-6f); }
                if (MODE == 4) { const f32x4* s = (const f32x4*)(ssq + (size_t)row * 24); const f32x4 a = s[4], b = s[5];
                    const float t = ((a[0] + a[1]) + (a[2] + a[3])) + ((b[0] + b[1]) + (b[2] + b[3]));
                    rs = 1.0f / sqrtf(t * (1.0f / 512.0f) + 1e-6f); }
                float part = 0.f;
#pragma unroll
                for (int bj = 0; bj < 2; ++bj) {
                    const int col = colt + bj * HALF;
                    f32x4 v0 = acc[ai][bj][m][0], v1 = acc[ai][bj][m][1];
                    if (MODE == 1) {
#pragma unroll
                        for (int j = 0; j < 4; ++j) { const float p = fmaxf(v0[j] * rs, 0.f), q = fmaxf(v1[j] * rs, 0.f); v0[j] = p * p; v1[j] = q * q; } }
                    if (MODE == 2) { v0 = v0 * rs; v1 = v1 * rs;
                        if (want_ss) part += ((v0[0] * v0[0] + v0[1] * v0[1]) + (v0[2] * v0[2] + v0[3] * v0[3])) + ((v1[0] * v1[0] + v1[1] * v1[1]) + (v1[2] * v1[2] + v1[3] * v1[3]));
                        if (col >= 3584 && col < 4672) rope8(v0, v1, rope + ((size_t)(row & 4095) * 32 + ((col & 63) >> 1)) * 2); }
                    if (MODE == 3) { v0 = v0 * rs; v1 = v1 * rs; if ((col % 192) >= 128) rope8(v0, v1, rope + ((size_t)(row & 4095) * 32 + ((col & 63) >> 1)) * 2); }
                    if (MODE == 4) { v0 = v0 * rs; v1 = v1 * rs; }
                    u32x4 w; w.x = cvt_pk_bf16(v0[0], v0[1]); w.y = cvt_pk_bf16(v0[2], v0[3]); w.z = cvt_pk_bf16(v1[0], v1[1]); w.w = cvt_pk_bf16(v1[2], v1[3]);
                    *(u32x4*)(O + (size_t)row * ldc + col) = w;
                }
                if (want_ss) { part += __shfl_xor(part, 16); part += __shfl_xor(part, 32); if (fq == 0) ssq[(size_t)row * 24 + (u.pn - 8) * 4 + wc] = part; }
            }
    }
};
template <class Epi, class Sched, bool ALIGN_EPI = false, bool SP2 = false>
__device__ __forceinline__ void gemm_phase(PG8_LAS unsigned char* lds, const Gemm g, const Sched& S, const Epi& E) {
    int tid_ = threadIdx.x; asm volatile("" : "+v"(tid_));
    const int tid = tid_, wid = __builtin_amdgcn_readfirstlane(tid >> 6), lane = tid & 63, wr = wid >> 2, wc = wid & 3, fr = lane & 15, fq = lane >> 4;
    const int K = g.K, nt = K / BK;
    unsigned voffA[2], voffB[2];
#pragma unroll
    for (int i = 0; i < 2; ++i) { int R, C; stage_rc(tid * 16 + i * 8192, R, C); const int Rb = Epi::PERM ? ((R & ~31) + perm32(R & 31)) : R;
        voffA[i] = (unsigned)(R * g.lda + C) * 2u; voffB[i] = (unsigned)(Rb * K + C) * 2u; }
    const long kstep = g.krev ? -(long)(BK * 2) : (long)(BK * 2);
    const size_t hstep = (size_t)HALF * K * 2;
    const size_t tstep = 2 * hstep; const size_t hstepA = (size_t)HALF * g.lda * 2, tstepA = 2 * hstepA;
    const unsigned ldsw = (unsigned)wid * 1024u;
    const int aoff = lds_byte(wr * 64 + fr, fq * 8), boff = lds_byte(wc * 32 + fr, fq * 8);
#define PG8_SA(b, h) (((b) * 2 + (h)) * HTB)
#define PG8_SB(b, h) ((4 + (b) * 2 + (h)) * HTB)
#define PG8_STAGE(bufoff, gbase, voff) do { _Pragma("unroll") for (int _i = 0; _i < 2; ++_i) \
        __builtin_amdgcn_global_load_lds((const unsigned*)((const char*)(gbase) + (voff)[_i]), (PG8_LAS unsigned*)(lds + (bufoff) + ldsw + _i * 8192), 16, 0, 0); } while (0)
#define PG8_LDA(dst, b, h) do { _Pragma("unroll") for (int m = 0; m < 4; ++m) _Pragma("unroll") for (int k = 0; k < 2; ++k) dst[m][k] = *(const PG8_LAS bf16x8*)(lds + PG8_SA(b, h) + aoff + m * 2048 + k * 1024); } while (0)
#define PG8_LDB(dst, b, h) do { _Pragma("unroll") for (int n = 0; n < 2; ++n) _Pragma("unroll") for (int k = 0; k < 2; ++k) dst[n][k] = *(const PG8_LAS bf16x8*)(lds + PG8_SB(b, h) + boff + n * 2048 + k * 1024); } while (0)
#define PG8_MMA(ai, bj, At, Bt) do { __builtin_amdgcn_s_setprio(1); _Pragma("unroll") for (int m = 0; m < 4; ++m) _Pragma("unroll") for (int n = 0; n < 2; ++n) _Pragma("unroll") for (int k = 0; k < 2; ++k) \
        acc[ai][bj][m][n] = __builtin_amdgcn_mfma_f32_16x16x32_bf16(Bt[n][k], At[m][k], acc[ai][bj][m][n], 0, 0, 0); __builtin_amdgcn_s_setprio(0); } while (0)
#define PG8_WAIT_V(n) asm volatile("s_waitcnt vmcnt(" #n ")" ::: "memory")
#define PG8_WAIT_L(n) asm volatile("s_waitcnt lgkmcnt(" #n ")" ::: "memory")
#define PG8_BAR __builtin_amdgcn_s_barrier()
#define PG8_SCHED __builtin_amdgcn_sched_barrier(0)
    Unit cur, nxt; int ui = 0;
    if (!S.next(0, cur)) return;
    f32x4 acc[2][2][4][2];
#pragma unroll
    for (int a = 0; a < 2; ++a)
#pragma unroll
        for (int b = 0; b < 2; ++b)
#pragma unroll
            for (int m = 0; m < 4; ++m)
#pragma unroll
                for (int n = 0; n < 2; ++n) acc[a][b][m][n] = (f32x4){0.f, 0.f, 0.f, 0.f};
    bf16x8 At[4][2], B0[2][2], B1[2][2];
    const char* cA = (const char*)g.A + (size_t)cur.pm * tstepA; const char* cB = (const char*)g.Bt + (size_t)cur.pn * tstep;
    S.a_ready(cur);
    if constexpr (SP2) {
        PG8_STAGE(PG8_SB(0, 0), cB, voffB); PG8_STAGE(PG8_SB(0, 1), cB + hstep, voffB); PG8_STAGE(PG8_SA(0, 0), cA, voffA); PG8_STAGE(PG8_SA(0, 1), cA + hstepA, voffA);
        if (wr == 1) PG8_BAR;
        PG8_WAIT_V(2); PG8_BAR;
        PG8_STAGE(PG8_SB(1, 0), cB + kstep, voffB); PG8_STAGE(PG8_SA(1, 0), cA + kstep, voffA); PG8_STAGE(PG8_SB(1, 1), cB + hstep + kstep, voffB);
        PG8_WAIT_V(6); PG8_BAR;
    } else {
        PG8_STAGE(PG8_SB(0, 0), cB, voffB); PG8_STAGE(PG8_SA(0, 0), cA, voffA); PG8_STAGE(PG8_SB(0, 1), cB + hstep, voffB); PG8_STAGE(PG8_SA(0, 1), cA + hstepA, voffA);
        if (wr == 1) PG8_BAR;
        PG8_WAIT_V(4); PG8_BAR;
        PG8_STAGE(PG8_SB(1, 0), cB + kstep, voffB); PG8_STAGE(PG8_SA(1, 0), cA + kstep, voffA); PG8_STAGE(PG8_SB(1, 1), cB + hstep + kstep, voffB);
        PG8_WAIT_V(6); PG8_BAR;
    }
    for (;;) {
        const bool has_next = S.next(ui + 1, nxt);
        const char* nA = has_next ? (const char*)g.A + (size_t)nxt.pm * tstepA : cA; const char* nB = has_next ? (const char*)g.Bt + (size_t)nxt.pn * tstep : cB;
        for (int t = 0; t < nt; t += 2) {
            const bool last = (t == nt - 2);
            const char* a1 = cA + (long)(t + 1) * kstep;
            const char* a2 = last ? nA : cA + (long)(t + 2) * kstep; const char* b2 = last ? nB : cB + (long)(t + 2) * kstep;
            const char* a3 = a2 + kstep; const char* b3 = b2 + kstep;
            if (last && has_next) S.a_ready(nxt);
            if constexpr (SP2) {
            PG8_LDB(B0, 0, 0); PG8_LDB(B1, 0, 1); PG8_SCHED; PG8_LDA(At, 0, 0); PG8_STAGE(PG8_SA(1, 1), a1 + hstepA, voffA);
            PG8_WAIT_V(8); PG8_WAIT_L(0); PG8_BAR; PG8_MMA(0, 0, At, B0); PG8_MMA(0, 1, At, B1); PG8_BAR; PG8_SCHED;
            PG8_LDA(At, 0, 1); PG8_STAGE(PG8_SB(0, 0), b2, voffB); PG8_STAGE(PG8_SB(0, 1), b2 + hstep, voffB); PG8_STAGE(PG8_SA(0, 0), a2, voffA);
            PG8_WAIT_V(8); PG8_WAIT_L(0); PG8_BAR; PG8_MMA(1, 0, At, B0); PG8_MMA(1, 1, At, B1); PG8_BAR; PG8_SCHED;
            PG8_LDB(B0, 1, 0); PG8_LDB(B1, 1, 1); PG8_SCHED; PG8_LDA(At, 1, 0); PG8_STAGE(PG8_SA(0, 1), a2 + hstepA, voffA);
            PG8_WAIT_V(8); PG8_WAIT_L(0); PG8_BAR; PG8_MMA(0, 0, At, B0); PG8_MMA(0, 1, At, B1); PG8_BAR; PG8_SCHED;
            PG8_LDA(At, 1, 1); PG8_STAGE(PG8_SB(1, 0), b3, voffB); PG8_STAGE(PG8_SB(1, 1), b3 + hstep, voffB); PG8_STAGE(PG8_SA(1, 0), a3, voffA);
            PG8_WAIT_V(8); PG8_WAIT_L(0); PG8_BAR; PG8_MMA(1, 0, At, B0); PG8_MMA(1, 1, At, B1); PG8_BAR; PG8_SCHED;
            } else {
            PG8_LDB(B0, 0, 0); PG8_SCHED; PG8_LDA(At, 0, 0); PG8_STAGE(PG8_SA(1, 1), a1 + hstepA, voffA);
            PG8_WAIT_L(8); PG8_BAR; PG8_WAIT_L(0); PG8_MMA(0, 0, At, B0); PG8_BAR; PG8_SCHED;
            PG8_LDB(B1, 0, 1); PG8_STAGE(PG8_SB(0, 0), b2, voffB);
            PG8_BAR; PG8_WAIT_L(0); PG8_MMA(0, 1, At, B1); PG8_BAR;
            PG8_LDA(At, 0, 1); PG8_STAGE(PG8_SA(0, 0), a2, voffA);
            PG8_BAR; PG8_WAIT_L(0); PG8_MMA(1, 0, At, B0); PG8_BAR; PG8_SCHED;
            PG8_STAGE(PG8_SB(0, 1), b2 + hstep, voffB);
            PG8_WAIT_V(6); PG8_BAR; PG8_MMA(1, 1, At, B1); PG8_BAR;
            PG8_LDB(B0, 1, 0); PG8_SCHED; PG8_LDA(At, 1, 0); PG8_STAGE(PG8_SA(0, 1), a2 + hstepA, voffA);
            PG8_WAIT_L(8); PG8_BAR; PG8_WAIT_L(0); PG8_MMA(0, 0, At, B0); PG8_BAR; PG8_SCHED;
            PG8_LDB(B1, 1, 1); PG8_STAGE(PG8_SB(1, 0), b3, voffB);
            PG8_BAR; PG8_WAIT_L(0); PG8_MMA(0, 1, At, B1); PG8_BAR;
            PG8_LDA(At, 1, 1); PG8_STAGE(PG8_SA(1, 0), a3, voffA);
            PG8_BAR; PG8_WAIT_L(0); PG8_MMA(1, 0, At, B0); PG8_BAR; PG8_SCHED;
            PG8_STAGE(PG8_SB(1, 1), b3 + hstep, voffB);
            PG8_WAIT_V(6); PG8_BAR; PG8_MMA(1, 1, At, B1); PG8_BAR;
            }
        }
        if constexpr (ALIGN_EPI) { if (wr == 0) PG8_BAR; }
        if constexpr (!Epi::AFTER_DRAIN) { E(acc, cur, wr, wc, fr, fq); S.done(cur); }
        if (!has_next) break;
#pragma unroll
        for (int a = 0; a < 2; ++a)
#pragma unroll
            for (int b = 0; b < 2; ++b)
#pragma unroll
                for (int m = 0; m < 4; ++m)
#pragma unroll
                    for (int n = 0; n < 2; ++n) acc[a][b][m][n] = (f32x4){0.f, 0.f, 0.f, 0.f};
        cur = nxt; cA = nA; cB = nB; ++ui;
        if constexpr (ALIGN_EPI) { if (wr == 1) PG8_BAR; }
    }
    PG8_WAIT_V(0);
    if constexpr (!ALIGN_EPI) { if (wr == 0) PG8_BAR; }
    PG8_BAR;
    if constexpr (Epi::AFTER_DRAIN) { E.fused(acc, cur, wr, wc, fr, fq, lds, wid, lane); S.done(cur); }
#undef PG8_SA
#undef PG8_SB
#undef PG8_STAGE
#undef PG8_LDA
#undef PG8_LDB
#undef PG8_MMA
#undef PG8_WAIT_V
#undef PG8_WAIT_L
#undef PG8_BAR
#undef PG8_SCHED
}
}
namespace att {
#define ATT_LAS __attribute__((address_space(3)))
typedef unsigned short bf16;
using bf16x8 = __attribute__((ext_vector_type(8))) short;
using s16x4  = __attribute__((ext_vector_type(4))) short;
using f32x16 = __attribute__((ext_vector_type(16))) float;
using u32x4  = __attribute__((ext_vector_type(4))) unsigned;
constexpr float SCALE = 0.07216878364870322f;
constexpr float THR = 8.f;
constexpr int SHM_V = 16384, SHM_K = 16384, SHM_R = 8192;
constexpr int OFF_V = 0, OFF_K = 2 * SHM_V, OFF_R = OFF_K + 2 * SHM_K, OFF_WS = OFF_R + 2 * SHM_R, ATT_LDS_BYTES = OFF_WS + 8 * 64 * 4;
#define KSWZ(row, colB) ((row) * 256 + ((colB) ^ (((row) & 7) << 4)))
#define RSWZ(row, colB) ((row) * 128 + ((colB) ^ (((row) & 7) << 4)))
#define SBAR() __builtin_amdgcn_sched_barrier(0)
__device__ __forceinline__ int crow(int r, int hi) { return (r & 3) + 8 * (r >> 2) + 4 * hi; }
__device__ __forceinline__ unsigned cvtpk(float lo, float hi) { unsigned r; asm volatile("v_cvt_pk_bf16_f32 %0, %1, %2" : "=v"(r) : "v"(lo), "v"(hi)); return r; }
__device__ __forceinline__ void partialSM(f32x16& p0, f32x16& p1, float& m_reg, float& mn, float& alpha) {
  constexpr float C = SCALE * 1.4426950408889634f;
  float pmax = p0[0];
#pragma unroll
  for (int r = 1; r < 16; ++r) pmax = fmaxf(pmax, p0[r]);
#pragma unroll
  for (int r = 0; r < 16; ++r) pmax = fmaxf(pmax, p1[r]);
  { auto rr = __builtin_amdgcn_permlane32_swap(__float_as_uint(pmax), __float_as_uint(pmax), false, false);
    pmax = fmaxf(__uint_as_float(rr[0]), __uint_as_float(rr[1])); }
  if (__builtin_expect(__all(pmax - m_reg <= THR / SCALE), 1)) { mn = m_reg; alpha = 1.f; }
  else { mn = fmaxf(m_reg, pmax); alpha = __builtin_amdgcn_exp2f((m_reg - mn) * C); m_reg = mn; }
  float mnC = -mn * C;
#pragma unroll
  for (int r = 0; r < 16; ++r) p0[r] = fmaf(p0[r], C, mnC);
#pragma unroll
  for (int r = 0; r < 16; ++r) p1[r] = fmaf(p1[r], C, mnC);
#pragma unroll
  for (int r = 0; r < 16; ++r) p0[r] = __builtin_amdgcn_exp2f(p0[r]);
}
__device__ __forceinline__ void finishSM(f32x16& p0, f32x16& p1, float alpha, float& l_reg, bf16x8& pa0, bf16x8& pa1, bf16x8& pa2, bf16x8& pa3) {
#pragma unroll
  for (int r = 0; r < 16; ++r) p1[r] = __builtin_amdgcn_exp2f(p1[r]);
  float ps = 0;
#pragma unroll
  for (int r = 0; r < 16; ++r) ps += p0[r];
#pragma unroll
  for (int r = 0; r < 16; ++r) ps += p1[r];
  { auto rr = __builtin_amdgcn_permlane32_swap(__float_as_uint(ps), __float_as_uint(ps), false, false);
    ps = __uint_as_float(rr[0]) + __uint_as_float(rr[1]); }
  l_reg = l_reg * alpha + ps;
#define PK4(P, BASE, OUT) do { unsigned a0 = cvtpk(P[BASE + 0], P[BASE + 1]), a1 = cvtpk(P[BASE + 2], P[BASE + 3]);   \
    unsigned b0 = cvtpk(P[BASE + 4], P[BASE + 5]), b1 = cvtpk(P[BASE + 6], P[BASE + 7]);                              \
    auto r0 = __builtin_amdgcn_permlane32_swap(a0, b0, false, false); auto r1 = __builtin_amdgcn_permlane32_swap(a1, b1, false, false); \
    u32x4 w = {r0[0], r1[0], r0[1], r1[1]}; OUT = *reinterpret_cast<bf16x8*>(&w); } while (0)
  PK4(p0, 0, pa0); PK4(p0, 8, pa1); PK4(p1, 0, pa2); PK4(p1, 8, pa3);
#undef PK4
}
__device__ __forceinline__ void qkt(f32x16& p0, f32x16& p1, const ATT_LAS char* Ks, const ATT_LAS char* Rs, const bf16x8* qr, int r32, int hi) {
  p0 = f32x16{}; p1 = f32x16{};
#pragma unroll
  for (int d0 = 0; d0 < 8; ++d0) { const int cb = (d0 * 16 + hi * 8) * 2;
    const bf16x8 b0 = *reinterpret_cast<const ATT_LAS bf16x8*>(Ks + KSWZ(r32, cb));
    const bf16x8 b1 = *reinterpret_cast<const ATT_LAS bf16x8*>(Ks + KSWZ(32 + r32, cb));
    p0 = __builtin_amdgcn_mfma_f32_32x32x16_bf16(b0, qr[d0], p0, 0, 0, 0);
    p1 = __builtin_amdgcn_mfma_f32_32x32x16_bf16(b1, qr[d0], p1, 0, 0, 0); }
#pragma unroll
  for (int d0 = 0; d0 < 4; ++d0) { const int cb = (d0 * 16 + hi * 8) * 2;
    const bf16x8 b0 = *reinterpret_cast<const ATT_LAS bf16x8*>(Rs + RSWZ(r32, cb));
    const bf16x8 b1 = *reinterpret_cast<const ATT_LAS bf16x8*>(Rs + RSWZ(32 + r32, cb));
    p0 = __builtin_amdgcn_mfma_f32_32x32x16_bf16(b0, qr[8 + d0], p0, 0, 0, 0);
    p1 = __builtin_amdgcn_mfma_f32_32x32x16_bf16(b1, qr[8 + d0], p1, 0, 0, 0); }
}
__device__ __forceinline__ int v_st(int k, int c) { const int kk = (k & ~0xC) | ((k & 4) << 1) | ((k & 8) >> 1); return ((kk >> 3) * 4 + (c >> 5)) * 512 + ((kk & 7) * 32 + (c & 31)) * 2; }
__device__ __forceinline__ int v_rd_base(int lane) { return ((lane & 3) << 3) | (((lane >> 2) & 3) << 6) | (((lane >> 4) & 1) << 5) | (((lane >> 5) & 1) << 8); }
constexpr int v_rd_off(int d0, int ks, int half) { return d0 * 512 + ks * 4096 + half * 2048; }
template <int OFF> __device__ __forceinline__ s16x4 tr_read(int vb) {
  s16x4 r; asm volatile("ds_read_b64_tr_b16 %0, %1 offset:%2" : "=&v"(r) : "v"(vb), "i"(OFF) : "memory"); return r;
}
template <int D0> __device__ __forceinline__ void pv_one(f32x16& od, int vb, bf16x8 pa0, bf16x8 pa1, bf16x8 pa2, bf16x8 pa3) {
  const s16x4 l0 = tr_read<v_rd_off(D0, 0, 0)>(vb), h0 = tr_read<v_rd_off(D0, 0, 1)>(vb), l1 = tr_read<v_rd_off(D0, 1, 0)>(vb), h1 = tr_read<v_rd_off(D0, 1, 1)>(vb);
  const s16x4 l2 = tr_read<v_rd_off(D0, 2, 0)>(vb), h2 = tr_read<v_rd_off(D0, 2, 1)>(vb), l3 = tr_read<v_rd_off(D0, 3, 0)>(vb), h3 = tr_read<v_rd_off(D0, 3, 1)>(vb);
  asm volatile("s_waitcnt lgkmcnt(0)" ::: "memory"); SBAR();
#define PK(L, H) (bf16x8){L[0], L[1], L[2], L[3], H[0], H[1], H[2], H[3]}
  od = __builtin_amdgcn_mfma_f32_32x32x16_bf16(pa0, PK(l0, h0), od, 0, 0, 0);
  od = __builtin_amdgcn_mfma_f32_32x32x16_bf16(pa1, PK(l1, h1), od, 0, 0, 0);
  od = __builtin_amdgcn_mfma_f32_32x32x16_bf16(pa2, PK(l2, h2), od, 0, 0, 0);
  od = __builtin_amdgcn_mfma_f32_32x32x16_bf16(pa3, PK(l3, h3), od, 0, 0, 0);
#undef PK
}
__device__ __forceinline__ void pv_d0(f32x16* o, int vb, bf16x8 pa0, bf16x8 pa1, bf16x8 pa2, bf16x8 pa3) {
  pv_one<0>(o[0], vb, pa0, pa1, pa2, pa3); pv_one<1>(o[1], vb, pa0, pa1, pa2, pa3); pv_one<2>(o[2], vb, pa0, pa1, pa2, pa3); pv_one<3>(o[3], vb, pa0, pa1, pa2, pa3);
}
__device__ __forceinline__ unsigned short f2bf(float f) { unsigned u = __builtin_bit_cast(unsigned, f); return (unsigned short)((u + 0x7fffu + ((u >> 16) & 1u)) >> 16); }
__device__ __forceinline__ void attn_unit(const bf16* __restrict__ Q, const bf16* __restrict__ KV, const bf16* __restrict__ PROJ, bf16* __restrict__ CAT, int b, int h, int qb, ATT_LAS char* lds) {
  int tid_ = threadIdx.x; asm volatile("" : "+v"(tid_));
  const int tid = tid_, wid = __builtin_amdgcn_readfirstlane(tid >> 6), lane = tid & 63, r32 = lane & 31, hi = lane >> 5;
  ATT_LAS char* V_lds = lds + OFF_V; ATT_LAS char* K_lds = lds + OFF_K; ATT_LAS char* R_lds = lds + OFF_R;
  ATT_LAS float* wsp = (ATT_LAS float*)(lds + OFF_WS) + wid * 64; ATT_LAS float* li_l = wsp; ATT_LAS float* al_l = wsp + 32;
  float m_reg = -1e30f, l_reg = 0; f32x16 o[4] = {}; bf16x8 qr[12];
  const size_t tok0 = (size_t)b * 4096;
  const bf16* Qw = Q + (tok0 + (size_t)qb * 256 + wid * 32 + r32) * 3072 + h * 192 + hi * 8;
#pragma unroll
  for (int d0 = 0; d0 < 12; ++d0) qr[d0] = *reinterpret_cast<const bf16x8*>(Qw + d0 * 16);
  const int cw = qb * 4 + (wid >> 1), NT = qb * 4 + 4;
  const int sr = tid >> 4, sc = (tid & 15) * 8, vst0 = v_st(sr, sc), vst1 = v_st(32 + sr, sc), kst0 = KSWZ(sr, sc * 2), kst1 = KSWZ(32 + sr, sc * 2);
  const int rr = tid >> 3, rc = (tid & 7) * 8, rst = RSWZ(rr, rc * 2);
  const bf16* Kg = KV + tok0 * 4096 + h * 256;
  const bf16* Rg = PROJ + tok0 * 6912 + 3584;
  const int vb0 = (int)(uintptr_t)V_lds + v_rd_base(lane);
  bf16x8 sv0, sv1, sk0, sk1, srp;
#define ATT_SLOAD(k0) do { sv0 = *reinterpret_cast<const bf16x8*>(Kg + (size_t)((k0) + sr) * 4096 + 128 + sc); sv1 = *reinterpret_cast<const bf16x8*>(Kg + (size_t)((k0) + 32 + sr) * 4096 + 128 + sc); \
    sk0 = *reinterpret_cast<const bf16x8*>(Kg + (size_t)((k0) + sr) * 4096 + sc); sk1 = *reinterpret_cast<const bf16x8*>(Kg + (size_t)((k0) + 32 + sr) * 4096 + sc); \
    srp = *reinterpret_cast<const bf16x8*>(Rg + (size_t)((k0) + rr) * 6912 + rc); } while (0)
#define ATT_SWRITE(bf) do { *reinterpret_cast<ATT_LAS bf16x8*>(V_lds + (bf) * SHM_V + vst0) = sv0; *reinterpret_cast<ATT_LAS bf16x8*>(V_lds + (bf) * SHM_V + vst1) = sv1; \
    *reinterpret_cast<ATT_LAS bf16x8*>(K_lds + (bf) * SHM_K + kst0) = sk0; *reinterpret_cast<ATT_LAS bf16x8*>(K_lds + (bf) * SHM_K + kst1) = sk1; \
    *reinterpret_cast<ATT_LAS bf16x8*>(R_lds + (bf) * SHM_R + rst) = srp; } while (0)
#define ATT_RESC(a) do { if (__any((a) < 1.f)) { if (hi == 0) al_l[r32] = (a); asm volatile("s_waitcnt lgkmcnt(0)" ::: "memory"); \
    _Pragma("unroll") for (int d = 0; d < 4; ++d) _Pragma("unroll") for (int r = 0; r < 16; ++r) o[d][r] *= al_l[crow(r, hi)]; } } while (0)
  ATT_SLOAD(0); asm volatile("s_waitcnt vmcnt(0)" ::: "memory"); ATT_SWRITE(0); __syncthreads();
  for (int t = 0; t < NT; ++t) {
    const int bf = t & 1;
    if (t + 1 < NT) ATT_SLOAD((t + 1) * 64);
    if (t <= cw) {
      f32x16 p0, p1; float mn, al; bf16x8 pa0, pa1, pa2, pa3;
      qkt(p0, p1, K_lds + bf * SHM_K, R_lds + bf * SHM_R, qr, r32, hi);
      partialSM(p0, p1, m_reg, mn, al);
      ATT_RESC(al);
      finishSM(p0, p1, al, l_reg, pa0, pa1, pa2, pa3); SBAR();
      pv_d0(o, vb0 + bf * SHM_V, pa0, pa1, pa2, pa3);
    }
    if (t + 1 < NT) { asm volatile("s_waitcnt vmcnt(0)" ::: "memory"); ATT_SWRITE(bf ^ 1); }
    __syncthreads();
  }
  if (hi == 0) li_l[r32] = l_reg; asm volatile("s_waitcnt lgkmcnt(0)" ::: "memory");
  float rli[16];
#pragma unroll
  for (int r = 0; r < 16; ++r) rli[r] = __builtin_amdgcn_rcpf(li_l[crow(r, hi)]);
  bf16* Ow = CAT + (tok0 + (size_t)qb * 256 + wid * 32) * 4096 + 1024 + h * 128;
#pragma unroll
  for (int r = 0; r < 16; ++r) { const int orow = crow(r, hi);
#pragma unroll
    for (int d0 = 0; d0 < 4; ++d0) Ow[(size_t)orow * 4096 + d0 * 32 + r32] = f2bf(o[d0][r] * rli[r]); }
#undef ATT_SLOAD
#undef ATT_SWRITE
#undef ATT_RESC
}
}
constexpr int NWAVES = 8;
constexpr int BATCH = 2, SEQ = 4096, DM = 4096, M = BATCH * SEQ, DEPTH = 2, FF = 16384;
constexpr int INW = 6720, INP = 6912;
constexpr int C_U = 0, C_V = 1024, C_CQ = 2048, C_CKV = 3072, C_KR = 3584, C_RQ = 3648, C_RK = 4160, C_RV = 4672, C_RG = 5696;
constexpr int QW = 3072, KVW = 4096;
constexpr float EPS = 1e-6f;
constexpr size_t MiB = 1u << 20;
constexpr size_t WS_CTL = 0, CTL_ZERO_BYTES = 1 * MiB;
constexpr size_t WS_ROPE = 1 * MiB;
constexpr size_t WS_SSQ = 2 * MiB;
constexpr size_t WS_RS = 3 * MiB;
constexpr size_t WS_W = 4 * MiB, LW = 353 * MiB;
constexpr size_t W_IN = 0, W_Q = 54 * MiB, W_KV = 60 * MiB, W_OUT = 64 * MiB, W_UP = 96 * MiB, W_DOWN = 224 * MiB, W_SGU = 352 * MiB;
constexpr size_t WS_H = WS_W + 2 * LW;
constexpr size_t WS_PROJ = WS_H + 64 * MiB;
constexpr size_t WS_Q = WS_PROJ + 108 * MiB;
constexpr size_t WS_KV = WS_Q + 48 * MiB;
constexpr size_t WS_CAT = WS_KV + 64 * MiB;
constexpr size_t WS_MIX = WS_CAT + 64 * MiB;
constexpr size_t WS_ACT = WS_MIX + 64 * MiB;
constexpr size_t WS_KVS = WS_ACT + 256 * MiB;
constexpr size_t WS_SB = WS_KVS + 32 * MiB;
constexpr size_t WS_END = WS_SB + 16 * MiB;
static_assert((size_t)INP * DM * 2 == 54 * MiB && (size_t)M * INP * 2 == 108 * MiB, "map");
constexpr int CW_BAR = 4096;
constexpr int RING_OFF = 0, RING_BYTES = 131072;
constexpr int LDSCTL_OFF = RING_BYTES, MISC_OFF = LDSCTL_OFF + 320;
constexpr int LDS_BYTES = 147456;
#define GAS __attribute__((address_space(1)))
#define LAS __attribute__((address_space(3)))
typedef unsigned short bf16;
typedef unsigned v4u __attribute__((ext_vector_type(4)));
typedef float f32x4 __attribute__((ext_vector_type(4)));
typedef short bf16x8 __attribute__((ext_vector_type(8)));
typedef GAS unsigned gu32;
typedef GAS unsigned long long gu64;
#define RLX_AGENT __ATOMIC_RELAXED, __HIP_MEMORY_SCOPE_AGENT
#define LDS_WAIT() asm volatile("s_waitcnt lgkmcnt(0)" ::: "memory")
#define VM_WAIT() asm volatile("s_waitcnt vmcnt(0)" ::: "memory")
__device__ __forceinline__ unsigned long long rt() { return __builtin_amdgcn_s_memrealtime(); }
__device__ __forceinline__ unsigned f2bf(float f) { unsigned u = __builtin_bit_cast(unsigned, f); return (u + 0x7fffu + ((u >> 16) & 1u)) >> 16; }
__device__ __forceinline__ unsigned pk2(float lo, float hi) { return f2bf(lo) | (f2bf(hi) << 16); }

#define XB_TMO      128
#define XB_XCNT(j)  (256  + 64 * (j))
#define XB_XSUB(j)  (1280 + 64 * (j))
#define XB_XGEN(j)  (2304 + 64 * (j))
#define XB_TOP      3328
#define XB_TOPGEN   3392
#define XCD_BAR_WORDS 3456
#define XB_SPIN_CAP (1u << 18)

__device__ __forceinline__ unsigned xb_ld(unsigned* p)              { return __hip_atomic_load(p, __ATOMIC_RELAXED, __HIP_MEMORY_SCOPE_AGENT); }
__device__ __forceinline__ unsigned xb_add(unsigned* p, unsigned v) { return __hip_atomic_fetch_add(p, v, __ATOMIC_RELAXED, __HIP_MEMORY_SCOPE_AGENT); }
__device__ __forceinline__ unsigned xb_xcc_id() { return (unsigned)__builtin_amdgcn_s_getreg((3 << 11) | 20) & 0xFu; }
#define XB_SPIN(cond, bar) do { unsigned _sp = 0; while (cond) { __builtin_amdgcn_s_sleep(1); \
    if ((++_sp & 255u) == 0u) { if (xb_ld(&(bar)[XB_TMO])) break; if (_sp > XB_SPIN_CAP) { atomicAdd(&(bar)[XB_TMO], 1u); break; } } } } while (0)

struct XcdBarrier {
    unsigned* bar; unsigned x;
    volatile LAS unsigned* st;
};

__device__ __forceinline__ XcdBarrier xcd_barrier_post(unsigned* bar, volatile LAS unsigned* st) {
    XcdBarrier b; b.bar = bar; b.x = xb_xcc_id(); b.st = st;
    if (threadIdx.x == 0) (void)xb_add(&bar[XB_XCNT(b.x)], 1u);
    return b;
}
__device__ __forceinline__ void xcd_barrier_complete(unsigned* bar, unsigned x, unsigned& nloc, unsigned& nx) {
    const unsigned G = gridDim.x * gridDim.y * gridDim.z;
    unsigned sum, cnt, mine, sp = 0u;
    for (;;) {
        sum = 0u; cnt = 0u; mine = 0u;
#pragma unroll
        for (unsigned j = 0; j < 16; ++j) { const unsigned c = xb_ld(&bar[XB_XCNT(j)]); sum += c; cnt += (c > 0u) ? 1u : 0u; mine = (j == x) ? c : mine; }
        if (sum == G) break;
        __builtin_amdgcn_s_sleep(1);
        if ((++sp & 255u) == 0u) { if (xb_ld(&bar[XB_TMO])) break; if (sp > XB_SPIN_CAP) { atomicAdd(&bar[XB_TMO], 1u); break; } }
    }
    nloc = mine > 0u ? mine : 1u; nx = cnt > 0u ? cnt : 1u;
}

__device__ __forceinline__ void xcd_barrier(const XcdBarrier& b) {
    asm volatile("s_waitcnt vmcnt(0)" ::: "memory");
    __syncthreads();
    if (threadIdx.x == 0) {
        unsigned* bar = b.bar;
        __builtin_amdgcn_s_waitcnt(0);
        unsigned nloc = b.st[0], nx = b.st[1];
        if (nloc == 0u) { xcd_barrier_complete(bar, b.x, nloc, nx); b.st[0] = nloc; b.st[1] = nx; }
        const unsigned old = xb_add(&bar[XB_XSUB(b.x)], 1u);
        const unsigned gen = old / nloc;
        if (old + 1u == (gen + 1u) * nloc) {
            __builtin_amdgcn_fence(__ATOMIC_RELEASE, "agent");
            asm volatile("s_waitcnt vmcnt(0)" ::: "memory");
            const unsigned og = xb_add(&bar[XB_TOP], 1u);
            const unsigned tg = og / nx;
            if (og + 1u == (tg + 1u) * nx) xb_add(&bar[XB_TOPGEN], 1u);
            else XB_SPIN(xb_ld(&bar[XB_TOPGEN]) == tg, bar);
            __builtin_amdgcn_fence(__ATOMIC_ACQUIRE, "agent");
            xb_add(&bar[XB_XGEN(b.x)], 1u);
            asm volatile("s_waitcnt vmcnt(0)" ::: "memory");
        } else {
            XB_SPIN(xb_ld(&bar[XB_XGEN(b.x)]) == gen, bar);
            __builtin_amdgcn_fence(__ATOMIC_ACQUIRE, "agent");
            asm volatile("s_waitcnt vmcnt(0)" ::: "memory");
        }
    }
    __syncthreads();
}
typedef float f32x16 __attribute__((ext_vector_type(16)));
struct Frame {
    LAS unsigned char* lds; int tid, lane, wave, vcu, G;
};
__device__ __forceinline__ Frame make_frame(LAS unsigned char* lds) {
    Frame F; F.lds = lds; int t = threadIdx.x; asm volatile("" : "+v"(t)); int bx = blockIdx.x; asm volatile("" : "+s"(bx));
    F.tid = t; F.lane = t & 63; F.wave = __builtin_amdgcn_readfirstlane(t >> 6); F.G = gridDim.x;
    F.vcu = (F.G % 8 == 0) ? (bx % 8) * (F.G / 8) + bx / 8 : bx; return F;
}
__device__ __forceinline__ float bf2f(unsigned short h) { return __builtin_bit_cast(float, (unsigned)h << 16); }
__device__ __forceinline__ unsigned short f2bf16(float f) { return (unsigned short)f2bf(f); }
__device__ __forceinline__ float wave_sum(float v) {
#pragma unroll
    for (int o = 1; o < 64; o <<= 1) v += __shfl_xor(v, o);
    return v;
}
__device__ __forceinline__ int crow32(int r, int hi) { return (r & 3) + 8 * (r >> 2) + 4 * hi; }
template <int KSTEPS> __device__ __forceinline__ void mfma_lds(f32x16& acc, const LAS bf16* A, int pa, const LAS bf16* Bt, int pb, int r32, int hi) {
#pragma unroll
    for (int s = 0; s < KSTEPS; ++s) {
        const bf16x8 a = *(const LAS bf16x8*)(A + r32 * pa + s * 16 + hi * 8);
        const bf16x8 b = *(const LAS bf16x8*)(Bt + r32 * pb + s * 16 + hi * 8);
        acc = __builtin_amdgcn_mfma_f32_32x32x16_bf16(a, b, acc, 0, 0, 0);
    }
}
struct CvtDesc { const float* W; bf16* WT; const float* kgain; int K, N, k0, n0, kind; };
__device__ __forceinline__ void cvt_load(const CvtDesc& d, float (&v)[32], int lane) {
    const int nd = d.n0 + (lane & 31); bool ok = true; int sc = nd; float cs = 1.f;
    if (d.kind == 1) { ok = nd < INW; sc = (nd >= C_KR && nd < C_RV) ? (nd & ~63) + ((nd & 63) >> 1) + 32 * (nd & 1) : nd; cs = (nd >= C_RQ && nd < C_RK) ? 0.125f : 1.f; if (!ok) sc = 0; }
    if (d.kind == 2) { sc = ((nd % 192) >= 128) ? (nd & ~63) + ((nd & 63) >> 1) + 32 * (nd & 1) : nd; }
    const float* src = d.W + (size_t)(d.k0 + (lane >> 5)) * d.N + sc;
#pragma unroll
    for (int i = 0; i < 32; ++i) v[i] = __builtin_nontemporal_load(src + (size_t)(2 * i) * d.N);
    if (d.kgain) {
#pragma unroll
        for (int i = 0; i < 32; ++i) v[i] *= d.kgain[d.k0 + 2 * i + (lane >> 5)]; }
    if (d.kind == 1) {
#pragma unroll
        for (int i = 0; i < 32; ++i) v[i] = ok ? v[i] * cs : 0.f; }
}
template <bool NT = false> __device__ __forceinline__ void cvt_finish(const CvtDesc& d, const float (&v)[32], LAS float* scr, int lane) {
#pragma unroll
    for (int i = 0; i < 32; ++i) scr[(2 * i + (lane >> 5)) * 33 + (lane & 31)] = v[i];
    LDS_WAIT(); asm volatile("" ::: "memory");
    const int c = lane & 7;
#pragma unroll
    for (int j = 0; j < 4; ++j) { const int n = (lane >> 3) + 8 * j; const LAS float* s = scr + (8 * c) * 33 + n;
        v4u o; o.x = pk2(s[0 * 33], s[1 * 33]); o.y = pk2(s[2 * 33], s[3 * 33]); o.z = pk2(s[4 * 33], s[5 * 33]); o.w = pk2(s[6 * 33], s[7 * 33]);
        if (NT) __builtin_nontemporal_store(o, (GAS v4u*)(d.WT + (size_t)(d.n0 + n) * d.K + d.k0 + 8 * c)); else *(GAS v4u*)(d.WT + (size_t)(d.n0 + n) * d.K + d.k0 + 8 * c) = o; }
    LDS_WAIT(); asm volatile("" ::: "memory");
}
__device__ __forceinline__ void x_row_to_bf16(const float* __restrict__ xrow, bf16* __restrict__ orow, float* __restrict__ rs, int lane) {
    f32x4 v[16]; float s = 0.f;
#pragma unroll
    for (int j = 0; j < 8; ++j) { const f32x4* p = (const f32x4*)(xrow + 8 * (lane + 64 * j)); v[2 * j] = p[0]; v[2 * j + 1] = p[1]; }
#pragma unroll
    for (int j = 0; j < 16; ++j) s += (v[j][0] * v[j][0] + v[j][1] * v[j][1]) + (v[j][2] * v[j][2] + v[j][3] * v[j][3]);
    const float r = 1.0f / sqrtf(wave_sum(s) * (1.0f / 4096.0f) + EPS);
    if (lane == 0) *rs = r;
#pragma unroll
    for (int j = 0; j < 8; ++j) { const f32x4 a = v[2 * j], b = v[2 * j + 1];
        v4u o; o.x = pk2(a[0], a[1]); o.y = pk2(a[2], a[3]); o.z = pk2(b[0], b[1]); o.w = pk2(b[2], b[3]);
        *(v4u*)(orow + 8 * (lane + 64 * j)) = o; }
}
__device__ __forceinline__ void unpack8(const v4u q, float* y) {
    y[0] = __builtin_bit_cast(float, q.x << 16); y[1] = __builtin_bit_cast(float, q.x & 0xffff0000u); y[2] = __builtin_bit_cast(float, q.y << 16); y[3] = __builtin_bit_cast(float, q.y & 0xffff0000u);
    y[4] = __builtin_bit_cast(float, q.z << 16); y[5] = __builtin_bit_cast(float, q.z & 0xffff0000u); y[6] = __builtin_bit_cast(float, q.w << 16); y[7] = __builtin_bit_cast(float, q.w & 0xffff0000u);
}
__device__ __forceinline__ void residual_row(const float* __restrict__ xin32, bf16* xb, const bf16* __restrict__ yrow, const float* __restrict__ gpost, float* __restrict__ out32, float* __restrict__ rs_next, bool last, int lane) {
    float x[64], y[64]; float s = 0.f;
#pragma unroll
    for (int j = 0; j < 8; ++j) { unpack8(*(const v4u*)(yrow + 8 * (lane + 64 * j)), y + 8 * j);
        if (xin32) { const f32x4* p = (const f32x4*)(xin32 + 8 * (lane + 64 * j)); const f32x4 a = p[0], b = p[1];
#pragma unroll
            for (int e = 0; e < 4; ++e) { x[8 * j + e] = a[e]; x[8 * j + 4 + e] = b[e]; } }
        else unpack8(*(const v4u*)(xb + 8 * (lane + 64 * j)), x + 8 * j); }
#pragma unroll
    for (int i = 0; i < 64; ++i) s += y[i] * y[i];
    const float r = 1.0f / sqrtf(wave_sum(s) * (1.0f / 4096.0f) + EPS);
    float s2 = 0.f;
#pragma unroll
    for (int j = 0; j < 8; ++j) { const f32x4* gp = (const f32x4*)(gpost + 8 * (lane + 64 * j)); const f32x4 g0 = gp[0], g1 = gp[1];
#pragma unroll
        for (int e = 0; e < 4; ++e) { x[8 * j + e] += y[8 * j + e] * r * g0[e]; x[8 * j + 4 + e] += y[8 * j + 4 + e] * r * g1[e]; }
#pragma unroll
        for (int e = 0; e < 8; ++e) s2 += x[8 * j + e] * x[8 * j + e];
        if (last) { f32x4* op = (f32x4*)(out32 + 8 * (lane + 64 * j)); op[0] = (f32x4){x[8 * j], x[8 * j + 1], x[8 * j + 2], x[8 * j + 3]}; op[1] = (f32x4){x[8 * j + 4], x[8 * j + 5], x[8 * j + 6], x[8 * j + 7]}; }
        else { v4u o; o.x = pk2(x[8 * j], x[8 * j + 1]); o.y = pk2(x[8 * j + 2], x[8 * j + 3]); o.z = pk2(x[8 * j + 4], x[8 * j + 5]); o.w = pk2(x[8 * j + 6], x[8 * j + 7]);
            *(v4u*)(xb + 8 * (lane + 64 * j)) = o; } }
    if (!last) { const float r2 = 1.0f / sqrtf(wave_sum(s2) * (1.0f / 4096.0f) + EPS); if (lane == 0) *rs_next = r2; }
}
__device__ __forceinline__ float ret_lg(int h) { return log1pf(-exp2f(-5.0f - (float)h)); }
__device__ __forceinline__ void sgu_phase(LAS unsigned char* lds_, const bf16* __restrict__ PROJ, bf16* __restrict__ CAT, const bf16* __restrict__ SGW, const float* __restrict__ lng, const float* __restrict__ lnb, const float* __restrict__ bs) {
    const Frame F = make_frame(lds_);
    LAS bf16* Wm = (LAS bf16*)(F.lds + RING_OFF);
    LAS bf16* VT = Wm + 128 * 136;
    const int r32 = F.lane & 31, hi = F.lane >> 5;
    for (int unit = F.vcu; unit < 512; unit += F.G) {
        const int b = unit >> 8, n = (unit >> 3) & 31, g = unit & 7;
        const size_t R0 = (size_t)b * SEQ + (size_t)n * 128; const int cb = g * 128;
        for (int q = F.tid; q < 128 * 16; q += NWAVES * 64) { const int i = q >> 4, ch = q & 15;
            *(LAS bf16x8*)(Wm + i * 136 + ch * 8) = *(const bf16x8*)(SGW + ((size_t)g * 128 + i) * 128 + ch * 8); }
        const float g0 = lng[cb + 2 * F.lane], g1 = lng[cb + 2 * F.lane + 1], b0 = lnb[cb + 2 * F.lane], b1 = lnb[cb + 2 * F.lane + 1];
        for (int jj = 0; jj < 16; ++jj) { const int j = F.wave * 16 + jj;
            const unsigned pv = *(const unsigned*)(PROJ + (R0 + j) * INP + C_V + cb + 2 * F.lane);
            const float x0 = __builtin_bit_cast(float, pv << 16), x1 = __builtin_bit_cast(float, pv & 0xffff0000u);
            const float mu = wave_sum(x0 + x1) * (1.0f / 128.0f), d0 = x0 - mu, d1 = x1 - mu;
            const float rstd = 1.0f / sqrtf(wave_sum(d0 * d0 + d1 * d1) * (1.0f / 128.0f) + EPS);
            VT[(2 * F.lane) * 136 + j] = f2bf16(d0 * rstd * g0 + b0); VT[(2 * F.lane + 1) * 136 + j] = f2bf16(d1 * rstd * g1 + b1); }
        __syncthreads();
        const int ib = F.wave >> 1, cb0 = (F.wave & 1) * 2;
        f32x16 acc0 = {}, acc1 = {};
        mfma_lds<8>(acc0, Wm + ib * 32 * 136, 136, VT + (cb0 * 32) * 136, 136, r32, hi);
        mfma_lds<8>(acc1, Wm + ib * 32 * 136, 136, VT + ((cb0 + 1) * 32) * 136, 136, r32, hi);
#pragma unroll
        for (int r = 0; r < 16; ++r) { const int i = ib * 32 + crow32(r, hi); const float bias = bs[g * 128 + i]; const size_t row = R0 + i; const int c = cb0 * 32 + r32;
            const float u0 = bf2f(PROJ[row * INP + C_U + cb + c]), u1 = bf2f(PROJ[row * INP + C_U + cb + c + 32]);
            CAT[row * DM + cb + c] = f2bf16(u0 * (acc0[r] + bias)); CAT[row * DM + cb + c + 32] = f2bf16(u1 * (acc1[r] + bias)); }
        __syncthreads();
    }
}
__device__ __forceinline__ void ret1_phase(LAS unsigned char* lds_, const bf16* __restrict__ PROJ, float* __restrict__ KVS) {
    const Frame F = make_frame(lds_);
    LAS bf16* KT = (LAS bf16*)(F.lds + RING_OFF);
    LAS bf16* VT = KT + 64 * 72;
    const int r32 = F.lane & 31, hi = F.lane >> 5;
    const int m = F.tid >> 3, d0 = (F.tid & 7) * 8, e0 = (F.tid & 7) * 16;
    bf16x8 kv, va, vb;
#define R1_LOAD(u_) do { const int bh_ = (u_) >> 6, c_ = (u_) & 63; const size_t R_ = (size_t)(bh_ >> 3) * SEQ + (size_t)c_ * 64 + m; const int h_ = bh_ & 7; \
        kv = *(const bf16x8*)(PROJ + R_ * INP + C_RK + h_ * 64 + d0); va = *(const bf16x8*)(PROJ + R_ * INP + C_RV + h_ * 128 + e0); vb = *(const bf16x8*)(PROJ + R_ * INP + C_RV + h_ * 128 + e0 + 8); } while (0)
    if (F.vcu < 1024) R1_LOAD(F.vcu);
    for (int unit = F.vcu; unit < 1024; unit += F.G) {
        const int bh = unit >> 6, h = bh & 7; const float lg = ret_lg(h);
        const float kd = expf(lg * (float)(63 - m));
#pragma unroll
        for (int i = 0; i < 8; ++i) KT[(d0 + i) * 72 + m] = f2bf16(bf2f((unsigned short)kv[i]) * kd);
#pragma unroll
        for (int i = 0; i < 8; ++i) { VT[(e0 + i) * 72 + m] = (unsigned short)va[i]; VT[(e0 + 8 + i) * 72 + m] = (unsigned short)vb[i]; }
        __syncthreads();
        if (unit + F.G < 1024) R1_LOAD(unit + F.G);
        const int eb = F.wave >> 1, db = F.wave & 1;
        f32x16 acc = {};
        mfma_lds<4>(acc, VT + eb * 32 * 72, 72, KT + db * 32 * 72, 72, r32, hi);
#pragma unroll
        for (int r = 0; r < 16; ++r) KVS[((size_t)unit * 128 + eb * 32 + crow32(r, hi)) * 64 + db * 32 + r32] = acc[r];
        __syncthreads();
    }
#undef R1_LOAD
}
__device__ __forceinline__ void ret2_phase(LAS unsigned char* lds_, const float* __restrict__ KVS, bf16* __restrict__ SB) {
    const Frame F = make_frame(lds_);
    for (int gid = F.vcu * (NWAVES * 64) + F.tid; gid < 16 * 8192; gid += F.G * NWAVES * 64) {
        const int bh = gid >> 13, idx = gid & 8191; const float cd = expf(ret_lg(bh & 7) * 64.0f);
        float S = 0.f;
#pragma unroll 8
        for (int c = 0; c < 64; ++c) { const size_t o = ((size_t)bh * 64 + c) * 8192 + idx; SB[o] = f2bf16(S); S = cd * S + KVS[o]; }
    }
}
__device__ __forceinline__ void ret3_phase(LAS unsigned char* lds_, const bf16* __restrict__ PROJ, const bf16* __restrict__ SB, bf16* __restrict__ CAT) {
    const Frame F = make_frame(lds_);
    LAS bf16* Qs = (LAS bf16*)(F.lds + RING_OFF);
    LAS bf16* Ks = Qs + 64 * 72;
    LAS bf16* VT = Ks + 64 * 72;
    LAS bf16* Ss = VT + 128 * 72;
    LAS bf16* Ps = Ss + 128 * 72;
    LAS float* red = (LAS float*)(Ps + 64 * 72);
    const int r32 = F.lane & 31, hi = F.lane >> 5;
    const int m = F.tid >> 3, d0 = (F.tid & 7) * 8, e0 = (F.tid & 7) * 16;
    bf16x8 rq, rk, rva, rvb, rs0, rs1;
#define R3_LOAD(u_) do { const int bh_ = (u_) >> 6, c_ = (u_) & 63; const size_t R_ = (size_t)(bh_ >> 3) * SEQ + (size_t)c_ * 64 + m; const int h_ = bh_ & 7; \
        rq = *(const bf16x8*)(PROJ + R_ * INP + C_RQ + h_ * 64 + d0); rk = *(const bf16x8*)(PROJ + R_ * INP + C_RK + h_ * 64 + d0); \
        rva = *(const bf16x8*)(PROJ + R_ * INP + C_RV + h_ * 128 + e0); rvb = *(const bf16x8*)(PROJ + R_ * INP + C_RV + h_ * 128 + e0 + 8); \
        rs0 = *(const bf16x8*)(SB + (size_t)(u_) * 8192 + F.tid * 8); rs1 = *(const bf16x8*)(SB + (size_t)(u_) * 8192 + (F.tid + 512) * 8); } while (0)
    if (F.vcu < 1024) R3_LOAD(F.vcu);
    for (int unit = F.vcu; unit < 1024; unit += F.G) {
        const int bh = unit >> 6, c = unit & 63, b = bh >> 3, h = bh & 7; const float lg = ret_lg(h);
        const size_t R0 = (size_t)b * SEQ + (size_t)c * 64;
        *(LAS bf16x8*)(Qs + m * 72 + d0) = rq; *(LAS bf16x8*)(Ks + m * 72 + d0) = rk;
#pragma unroll
        for (int i = 0; i < 8; ++i) { VT[(e0 + i) * 72 + m] = (unsigned short)rva[i]; VT[(e0 + 8 + i) * 72 + m] = (unsigned short)rvb[i]; }
        *(LAS bf16x8*)(Ss + (F.tid >> 3) * 72 + (F.tid & 7) * 8) = rs0; *(LAS bf16x8*)(Ss + ((F.tid + 512) >> 3) * 72 + (F.tid & 7) * 8) = rs1;
        __syncthreads();
        if (unit + F.G < 1024) R3_LOAD(unit + F.G);
        const int lb = F.wave & 1, eb = F.wave >> 1;
        unsigned short gt[16];
#pragma unroll
        for (int r = 0; r < 16; ++r) gt[r] = PROJ[(R0 + lb * 32 + crow32(r, hi)) * INP + C_RG + h * 128 + eb * 32 + r32];
        f32x16 cross = {};
        mfma_lds<4>(cross, Qs + lb * 32 * 72, 72, Ss + eb * 32 * 72, 72, r32, hi);
        if (F.wave < 4) { const int mb = F.wave >> 1; f32x16 sc = {};
            mfma_lds<4>(sc, Qs + lb * 32 * 72, 72, Ks + mb * 32 * 72, 72, r32, hi);
#pragma unroll
            for (int r = 0; r < 16; ++r) { const int l = lb * 32 + crow32(r, hi), mm = mb * 32 + r32; const int ad = l > mm ? l - mm : mm - l;
                Ps[l * 72 + mm] = f2bf16(sc[r] * expf(lg * (float)ad)); } }
        __syncthreads();
        f32x16 o = {};
        mfma_lds<4>(o, Ps + lb * 32 * 72, 72, VT + eb * 32 * 72, 72, r32, hi);
#pragma unroll
        for (int r = 0; r < 16; ++r) { const int l = lb * 32 + crow32(r, hi); o[r] += cross[r] * expf(lg * (float)(l + 1));
            float s = o[r] * o[r];
#pragma unroll
            for (int x = 1; x < 32; x <<= 1) s += __shfl_xor(s, x);
            if (r32 == 0) red[l * 4 + eb] = s; }
        __syncthreads();
#pragma unroll
        for (int r = 0; r < 16; ++r) { const int l = lb * 32 + crow32(r, hi); const f32x4 t = *(const LAS f32x4*)(red + l * 4);
            const float rn = 1.0f / sqrtf(((t[0] + t[1]) + (t[2] + t[3])) * (1.0f / 128.0f) + EPS); const int e = eb * 32 + r32;
            const float g = bf2f(gt[r]); const float sg = g / (1.0f + expf(-g));
            CAT[(R0 + l) * DM + 3072 + h * 128 + e] = f2bf16(sg * (o[r] * rn)); }
        __syncthreads();
    }
#undef R3_LOAD
}
#define CVT_LOOP(NITEMS, NIF, NTS) do { for (int it = gw; it < (NITEMS); it += (NIF) * NGW) { float vv[NIF][32]; \
    _Pragma("unroll") for (int j = 0; j < (NIF); ++j) if (it + j * NGW < (NITEMS)) { const CvtDesc d = desc_of(it + j * NGW); cvt_load(d, vv[j], F.lane); } \
    _Pragma("unroll") for (int j = 0; j < (NIF); ++j) if (it + j * NGW < (NITEMS)) { const CvtDesc d = desc_of(it + j * NGW); cvt_finish<NTS>(d, vv[j], scr, F.lane); } } } while (0)
#ifndef PRO_NIF
#define PRO_NIF 2
#endif
#ifndef DEF_NIF
#define DEF_NIF 4
#endif
#ifndef DEF_NT
#define DEF_NT true
#endif
#ifndef DOWN_KREV
#define DOWN_KREV 1
#endif
#ifndef UP_DEFER
#define UP_DEFER 6144
#endif
#ifndef WARM_UP
#define WARM_UP 0
#endif
#ifndef DN_DEFER
#define DN_DEFER 32768
#endif
#ifndef GEMM_ALIGN
#define GEMM_ALIGN true
#endif
#ifndef GEMM_SP2
#define GEMM_SP2 true
#endif
#ifndef REP_PRO
#define REP_PRO 1
#endif
#ifndef REP_ATTN
#define REP_ATTN 1
#endif
#ifndef REP_UP
#define REP_UP 1
#endif
#ifndef REP_IN
#define REP_IN 1
#endif
#ifndef REP_QKV
#define REP_QKV 1
#endif
#ifndef REP_RET3
#define REP_RET3 1
#endif
#ifndef BAR_DUP
#define BAR_DUP 1
#endif
#ifndef REP_OUT
#define REP_OUT 1
#endif
#ifndef REP_DOWN
#define REP_DOWN 1
#endif
#ifndef REP_RES
#define REP_RES 1
#endif
#ifndef REP_BAR
#define REP_BAR 0
#endif
#ifndef REP_RET2
#define REP_RET2 1
#endif
#ifndef PROBE_IDX
#define PROBE_IDX -1
#endif
#ifndef PROBE_Q
#define PROBE_Q 20
#endif
#ifndef PROBE_L
#define PROBE_L 0
#endif
#ifndef REP_SMALL
#define REP_SMALL 1
#endif
struct Args { const float* in[17]; float* out; unsigned char* ws; };
typedef const Args __attribute__((address_space(4))) CArgs;
__device__ __forceinline__ CArgs* fresh_args() { CArgs* p = (CArgs*)__builtin_amdgcn_kernarg_segment_ptr(); asm volatile("" : "+s"(p)); return p; }
__device__ __forceinline__ void prologue_phase(LAS unsigned char* lds_) {
    const Frame F = make_frame(lds_); CArgs* A = fresh_args(); unsigned char* ws = A->ws; float* rope = (float*)(ws + WS_ROPE); bf16* H = (bf16*)(ws + WS_H);
    const int gw = F.vcu * NWAVES + F.wave, NGW = F.G * NWAVES;
        LAS float* scr = (LAS float*)(F.lds + RING_OFF + F.wave * 16384);
        constexpr int I_IN = (DM / 64) * (INP / 32), I_Q = (1024 / 64) * (QW / 32), I_KV = (512 / 64) * (KVW / 32), I_OUT = (DM / 64) * (DM / 32), I_UP = (DM / 64) * (FF / 32);
        constexpr int I_DNP = (FF / 64) * (DM / 32) - DN_DEFER;
        constexpr int I_UPP = I_UP - UP_DEFER;
        constexpr int I_L = I_IN + I_Q + I_KV + I_OUT + I_UPP + I_DNP;
        auto desc_of = [&](int it_) -> CvtDesc {
            const int it = DEPTH * I_L - 1 - it_; const int l = it / I_L; int r = it % I_L; unsigned char* wl = ws + WS_W + (size_t)l * LW; CvtDesc d; int nblk;
            if (r < I_IN) { d.W = A->in[5] + (size_t)l * DM * INW; d.WT = (bf16*)(wl + W_IN); d.kgain = A->in[1] + l * DM; d.K = DM; d.N = INW; nblk = INP / 32; d.kind = 1; }
            else if ((r -= I_IN) < I_Q) { d.W = A->in[11] + (size_t)l * 1024 * QW; d.WT = (bf16*)(wl + W_Q); d.kgain = A->in[10] + l * 1024; d.K = 1024; d.N = QW; nblk = QW / 32; d.kind = 2; }
            else if ((r -= I_Q) < I_KV) { d.W = A->in[13] + (size_t)l * 512 * KVW; d.WT = (bf16*)(wl + W_KV); d.kgain = A->in[12] + l * 512; d.K = 512; d.N = KVW; nblk = KVW / 32; d.kind = 0; }
            else if ((r -= I_KV) < I_OUT) { d.W = A->in[14] + (size_t)l * DM * DM; d.WT = (bf16*)(wl + W_OUT); d.kgain = nullptr; d.K = DM; d.N = DM; nblk = DM / 32; d.kind = 0; }
            else if ((r -= I_OUT) < I_UPP) { r += UP_DEFER; d.W = A->in[15] + (size_t)l * DM * FF; d.WT = (bf16*)(wl + W_UP); d.kgain = A->in[3] + l * DM; d.K = DM; d.N = FF; nblk = FF / 32; d.kind = 0; }
            else { r -= I_UPP; r += DN_DEFER; d.W = A->in[16] + (size_t)l * FF * DM; d.WT = (bf16*)(wl + W_DOWN); d.kgain = nullptr; d.K = FF; d.N = DM; nblk = DM / 32; d.kind = 0; }
            d.k0 = 64 * (r / nblk); d.n0 = 32 * (r % nblk); return d; };
        CVT_LOOP(DEPTH * I_L, PRO_NIF, false);
        for (int i = F.vcu * (NWAVES * 64) + F.tid; i < DEPTH * 8 * 128 * 128; i += F.G * NWAVES * 64) {
            const int l = i >> 17, r = i & 131071, ii = (r >> 7) & 127, jj = r & 127;
            ((bf16*)(ws + WS_W + (size_t)l * LW + W_SGU))[r] = ((jj >> 6) <= (ii >> 6)) ? f2bf16(A->in[8][i]) : (bf16)0; }
        for (int i = F.vcu * (NWAVES * 64) + F.tid; i < SEQ * 32; i += F.G * NWAVES * 64) {
            const int pos = i >> 5, j = i & 31; const float inv = (float)pow(10000.0, -(double)j / 32.0); const float ang = (float)pos * inv;
            float sn, cs; sincosf(ang, &sn, &cs); rope[2 * i] = cs; rope[2 * i + 1] = sn; }
        { float* rs0 = (float*)(ws + WS_RS); for (int m = gw; m < M; m += NGW) x_row_to_bf16(A->in[0] + (size_t)m * DM, H + (size_t)m * DM, rs0 + m, F.lane); }
}
template <int SLOT> __device__ __forceinline__ void convert_down_phase(LAS unsigned char* lds_, int l, int idx, int n) {
    const Frame F = make_frame(lds_); CArgs* A = fresh_args(); unsigned char* ws = A->ws;
    LAS float* scr = (LAS float*)(F.lds + RING_OFF + F.wave * 16384);
    constexpr int I_DN = (FF / 64) * (DM / 32), NB = DM / 32;
    const int gw = idx * NWAVES + F.wave, NGW = n * NWAVES;
    auto desc_of = [&](int r) -> CvtDesc { CvtDesc d; d.kind = 0;
        if (SLOT == 0) { d.W = A->in[16] + (size_t)l * FF * DM; d.WT = (bf16*)(ws + WS_W + (size_t)l * LW + W_DOWN); d.kgain = nullptr; d.K = FF; d.N = DM; d.k0 = 64 * (r / NB); d.n0 = 32 * (r % NB); }
        else { d.W = A->in[15] + (size_t)l * DM * FF; d.WT = (bf16*)(ws + WS_W + (size_t)l * LW + W_UP); d.kgain = A->in[3] + l * DM; d.K = DM; d.N = FF; d.k0 = 64 * (r / (FF / 32)); d.n0 = 32 * (r % (FF / 32)); }
        return d; };
    CVT_LOOP((SLOT == 0 ? DN_DEFER : UP_DEFER), DEF_NIF, DEF_NT);
}
__device__ __forceinline__ void residual_phase(LAS unsigned char* lds_, int l, int which, bool dry = false) {
    const Frame F = make_frame(lds_); CArgs* A = fresh_args(); unsigned char* ws = A->ws; const int gw = F.vcu * NWAVES + F.wave, NGW = F.G * NWAVES;
    const float* xin32 = (which == 0 && l == 0) ? A->in[0] : nullptr; const bf16* Y = (const bf16*)(ws + WS_MIX); bf16* XB = (bf16*)(ws + WS_H);
    const bool last = (which == 1 && l + 1 == DEPTH);
    float* out32 = dry ? (float*)(ws + WS_ACT) : A->out; float* rs_next = (float*)(ws + WS_RS) + (which == 0 ? M : 0) + (dry ? 2 * M : 0);
    if (dry) XB = (bf16*)(ws + WS_ACT + 134 * MiB);
    const float* gpost = (which == 0 ? A->in[2] : A->in[4]) + l * DM;
    for (int m = gw; m < M; m += NGW) residual_row(xin32 ? xin32 + (size_t)m * DM : nullptr, XB + (size_t)m * DM, Y + (size_t)m * DM, gpost, out32 + (size_t)m * DM, rs_next + m, last, F.lane);
}
__device__ __forceinline__ void warm_phase(LAS unsigned char* lds_, size_t off, size_t bytes, int l) {
    const Frame F = make_frame(lds_); CArgs* A = fresh_args(); const unsigned* p = (const unsigned*)(A->ws + WS_W + (size_t)l * LW + off);
    const size_t nlines = bytes / 128; unsigned acc = 0;
    for (size_t i = (size_t)F.vcu * (NWAVES * 64) + F.tid; i < nlines; i += (size_t)F.G * NWAVES * 64) acc += p[i * 32];
    if (acc == 0x12345678u) ((unsigned*)(A->ws + WS_CTL))[2048] = acc;
}
__device__ __forceinline__ void attn_phase(LAS unsigned char* lds_) {
    const Frame F = make_frame(lds_); CArgs* A = fresh_args(); unsigned char* ws = A->ws;
    const bf16* QB = (const bf16*)(ws + WS_Q); const bf16* KVB = (const bf16*)(ws + WS_KV); const bf16* PROJ = (const bf16*)(ws + WS_PROJ); bf16* CAT = (bf16*)(ws + WS_CAT);
    for (int p2 = 2 * F.vcu; p2 < 512; p2 += 2 * F.G)
        for (int k = 0; k < 2; ++k) { const int p = p2 >> 1, bh = p >> 3, s = p & 7;
            att::attn_unit(QB, KVB, PROJ, CAT, bh >> 4, bh & 15, k ? 15 - s : s, (ATT_LAS char*)(F.lds + RING_OFF)); }
}
template <int WHICH> __device__ __forceinline__ void gemm_call(LAS unsigned char* lds_, int l) {
    CArgs* A = fresh_args(); unsigned char* ws = A->ws; unsigned char* wl = ws + WS_W + (size_t)l * LW; int bx = blockIdx.x; asm volatile("" : "+s"(bx)); const int G = gridDim.x;
    float* rope = (float*)(ws + WS_ROPE); float* ssq = (float*)(ws + WS_SSQ); const float* rs = (const float*)(ws + WS_RS);
    bf16* H = (bf16*)(ws + WS_H); bf16* PROJ = (bf16*)(ws + WS_PROJ); bf16* QB = (bf16*)(ws + WS_Q); bf16* KVB = (bf16*)(ws + WS_KV);
    bf16* CAT = (bf16*)(ws + WS_CAT); bf16* MIX = (bf16*)(ws + WS_MIX); bf16* ACT = (bf16*)(ws + WS_ACT);
    pg8::StaticOrder S;
    if constexpr (WHICH == 0) { pg8::Gemm g{H, (const bf16*)(wl + W_IN), M, INP, DM, DM, 0}; S.init(M, INP, G, bx); pg8::Epi<2> E{PROJ, INP, rope, ssq, rs};
        pg8::gemm_phase<pg8::Epi<2>, pg8::StaticOrder, GEMM_ALIGN, GEMM_SP2>(lds_ + RING_OFF, g, S, E); }
    if constexpr (WHICH == 1) { pg8::Gemm g{PROJ + C_CQ, (const bf16*)(wl + W_Q), M, QW, 1024, INP, 0}; S.init(M, QW, G, bx); pg8::Epi<3> E{QB, QW, rope, ssq, nullptr};
        pg8::gemm_phase<pg8::Epi<3>, pg8::StaticOrder, GEMM_ALIGN, GEMM_SP2>(lds_ + RING_OFF, g, S, E); }
    if constexpr (WHICH == 2) { pg8::Gemm g{PROJ + C_CKV, (const bf16*)(wl + W_KV), M, KVW, 512, INP, 0}; S.init(M, KVW, G, bx); pg8::Epi<4> E{KVB, KVW, rope, ssq, nullptr};
        pg8::gemm_phase<pg8::Epi<4>, pg8::StaticOrder, GEMM_ALIGN, GEMM_SP2>(lds_ + RING_OFF, g, S, E); }
    if constexpr (WHICH == 3) { pg8::Gemm g{CAT, (const bf16*)(wl + W_OUT), M, DM, DM, DM, 0}; S.init(M, DM, G, bx); pg8::Epi<0> E{MIX, DM, rope, ssq, nullptr};
        pg8::gemm_phase<pg8::Epi<0>, pg8::StaticOrder, GEMM_ALIGN, GEMM_SP2>(lds_ + RING_OFF, g, S, E); }
    if constexpr (WHICH == 4) { pg8::Gemm g{H, (const bf16*)(wl + W_UP), M, FF, DM, DM, 0}; S.init(M, FF, G, bx); pg8::Epi<1> E{ACT, FF, rope, ssq, rs + M};
        pg8::gemm_phase<pg8::Epi<1>, pg8::StaticOrder, GEMM_ALIGN, GEMM_SP2>(lds_ + RING_OFF, g, S, E); }
    if constexpr (WHICH == 5) { pg8::Gemm g{ACT + (DOWN_KREV ? FF - 64 : 0), (const bf16*)(wl + W_DOWN) + (DOWN_KREV ? FF - 64 : 0), M, DM, FF, FF, DOWN_KREV};     S.init(M, DM, G, bx); pg8::Epi<0> E{MIX, DM, rope, ssq, nullptr};
        pg8::gemm_phase<pg8::Epi<0>, pg8::StaticOrder, GEMM_ALIGN, GEMM_SP2>(lds_ + RING_OFF, g, S, E); }
}
__device__ __forceinline__ void mixer_small_phases(LAS unsigned char* lds_, int l) {
    CArgs* A = fresh_args(); unsigned char* ws = A->ws;
    sgu_phase(lds_, (const bf16*)(ws + WS_PROJ), (bf16*)(ws + WS_CAT), (const bf16*)(ws + WS_W + (size_t)l * LW + W_SGU), A->in[6] + l * 1024, A->in[7] + l * 1024, A->in[9] + l * 1024);
    CArgs* A2 = fresh_args(); unsigned char* ws2 = A2->ws;
    ret1_phase(lds_, (const bf16*)(ws2 + WS_PROJ), (float*)(ws2 + WS_KVS));
}
__global__ void __launch_bounds__(NWAVES * 64, 2) mega_fwd(Args args) {
    extern __shared__ __attribute__((aligned(16))) unsigned char lds[];
    LAS unsigned char* L = (LAS unsigned char*)lds;
    volatile LAS unsigned* MISC = (volatile LAS unsigned*)(L + MISC_OFF);
    for (int u = threadIdx.x; u < (LDS_BYTES - LDSCTL_OFF) / 4; u += NWAVES * 64) ((LAS unsigned*)(L + LDSCTL_OFF))[u] = 0u;
    __syncthreads();
    XcdBarrier bar = xcd_barrier_post((unsigned*)(args.ws + WS_CTL) + CW_BAR, MISC + 8);
#define GRID_BAR() do { for (int bd_ = 0; bd_ < BAR_DUP; ++bd_) { XcdBarrier b_ = bar; asm volatile("" : "+s"(b_.bar), "+s"(b_.x)); xcd_barrier(b_); } } while (0)
    unsigned long long tp0 = 0, tp1 = 0;
#define STAMP(kk, cond) do { if (PROBE_IDX >= 0 && (cond)) { if (PROBE_IDX == (kk)) tp0 = __builtin_amdgcn_s_memrealtime(); if (PROBE_IDX + 1 == (kk)) tp1 = __builtin_amdgcn_s_memrealtime(); } } while (0)
    STAMP(0, true);
    for (int rep_ = 0; rep_ < REP_PRO; ++rep_) prologue_phase(L);
    GRID_BAR();
    for (int l = 0; l < DEPTH; ++l) {
        STAMP(1, l == PROBE_L);
        for (int rep_ = 0; rep_ < REP_IN; ++rep_) gemm_call<0>(L, l);
        { int bx = blockIdx.x; asm volatile("" : "+s"(bx)); const int G = gridDim.x, NT_IN = (M / 256) * (INP / 256), nfull = NT_IN % G;
          if (nfull == 0) convert_down_phase<0>(L, l, bx, G); else if (bx >= nfull) convert_down_phase<0>(L, l, bx - nfull, G - nfull); }
        GRID_BAR();
        STAMP(2, l == PROBE_L);
        for (int rep_ = 0; rep_ < REP_QKV; ++rep_) { gemm_call<1>(L, l);
            if (UP_DEFER > 0) { int bx = blockIdx.x; asm volatile("" : "+s"(bx)); const int G = gridDim.x, nfull = ((M / 256) * (QW / 256)) % G;
                if (nfull != 0 && bx >= nfull) convert_down_phase<1>(L, l, bx - nfull, G - nfull); else if (nfull == 0) convert_down_phase<1>(L, l, bx, G);
                __syncthreads(); }
            gemm_call<2>(L, l); }
        for (int rep_ = 0; rep_ < REP_SMALL; ++rep_) mixer_small_phases(L, l);
        GRID_BAR();
        STAMP(3, l == PROBE_L);
        for (int rep_ = 0; rep_ < REP_RET2; ++rep_) { CArgs* A = fresh_args(); unsigned char* ws = A->ws; ret2_phase(L, (const float*)(ws + WS_KVS), (bf16*)(ws + WS_SB)); }
        for (int rep_ = 0; rep_ < REP_ATTN; ++rep_) attn_phase(L);
        GRID_BAR();
        STAMP(4, l == PROBE_L);
        for (int rep_ = 0; rep_ < REP_RET3; ++rep_) { CArgs* A = fresh_args(); unsigned char* ws = A->ws; ret3_phase(L, (const bf16*)(ws + WS_PROJ), (const bf16*)(ws + WS_SB), (bf16*)(ws + WS_CAT)); }
        GRID_BAR();
        STAMP(5, l == PROBE_L);
        for (int rep_ = 0; rep_ < REP_OUT; ++rep_) gemm_call<3>(L, l);
        GRID_BAR();
        STAMP(6, l == PROBE_L);
        for (int rep_ = 0; rep_ < REP_RES; ++rep_) residual_phase(L, l, 0, rep_ + 1 < REP_RES);
        if (WARM_UP) warm_phase(L, W_UP, (size_t)FF * DM * 2, l);
        GRID_BAR();
        STAMP(7, l == PROBE_L);
        for (int rep_ = 0; rep_ < REP_UP; ++rep_) { if (rep_ && REP_BAR) GRID_BAR(); gemm_call<4>(L, l); }
        GRID_BAR();
        STAMP(8, l == PROBE_L);
        for (int rep_ = 0; rep_ < REP_DOWN; ++rep_) gemm_call<5>(L, l);
        GRID_BAR();
        STAMP(9, l == PROBE_L);
        for (int rep_ = 0; rep_ < REP_RES; ++rep_) residual_phase(L, l, 1, rep_ + 1 < REP_RES);
        STAMP(10, l == PROBE_L);
        if (l + 1 < DEPTH) GRID_BAR();
    }
    if (PROBE_IDX >= 0 && blockIdx.x == 0 && threadIdx.x == 0) { asm volatile("s_waitcnt vmcnt(0)" ::: "memory"); args.out[0] = (float)(((tp1 - tp0) + PROBE_Q * 50ull) / (PROBE_Q * 100ull)) * (float)(PROBE_Q * 10); }
}

extern "C" void kernel_launch(void* const* d_in, const int* in_sizes, int n_in, void* d_out, int out_size, void* d_ws, size_t ws_size, hipStream_t stream) {
    static int grid = 0;
    if (grid == 0) {
        if (n_in != 17 || in_sizes[0] != M * DM || out_size != M * DM || ws_size < WS_END) { fprintf(stderr, "kernel_launch: shape mismatch (n_in %d, in0 %d, out %d, ws %zu < %zu)\n", n_in, n_in > 0 ? in_sizes[0] : -1, out_size, ws_size, (size_t)WS_END); grid = -1; return; }
        int dev = 0, cus = 0, per_cu = 0;
        if (hipGetDevice(&dev) != hipSuccess || hipDeviceGetAttribute(&cus, hipDeviceAttributeMultiprocessorCount, dev) != hipSuccess) { grid = -1; return; }
        if (hipFuncSetAttribute((const void*)mega_fwd, hipFuncAttributeMaxDynamicSharedMemorySize, LDS_BYTES) != hipSuccess) { fprintf(stderr, "kernel_launch: hipFuncSetAttribute failed\n"); grid = -1; return; }
        if (hipOccupancyMaxActiveBlocksPerMultiprocessor(&per_cu, (const void*)mega_fwd, NWAVES * 64, LDS_BYTES) != hipSuccess || per_cu < 1)
            fprintf(stderr, "kernel_launch: note: occupancy query reports %d workgroups per CU\n", per_cu);
        (void)hipGetLastError();
        grid = cus;
    }
    if (grid < 0) return;
    if (hipMemsetAsync((char*)d_ws + WS_CTL, 0, CTL_ZERO_BYTES, stream) != hipSuccess) { fprintf(stderr, "kernel_launch: memset failed\n"); return; }
    Args a{};
    for (int i = 0; i < 17; ++i) a.in[i] = (const float*)d_in[i];
    a.out = (float*)d_out; a.ws = (unsigned char*)d_ws;
    hipLaunchKernelGGL(mega_fwd, dim3(grid), dim3(NWAVES * 64), LDS_BYTES, stream, a);
    const hipError_t le = hipPeekAtLastError();
    if (le != hipSuccess) fprintf(stderr, "kernel_launch: launch failed: %s\n", hipGetErrorName(le));
}
```

```cpp
#include <hip/hip_runtime.h>
#include <cstdio>
#include <cstdint>
namespace pg8 {
#define PG8_LAS __attribute__((address_space(3)))
typedef unsigned short bf16_t;
typedef short bf16x8 __attribute__((ext_vector_type(8)));
typedef float f32x4 __attribute__((ext_vector_type(4)));
typedef unsigned u32x4 __attribute__((ext_vector_type(4)));
constexpr int BM = 256, BK = 64, HALF = 128, HTB = HALF * BK * 2  , STAGE_BYTES = 8 * HTB, NXCD = 8, WGM = 8;

__host__ __device__ __forceinline__ int lds_byte(int r, int c) { const int st = (r >> 4) * 2 + (c >> 5), rr = r & 15, cc = c & 31, ob = rr * 64 + cc * 2; return st * 1024 + (ob ^ (((ob >> 9) & 1) << 5)); }
__host__ __device__ __forceinline__ void stage_rc(int b, int& R, int& C) { const int st = b / 1024, sb = b % 1024, swz = sb ^ (((sb >> 9) & 1) << 5); R = (st >> 1) * 16 + swz / 64; C = (st & 1) * 32 + (swz % 64) / 2; }
__host__ __device__ __forceinline__ int perm32(int rho) { const int n = rho >> 4, i = rho & 15; return 8 * (i >> 2) + 4 * n + (i & 3); }

struct Unit { int pm, pn; };
struct Gemm { const bf16_t* A; const bf16_t* Bt; int M, N, K, lda, krev; };

struct StaticOrder {
    int nM, nN, nwg, G, c;
    __host__ __device__ void init(int M, int N, int G_, int c_) { nM = M / BM; nN = N / BM; nwg = nM * nN; G = G_; c = c_; }
    __host__ __device__ bool next(int i, Unit& u) const {
        const long L = (long)i * G + c; if (L >= nwg) return false;
        int wgid = (int)L; { const int q = nwg / NXCD, r = nwg % NXCD, xcd = wgid % NXCD, off = wgid / NXCD; wgid = (xcd < r ? xcd * (q + 1) : r * (q + 1) + (xcd - r) * q) + off; }
        const int nig = WGM * nN, gid = wgid / nig, fm = gid * WGM, gsz = (nM - fm) < WGM ? (nM - fm) : WGM;
        u.pm = fm + ((wgid % nig) % gsz); u.pn = (wgid % nig) / gsz; return true;
    }
    __device__ __forceinline__ void a_ready(const Unit&) const {}
    __device__ __forceinline__ void done(const Unit&) const {}
};
__device__ __forceinline__ unsigned cvt_pk_bf16(float lo, float hi) { unsigned r; asm volatile("v_cvt_pk_bf16_f32 %0, %1, %2" : "=v"(r) : "v"(lo), "v"(hi)); return r; }
__device__ __forceinline__ void rope8(f32x4& v0, f32x4& v1, const float* tab) {
    const f32x4 t0 = *(const f32x4*)tab, t1 = *(const f32x4*)(tab + 4);
    f32x4 a, b;
    a[0] = v0[0] * t0[0] - v0[1] * t0[1]; a[1] = v0[0] * t0[1] + v0[1] * t0[0];
    a[2] = v0[2] * t0[2] - v0[3] * t0[3]; a[3] = v0[2] * t0[3] + v0[3] * t0[2];
    b[0] = v1[0] * t1[0] - v1[1] * t1[1]; b[1] = v1[0] * t1[1] + v1[1] * t1[0];
    b[2] = v1[2] * t1[2] - v1[3] * t1[3]; b[3] = v1[2] * t1[3] + v1[3] * t1[2];
    v0 = a; v1 = b;
}
template <int MODE> struct Epi {
    static constexpr bool PERM = true, AFTER_DRAIN = false;
    bf16_t* O; int ldc; const float* rope; float* ssq; const float* rsc; const PG8_LAS float* rs_lds; int rs_pm;
    __device__ __forceinline__ void operator()(const f32x4 (&acc)[2][2][4][2], const Unit& u, int wr, int wc, int fr, int fq) const {
        const int row0 = u.pm * BM + wr * 64 + fr, colt = u.pn * BM + wc * 32 + 8 * fq;
        const bool want_ss = (MODE == 2) && u.pn >= 8 && u.pn < 14;
#pragma unroll
        for (int ai = 0; ai < 2; ++ai)
#pragma unroll
            for (int m = 0; m < 4; ++m) {
                const int row = row0 + ai * HALF + m * 16;
                float rs = 1.f;
                if (MODE == 1 || MODE == 2) rs = rsc[row];
                if (MODE == 3) { const f32x4* s = (const f32x4*)(ssq + (size_t)row * 24); const f32x4 a = s[0], b = s[1], c = s[2], d = s[3];
                    const float t = ((a[0] + a[1]) + (a[2] + a[3])) + ((b[0] + b[1]) + (b[2] + b[3])) + ((c[0] + c[1]) + (c[2] + c[3])) + ((d[0] + d[1]) + (d[2] + d[3]));
                    rs = 1.0f / sqrtf(t * (1.0f / 1024.0f) + 1e-6f); }
                if (MODE == 4) { const f32x4* s = (const f32x4*)(ssq + (size_t)row * 24); const f32x4 a = s[4], b = s[5];
                    const float t = ((a[0] + a[1]) + (a[2] + a[3])) + ((b[0] + b[1]) + (b[2] + b[3]));
                    rs = 1.0f / sqrtf(t * (1.0f / 512.0f) + 1e-6f); }
                float part = 0.f;
#pragma unroll
                for (int bj = 0; bj < 2; ++bj) {
                    const int col = colt + bj * HALF;
                    f32x4 v0 = acc[ai][bj][m][0], v1 = acc[ai][bj][m][1];
                    if (MODE == 1) {
#pragma unroll
                        for (int j = 0; j < 4; ++j) { const float p = fmaxf(v0[j] * rs, 0.f), q = fmaxf(v1[j] * rs, 0.f); v0[j] = p * p; v1[j] = q * q; } }
                    if (MODE == 2) { v0 = v0 * rs; v1 = v1 * rs;
                        if (want_ss) part += ((v0[0] * v0[0] + v0[1] * v0[1]) + (v0[2] * v0[2] + v0[3] * v0[3])) + ((v1[0] * v1[0] + v1[1] * v1[1]) + (v1[2] * v1[2] + v1[3] * v1[3]));
                        if (col >= 3584 && col < 4672) rope8(v0, v1, rope + ((size_t)(row & 4095) * 32 + ((col & 63) >> 1)) * 2); }
                    if (MODE == 3) { v0 = v0 * rs; v1 = v1 * rs; if ((col % 192) >= 128) rope8(v0, v1, rope + ((size_t)(row & 4095) * 32 + ((col & 63) >> 1)) * 2); }
                    if (MODE == 4) { v0 = v0 * rs; v1 = v1 * rs; }
                    u32x4 w; w.x = cvt_pk_bf16(v0[0], v0[1]); w.y = cvt_pk_bf16(v0[2], v0[3]); w.z = cvt_pk_bf16(v1[0], v1[1]); w.w = cvt_pk_bf16(v1[2], v1[3]);
                    *(u32x4*)(O + (size_t)row * ldc + col) = w;
                }
                if (want_ss) { part += __shfl_xor(part, 16); part += __shfl_xor(part, 32); if (fq == 0) ssq[(size_t)row * 24 + (u.pn - 8) * 4 + wc] = part; }
            }
    }
};
template <class Epi, class Sched, bool ALIGN_EPI = false, bool SP2 = false>
__device__ __forceinline__ void gemm_phase(PG8_LAS unsigned char* lds, const Gemm g, const Sched& S, const Epi& E) {
    int tid_ = threadIdx.x; asm volatile("" : "+v"(tid_));
    const int tid = tid_, wid = __builtin_amdgcn_readfirstlane(tid >> 6), lane = tid & 63, wr = wid >> 2, wc = wid & 3, fr = lane & 15, fq = lane >> 4;
    const int K = g.K, nt = K / BK;
    unsigned voffA[2], voffB[2];
#pragma unroll
    for (int i = 0; i < 2; ++i) { int R, C; stage_rc(tid * 16 + i * 8192, R, C); const int Rb = Epi::PERM ? ((R & ~31) + perm32(R & 31)) : R;
        voffA[i] = (unsigned)(R * g.lda + C) * 2u; voffB[i] = (unsigned)(Rb * K + C) * 2u; }
    const long kstep = g.krev ? -(long)(BK * 2) : (long)(BK * 2);
    const size_t hstep = (size_t)HALF * K * 2;
    const size_t tstep = 2 * hstep; const size_t hstepA = (size_t)HALF * g.lda * 2, tstepA = 2 * hstepA;
    const unsigned ldsw = (unsigned)wid * 1024u;
    const int aoff = lds_byte(wr * 64 + fr, fq * 8), boff = lds_byte(wc * 32 + fr, fq * 8);
#define PG8_SA(b, h) (((b) * 2 + (h)) * HTB)
#define PG8_SB(b, h) ((4 + (b) * 2 + (h)) * HTB)
#define PG8_STAGE(bufoff, gbase, voff) do { _Pragma("unroll") for (int _i = 0; _i < 2; ++_i) \
        __builtin_amdgcn_global_load_lds((const unsigned*)((const char*)(gbase) + (voff)[_i]), (PG8_LAS unsigned*)(lds + (bufoff) + ldsw + _i * 8192), 16, 0, 0); } while (0)
#define PG8_LDA(dst, b, h) do { _Pragma("unroll") for (int m = 0; m < 4; ++m) _Pragma("unroll") for (int k = 0; k < 2; ++k) dst[m][k] = *(const PG8_LAS bf16x8*)(lds + PG8_SA(b, h) + aoff + m * 2048 + k * 1024); } while (0)
#define PG8_LDB(dst, b, h) do { _Pragma("unroll") for (int n = 0; n < 2; ++n) _Pragma("unroll") for (int k = 0; k < 2; ++k) dst[n][k] = *(const PG8_LAS bf16x8*)(lds + PG8_SB(b, h) + boff + n * 2048 + k * 1024); } while (0)
#define PG8_MMA(ai, bj, At, Bt) do { __builtin_amdgcn_s_setprio(1); _Pragma("unroll") for (int m = 0; m < 4; ++m) _Pragma("unroll") for (int n = 0; n < 2; ++n) _Pragma("unroll") for (int k = 0; k < 2; ++k) \
        acc[ai][bj][m][n] = __builtin_amdgcn_mfma_f32_16x16x32_bf16(Bt[n][k], At[m][k], acc[ai][bj][m][n], 0, 0, 0); __builtin_amdgcn_s_setprio(0); } while (0)
#define PG8_WAIT_V(n) asm volatile("s_waitcnt vmcnt(" #n ")" ::: "memory")
#define PG8_WAIT_L(n) asm volatile("s_waitcnt lgkmcnt(" #n ")" ::: "memory")
#define PG8_BAR __builtin_amdgcn_s_barrier()
#define PG8_SCHED __builtin_amdgcn_sched_barrier(0)
    Unit cur, nxt; int ui = 0;
    if (!S.next(0, cur)) return;
    f32x4 acc[2][2][4][2];
#pragma unroll
    for (int a = 0; a < 2; ++a)
#pragma unroll
        for (int b = 0; b < 2; ++b)
#pragma unroll
            for (int m = 0; m < 4; ++m)
#pragma unroll
                for (int n = 0; n < 2; ++n) acc[a][b][m][n] = (f32x4){0.f, 0.f, 0.f, 0.f};
    bf16x8 At[4][2], B0[2][2], B1[2][2];
    const char* cA = (const char*)g.A + (size_t)cur.pm * tstepA; const char* cB = (const char*)g.Bt + (size_t)cur.pn * tstep;
    S.a_ready(cur);
    if constexpr (SP2) {
        PG8_STAGE(PG8_SB(0, 0), cB, voffB); PG8_STAGE(PG8_SB(0, 1), cB + hstep, voffB); PG8_STAGE(PG8_SA(0, 0), cA, voffA); PG8_STAGE(PG8_SA(0, 1), cA + hstepA, voffA);
        if (wr == 1) PG8_BAR;
        PG8_WAIT_V(2); PG8_BAR;
        PG8_STAGE(PG8_SB(1, 0), cB + kstep, voffB); PG8_STAGE(PG8_SA(1, 0), cA + kstep, voffA); PG8_STAGE(PG8_SB(1, 1), cB + hstep + kstep, voffB);
        PG8_WAIT_V(6); PG8_BAR;
    } else {
        PG8_STAGE(PG8_SB(0, 0), cB, voffB); PG8_STAGE(PG8_SA(0, 0), cA, voffA); PG8_STAGE(PG8_SB(0, 1), cB + hstep, voffB); PG8_STAGE(PG8_SA(0, 1), cA + hstepA, voffA);
        if (wr == 1) PG8_BAR;
        PG8_WAIT_V(4); PG8_BAR;
        PG8_STAGE(PG8_SB(1, 0), cB + kstep, voffB); PG8_STAGE(PG8_SA(1, 0), cA + kstep, voffA); PG8_STAGE(PG8_SB(1, 1), cB + hstep + kstep, voffB);
        PG8_WAIT_V(6); PG8_BAR;
    }
    for (;;) {
        const bool has_next = S.next(ui + 1, nxt);
        const char* nA = has_next ? (const char*)g.A + (size_t)nxt.pm * tstepA : cA; const char* nB = has_next ? (const char*)g.Bt + (size_t)nxt.pn * tstep : cB;
        for (int t = 0; t < nt; t += 2) {
            const bool last = (t == nt - 2);
            const char* a1 = cA + (long)(t + 1) * kstep;
            const char* a2 = last ? nA : cA + (long)(t + 2) * kstep; const char* b2 = last ? nB : cB + (long)(t + 2) * kstep;
            const char* a3 = a2 + kstep; const char* b3 = b2 + kstep;
            if (last && has_next) S.a_ready(nxt);
            if constexpr (SP2) {
            PG8_LDB(B0, 0, 0); PG8_LDB(B1, 0, 1); PG8_SCHED; PG8_LDA(At, 0, 0); PG8_STAGE(PG8_SA(1, 1), a1 + hstepA, voffA);
            PG8_WAIT_V(8); PG8_WAIT_L(0); PG8_BAR; PG8_MMA(0, 0, At, B0); PG8_MMA(0, 1, At, B1); PG8_BAR; PG8_SCHED;
            PG8_LDA(At, 0, 1); PG8_STAGE(PG8_SB(0, 0), b2, voffB); PG8_STAGE(PG8_SB(0, 1), b2 + hstep, voffB); PG8_STAGE(PG8_SA(0, 0), a2, voffA);
            PG8_WAIT_V(8); PG8_WAIT_L(0); PG8_BAR; PG8_MMA(1, 0, At, B0); PG8_MMA(1, 1, At, B1); PG8_BAR; PG8_SCHED;
            PG8_LDB(B0, 1, 0); PG8_LDB(B1, 1, 1); PG8_SCHED; PG8_LDA(At, 1, 0); PG8_STAGE(PG8_SA(0, 1), a2 + hstepA, voffA);
            PG8_WAIT_V(8); PG8_WAIT_L(0); PG8_BAR; PG8_MMA(0, 0, At, B0); PG8_MMA(0, 1, At, B1); PG8_BAR; PG8_SCHED;
            PG8_LDA(At, 1, 1); PG8_STAGE(PG8_SB(1, 0), b3, voffB); PG8_STAGE(PG8_SB(1, 1), b3 + hstep, voffB); PG8_STAGE(PG8_SA(1, 0), a3, voffA);
            PG8_WAIT_V(8); PG8_WAIT_L(0); PG8_BAR; PG8_MMA(1, 0, At, B0); PG8_MMA(1, 1, At, B1); PG8_BAR; PG8_SCHED;
            } else {
            PG8_LDB(B0, 0, 0); PG8_SCHED; PG8_LDA(At, 0, 0); PG8_STAGE(PG8_SA(1, 1), a1 + hstepA, voffA);
            PG8_WAIT_L(8); PG8_BAR; PG8_WAIT_L(0); PG8_MMA(0, 0, At, B0); PG8_BAR; PG8_SCHED;
            PG8_LDB(B1, 0, 1); PG8_STAGE(PG8_SB(0, 0), b2, voffB);
            PG8_BAR; PG8_WAIT_L(0); PG8_MMA(0, 1, At, B1); PG8_BAR;
            PG8_LDA(At, 0, 1); PG8_STAGE(PG8_SA(0, 0), a2, voffA);
            PG8_BAR; PG8_WAIT_L(0); PG8_MMA(1, 0, At, B0); PG8_BAR; PG8_SCHED;
            PG8_STAGE(PG8_SB(0, 1), b2 + hstep, voffB);
            PG8_WAIT_V(6); PG8_BAR; PG8_MMA(1, 1, At, B1); PG8_BAR;
            PG8_LDB(B0, 1, 0); PG8_SCHED; PG8_LDA(At, 1, 0); PG8_STAGE(PG8_SA(0, 1), a2 + hstepA, voffA);
            PG8_WAIT_L(8); PG8_BAR; PG8_WAIT_L(0); PG8_MMA(0, 0, At, B0); PG8_BAR; PG8_SCHED;
            PG8_LDB(B1, 1, 1); PG8_STAGE(PG8_SB(1, 0), b3, voffB);
            PG8_BAR; PG8_WAIT_L(0); PG8_MMA(0, 1, At, B1); PG8_BAR;
            PG8_LDA(At, 1, 1); PG8_STAGE(PG8_SA(1, 0), a3, voffA);
            PG8_BAR; PG8_WAIT_L(0); PG8_MMA(1, 0, At, B0); PG8_BAR; PG8_SCHED;
            PG8_STAGE(PG8_SB(1, 1), b3 + hstep, voffB);
            PG8_WAIT_V(6); PG8_BAR; PG8_MMA(1, 1, At, B1); PG8_BAR;
            }
        }
        if constexpr (ALIGN_EPI) { if (wr == 0) PG8_BAR; }
        if constexpr (!Epi::AFTER_DRAIN) { E(acc, cur, wr, wc, fr, fq); S.done(cur); }
        if (!has_next) break;
#pragma unroll
        for (int a = 0; a < 2; ++a)
#pragma unroll
            for (int b = 0; b < 2; ++b)
#pragma unroll
                for (int m = 0; m < 4; ++m)
#pragma unroll
                    for (int n = 0; n < 2; ++n) acc[a][b][m][n] = (f32x4){0.f, 0.f, 0.f, 0.f};
        cur = nxt; cA = nA; cB = nB; ++ui;
        if constexpr (ALIGN_EPI) { if (wr == 1) PG8_BAR; }
    }
    PG8_WAIT_V(0);
    if constexpr (!ALIGN_EPI) { if (wr == 0) PG8_BAR; }
    PG8_BAR;
    if constexpr (Epi::AFTER_DRAIN) { E.fused(acc, cur, wr, wc, fr, fq, lds, wid, lane); S.done(cur); }
#undef PG8_SA
#undef PG8_SB
#undef PG8_STAGE
#undef PG8_LDA
#undef PG8_LDB
#undef PG8_MMA
#undef PG8_WAIT_V
#undef PG8_WAIT_L
#undef PG8_BAR
#undef PG8_SCHED
}
}
namespace att {
#define ATT_LAS __attribute__((address_space(3)))
typedef unsigned short bf16;
using bf16x8 = __attribute__((ext_vector_type(8))) short;
using s16x4  = __attribute__((ext_vector_type(4))) short;
using f32x16 = __attribute__((ext_vector_type(16))) float;
using u32x4  = __attribute__((ext_vector_type(4))) unsigned;
constexpr float SCALE = 0.07216878364870322f;
constexpr float THR = 8.f;
constexpr int SHM_V = 16384, SHM_K = 16384, SHM_R = 8192;
constexpr int OFF_V = 0, OFF_K = 2 * SHM_V, OFF_R = OFF_K + 2 * SHM_K, OFF_WS = OFF_R + 2 * SHM_R, ATT_LDS_BYTES = OFF_WS + 8 * 64 * 4;
#define KSWZ(row, colB) ((row) * 256 + ((colB) ^ (((row) & 7) << 4)))
#define RSWZ(row, colB) ((row) * 128 + ((colB) ^ (((row) & 7) << 4)))
#define SBAR() __builtin_amdgcn_sched_barrier(0)
__device__ __forceinline__ int crow(int r, int hi) { return (r & 3) + 8 * (r >> 2) + 4 * hi; }
__device__ __forceinline__ unsigned cvtpk(float lo, float hi) { unsigned r; asm volatile("v_cvt_pk_bf16_f32 %0, %1, %2" : "=v"(r) : "v"(lo), "v"(hi)); return r; }
__device__ __forceinline__ void partialSM(f32x16& p0, f32x16& p1, float& m_reg, float& mn, float& alpha) {
  constexpr float C = SCALE * 1.4426950408889634f;
  float pmax = p0[0];
#pragma unroll
  for (int r = 1; r < 16; ++r) pmax = fmaxf(pmax, p0[r]);
#pragma unroll
  for (int r = 0; r < 16; ++r) pmax = fmaxf(pmax, p1[r]);
  { auto rr = __builtin_amdgcn_permlane32_swap(__float_as_uint(pmax), __float_as_uint(pmax), false, false);
    pmax = fmaxf(__uint_as_float(rr[0]), __uint_as_float(rr[1])); }
  if (__builtin_expect(__all(pmax - m_reg <= THR / SCALE), 1)) { mn = m_reg; alpha = 1.f; }
  else { mn = fmaxf(m_reg, pmax); alpha = __builtin_amdgcn_exp2f((m_reg - mn) * C); m_reg = mn; }
  float mnC = -mn * C;
#pragma unroll
  for (int r = 0; r < 16; ++r) p0[r] = fmaf(p0[r], C, mnC);
#pragma unroll
  for (int r = 0; r < 16; ++r) p1[r] = fmaf(p1[r], C, mnC);
#pragma unroll
  for (int r = 0; r < 16; ++r) p0[r] = __builtin_amdgcn_exp2f(p0[r]);
}
__device__ __forceinline__ void finishSM(f32x16& p0, f32x16& p1, float alpha, float& l_reg, bf16x8& pa0, bf16x8& pa1, bf16x8& pa2, bf16x8& pa3) {
#pragma unroll
  for (int r = 0; r < 16; ++r) p1[r] = __builtin_amdgcn_exp2f(p1[r]);
  float ps = 0;
#pragma unroll
  for (int r = 0; r < 16; ++r) ps += p0[r];
#pragma unroll
  for (int r = 0; r < 16; ++r) ps += p1[r];
  { auto rr = __builtin_amdgcn_permlane32_swap(__float_as_uint(ps), __float_as_uint(ps), false, false);
    ps = __uint_as_float(rr[0]) + __uint_as_float(rr[1]); }
  l_reg = l_reg * alpha + ps;
#define PK4(P, BASE, OUT) do { unsigned a0 = cvtpk(P[BASE + 0], P[BASE + 1]), a1 = cvtpk(P[BASE + 2], P[BASE + 3]);   \
    unsigned b0 = cvtpk(P[BASE + 4], P[BASE + 5]), b1 = cvtpk(P[BASE + 6], P[BASE + 7]);                              \
    auto r0 = __builtin_amdgcn_permlane32_swap(a0, b0, false, false); auto r1 = __builtin_amdgcn_permlane32_swap(a1, b1, false, false); \
    u32x4 w = {r0[0], r1[0], r0[1], r1[1]}; OUT = *reinterpret_cast<bf16x8*>(&w); } while (0)
  PK4(p0, 0, pa0); PK4(p0, 8, pa1); PK4(p1, 0, pa2); PK4(p1, 8, pa3);
#undef PK4
}
__device__ __forceinline__ void qkt(f32x16& p0, f32x16& p1, const ATT_LAS char* Ks, const ATT_LAS char* Rs, const bf16x8* qr, int r32, int hi) {
  p0 = f32x16{}; p1 = f32x16{};
#pragma unroll
  for (int d0 = 0; d0 < 8; ++d0) { const int cb = (d0 * 16 + hi * 8) * 2;
    const bf16x8 b0 = *reinterpret_cast<const ATT_LAS bf16x8*>(Ks + KSWZ(r32, cb));
    const bf16x8 b1 = *reinterpret_cast<const ATT_LAS bf16x8*>(Ks + KSWZ(32 + r32, cb));
    p0 = __builtin_amdgcn_mfma_f32_32x32x16_bf16(b0, qr[d0], p0, 0, 0, 0);
    p1 = __builtin_amdgcn_mfma_f32_32x32x16_bf16(b1, qr[d0], p1, 0, 0, 0); }
#pragma unroll
  for (int d0 = 0; d0 < 4; ++d0) { const int cb = (d0 * 16 + hi * 8) * 2;
    const bf16x8 b0 = *reinterpret_cast<const ATT_LAS bf16x8*>(Rs + RSWZ(r32, cb));
    const bf16x8 b1 = *reinterpret_cast<const ATT_LAS bf16x8*>(Rs + RSWZ(32 + r32, cb));
    p0 = __builtin_amdgcn_mfma_f32_32x32x16_bf16(b0, qr[8 + d0], p0, 0, 0, 0);
    p1 = __builtin_amdgcn_mfma_f32_32x32x16_bf16(b1, qr[8 + d0], p1, 0, 0, 0); }
}
__device__ __forceinline__ int v_st(int k, int c) { const int kk = (k & ~0xC) | ((k & 4) << 1) | ((k & 8) >> 1); return ((kk >> 3) * 4 + (c >> 5)) * 512 + ((kk & 7) * 32 + (c & 31)) * 2; }
__device__ __forceinline__ int v_rd_base(int lane) { return ((lane & 3) << 3) | (((lane >> 2) & 3) << 6) | (((lane >> 4) & 1) << 5) | (((lane >> 5) & 1) << 8); }
constexpr int v_rd_off(int d0, int ks, int half) { return d0 * 512 + ks * 4096 + half * 2048; }
template <int OFF> __device__ __forceinline__ s16x4 tr_read(int vb) {
  s16x4 r; asm volatile("ds_read_b64_tr_b16 %0, %1 offset:%2" : "=&v"(r) : "v"(vb), "i"(OFF) : "memory"); return r;
}
template <int D0> __device__ __forceinline__ void pv_one(f32x16& od, int vb, bf16x8 pa0, bf16x8 pa1, bf16x8 pa2, bf16x8 pa3) {
  const s16x4 l0 = tr_read<v_rd_off(D0, 0, 0)>(vb), h0 = tr_read<v_rd_off(D0, 0, 1)>(vb), l1 = tr_read<v_rd_off(D0, 1, 0)>(vb), h1 = tr_read<v_rd_off(D0, 1, 1)>(vb);
  const s16x4 l2 = tr_read<v_rd_off(D0, 2, 0)>(vb), h2 = tr_read<v_rd_off(D0, 2, 1)>(vb), l3 = tr_read<v_rd_off(D0, 3, 0)>(vb), h3 = tr_read<v_rd_off(D0, 3, 1)>(vb);
  asm volatile("s_waitcnt lgkmcnt(0)" ::: "memory"); SBAR();
#define PK(L, H) (bf16x8){L[0], L[1], L[2], L[3], H[0], H[1], H[2], H[3]}
  od = __builtin_amdgcn_mfma_f32_32x32x16_bf16(pa0, PK(l0, h0), od, 0, 0, 0);
  od = __builtin_amdgcn_mfma_f32_32x32x16_bf16(pa1, PK(l1, h1), od, 0, 0, 0);
  od = __builtin_amdgcn_mfma_f32_32x32x16_bf16(pa2, PK(l2, h2), od, 0, 0, 0);
  od = __builtin_amdgcn_mfma_f32_32x32x16_bf16(pa3, PK(l3, h3), od, 0, 0, 0);
#undef PK
}
__device__ __forceinline__ void pv_d0(f32x16* o, int vb, bf16x8 pa0, bf16x8 pa1, bf16x8 pa2, bf16x8 pa3) {
  pv_one<0>(o[0], vb, pa0, pa1, pa2, pa3); pv_one<1>(o[1], vb, pa0, pa1, pa2, pa3); pv_one<2>(o[2], vb, pa0, pa1, pa2, pa3); pv_one<3>(o[3], vb, pa0, pa1, pa2, pa3);
}
__device__ __forceinline__ unsigned short f2bf(float f) { unsigned u = __builtin_bit_cast(unsigned, f); return (unsigned short)((u + 0x7fffu + ((u >> 16) & 1u)) >> 16); }
__device__ __forceinline__ void attn_unit(const bf16* __restrict__ Q, const bf16* __restrict__ KV, const bf16* __restrict__ PROJ, bf16* __restrict__ CAT, int b, int h, int qb, ATT_LAS char* lds) {
  int tid_ = threadIdx.x; asm volatile("" : "+v"(tid_));
  const int tid = tid_, wid = __builtin_amdgcn_readfirstlane(tid >> 6), lane = tid & 63, r32 = lane & 31, hi = lane >> 5;
  ATT_LAS char* V_lds = lds + OFF_V; ATT_LAS char* K_lds = lds + OFF_K; ATT_LAS char* R_lds = lds + OFF_R;
  ATT_LAS float* wsp = (ATT_LAS float*)(lds + OFF_WS) + wid * 64; ATT_LAS float* li_l = wsp; ATT_LAS float* al_l = wsp + 32;
  float m_reg = -1e30f, l_reg = 0; f32x16 o[4] = {}; bf16x8 qr[12];
  const size_t tok0 = (size_t)b * 4096;
  const bf16* Qw = Q + (tok0 + (size_t)qb * 256 + wid * 32 + r32) * 3072 + h * 192 + hi * 8;
#pragma unroll
  for (int d0 = 0; d0 < 12; ++d0) qr[d0] = *reinterpret_cast<const bf16x8*>(Qw + d0 * 16);
  const int cw = qb * 4 + (wid >> 1), NT = qb * 4 + 4;
  const int sr = tid >> 4, sc = (tid & 15) * 8, vst0 = v_st(sr, sc), vst1 = v_st(32 + sr, sc), kst0 = KSWZ(sr, sc * 2), kst1 = KSWZ(32 + sr, sc * 2);
  const int rr = tid >> 3, rc = (tid & 7) * 8, rst = RSWZ(rr, rc * 2);
  const bf16* Kg = KV + tok0 * 4096 + h * 256;
  const bf16* Rg = PROJ + tok0 * 6912 + 3584;
  const int vb0 = (int)(uintptr_t)V_lds + v_rd_base(lane);
  bf16x8 sv0, sv1, sk0, sk1, srp;
#define ATT_SLOAD(k0) do { sv0 = *reinterpret_cast<const bf16x8*>(Kg + (size_t)((k0) + sr) * 4096 + 128 + sc); sv1 = *reinterpret_cast<const bf16x8*>(Kg + (size_t)((k0) + 32 + sr) * 4096 + 128 + sc); \
    sk0 = *reinterpret_cast<const bf16x8*>(Kg + (size_t)((k0) + sr) * 4096 + sc); sk1 = *reinterpret_cast<const bf16x8*>(Kg + (size_t)((k0) + 32 + sr) * 4096 + sc); \
    srp = *reinterpret_cast<const bf16x8*>(Rg + (size_t)((k0) + rr) * 6912 + rc); } while (0)
#define ATT_SWRITE(bf) do { *reinterpret_cast<ATT_LAS bf16x8*>(V_lds + (bf) * SHM_V + vst0) = sv0; *reinterpret_cast<ATT_LAS bf16x8*>(V_lds + (bf) * SHM_V + vst1) = sv1; \
    *reinterpret_cast<ATT_LAS bf16x8*>(K_lds + (bf) * SHM_K + kst0) = sk0; *reinterpret_cast<ATT_LAS bf16x8*>(K_lds + (bf) * SHM_K + kst1) = sk1; \
    *reinterpret_cast<ATT_LAS bf16x8*>(R_lds + (bf) * SHM_R + rst) = srp; } while (0)
#define ATT_RESC(a) do { if (__any((a) < 1.f)) { if (hi == 0) al_l[r32] = (a); asm volatile("s_waitcnt lgkmcnt(0)" ::: "memory"); \
    _Pragma("unroll") for (int d = 0; d < 4; ++d) _Pragma("unroll") for (int r = 0; r < 16; ++r) o[d][r] *= al_l[crow(r, hi)]; } } while (0)
  ATT_SLOAD(0); asm volatile("s_waitcnt vmcnt(0)" ::: "memory"); ATT_SWRITE(0); __syncthreads();
  for (int t = 0; t < NT; ++t) {
    const int bf = t & 1;
    if (t + 1 < NT) ATT_SLOAD((t + 1) * 64);
    if (t <= cw) {
      f32x16 p0, p1; float mn, al; bf16x8 pa0, pa1, pa2, pa3;
      qkt(p0, p1, K_lds + bf * SHM_K, R_lds + bf * SHM_R, qr, r32, hi);
      partialSM(p0, p1, m_reg, mn, al);
      ATT_RESC(al);
      finishSM(p0, p1, al, l_reg, pa0, pa1, pa2, pa3); SBAR();
      pv_d0(o, vb0 + bf * SHM_V, pa0, pa1, pa2, pa3);
    }
    if (t + 1 < NT) { asm volatile("s_waitcnt vmcnt(0)" ::: "memory"); ATT_SWRITE(bf ^ 1); }
    __syncthreads();
  }
  if (hi == 0) li_l[r32] = l_reg; asm volatile("s_waitcnt lgkmcnt(0)" ::: "memory");
  float rli[16];
#pragma unroll
  for (int r = 0; r < 16; ++r) rli[r] = __builtin_amdgcn_rcpf(li_l[crow(r, hi)]);
  bf16* Ow = CAT + (tok0 + (size_t)qb * 256 + wid * 32) * 4096 + 1024 + h * 128;
#pragma unroll
  for (int r = 0; r < 16; ++r) { const int orow = crow(r, hi);
#pragma unroll
    for (int d0 = 0; d0 < 4; ++d0) Ow[(size_t)orow * 4096 + d0 * 32 + r32] = f2bf(o[d0][r] * rli[r]); }
#undef ATT_SLOAD
#undef ATT_SWRITE
#undef ATT_RESC
}
}
constexpr int NWAVES = 8;
constexpr int BATCH = 2, SEQ = 4096, DM = 4096, M = BATCH * SEQ, DEPTH = 2, FF = 16384;
constexpr int INW = 6720, INP = 6912;
constexpr int C_U = 0, C_V = 1024, C_CQ = 2048, C_CKV = 3072, C_KR = 3584, C_RQ = 3648, C_RK = 4160, C_RV = 4672, C_RG = 5696;
constexpr int QW = 3072, KVW = 4096;
constexpr float EPS = 1e-6f;
constexpr size_t MiB = 1u << 20;
constexpr size_t WS_CTL = 0, CTL_ZERO_BYTES = 1 * MiB;
constexpr size_t WS_ROPE = 1 * MiB;
constexpr size_t WS_SSQ = 2 * MiB;
constexpr size_t WS_RS = 3 * MiB;
constexpr size_t WS_W = 4 * MiB, LW = 353 * MiB;
constexpr size_t W_IN = 0, W_Q = 54 * MiB, W_KV = 60 * MiB, W_OUT = 64 * MiB, W_UP = 96 * MiB, W_DOWN = 224 * MiB, W_SGU = 352 * MiB;
constexpr size_t WS_H = WS_W + 2 * LW;
constexpr size_t WS_PROJ = WS_H + 64 * MiB;
constexpr size_t WS_Q = WS_PROJ + 108 * MiB;
constexpr size_t WS_KV = WS_Q + 48 * MiB;
constexpr size_t WS_CAT = WS_KV + 64 * MiB;
constexpr size_t WS_MIX = WS_CAT + 64 * MiB;
constexpr size_t WS_ACT = WS_MIX + 64 * MiB;
constexpr size_t WS_KVS = WS_ACT + 256 * MiB;
constexpr size_t WS_SB = WS_KVS + 32 * MiB;
constexpr size_t WS_END = WS_SB + 16 * MiB;
static_assert((size_t)INP * DM * 2 == 54 * MiB && (size_t)M * INP * 2 == 108 * MiB, "map");
constexpr int CW_BAR = 4096;
constexpr int RING_OFF = 0, RING_BYTES = 131072;
constexpr int LDSCTL_OFF = RING_BYTES, MISC_OFF = LDSCTL_OFF + 320;
constexpr int LDS_BYTES = 147456;
#define GAS __attribute__((address_space(1)))
#define LAS __attribute__((address_space(3)))
typedef unsigned short bf16;
typedef unsigned v4u __attribute__((ext_vector_type(4)));
typedef float f32x4 __attribute__((ext_vector_type(4)));
typedef short bf16x8 __attribute__((ext_vector_type(8)));
typedef GAS unsigned gu32;
typedef GAS unsigned long long gu64;
#define RLX_AGENT __ATOMIC_RELAXED, __HIP_MEMORY_SCOPE_AGENT
#define LDS_WAIT() asm volatile("s_waitcnt lgkmcnt(0)" ::: "memory")
#define VM_WAIT() asm volatile("s_waitcnt vmcnt(0)" ::: "memory")
__device__ __forceinline__ unsigned long long rt() { return __builtin_amdgcn_s_memrealtime(); }
__device__ __forceinline__ unsigned f2bf(float f) { unsigned u = __builtin_bit_cast(unsigned, f); return (u + 0x7fffu + ((u >> 16) & 1u)) >> 16; }
__device__ __forceinline__ unsigned pk2(float lo, float hi) { return f2bf(lo) | (f2bf(hi) << 16); }

#define XB_TMO      128
#define XB_XCNT(j)  (256  + 64 * (j))
#define XB_XSUB(j)  (1280 + 64 * (j))
#define XB_XGEN(j)  (2304 + 64 * (j))
#define XB_TOP      3328
#define XB_TOPGEN   3392
#define XCD_BAR_WORDS 3456
#define XB_SPIN_CAP (1u << 18)

__device__ __forceinline__ unsigned xb_ld(unsigned* p)              { return __hip_atomic_load(p, __ATOMIC_RELAXED, __HIP_MEMORY_SCOPE_AGENT); }
__device__ __forceinline__ unsigned xb_add(unsigned* p, unsigned v) { return __hip_atomic_fetch_add(p, v, __ATOMIC_RELAXED, __HIP_MEMORY_SCOPE_AGENT); }
__device__ __forceinline__ unsigned xb_xcc_id() { return (unsigned)__builtin_amdgcn_s_getreg((3 << 11) | 20) & 0xFu; }
#define XB_SPIN(cond, bar) do { unsigned _sp = 0; while (cond) { __builtin_amdgcn_s_sleep(1); \
    if ((++_sp & 255u) == 0u) { if (xb_ld(&(bar)[XB_TMO])) break; if (_sp > XB_SPIN_CAP) { atomicAdd(&(bar)[XB_TMO], 1u); break; } } } } while (0)

struct XcdBarrier {
    unsigned* bar; unsigned x;
    volatile LAS unsigned* st;
};

__device__ __forceinline__ XcdBarrier xcd_barrier_post(unsigned* bar, volatile LAS unsigned* st) {
    XcdBarrier b; b.bar = bar; b.x = xb_xcc_id(); b.st = st;
    if (threadIdx.x == 0) (void)xb_add(&bar[XB_XCNT(b.x)], 1u);
    return b;
}
__device__ __forceinline__ void xcd_barrier_complete(unsigned* bar, unsigned x, unsigned& nloc, unsigned& nx) {
    const unsigned G = gridDim.x * gridDim.y * gridDim.z;
    unsigned sum, cnt, mine, sp = 0u;
    for (;;) {
        sum = 0u; cnt = 0u; mine = 0u;
#pragma unroll
        for (unsigned j = 0; j < 16; ++j) { const unsigned c = xb_ld(&bar[XB_XCNT(j)]); sum += c; cnt += (c > 0u) ? 1u : 0u; mine = (j == x) ? c : mine; }
        if (sum == G) break;
        __builtin_amdgcn_s_sleep(1);
        if ((++sp & 255u) == 0u) { if (xb_ld(&bar[XB_TMO])) break; if (sp > XB_SPIN_CAP) { atomicAdd(&bar[XB_TMO], 1u); break; } }
    }
    nloc = mine > 0u ? mine : 1u; nx = cnt > 0u ? cnt : 1u;
}

__device__ __forceinline__ void xcd_barrier(const XcdBarrier& b) {
    asm volatile("s_waitcnt vmcnt(0)" ::: "memory");
    __syncthreads();
    if (threadIdx.x == 0) {
        unsigned* bar = b.bar;
        __builtin_amdgcn_s_waitcnt(0);
        unsigned nloc = b.st[0], nx = b.st[1];
        if (nloc == 0u) { xcd_barrier_complete(bar, b.x, nloc, nx); b.st[0] = nloc; b.st[1] = nx; }
        const unsigned old = xb_add(&bar[XB_XSUB(b.x)], 1u);
        const unsigned gen = old / nloc;
        if (old + 1u == (gen + 1u) * nloc) {
            __builtin_amdgcn_fence(__ATOMIC_RELEASE, "agent");
            asm volatile("s_waitcnt vmcnt(0)" ::: "memory");
            const unsigned og = xb_add(&bar[XB_TOP], 1u);
            const unsigned tg = og / nx;
            if (og + 1u == (tg + 1u) * nx) xb_add(&bar[XB_TOPGEN], 1u);
            else XB_SPIN(xb_ld(&bar[XB_TOPGEN]) == tg, bar);
            __builtin_amdgcn_fence(__ATOMIC_ACQUIRE, "agent");
            xb_add(&bar[XB_XGEN(b.x)], 1u);
            asm volatile("s_waitcnt vmcnt(0)" ::: "memory");
        } else {
            XB_SPIN(xb_ld(&bar[XB_XGEN(b.x)]) == gen, bar);
            __builtin_amdgcn_fence(__ATOMIC_ACQUIRE, "agent");
            asm volatile("s_waitcnt vmcnt(0)" ::: "memory");
        }
    }
    __syncthreads();
}
typedef float f32x16 __attribute__((ext_vector_type(16)));
struct Frame {
    LAS unsigned char* lds; int tid, lane, wave, vcu, G;
};
__device__ __forceinline__ Frame make_frame(LAS unsigned char* lds) {
    Frame F; F.lds = lds; int t = threadIdx.x; asm volatile("" : "+v"(t)); int bx = blockIdx.x; asm volatile("" : "+s"(bx));
    F.tid = t; F.lane = t & 63; F.wave = __builtin_amdgcn_readfirstlane(t >> 6); F.G = gridDim.x;
    F.vcu = (F.G % 8 == 0) ? (bx % 8) * (F.G / 8) + bx / 8 : bx; return F;
}
__device__ __forceinline__ float bf2f(unsigned short h) { return __builtin_bit_cast(float, (unsigned)h << 16); }
__device__ __forceinline__ unsigned short f2bf16(float f) { return (unsigned short)f2bf(f); }
__device__ __forceinline__ float wave_sum(float v) {
#pragma unroll
    for (int o = 1; o < 64; o <<= 1) v += __shfl_xor(v, o);
    return v;
}
__device__ __forceinline__ int crow32(int r, int hi) { return (r & 3) + 8 * (r >> 2) + 4 * hi; }
template <int KSTEPS> __device__ __forceinline__ void mfma_lds(f32x16& acc, const LAS bf16* A, int pa, const LAS bf16* Bt, int pb, int r32, int hi) {
#pragma unroll
    for (int s = 0; s < KSTEPS; ++s) {
        const bf16x8 a = *(const LAS bf16x8*)(A + r32 * pa + s * 16 + hi * 8);
        const bf16x8 b = *(const LAS bf16x8*)(Bt + r32 * pb + s * 16 + hi * 8);
        acc = __builtin_amdgcn_mfma_f32_32x32x16_bf16(a, b, acc, 0, 0, 0);
    }
}
struct CvtDesc { const float* W; bf16* WT; const float* kgain; int K, N, k0, n0, kind; };
__device__ __forceinline__ void cvt_load(const CvtDesc& d, float (&v)[32], int lane) {
    const int nd = d.n0 + (lane & 31); bool ok = true; int sc = nd; float cs = 1.f;
    if (d.kind == 1) { ok = nd < INW; sc = (nd >= C_KR && nd < C_RV) ? (nd & ~63) + ((nd & 63) >> 1) + 32 * (nd & 1) : nd; cs = (nd >= C_RQ && nd < C_RK) ? 0.125f : 1.f; if (!ok) sc = 0; }
    if (d.kind == 2) { sc = ((nd % 192) >= 128) ? (nd & ~63) + ((nd & 63) >> 1) + 32 * (nd & 1) : nd; }
    const float* src = d.W + (size_t)(d.k0 + (lane >> 5)) * d.N + sc;
#pragma unroll
    for (int i = 0; i < 32; ++i) v[i] = __builtin_nontemporal_load(src + (size_t)(2 * i) * d.N);
    if (d.kgain) {
#pragma unroll
        for (int i = 0; i < 32; ++i) v[i] *= d.kgain[d.k0 + 2 * i + (lane >> 5)]; }
    if (d.kind == 1) {
#pragma unroll
        for (int i = 0; i < 32; ++i) v[i] = ok ? v[i] * cs : 0.f; }
}
template <bool NT = false> __device__ __forceinline__ void cvt_finish(const CvtDesc& d, const float (&v)[32], LAS float* scr, int lane) {
#pragma unroll
    for (int i = 0; i < 32; ++i) scr[(2 * i + (lane >> 5)) * 33 + (lane & 31)] = v[i];
    LDS_WAIT(); asm volatile("" ::: "memory");
    const int c = lane & 7;
#pragma unroll
    for (int j = 0; j < 4; ++j) { const int n = (lane >> 3) + 8 * j; const LAS float* s = scr + (8 * c) * 33 + n;
        v4u o; o.x = pk2(s[0 * 33], s[1 * 33]); o.y = pk2(s[2 * 33], s[3 * 33]); o.z = pk2(s[4 * 33], s[5 * 33]); o.w = pk2(s[6 * 33], s[7 * 33]);
        if (NT) __builtin_nontemporal_store(o, (GAS v4u*)(d.WT + (size_t)(d.n0 + n) * d.K + d.k0 + 8 * c)); else *(GAS v4u*)(d.WT + (size_t)(d.n0 + n) * d.K + d.k0 + 8 * c) = o; }
    LDS_WAIT(); asm volatile("" ::: "memory");
}
__device__ __forceinline__ void x_row_to_bf16(const float* __restrict__ xrow, bf16* __restrict__ orow, float* __restrict__ rs, int lane) {
    f32x4 v[16]; float s = 0.f;
#pragma unroll
    for (int j = 0; j < 8; ++j) { const f32x4* p = (const f32x4*)(xrow + 8 * (lane + 64 * j)); v[2 * j] = p[0]; v[2 * j + 1] = p[1]; }
#pragma unroll
    for (int j = 0; j < 16; ++j) s += (v[j][0] * v[j][0] + v[j][1] * v[j][1]) + (v[j][2] * v[j][2] + v[j][3] * v[j][3]);
    const float r = 1.0f / sqrtf(wave_sum(s) * (1.0f / 4096.0f) + EPS);
    if (lane == 0) *rs = r;
#pragma unroll
    for (int j = 0; j < 8; ++j) { const f32x4 a = v[2 * j], b = v[2 * j + 1];
        v4u o; o.x = pk2(a[0], a[1]); o.y = pk2(a[2], a[3]); o.z = pk2(b[0], b[1]); o.w = pk2(b[2], b[3]);
        *(v4u*)(orow + 8 * (lane + 64 * j)) = o; }
}
__device__ __forceinline__ void unpack8(const v4u q, float* y) {
    y[0] = __builtin_bit_cast(float, q.x << 16); y[1] = __builtin_bit_cast(float, q.x & 0xffff0000u); y[2] = __builtin_bit_cast(float, q.y << 16); y[3] = __builtin_bit_cast(float, q.y & 0xffff0000u);
    y[4] = __builtin_bit_cast(float, q.z << 16); y[5] = __builtin_bit_cast(float, q.z & 0xffff0000u); y[6] = __builtin_bit_cast(float, q.w << 16); y[7] = __builtin_bit_cast(float, q.w & 0xffff0000u);
}
__device__ __forceinline__ void residual_row(const float* __restrict__ xin32, bf16* xb, const bf16* __restrict__ yrow, const float* __restrict__ gpost, float* __restrict__ out32, float* __restrict__ rs_next, bool last, int lane) {
    float x[64], y[64]; float s = 0.f;
#pragma unroll
    for (int j = 0; j < 8; ++j) { unpack8(*(const v4u*)(yrow + 8 * (lane + 64 * j)), y + 8 * j);
        if (xin32) { const f32x4* p = (const f32x4*)(xin32 + 8 * (lane + 64 * j)); const f32x4 a = p[0], b = p[1];
#pragma unroll
            for (int e = 0; e < 4; ++e) { x[8 * j + e] = a[e]; x[8 * j + 4 + e] = b[e]; } }
        else unpack8(*(const v4u*)(xb + 8 * (lane + 64 * j)), x + 8 * j); }
#pragma unroll
    for (int i = 0; i < 64; ++i) s += y[i] * y[i];
    const float r = 1.0f / sqrtf(wave_sum(s) * (1.0f / 4096.0f) + EPS);
    float s2 = 0.f;
#pragma unroll
    for (int j = 0; j < 8; ++j) { const f32x4* gp = (const f32x4*)(gpost + 8 * (lane + 64 * j)); const f32x4 g0 = gp[0], g1 = gp[1];
#pragma unroll
        for (int e = 0; e < 4; ++e) { x[8 * j + e] += y[8 * j + e] * r * g0[e]; x[8 * j + 4 + e] += y[8 * j + 4 + e] * r * g1[e]; }
#pragma unroll
        for (int e = 0; e < 8; ++e) s2 += x[8 * j + e] * x[8 * j + e];
        if (last) { f32x4* op = (f32x4*)(out32 + 8 * (lane + 64 * j)); op[0] = (f32x4){x[8 * j], x[8 * j + 1], x[8 * j + 2], x[8 * j + 3]}; op[1] = (f32x4){x[8 * j + 4], x[8 * j + 5], x[8 * j + 6], x[8 * j + 7]}; }
        else { v4u o; o.x = pk2(x[8 * j], x[8 * j + 1]); o.y = pk2(x[8 * j + 2], x[8 * j + 3]); o.z = pk2(x[8 * j + 4], x[8 * j + 5]); o.w = pk2(x[8 * j + 6], x[8 * j + 7]);
            *(v4u*)(xb + 8 * (lane + 64 * j)) = o; } }
    if (!last) { const float r2 = 1.0f / sqrtf(wave_sum(s2) * (1.0f / 4096.0f) + EPS); if (lane == 0) *rs_next = r2; }
}
__device__ __forceinline__ float ret_lg(int h) { return log1pf(-exp2f(-5.0f - (float)h)); }
__device__ __forceinline__ void sgu_phase(LAS unsigned char* lds_, const bf16* __restrict__ PROJ, bf16* __restrict__ CAT, const bf16* __restrict__ SGW, const float* __restrict__ lng, const float* __restrict__ lnb, const float* __restrict__ bs) {
    const Frame F = make_frame(lds_);
    LAS bf16* Wm = (LAS bf16*)(F.lds + RING_OFF);
    LAS bf16* VT = Wm + 128 * 136;
    const int r32 = F.lane & 31, hi = F.lane >> 5;
    for (int unit = F.vcu; unit < 512; unit += F.G) {
        const int b = unit >> 8, n = (unit >> 3) & 31, g = unit & 7;
        const size_t R0 = (size_t)b * SEQ + (size_t)n * 128; const int cb = g * 128;
        for (int q = F.tid; q < 128 * 16; q += NWAVES * 64) { const int i = q >> 4, ch = q & 15;
            *(LAS bf16x8*)(Wm + i * 136 + ch * 8) = *(const bf16x8*)(SGW + ((size_t)g * 128 + i) * 128 + ch * 8); }
        const float g0 = lng[cb + 2 * F.lane], g1 = lng[cb + 2 * F.lane + 1], b0 = lnb[cb + 2 * F.lane], b1 = lnb[cb + 2 * F.lane + 1];
        for (int jj = 0; jj < 16; ++jj) { const int j = F.wave * 16 + jj;
            const unsigned pv = *(const unsigned*)(PROJ + (R0 + j) * INP + C_V + cb + 2 * F.lane);
            const float x0 = __builtin_bit_cast(float, pv << 16), x1 = __builtin_bit_cast(float, pv & 0xffff0000u);
            const float mu = wave_sum(x0 + x1) * (1.0f / 128.0f), d0 = x0 - mu, d1 = x1 - mu;
            const float rstd = 1.0f / sqrtf(wave_sum(d0 * d0 + d1 * d1) * (1.0f / 128.0f) + EPS);
            VT[(2 * F.lane) * 136 + j] = f2bf16(d0 * rstd * g0 + b0); VT[(2 * F.lane + 1) * 136 + j] = f2bf16(d1 * rstd * g1 + b1); }
        __syncthreads();
        const int ib = F.wave >> 1, cb0 = (F.wave & 1) * 2;
        f32x16 acc0 = {}, acc1 = {};
        mfma_lds<8>(acc0, Wm + ib * 32 * 136, 136, VT + (cb0 * 32) * 136, 136, r32, hi);
        mfma_lds<8>(acc1, Wm + ib * 32 * 136, 136, VT + ((cb0 + 1) * 32) * 136, 136, r32, hi);
#pragma unroll
        for (int r = 0; r < 16; ++r) { const int i = ib * 32 + crow32(r, hi); const float bias = bs[g * 128 + i]; const size_t row = R0 + i; const int c = cb0 * 32 + r32;
            const float u0 = bf2f(PROJ[row * INP + C_U + cb + c]), u1 = bf2f(PROJ[row * INP + C_U + cb + c + 32]);
            CAT[row * DM + cb + c] = f2bf16(u0 * (acc0[r] + bias)); CAT[row * DM + cb + c + 32] = f2bf16(u1 * (acc1[r] + bias)); }
        __syncthreads();
    }
}
__device__ __forceinline__ void ret1_phase(LAS unsigned char* lds_, const bf16* __restrict__ PROJ, float* __restrict__ KVS) {
    const Frame F = make_frame(lds_);
    LAS bf16* KT = (LAS bf16*)(F.lds + RING_OFF);
    LAS bf16* VT = KT + 64 * 72;
    const int r32 = F.lane & 31, hi = F.lane >> 5;
    const int m = F.tid >> 3, d0 = (F.tid & 7) * 8, e0 = (F.tid & 7) * 16;
    bf16x8 kv, va, vb;
#define R1_LOAD(u_) do { const int bh_ = (u_) >> 6, c_ = (u_) & 63; const size_t R_ = (size_t)(bh_ >> 3) * SEQ + (size_t)c_ * 64 + m; const int h_ = bh_ & 7; \
        kv = *(const bf16x8*)(PROJ + R_ * INP + C_RK + h_ * 64 + d0); va = *(const bf16x8*)(PROJ + R_ * INP + C_RV + h_ * 128 + e0); vb = *(const bf16x8*)(PROJ + R_ * INP + C_RV + h_ * 128 + e0 + 8); } while (0)
    if (F.vcu < 1024) R1_LOAD(F.vcu);
    for (int unit = F.vcu; unit < 1024; unit += F.G) {
        const int bh = unit >> 6, h = bh & 7; const float lg = ret_lg(h);
        const float kd = expf(lg * (float)(63 - m));
#pragma unroll
        for (int i = 0; i < 8; ++i) KT[(d0 + i) * 72 + m] = f2bf16(bf2f((unsigned short)kv[i]) * kd);
#pragma unroll
        for (int i = 0; i < 8; ++i) { VT[(e0 + i) * 72 + m] = (unsigned short)va[i]; VT[(e0 + 8 + i) * 72 + m] = (unsigned short)vb[i]; }
        __syncthreads();
        if (unit + F.G < 1024) R1_LOAD(unit + F.G);
        const int eb = F.wave >> 1, db = F.wave & 1;
        f32x16 acc = {};
        mfma_lds<4>(acc, VT + eb * 32 * 72, 72, KT + db * 32 * 72, 72, r32, hi);
#pragma unroll
        for (int r = 0; r < 16; ++r) KVS[((size_t)unit * 128 + eb * 32 + crow32(r, hi)) * 64 + db * 32 + r32] = acc[r];
        __syncthreads();
    }
#undef R1_LOAD
}
__device__ __forceinline__ void ret2_phase(LAS unsigned char* lds_, const float* __restrict__ KVS, bf16* __restrict__ SB) {
    const Frame F = make_frame(lds_);
    for (int gid = F.vcu * (NWAVES * 64) + F.tid; gid < 16 * 8192; gid += F.G * NWAVES * 64) {
        const int bh = gid >> 13, idx = gid & 8191; const float cd = expf(ret_lg(bh & 7) * 64.0f);
        const size_t o0 = (size_t)bh * 64 * 8192 + idx;
        float S = 0.f;
#pragma unroll
        for (int c0 = 0; c0 < 64; c0 += 32) {
            float kv[32];
#pragma unroll
            for (int c = 0; c < 32; ++c) kv[c] = KVS[o0 + (size_t)(c0 + c) * 8192];
#pragma unroll
            for (int c = 0; c < 32; ++c) { SB[o0 + (size_t)(c0 + c) * 8192] = f2bf16(S); S = cd * S + kv[c]; }
        }
    }
}
__device__ __forceinline__ void ret3_phase(LAS unsigned char* lds_, const bf16* __restrict__ PROJ, const bf16* __restrict__ SB, bf16* __restrict__ CAT) {
    const Frame F = make_frame(lds_);
    LAS bf16* Qs = (LAS bf16*)(F.lds + RING_OFF);
    LAS bf16* Ks = Qs + 64 * 72;
    LAS bf16* VT = Ks + 64 * 72;
    LAS bf16* Ss = VT + 128 * 72;
    LAS bf16* Ps = Ss + 128 * 72;
    LAS float* red = (LAS float*)(Ps + 64 * 72);
    const int r32 = F.lane & 31, hi = F.lane >> 5;
    const int m = F.tid >> 3, d0 = (F.tid & 7) * 8, e0 = (F.tid & 7) * 16;
    bf16x8 rq, rk, rva, rvb, rs0, rs1;
#define R3_LOAD(u_) do { const int bh_ = (u_) >> 6, c_ = (u_) & 63; const size_t R_ = (size_t)(bh_ >> 3) * SEQ + (size_t)c_ * 64 + m; const int h_ = bh_ & 7; \
        rq = *(const bf16x8*)(PROJ + R_ * INP + C_RQ + h_ * 64 + d0); rk = *(const bf16x8*)(PROJ + R_ * INP + C_RK + h_ * 64 + d0); \
        rva = *(const bf16x8*)(PROJ + R_ * INP + C_RV + h_ * 128 + e0); rvb = *(const bf16x8*)(PROJ + R_ * INP + C_RV + h_ * 128 + e0 + 8); \
        rs0 = *(const bf16x8*)(SB + (size_t)(u_) * 8192 + F.tid * 8); rs1 = *(const bf16x8*)(SB + (size_t)(u_) * 8192 + (F.tid + 512) * 8); } while (0)
    if (F.vcu < 1024) R3_LOAD(F.vcu);
    for (int unit = F.vcu; unit < 1024; unit += F.G) {
        const int bh = unit >> 6, c = unit & 63, b = bh >> 3, h = bh & 7; const float lg = ret_lg(h);
        const size_t R0 = (size_t)b * SEQ + (size_t)c * 64;
        *(LAS bf16x8*)(Qs + m * 72 + d0) = rq; *(LAS bf16x8*)(Ks + m * 72 + d0) = rk;
#pragma unroll
        for (int i = 0; i < 8; ++i) { VT[(e0 + i) * 72 + m] = (unsigned short)rva[i]; VT[(e0 + 8 + i) * 72 + m] = (unsigned short)rvb[i]; }
        *(LAS bf16x8*)(Ss + (F.tid >> 3) * 72 + (F.tid & 7) * 8) = rs0; *(LAS bf16x8*)(Ss + ((F.tid + 512) >> 3) * 72 + (F.tid & 7) * 8) = rs1;
        __syncthreads();
        if (unit + F.G < 1024) R3_LOAD(unit + F.G);
        const int lb = F.wave & 1, eb = F.wave >> 1;
        unsigned short gt[16];
#pragma unroll
        for (int r = 0; r < 16; ++r) gt[r] = PROJ[(R0 + lb * 32 + crow32(r, hi)) * INP + C_RG + h * 128 + eb * 32 + r32];
        f32x16 cross = {};
        mfma_lds<4>(cross, Qs + lb * 32 * 72, 72, Ss + eb * 32 * 72, 72, r32, hi);
        if (F.wave < 4) { const int mb = F.wave >> 1; f32x16 sc = {};
            mfma_lds<4>(sc, Qs + lb * 32 * 72, 72, Ks + mb * 32 * 72, 72, r32, hi);
#pragma unroll
            for (int r = 0; r < 16; ++r) { const int l = lb * 32 + crow32(r, hi), mm = mb * 32 + r32; const int ad = l > mm ? l - mm : mm - l;
                Ps[l * 72 + mm] = f2bf16(sc[r] * expf(lg * (float)ad)); } }
        __syncthreads();
        f32x16 o = {};
        mfma_lds<4>(o, Ps + lb * 32 * 72, 72, VT + eb * 32 * 72, 72, r32, hi);
#pragma unroll
        for (int r = 0; r < 16; ++r) { const int l = lb * 32 + crow32(r, hi); o[r] += cross[r] * expf(lg * (float)(l + 1));
            float s = o[r] * o[r];
#pragma unroll
            for (int x = 1; x < 32; x <<= 1) s += __shfl_xor(s, x);
            if (r32 == 0) red[l * 4 + eb] = s; }
        __syncthreads();
#pragma unroll
        for (int r = 0; r < 16; ++r) { const int l = lb * 32 + crow32(r, hi); const f32x4 t = *(const LAS f32x4*)(red + l * 4);
            const float rn = 1.0f / sqrtf(((t[0] + t[1]) + (t[2] + t[3])) * (1.0f / 128.0f) + EPS); const int e = eb * 32 + r32;
            const float g = bf2f(gt[r]); const float sg = g / (1.0f + expf(-g));
            CAT[(R0 + l) * DM + 3072 + h * 128 + e] = f2bf16(sg * (o[r] * rn)); }
        __syncthreads();
    }
#undef R3_LOAD
}
#define CVT_LOOP(NITEMS, NIF, NTS) do { for (int it = gw; it < (NITEMS); it += (NIF) * NGW) { float vv[NIF][32]; \
    _Pragma("unroll") for (int j = 0; j < (NIF); ++j) if (it + j * NGW < (NITEMS)) { const CvtDesc d = desc_of(it + j * NGW); cvt_load(d, vv[j], F.lane); } \
    _Pragma("unroll") for (int j = 0; j < (NIF); ++j) if (it + j * NGW < (NITEMS)) { const CvtDesc d = desc_of(it + j * NGW); cvt_finish<NTS>(d, vv[j], scr, F.lane); } } } while (0)
#ifndef PRO_NIF
#define PRO_NIF 2
#endif
#ifndef DEF_NIF
#define DEF_NIF 4
#endif
#ifndef DEF_NT
#define DEF_NT true
#endif
#ifndef DOWN_KREV
#define DOWN_KREV 1
#endif
#ifndef UP_DEFER
#define UP_DEFER 6144
#endif
#ifndef WARM_UP
#define WARM_UP 0
#endif
#ifndef MID_CONV
#define MID_CONV 1
#endif
#ifndef DN_DEFER
#define DN_DEFER 32768
#endif
#ifndef GEMM_ALIGN
#define GEMM_ALIGN true
#endif
#ifndef GEMM_SP2
#define GEMM_SP2 true
#endif
#ifndef REP_PRO
#define REP_PRO 1
#endif
#ifndef REP_ATTN
#define REP_ATTN 1
#endif
#ifndef REP_UP
#define REP_UP 1
#endif
#ifndef REP_IN
#define REP_IN 1
#endif
#ifndef REP_QKV
#define REP_QKV 1
#endif
#ifndef REP_RET3
#define REP_RET3 1
#endif
#ifndef BAR_DUP
#define BAR_DUP 1
#endif
#ifndef REP_OUT
#define REP_OUT 1
#endif
#ifndef REP_DOWN
#define REP_DOWN 1
#endif
#ifndef REP_RES
#define REP_RES 1
#endif
#ifndef REP_BAR
#define REP_BAR 0
#endif
#ifndef REP_RET2
#define REP_RET2 1
#endif
#ifndef PROBE_IDX
#define PROBE_IDX -1
#endif
#ifndef PROBE_Q
#define PROBE_Q 20
#endif
#ifndef PROBE_L
#define PROBE_L 0
#endif
#ifndef REP_SMALL
#define REP_SMALL 1
#endif
struct Args { const float* in[17]; float* out; unsigned char* ws; };
typedef const Args __attribute__((address_space(4))) CArgs;
__device__ __forceinline__ CArgs* fresh_args() { CArgs* p = (CArgs*)__builtin_amdgcn_kernarg_segment_ptr(); asm volatile("" : "+s"(p)); return p; }
__device__ __forceinline__ void prologue_phase(LAS unsigned char* lds_, int part) {
    const Frame F = make_frame(lds_); CArgs* A = fresh_args(); unsigned char* ws = A->ws; float* rope = (float*)(ws + WS_ROPE); bf16* H = (bf16*)(ws + WS_H);
    const int gw = F.vcu * NWAVES + F.wave, NGW = F.G * NWAVES;
        LAS float* scr = (LAS float*)(F.lds + RING_OFF + F.wave * 16384);
        constexpr int I_IN = (DM / 64) * (INP / 32), I_Q = (1024 / 64) * (QW / 32), I_KV = (512 / 64) * (KVW / 32), I_OUT = (DM / 64) * (DM / 32), I_UP = (DM / 64) * (FF / 32);
        constexpr int I_DNP = (FF / 64) * (DM / 32) - DN_DEFER;
        constexpr int I_UPP = I_UP - UP_DEFER;
        constexpr int I_L = I_IN + I_Q + I_KV + I_OUT + I_UPP + I_DNP;
        const int CV0 = (MID_CONV && part == 1) ? I_L : 0, NCV = MID_CONV ? I_L : DEPTH * I_L;
        auto desc_of = [&](int it_) -> CvtDesc {
            const int it = NCV - 1 - it_ + CV0; const int l = it / I_L; int r = it % I_L; unsigned char* wl = ws + WS_W + (size_t)l * LW; CvtDesc d; int nblk;
            if (r < I_IN) { d.W = A->in[5] + (size_t)l * DM * INW; d.WT = (bf16*)(wl + W_IN); d.kgain = A->in[1] + l * DM; d.K = DM; d.N = INW; nblk = INP / 32; d.kind = 1; }
            else if ((r -= I_IN) < I_Q) { d.W = A->in[11] + (size_t)l * 1024 * QW; d.WT = (bf16*)(wl + W_Q); d.kgain = A->in[10] + l * 1024; d.K = 1024; d.N = QW; nblk = QW / 32; d.kind = 2; }
            else if ((r -= I_Q) < I_KV) { d.W = A->in[13] + (size_t)l * 512 * KVW; d.WT = (bf16*)(wl + W_KV); d.kgain = A->in[12] + l * 512; d.K = 512; d.N = KVW; nblk = KVW / 32; d.kind = 0; }
            else if ((r -= I_KV) < I_OUT) { d.W = A->in[14] + (size_t)l * DM * DM; d.WT = (bf16*)(wl + W_OUT); d.kgain = nullptr; d.K = DM; d.N = DM; nblk = DM / 32; d.kind = 0; }
            else if ((r -= I_OUT) < I_UPP) { r += UP_DEFER; d.W = A->in[15] + (size_t)l * DM * FF; d.WT = (bf16*)(wl + W_UP); d.kgain = A->in[3] + l * DM; d.K = DM; d.N = FF; nblk = FF / 32; d.kind = 0; }
            else { r -= I_UPP; r += DN_DEFER; d.W = A->in[16] + (size_t)l * FF * DM; d.WT = (bf16*)(wl + W_DOWN); d.kgain = nullptr; d.K = FF; d.N = DM; nblk = DM / 32; d.kind = 0; }
            d.k0 = 64 * (r / nblk); d.n0 = 32 * (r % nblk); return d; };
        CVT_LOOP(NCV, PRO_NIF, false);
        if (part == 1) return;
        for (int i = F.vcu * (NWAVES * 64) + F.tid; i < DEPTH * 8 * 128 * 128; i += F.G * NWAVES * 64) {
            const int l = i >> 17, r = i & 131071, ii = (r >> 7) & 127, jj = r & 127;
            ((bf16*)(ws + WS_W + (size_t)l * LW + W_SGU))[r] = ((jj >> 6) <= (ii >> 6)) ? f2bf16(A->in[8][i]) : (bf16)0; }
        for (int i = F.vcu * (NWAVES * 64) + F.tid; i < SEQ * 32; i += F.G * NWAVES * 64) {
            const int pos = i >> 5, j = i & 31; const float inv = (float)pow(10000.0, -(double)j / 32.0); const float ang = (float)pos * inv;
            float sn, cs; sincosf(ang, &sn, &cs); rope[2 * i] = cs; rope[2 * i + 1] = sn; }
        { float* rs0 = (float*)(ws + WS_RS); for (int m = gw; m < M; m += NGW) x_row_to_bf16(A->in[0] + (size_t)m * DM, H + (size_t)m * DM, rs0 + m, F.lane); }
}
template <int SLOT> __device__ __forceinline__ void convert_down_phase(LAS unsigned char* lds_, int l, int idx, int n) {
    const Frame F = make_frame(lds_); CArgs* A = fresh_args(); unsigned char* ws = A->ws;
    LAS float* scr = (LAS float*)(F.lds + RING_OFF + F.wave * 16384);
    constexpr int I_DN = (FF / 64) * (DM / 32), NB = DM / 32;
    const int gw = idx * NWAVES + F.wave, NGW = n * NWAVES;
    auto desc_of = [&](int r) -> CvtDesc { CvtDesc d; d.kind = 0;
        if (SLOT == 0) { d.W = A->in[16] + (size_t)l * FF * DM; d.WT = (bf16*)(ws + WS_W + (size_t)l * LW + W_DOWN); d.kgain = nullptr; d.K = FF; d.N = DM; d.k0 = 64 * (r / NB); d.n0 = 32 * (r % NB); }
        else { d.W = A->in[15] + (size_t)l * DM * FF; d.WT = (bf16*)(ws + WS_W + (size_t)l * LW + W_UP); d.kgain = A->in[3] + l * DM; d.K = DM; d.N = FF; d.k0 = 64 * (r / (FF / 32)); d.n0 = 32 * (r % (FF / 32)); }
        return d; };
    CVT_LOOP((SLOT == 0 ? DN_DEFER : UP_DEFER), DEF_NIF, DEF_NT);
}
__device__ __forceinline__ void residual_phase(LAS unsigned char* lds_, int l, int which, bool dry = false) {
    const Frame F = make_frame(lds_); CArgs* A = fresh_args(); unsigned char* ws = A->ws; const int gw = F.vcu * NWAVES + F.wave, NGW = F.G * NWAVES;
    const float* xin32 = (which == 0 && l == 0) ? A->in[0] : nullptr; const bf16* Y = (const bf16*)(ws + WS_MIX); bf16* XB = (bf16*)(ws + WS_H);
    const bool last = (which == 1 && l + 1 == DEPTH);
    float* out32 = dry ? (float*)(ws + WS_ACT) : A->out; float* rs_next = (float*)(ws + WS_RS) + (which == 0 ? M : 0) + (dry ? 2 * M : 0);
    if (dry) XB = (bf16*)(ws + WS_ACT + 134 * MiB);
    const float* gpost = (which == 0 ? A->in[2] : A->in[4]) + l * DM;
    for (int m = gw; m < M; m += NGW) residual_row(xin32 ? xin32 + (size_t)m * DM : nullptr, XB + (size_t)m * DM, Y + (size_t)m * DM, gpost, out32 + (size_t)m * DM, rs_next + m, last, F.lane);
}
__device__ __forceinline__ void warm_phase(LAS unsigned char* lds_, size_t off, size_t bytes, int l) {
    const Frame F = make_frame(lds_); CArgs* A = fresh_args(); const unsigned* p = (const unsigned*)(A->ws + WS_W + (size_t)l * LW + off);
    const size_t nlines = bytes / 128; unsigned acc = 0;
    for (size_t i = (size_t)F.vcu * (NWAVES * 64) + F.tid; i < nlines; i += (size_t)F.G * NWAVES * 64) acc += p[i * 32];
    if (acc == 0x12345678u) ((unsigned*)(A->ws + WS_CTL))[2048] = acc;
}
__device__ __forceinline__ void attn_phase(LAS unsigned char* lds_) {
    const Frame F = make_frame(lds_); CArgs* A = fresh_args(); unsigned char* ws = A->ws;
    const bf16* QB = (const bf16*)(ws + WS_Q); const bf16* KVB = (const bf16*)(ws + WS_KV); const bf16* PROJ = (const bf16*)(ws + WS_PROJ); bf16* CAT = (bf16*)(ws + WS_CAT);
    for (int p2 = 2 * F.vcu; p2 < 512; p2 += 2 * F.G)
        for (int k = 0; k < 2; ++k) { const int p = p2 >> 1, bh = p >> 3, s = p & 7;
            att::attn_unit(QB, KVB, PROJ, CAT, bh >> 4, bh & 15, k ? 15 - s : s, (ATT_LAS char*)(F.lds + RING_OFF)); }
}
template <int WHICH> __device__ __forceinline__ void gemm_call(LAS unsigned char* lds_, int l) {
    CArgs* A = fresh_args(); unsigned char* ws = A->ws; unsigned char* wl = ws + WS_W + (size_t)l * LW; int bx = blockIdx.x; asm volatile("" : "+s"(bx)); const int G = gridDim.x;
    float* rope = (float*)(ws + WS_ROPE); float* ssq = (float*)(ws + WS_SSQ); const float* rs = (const float*)(ws + WS_RS);
    bf16* H = (bf16*)(ws + WS_H); bf16* PROJ = (bf16*)(ws + WS_PROJ); bf16* QB = (bf16*)(ws + WS_Q); bf16* KVB = (bf16*)(ws + WS_KV);
    bf16* CAT = (bf16*)(ws + WS_CAT); bf16* MIX = (bf16*)(ws + WS_MIX); bf16* ACT = (bf16*)(ws + WS_ACT);
    pg8::StaticOrder S; const LAS float* rsl = (const LAS float*)(lds_ + LDSCTL_OFF + 1024);
    if constexpr (WHICH == 0) { pg8::Gemm g{H, (const bf16*)(wl + W_IN), M, INP, DM, DM, 0}; S.init(M, INP, G, bx); pg8::Epi<2> E{PROJ, INP, rope, ssq, rs, rsl, -1};
        pg8::gemm_phase<pg8::Epi<2>, pg8::StaticOrder, GEMM_ALIGN, GEMM_SP2>(lds_ + RING_OFF, g, S, E); }
    if constexpr (WHICH == 1) { pg8::Gemm g{PROJ + C_CQ, (const bf16*)(wl + W_Q), M, QW, 1024, INP, 0}; S.init(M, QW, G, bx); pg8::Epi<3> E{QB, QW, rope, ssq, nullptr, rsl, -1};
        pg8::gemm_phase<pg8::Epi<3>, pg8::StaticOrder, GEMM_ALIGN, GEMM_SP2>(lds_ + RING_OFF, g, S, E); }
    if constexpr (WHICH == 2) { pg8::Gemm g{PROJ + C_CKV, (const bf16*)(wl + W_KV), M, KVW, 512, INP, 0}; S.init(M, KVW, G, bx); pg8::Epi<4> E{KVB, KVW, rope, ssq, nullptr, rsl, -1};
        pg8::gemm_phase<pg8::Epi<4>, pg8::StaticOrder, GEMM_ALIGN, GEMM_SP2>(lds_ + RING_OFF, g, S, E); }
    if constexpr (WHICH == 3) { pg8::Gemm g{CAT, (const bf16*)(wl + W_OUT), M, DM, DM, DM, 0}; S.init(M, DM, G, bx); pg8::Epi<0> E{MIX, DM, rope, ssq, nullptr, rsl, -1};
        pg8::gemm_phase<pg8::Epi<0>, pg8::StaticOrder, GEMM_ALIGN, GEMM_SP2>(lds_ + RING_OFF, g, S, E); }
    if constexpr (WHICH == 4) { pg8::Gemm g{H, (const bf16*)(wl + W_UP), M, FF, DM, DM, 0}; S.init(M, FF, G, bx); pg8::Epi<1> E{ACT, FF, rope, ssq, rs + M, rsl, -1};
        pg8::gemm_phase<pg8::Epi<1>, pg8::StaticOrder, GEMM_ALIGN, GEMM_SP2>(lds_ + RING_OFF, g, S, E); }
    if constexpr (WHICH == 5) { pg8::Gemm g{ACT + (DOWN_KREV ? FF - 64 : 0), (const bf16*)(wl + W_DOWN) + (DOWN_KREV ? FF - 64 : 0), M, DM, FF, FF, DOWN_KREV};     S.init(M, DM, G, bx); pg8::Epi<0> E{MIX, DM, rope, ssq, nullptr, rsl, -1};
        pg8::gemm_phase<pg8::Epi<0>, pg8::StaticOrder, GEMM_ALIGN, GEMM_SP2>(lds_ + RING_OFF, g, S, E); }
}
__device__ __forceinline__ void mixer_small_phases(LAS unsigned char* lds_, int l) {
    CArgs* A = fresh_args(); unsigned char* ws = A->ws;
    sgu_phase(lds_, (const bf16*)(ws + WS_PROJ), (bf16*)(ws + WS_CAT), (const bf16*)(ws + WS_W + (size_t)l * LW + W_SGU), A->in[6] + l * 1024, A->in[7] + l * 1024, A->in[9] + l * 1024);
    CArgs* A2 = fresh_args(); unsigned char* ws2 = A2->ws;
    ret1_phase(lds_, (const bf16*)(ws2 + WS_PROJ), (float*)(ws2 + WS_KVS));
}
__global__ void __launch_bounds__(NWAVES * 64, 2) mega_fwd(Args args) {
    extern __shared__ __attribute__((aligned(16))) unsigned char lds[];
    LAS unsigned char* L = (LAS unsigned char*)lds;
    volatile LAS unsigned* MISC = (volatile LAS unsigned*)(L + MISC_OFF);
    for (int u = threadIdx.x; u < (LDS_BYTES - LDSCTL_OFF) / 4; u += NWAVES * 64) ((LAS unsigned*)(L + LDSCTL_OFF))[u] = 0u;
    __syncthreads();
    XcdBarrier bar = xcd_barrier_post((unsigned*)(args.ws + WS_CTL) + CW_BAR, MISC + 8);
#define GRID_BAR() do { for (int bd_ = 0; bd_ < BAR_DUP; ++bd_) { XcdBarrier b_ = bar; asm volatile("" : "+s"(b_.bar), "+s"(b_.x)); xcd_barrier(b_); } } while (0)
    unsigned long long tp0 = 0, tp1 = 0;
#define STAMP(kk, cond) do { if (PROBE_IDX >= 0 && (cond)) { if (PROBE_IDX == (kk)) tp0 = __builtin_amdgcn_s_memrealtime(); if (PROBE_IDX + 1 == (kk)) tp1 = __builtin_amdgcn_s_memrealtime(); } } while (0)
    STAMP(0, true);
    for (int rep_ = 0; rep_ < REP_PRO; ++rep_) prologue_phase(L, 0);
    GRID_BAR();
    for (int l = 0; l < DEPTH; ++l) {
        STAMP(1, l == PROBE_L);
        for (int rep_ = 0; rep_ < REP_IN; ++rep_) gemm_call<0>(L, l);
        { int bx = blockIdx.x; asm volatile("" : "+s"(bx)); const int G = gridDim.x, NT_IN = (M / 256) * (INP / 256), nfull = NT_IN % G;
          if (nfull == 0) convert_down_phase<0>(L, l, bx, G); else if (bx >= nfull) convert_down_phase<0>(L, l, bx - nfull, G - nfull); }
        GRID_BAR();
        STAMP(2, l == PROBE_L);
        for (int rep_ = 0; rep_ < REP_QKV; ++rep_) { gemm_call<1>(L, l);
            if (UP_DEFER > 0) { int bx = blockIdx.x; asm volatile("" : "+s"(bx)); const int G = gridDim.x, nfull = ((M / 256) * (QW / 256)) % G;
                if (nfull != 0 && bx >= nfull) convert_down_phase<1>(L, l, bx - nfull, G - nfull); else if (nfull == 0) convert_down_phase<1>(L, l, bx, G);
                __syncthreads(); }
            gemm_call<2>(L, l); }
        for (int rep_ = 0; rep_ < REP_SMALL; ++rep_) mixer_small_phases(L, l);
        GRID_BAR();
        STAMP(3, l == PROBE_L);
        for (int rep_ = 0; rep_ < REP_RET2; ++rep_) { CArgs* A = fresh_args(); unsigned char* ws = A->ws; ret2_phase(L, (const float*)(ws + WS_KVS), (bf16*)(ws + WS_SB)); }
        for (int rep_ = 0; rep_ < REP_ATTN; ++rep_) attn_phase(L);
        GRID_BAR();
        STAMP(4, l == PROBE_L);
        for (int rep_ = 0; rep_ < REP_RET3; ++rep_) { CArgs* A = fresh_args(); unsigned char* ws = A->ws; ret3_phase(L, (const bf16*)(ws + WS_PROJ), (const bf16*)(ws + WS_SB), (bf16*)(ws + WS_CAT)); }
        GRID_BAR();
        STAMP(5, l == PROBE_L);
        for (int rep_ = 0; rep_ < REP_OUT; ++rep_) gemm_call<3>(L, l);
        GRID_BAR();
        STAMP(6, l == PROBE_L);
        for (int rep_ = 0; rep_ < REP_RES; ++rep_) residual_phase(L, l, 0, rep_ + 1 < REP_RES);
        if (WARM_UP) warm_phase(L, W_UP, (size_t)FF * DM * 2, l);
        GRID_BAR();
        STAMP(7, l == PROBE_L);
        for (int rep_ = 0; rep_ < REP_UP; ++rep_) { if (rep_ && REP_BAR) GRID_BAR(); gemm_call<4>(L, l); }
        GRID_BAR();
        STAMP(8, l == PROBE_L);
        if (MID_CONV && l == 0) { prologue_phase(L, 1); __syncthreads(); }
        for (int rep_ = 0; rep_ < REP_DOWN; ++rep_) gemm_call<5>(L, l);
        GRID_BAR();
        STAMP(9, l == PROBE_L);
        for (int rep_ = 0; rep_ < REP_RES; ++rep_) residual_phase(L, l, 1, rep_ + 1 < REP_RES);
        STAMP(10, l == PROBE_L);
        if (l + 1 < DEPTH) GRID_BAR();
    }
    if (PROBE_IDX >= 0 && blockIdx.x == 0 && threadIdx.x == 0) { asm volatile("s_waitcnt vmcnt(0)" ::: "memory"); args.out[0] = (float)(((tp1 - tp0) + PROBE_Q * 50ull) / (PROBE_Q * 100ull)) * (float)(PROBE_Q * 10); }
}

extern "C" void kernel_launch(void* const* d_in, const int* in_sizes, int n_in, void* d_out, int out_size, void* d_ws, size_t ws_size, hipStream_t stream) {
    static int grid = 0;
    if (grid == 0) {
        if (n_in != 17 || in_sizes[0] != M * DM || out_size != M * DM || ws_size < WS_END) { fprintf(stderr, "kernel_launch: shape mismatch (n_in %d, in0 %d, out %d, ws %zu < %zu)\n", n_in, n_in > 0 ? in_sizes[0] : -1, out_size, ws_size, (size_t)WS_END); grid = -1; return; }
        int dev = 0, cus = 0, per_cu = 0;
        if (hipGetDevice(&dev) != hipSuccess || hipDeviceGetAttribute(&cus, hipDeviceAttributeMultiprocessorCount, dev) != hipSuccess) { grid = -1; return; }
        if (hipFuncSetAttribute((const void*)mega_fwd, hipFuncAttributeMaxDynamicSharedMemorySize, LDS_BYTES) != hipSuccess) { fprintf(stderr, "kernel_launch: hipFuncSetAttribute failed\n"); grid = -1; return; }
        if (hipOccupancyMaxActiveBlocksPerMultiprocessor(&per_cu, (const void*)mega_fwd, NWAVES * 64, LDS_BYTES) != hipSuccess || per_cu < 1)
            fprintf(stderr, "kernel_launch: note: occupancy query reports %d workgroups per CU\n", per_cu);
        (void)hipGetLastError();
        grid = cus;
    }
    if (grid < 0) return;
    if (hipMemsetAsync((char*)d_ws + WS_CTL, 0, CTL_ZERO_BYTES, stream) != hipSuccess) { fprintf(stderr, "kernel_launch: memset failed\n"); return; }
    Args a{};
    for (int i = 0; i < 17; ++i) a.in[i] = (const float*)d_in[i];
    a.out = (float*)d_out; a.ws = (unsigned char*)d_ws;
    hipLaunchKernelGGL(mega_fwd, dim3(grid), dim3(NWAVES * 64), LDS_BYTES, stream, a);
    const hipError_t le = hipPeekAtLastError();
    if (le != hipSuccess) fprintf(stderr, "kernel_launch: launch failed: %s\n", hipGetErrorName(le));
}
```

```cpp
#include <hip/hip_runtime.h>
#include <cstdio>
#include <cstdint>
namespace pg8 {
#define PG8_LAS __attribute__((address_space(3)))
typedef unsigned short bf16_t;
typedef short bf16x8 __attribute__((ext_vector_type(8)));
typedef float f32x4 __attribute__((ext_vector_type(4)));
typedef unsigned u32x4 __attribute__((ext_vector_type(4)));
constexpr int BM = 256, BK = 64, HALF = 128, HTB = HALF * BK * 2  , STAGE_BYTES = 8 * HTB, NXCD = 8, WGM = 8;

__host__ __device__ __forceinline__ int lds_byte(int r, int c) { const int st = (r >> 4) * 2 + (c >> 5), rr = r & 15, cc = c & 31, ob = rr * 64 + cc * 2; return st * 1024 + (ob ^ (((ob >> 9) & 1) << 5)); }
__host__ __device__ __forceinline__ void stage_rc(int b, int& R, int& C) { const int st = b / 1024, sb = b % 1024, swz = sb ^ (((sb >> 9) & 1) << 5); R = (st >> 1) * 16 + swz / 64; C = (st & 1) * 32 + (swz % 64) / 2; }
__host__ __device__ __forceinline__ int perm32(int rho) { const int n = rho >> 4, i = rho & 15; return 8 * (i >> 2) + 4 * n + (i & 3); }

struct Unit { int pm, pn; };
struct Gemm { const bf16_t* A; const bf16_t* Bt; int M, N, K, lda, krev; };

struct StaticOrder {
    int nM, nN, nwg, G, c;
    __host__ __device__ void init(int M, int N, int G_, int c_) { nM = M / BM; nN = N / BM; nwg = nM * nN; G = G_; c = c_; }
    __host__ __device__ bool next(int i, Unit& u) const {
        const long L = (long)i * G + c; if (L >= nwg) return false;
        int wgid = (int)L; { const int q = nwg / NXCD, r = nwg % NXCD, xcd = wgid % NXCD, off = wgid / NXCD; wgid = (xcd < r ? xcd * (q + 1) : r * (q + 1) + (xcd - r) * q) + off; }
        const int nig = WGM * nN, gid = wgid / nig, fm = gid * WGM, gsz = (nM - fm) < WGM ? (nM - fm) : WGM;
        u.pm = fm + ((wgid % nig) % gsz); u.pn = (wgid % nig) / gsz; return true;
    }
    __device__ __forceinline__ void a_ready(const Unit&) const {}
    __device__ __forceinline__ void done(const Unit&) const {}
};
__device__ __forceinline__ unsigned cvt_pk_bf16(float lo, float hi) { unsigned r; asm volatile("v_cvt_pk_bf16_f32 %0, %1, %2" : "=v"(r) : "v"(lo), "v"(hi)); return r; }
__device__ __forceinline__ void rope8(f32x4& v0, f32x4& v1, const float* tab) {
    const f32x4 t0 = *(const f32x4*)tab, t1 = *(const f32x4*)(tab + 4);
    f32x4 a, b;
    a[0] = v0[0] * t0[0] - v0[1] * t0[1]; a[1] = v0[0] * t0[1] + v0[1] * t0[0];
    a[2] = v0[2] * t0[2] - v0[3] * t0[3]; a[3] = v0[2] * t0[3] + v0[3] * t0[2];
    b[0] = v1[0] * t1[0] - v1[1] * t1[1]; b[1] = v1[0] * t1[1] + v1[1] * t1[0];
    b[2] = v1[2] * t1[2] - v1[3] * t1[3]; b[3] = v1[2] * t1[3] + v1[3] * t1[2];
    v0 = a; v1 = b;
}
template <int MODE> struct Epi {
    static constexpr bool PERM = true, AFTER_DRAIN = false;
    bf16_t* O; int ldc; const float* rope; float* ssq; const float* rsc; const PG8_LAS float* rs_lds; int rs_pm;
    __device__ __forceinline__ void operator()(const f32x4 (&acc)[2][2][4][2], const Unit& u, int wr, int wc, int fr, int fq) const {
        const int row0 = u.pm * BM + wr * 64 + fr, colt = u.pn * BM + wc * 32 + 8 * fq;
        const bool want_ss = (MODE == 2) && u.pn >= 8 && u.pn < 14;
#pragma unroll
        for (int ai = 0; ai < 2; ++ai)
#pragma unroll
            for (int m = 0; m < 4; ++m) {
                const int row = row0 + ai * HALF + m * 16;
                float rs = 1.f;
                if (MODE == 1 || MODE == 2) rs = rsc[row];
                if (MODE == 3) { const f32x4* s = (const f32x4*)(ssq + (size_t)row * 24); const f32x4 a = s[0], b = s[1], c = s[2], d = s[3];
                    const float t = ((a[0] + a[1]) + (a[2] + a[3])) + ((b[0] + b[1]) + (b[2] + b[3])) + ((c[0] + c[1]) + (c[2] + c[3])) + ((d[0] + d[1]) + (d[2] + d[3]));
                    rs = 1.0f / sqrtf(t * (1.0f / 1024.0f) + 1e-6f); }
                if (MODE == 4) { const f32x4* s = (const f32x4*)(ssq + (size_t)row * 24); const f32x4 a = s[4], b = s[5];
                    const float t = ((a[0] + a[1]) + (a[2] + a[3])) + ((b[0] + b[1]) + (b[2] + b[3]));
                    rs = 1.0f / sqrtf(t * (1.0f / 512.0f) + 1e-6f); }
                float part = 0.f;
#pragma unroll
                for (int bj = 0; bj < 2; ++bj) {
                    const int col = colt + bj * HALF;
                    f32x4 v0 = acc[ai][bj][m][0], v1 = acc[ai][bj][m][1];
                    if (MODE == 1) {
#pragma unroll
                        for (int j = 0; j < 4; ++j) { const float p = fmaxf(v0[j] * rs, 0.f), q = fmaxf(v1[j] * rs, 0.f); v0[j] = p * p; v1[j] = q * q; } }
                    if (MODE == 2) { v0 = v0 * rs; v1 = v1 * rs;
                        if (want_ss) part += ((v0[0] * v0[0] + v0[1] * v0[1]) + (v0[2] * v0[2] + v0[3] * v0[3])) + ((v1[0] * v1[0] + v1[1] * v1[1]) + (v1[2] * v1[2] + v1[3] * v1[3]));
                        if (col >= 3584 && col < 4672) rope8(v0, v1, rope + ((size_t)(row & 4095) * 32 + ((col & 63) >> 1)) * 2); }
                    if (MODE == 3) { v0 = v0 * rs; v1 = v1 * rs; if ((col % 192) >= 128) rope8(v0, v1, rope + ((size_t)(row & 4095) * 32 + ((col & 63) >> 1)) * 2); }
                    if (MODE == 4) { v0 = v0 * rs; v1 = v1 * rs; }
                    u32x4 w; w.x = cvt_pk_bf16(v0[0], v0[1]); w.y = cvt_pk_bf16(v0[2], v0[3]); w.z = cvt_pk_bf16(v1[0], v1[1]); w.w = cvt_pk_bf16(v1[2], v1[3]);
                    *(u32x4*)(O + (size_t)row * ldc + col) = w;
                }
                if (want_ss) { part += __shfl_xor(part, 16); part += __shfl_xor(part, 32); if (fq == 0) ssq[(size_t)row * 24 + (u.pn - 8) * 4 + wc] = part; }
            }
    }
};
template <class Epi, class Sched, bool ALIGN_EPI = false, bool SP2 = false>
__device__ __forceinline__ void gemm_phase(PG8_LAS unsigned char* lds, const Gemm g, const Sched& S, const Epi& E) {
    int tid_ = threadIdx.x; asm volatile("" : "+v"(tid_));
    const int tid = tid_, wid = __builtin_amdgcn_readfirstlane(tid >> 6), lane = tid & 63, wr = wid >> 2, wc = wid & 3, fr = lane & 15, fq = lane >> 4;
    const int K = g.K, nt = K / BK;
    unsigned voffA[2], voffB[2];
#pragma unroll
    for (int i = 0; i < 2; ++i) { int R, C; stage_rc(tid * 16 + i * 8192, R, C); const int Rb = Epi::PERM ? ((R & ~31) + perm32(R & 31)) : R;
        voffA[i] = (unsigned)(R * g.lda + C) * 2u; voffB[i] = (unsigned)(Rb * K + C) * 2u; }
    const long kstep = g.krev ? -(long)(BK * 2) : (long)(BK * 2);
    const size_t hstep = (size_t)HALF * K * 2;
    const size_t tstep = 2 * hstep; const size_t hstepA = (size_t)HALF * g.lda * 2, tstepA = 2 * hstepA;
    const unsigned ldsw = (unsigned)wid * 1024u;
    const int aoff = lds_byte(wr * 64 + fr, fq * 8), boff = lds_byte(wc * 32 + fr, fq * 8);
#define PG8_SA(b, h) (((b) * 2 + (h)) * HTB)
#define PG8_SB(b, h) ((4 + (b) * 2 + (h)) * HTB)
#define PG8_STAGE(bufoff, gbase, voff) do { _Pragma("unroll") for (int _i = 0; _i < 2; ++_i) \
        __builtin_amdgcn_global_load_lds((const unsigned*)((const char*)(gbase) + (voff)[_i]), (PG8_LAS unsigned*)(lds + (bufoff) + ldsw + _i * 8192), 16, 0, 0); } while (0)
#define PG8_LDA(dst, b, h) do { _Pragma("unroll") for (int m = 0; m < 4; ++m) _Pragma("unroll") for (int k = 0; k < 2; ++k) dst[m][k] = *(const PG8_LAS bf16x8*)(lds + PG8_SA(b, h) + aoff + m * 2048 + k * 1024); } while (0)
#define PG8_LDB(dst, b, h) do { _Pragma("unroll") for (int n = 0; n < 2; ++n) _Pragma("unroll") for (int k = 0; k < 2; ++k) dst[n][k] = *(const PG8_LAS bf16x8*)(lds + PG8_SB(b, h) + boff + n * 2048 + k * 1024); } while (0)
#define PG8_MMA(ai, bj, At, Bt) do { __builtin_amdgcn_s_setprio(1); _Pragma("unroll") for (int m = 0; m < 4; ++m) _Pragma("unroll") for (int n = 0; n < 2; ++n) _Pragma("unroll") for (int k = 0; k < 2; ++k) \
        acc[ai][bj][m][n] = __builtin_amdgcn_mfma_f32_16x16x32_bf16(Bt[n][k], At[m][k], acc[ai][bj][m][n], 0, 0, 0); __builtin_amdgcn_s_setprio(0); } while (0)
#define PG8_WAIT_V(n) asm volatile("s_waitcnt vmcnt(" #n ")" ::: "memory")
#define PG8_WAIT_L(n) asm volatile("s_waitcnt lgkmcnt(" #n ")" ::: "memory")
#define PG8_BAR __builtin_amdgcn_s_barrier()
#define PG8_SCHED __builtin_amdgcn_sched_barrier(0)
    Unit cur, nxt; int ui = 0;
    if (!S.next(0, cur)) return;
    f32x4 acc[2][2][4][2];
#pragma unroll
    for (int a = 0; a < 2; ++a)
#pragma unroll
        for (int b = 0; b < 2; ++b)
#pragma unroll
            for (int m = 0; m < 4; ++m)
#pragma unroll
                for (int n = 0; n < 2; ++n) acc[a][b][m][n] = (f32x4){0.f, 0.f, 0.f, 0.f};
    bf16x8 At[4][2], B0[2][2], B1[2][2];
    const char* cA = (const char*)g.A + (size_t)cur.pm * tstepA; const char* cB = (const char*)g.Bt + (size_t)cur.pn * tstep;
    S.a_ready(cur);
    if constexpr (SP2) {
        PG8_STAGE(PG8_SB(0, 0), cB, voffB); PG8_STAGE(PG8_SB(0, 1), cB + hstep, voffB); PG8_STAGE(PG8_SA(0, 0), cA, voffA); PG8_STAGE(PG8_SA(0, 1), cA + hstepA, voffA);
        if (wr == 1) PG8_BAR;
        PG8_WAIT_V(2); PG8_BAR;
        PG8_STAGE(PG8_SB(1, 0), cB + kstep, voffB); PG8_STAGE(PG8_SA(1, 0), cA + kstep, voffA); PG8_STAGE(PG8_SB(1, 1), cB + hstep + kstep, voffB);
        PG8_WAIT_V(6); PG8_BAR;
    } else {
        PG8_STAGE(PG8_SB(0, 0), cB, voffB); PG8_STAGE(PG8_SA(0, 0), cA, voffA); PG8_STAGE(PG8_SB(0, 1), cB + hstep, voffB); PG8_STAGE(PG8_SA(0, 1), cA + hstepA, voffA);
        if (wr == 1) PG8_BAR;
        PG8_WAIT_V(4); PG8_BAR;
        PG8_STAGE(PG8_SB(1, 0), cB + kstep, voffB); PG8_STAGE(PG8_SA(1, 0), cA + kstep, voffA); PG8_STAGE(PG8_SB(1, 1), cB + hstep + kstep, voffB);
        PG8_WAIT_V(6); PG8_BAR;
    }
    for (;;) {
        const bool has_next = S.next(ui + 1, nxt);
        const char* nA = has_next ? (const char*)g.A + (size_t)nxt.pm * tstepA : cA; const char* nB = has_next ? (const char*)g.Bt + (size_t)nxt.pn * tstep : cB;
        for (int t = 0; t < nt; t += 2) {
            const bool last = (t == nt - 2);
            const char* a1 = cA + (long)(t + 1) * kstep;
            const char* a2 = last ? nA : cA + (long)(t + 2) * kstep; const char* b2 = last ? nB : cB + (long)(t + 2) * kstep;
            const char* a3 = a2 + kstep; const char* b3 = b2 + kstep;
            if (last && has_next) S.a_ready(nxt);
            if constexpr (SP2) {
            PG8_LDB(B0, 0, 0); PG8_LDB(B1, 0, 1); PG8_SCHED; PG8_LDA(At, 0, 0); PG8_STAGE(PG8_SA(1, 1), a1 + hstepA, voffA);
            PG8_WAIT_V(8); PG8_WAIT_L(0); PG8_BAR; PG8_MMA(0, 0, At, B0); PG8_MMA(0, 1, At, B1); PG8_BAR; PG8_SCHED;
            PG8_LDA(At, 0, 1); PG8_STAGE(PG8_SB(0, 0), b2, voffB); PG8_STAGE(PG8_SB(0, 1), b2 + hstep, voffB); PG8_STAGE(PG8_SA(0, 0), a2, voffA);
            PG8_WAIT_V(8); PG8_WAIT_L(0); PG8_BAR; PG8_MMA(1, 0, At, B0); PG8_MMA(1, 1, At, B1); PG8_BAR; PG8_SCHED;
            PG8_LDB(B0, 1, 0); PG8_LDB(B1, 1, 1); PG8_SCHED; PG8_LDA(At, 1, 0); PG8_STAGE(PG8_SA(0, 1), a2 + hstepA, voffA);
            PG8_WAIT_V(8); PG8_WAIT_L(0); PG8_BAR; PG8_MMA(0, 0, At, B0); PG8_MMA(0, 1, At, B1); PG8_BAR; PG8_SCHED;
            PG8_LDA(At, 1, 1); PG8_STAGE(PG8_SB(1, 0), b3, voffB); PG8_STAGE(PG8_SB(1, 1), b3 + hstep, voffB); PG8_STAGE(PG8_SA(1, 0), a3, voffA);
            PG8_WAIT_V(8); PG8_WAIT_L(0); PG8_BAR; PG8_MMA(1, 0, At, B0); PG8_MMA(1, 1, At, B1); PG8_BAR; PG8_SCHED;
            } else {
            PG8_LDB(B0, 0, 0); PG8_SCHED; PG8_LDA(At, 0, 0); PG8_STAGE(PG8_SA(1, 1), a1 + hstepA, voffA);
            PG8_WAIT_L(8); PG8_BAR; PG8_WAIT_L(0); PG8_MMA(0, 0, At, B0); PG8_BAR; PG8_SCHED;
            PG8_LDB(B1, 0, 1); PG8_STAGE(PG8_SB(0, 0), b2, voffB);
            PG8_BAR; PG8_WAIT_L(0); PG8_MMA(0, 1, At, B1); PG8_BAR;
            PG8_LDA(At, 0, 1); PG8_STAGE(PG8_SA(0, 0), a2, voffA);
            PG8_BAR; PG8_WAIT_L(0); PG8_MMA(1, 0, At, B0); PG8_BAR; PG8_SCHED;
            PG8_STAGE(PG8_SB(0, 1), b2 + hstep, voffB);
            PG8_WAIT_V(6); PG8_BAR; PG8_MMA(1, 1, At, B1); PG8_BAR;
            PG8_LDB(B0, 1, 0); PG8_SCHED; PG8_LDA(At, 1, 0); PG8_STAGE(PG8_SA(0, 1), a2 + hstepA, voffA);
            PG8_WAIT_L(8); PG8_BAR; PG8_WAIT_L(0); PG8_MMA(0, 0, At, B0); PG8_BAR; PG8_SCHED;
            PG8_LDB(B1, 1, 1); PG8_STAGE(PG8_SB(1, 0), b3, voffB);
            PG8_BAR; PG8_WAIT_L(0); PG8_MMA(0, 1, At, B1); PG8_BAR;
            PG8_LDA(At, 1, 1); PG8_STAGE(PG8_SA(1, 0), a3, voffA);
            PG8_BAR; PG8_WAIT_L(0); PG8_MMA(1, 0, At, B0); PG8_BAR; PG8_SCHED;
            PG8_STAGE(PG8_SB(1, 1), b3 + hstep, voffB);
            PG8_WAIT_V(6); PG8_BAR; PG8_MMA(1, 1, At, B1); PG8_BAR;
            }
        }
        if constexpr (ALIGN_EPI) { if (wr == 0) PG8_BAR; }
        if constexpr (!Epi::AFTER_DRAIN) { E(acc, cur, wr, wc, fr, fq); S.done(cur); }
        if (!has_next) break;
#pragma unroll
        for (int a = 0; a < 2; ++a)
#pragma unroll
            for (int b = 0; b < 2; ++b)
#pragma unroll
                for (int m = 0; m < 4; ++m)
#pragma unroll
                    for (int n = 0; n < 2; ++n) acc[a][b][m][n] = (f32x4){0.f, 0.f, 0.f, 0.f};
        cur = nxt; cA = nA; cB = nB; ++ui;
        if constexpr (ALIGN_EPI) { if (wr == 1) PG8_BAR; }
    }
    PG8_WAIT_V(0);
    if constexpr (!ALIGN_EPI) { if (wr == 0) PG8_BAR; }
    PG8_BAR;
    if constexpr (Epi::AFTER_DRAIN) { E.fused(acc, cur, wr, wc, fr, fq, lds, wid, lane); S.done(cur); }
#undef PG8_SA
#undef PG8_SB
#undef PG8_STAGE
#undef PG8_LDA
#undef PG8_LDB
#undef PG8_MMA
#undef PG8_WAIT_V
#undef PG8_WAIT_L
#undef PG8_BAR
#undef PG8_SCHED
}
}
namespace att {
#define ATT_LAS __attribute__((address_space(3)))
typedef unsigned short bf16;
using bf16x8 = __attribute__((ext_vector_type(8))) short;
using s16x4  = __attribute__((ext_vector_type(4))) short;
using f32x16 = __attribute__((ext_vector_type(16))) float;
using u32x4  = __attribute__((ext_vector_type(4))) unsigned;
constexpr float SCALE = 0.07216878364870322f;
constexpr float THR = 8.f;
constexpr int SHM_V = 16384, SHM_K = 16384, SHM_R = 8192;
constexpr int OFF_V = 0, OFF_K = 2 * SHM_V, OFF_R = OFF_K + 2 * SHM_K, OFF_WS = OFF_R + 2 * SHM_R, ATT_LDS_BYTES = OFF_WS + 8 * 64 * 4;
#define KSWZ(row, colB) ((row) * 256 + ((colB) ^ (((row) & 7) << 4)))
#define RSWZ(row, colB) ((row) * 128 + ((colB) ^ (((row) & 7) << 4)))
#define SBAR() __builtin_amdgcn_sched_barrier(0)
__device__ __forceinline__ int crow(int r, int hi) { return (r & 3) + 8 * (r >> 2) + 4 * hi; }
__device__ __forceinline__ unsigned cvtpk(float lo, float hi) { unsigned r; asm volatile("v_cvt_pk_bf16_f32 %0, %1, %2" : "=v"(r) : "v"(lo), "v"(hi)); return r; }
__device__ __forceinline__ void partialSM(f32x16& p0, f32x16& p1, float& m_reg, float& mn, float& alpha) {
  constexpr float C = SCALE * 1.4426950408889634f;
  float pmax = p0[0];
#pragma unroll
  for (int r = 1; r < 16; ++r) pmax = fmaxf(pmax, p0[r]);
#pragma unroll
  for (int r = 0; r < 16; ++r) pmax = fmaxf(pmax, p1[r]);
  { auto rr = __builtin_amdgcn_permlane32_swap(__float_as_uint(pmax), __float_as_uint(pmax), false, false);
    pmax = fmaxf(__uint_as_float(rr[0]), __uint_as_float(rr[1])); }
  if (__builtin_expect(__all(pmax - m_reg <= THR / SCALE), 1)) { mn = m_reg; alpha = 1.f; }
  else { mn = fmaxf(m_reg, pmax); alpha = __builtin_amdgcn_exp2f((m_reg - mn) * C); m_reg = mn; }
  float mnC = -mn * C;
#pragma unroll
  for (int r = 0; r < 16; ++r) p0[r] = fmaf(p0[r], C, mnC);
#pragma unroll
  for (int r = 0; r < 16; ++r) p1[r] = fmaf(p1[r], C, mnC);
#pragma unroll
  for (int r = 0; r < 16; ++r) p0[r] = __builtin_amdgcn_exp2f(p0[r]);
}
__device__ __forceinline__ void finishSM(f32x16& p0, f32x16& p1, float alpha, float& l_reg, bf16x8& pa0, bf16x8& pa1, bf16x8& pa2, bf16x8& pa3) {
#pragma unroll
  for (int r = 0; r < 16; ++r) p1[r] = __builtin_amdgcn_exp2f(p1[r]);
  float ps = 0;
#pragma unroll
  for (int r = 0; r < 16; ++r) ps += p0[r];
#pragma unroll
  for (int r = 0; r < 16; ++r) ps += p1[r];
  { auto rr = __builtin_amdgcn_permlane32_swap(__float_as_uint(ps), __float_as_uint(ps), false, false);
    ps = __uint_as_float(rr[0]) + __uint_as_float(rr[1]); }
  l_reg = l_reg * alpha + ps;
#define PK4(P, BASE, OUT) do { unsigned a0 = cvtpk(P[BASE + 0], P[BASE + 1]), a1 = cvtpk(P[BASE + 2], P[BASE + 3]);   \
    unsigned b0 = cvtpk(P[BASE + 4], P[BASE + 5]), b1 = cvtpk(P[BASE + 6], P[BASE + 7]);                              \
    auto r0 = __builtin_amdgcn_permlane32_swap(a0, b0, false, false); auto r1 = __builtin_amdgcn_permlane32_swap(a1, b1, false, false); \
    u32x4 w = {r0[0], r1[0], r0[1], r1[1]}; OUT = *reinterpret_cast<bf16x8*>(&w); } while (0)
  PK4(p0, 0, pa0); PK4(p0, 8, pa1); PK4(p1, 0, pa2); PK4(p1, 8, pa3);
#undef PK4
}
__device__ __forceinline__ void qkt(f32x16& p0, f32x16& p1, const ATT_LAS char* Ks, const ATT_LAS char* Rs, const bf16x8* qr, int r32, int hi) {
  p0 = f32x16{}; p1 = f32x16{};
#pragma unroll
  for (int d0 = 0; d0 < 8; ++d0) { const int cb = (d0 * 16 + hi * 8) * 2;
    const bf16x8 b0 = *reinterpret_cast<const ATT_LAS bf16x8*>(Ks + KSWZ(r32, cb));
    const bf16x8 b1 = *reinterpret_cast<const ATT_LAS bf16x8*>(Ks + KSWZ(32 + r32, cb));
    p0 = __builtin_amdgcn_mfma_f32_32x32x16_bf16(b0, qr[d0], p0, 0, 0, 0);
    p1 = __builtin_amdgcn_mfma_f32_32x32x16_bf16(b1, qr[d0], p1, 0, 0, 0); }
#pragma unroll
  for (int d0 = 0; d0 < 4; ++d0) { const int cb = (d0 * 16 + hi * 8) * 2;
    const bf16x8 b0 = *reinterpret_cast<const ATT_LAS bf16x8*>(Rs + RSWZ(r32, cb));
    const bf16x8 b1 = *reinterpret_cast<const ATT_LAS bf16x8*>(Rs + RSWZ(32 + r32, cb));
    p0 = __builtin_amdgcn_mfma_f32_32x32x16_bf16(b0, qr[8 + d0], p0, 0, 0, 0);
    p1 = __builtin_amdgcn_mfma_f32_32x32x16_bf16(b1, qr[8 + d0], p1, 0, 0, 0); }
}
__device__ __forceinline__ int v_st(int k, int c) { const int kk = (k & ~0xC) | ((k & 4) << 1) | ((k & 8) >> 1); return ((kk >> 3) * 4 + (c >> 5)) * 512 + ((kk & 7) * 32 + (c & 31)) * 2; }
__device__ __forceinline__ int v_rd_base(int lane) { return ((lane & 3) << 3) | (((lane >> 2) & 3) << 6) | (((lane >> 4) & 1) << 5) | (((lane >> 5) & 1) << 8); }
constexpr int v_rd_off(int d0, int ks, int half) { return d0 * 512 + ks * 4096 + half * 2048; }
template <int OFF> __device__ __forceinline__ s16x4 tr_read(int vb) {
  s16x4 r; asm volatile("ds_read_b64_tr_b16 %0, %1 offset:%2" : "=&v"(r) : "v"(vb), "i"(OFF) : "memory"); return r;
}
template <int D0> __device__ __forceinline__ void pv_one(f32x16& od, int vb, bf16x8 pa0, bf16x8 pa1, bf16x8 pa2, bf16x8 pa3) {
  const s16x4 l0 = tr_read<v_rd_off(D0, 0, 0)>(vb), h0 = tr_read<v_rd_off(D0, 0, 1)>(vb), l1 = tr_read<v_rd_off(D0, 1, 0)>(vb), h1 = tr_read<v_rd_off(D0, 1, 1)>(vb);
  const s16x4 l2 = tr_read<v_rd_off(D0, 2, 0)>(vb), h2 = tr_read<v_rd_off(D0, 2, 1)>(vb), l3 = tr_read<v_rd_off(D0, 3, 0)>(vb), h3 = tr_read<v_rd_off(D0, 3, 1)>(vb);
  asm volatile("s_waitcnt lgkmcnt(0)" ::: "memory"); SBAR();
#define PK(L, H) (bf16x8){L[0], L[1], L[2], L[3], H[0], H[1], H[2], H[3]}
  od = __builtin_amdgcn_mfma_f32_32x32x16_bf16(pa0, PK(l0, h0), od, 0, 0, 0);
  od = __builtin_amdgcn_mfma_f32_32x32x16_bf16(pa1, PK(l1, h1), od, 0, 0, 0);
  od = __builtin_amdgcn_mfma_f32_32x32x16_bf16(pa2, PK(l2, h2), od, 0, 0, 0);
  od = __builtin_amdgcn_mfma_f32_32x32x16_bf16(pa3, PK(l3, h3), od, 0, 0, 0);
#undef PK
}
__device__ __forceinline__ void pv_d0(f32x16* o, int vb, bf16x8 pa0, bf16x8 pa1, bf16x8 pa2, bf16x8 pa3) {
  pv_one<0>(o[0], vb, pa0, pa1, pa2, pa3); pv_one<1>(o[1], vb, pa0, pa1, pa2, pa3); pv_one<2>(o[2], vb, pa0, pa1, pa2, pa3); pv_one<3>(o[3], vb, pa0, pa1, pa2, pa3);
}
__device__ __forceinline__ unsigned short f2bf(float f) { unsigned u = __builtin_bit_cast(unsigned, f); return (unsigned short)((u + 0x7fffu + ((u >> 16) & 1u)) >> 16); }
__device__ __forceinline__ void attn_unit(const bf16* __restrict__ Q, const bf16* __restrict__ KV, const bf16* __restrict__ PROJ, bf16* __restrict__ CAT, int b, int h, int qb, ATT_LAS char* lds) {
  int tid_ = threadIdx.x; asm volatile("" : "+v"(tid_));
  const int tid = tid_, wid = __builtin_amdgcn_readfirstlane(tid >> 6), lane = tid & 63, r32 = lane & 31, hi = lane >> 5;
  ATT_LAS char* V_lds = lds + OFF_V; ATT_LAS char* K_lds = lds + OFF_K; ATT_LAS char* R_lds = lds + OFF_R;
  ATT_LAS float* wsp = (ATT_LAS float*)(lds + OFF_WS) + wid * 64; ATT_LAS float* li_l = wsp; ATT_LAS float* al_l = wsp + 32;
  float m_reg = -1e30f, l_reg = 0; f32x16 o[4] = {}; bf16x8 qr[12];
  const size_t tok0 = (size_t)b * 4096;
  const bf16* Qw = Q + (tok0 + (size_t)qb * 256 + wid * 32 + r32) * 3072 + h * 192 + hi * 8;
#pragma unroll
  for (int d0 = 0; d0 < 12; ++d0) qr[d0] = *reinterpret_cast<const bf16x8*>(Qw + d0 * 16);
  const int cw = qb * 4 + (wid >> 1), NT = qb * 4 + 4;
  const int sr = tid >> 4, sc = (tid & 15) * 8, vst0 = v_st(sr, sc), vst1 = v_st(32 + sr, sc), kst0 = KSWZ(sr, sc * 2), kst1 = KSWZ(32 + sr, sc * 2);
  const int rr = tid >> 3, rc = (tid & 7) * 8, rst = RSWZ(rr, rc * 2);
  const bf16* Kg = KV + tok0 * 4096 + h * 256;
  const bf16* Rg = PROJ + tok0 * 6912 + 3584;
  const int vb0 = (int)(uintptr_t)V_lds + v_rd_base(lane);
  bf16x8 sv0, sv1, sk0, sk1, srp;
#define ATT_SLOAD(k0) do { sv0 = *reinterpret_cast<const bf16x8*>(Kg + (size_t)((k0) + sr) * 4096 + 128 + sc); sv1 = *reinterpret_cast<const bf16x8*>(Kg + (size_t)((k0) + 32 + sr) * 4096 + 128 + sc); \
    sk0 = *reinterpret_cast<const bf16x8*>(Kg + (size_t)((k0) + sr) * 4096 + sc); sk1 = *reinterpret_cast<const bf16x8*>(Kg + (size_t)((k0) + 32 + sr) * 4096 + sc); \
    srp = *reinterpret_cast<const bf16x8*>(Rg + (size_t)((k0) + rr) * 6912 + rc); } while (0)
#define ATT_SWRITE(bf) do { *reinterpret_cast<ATT_LAS bf16x8*>(V_lds + (bf) * SHM_V + vst0) = sv0; *reinterpret_cast<ATT_LAS bf16x8*>(V_lds + (bf) * SHM_V + vst1) = sv1; \
    *reinterpret_cast<ATT_LAS bf16x8*>(K_lds + (bf) * SHM_K + kst0) = sk0; *reinterpret_cast<ATT_LAS bf16x8*>(K_lds + (bf) * SHM_K + kst1) = sk1; \
    *reinterpret_cast<ATT_LAS bf16x8*>(R_lds + (bf) * SHM_R + rst) = srp; } while (0)
#define ATT_RESC(a) do { if (__any((a) < 1.f)) { if (hi == 0) al_l[r32] = (a); asm volatile("s_waitcnt lgkmcnt(0)" ::: "memory"); \
    _Pragma("unroll") for (int d = 0; d < 4; ++d) _Pragma("unroll") for (int r = 0; r < 16; ++r) o[d][r] *= al_l[crow(r, hi)]; } } while (0)
  ATT_SLOAD(0); asm volatile("s_waitcnt vmcnt(0)" ::: "memory"); ATT_SWRITE(0); __syncthreads();
  for (int t = 0; t < NT; ++t) {
    const int bf = t & 1;
    if (t + 1 < NT) ATT_SLOAD((t + 1) * 64);
    if (t <= cw) {
      f32x16 p0, p1; float mn, al; bf16x8 pa0, pa1, pa2, pa3;
      qkt(p0, p1, K_lds + bf * SHM_K, R_lds + bf * SHM_R, qr, r32, hi);
      partialSM(p0, p1, m_reg, mn, al);
      ATT_RESC(al);
      finishSM(p0, p1, al, l_reg, pa0, pa1, pa2, pa3); SBAR();
      pv_d0(o, vb0 + bf * SHM_V, pa0, pa1, pa2, pa3);
    }
    if (t + 1 < NT) { asm volatile("s_waitcnt vmcnt(0)" ::: "memory"); ATT_SWRITE(bf ^ 1); }
    __syncthreads();
  }
  if (hi == 0) li_l[r32] = l_reg; asm volatile("s_waitcnt lgkmcnt(0)" ::: "memory");
  float rli[16];
#pragma unroll
  for (int r = 0; r < 16; ++r) rli[r] = __builtin_amdgcn_rcpf(li_l[crow(r, hi)]);
  bf16* Ow = CAT + (tok0 + (size_t)qb * 256 + wid * 32) * 4096 + 1024 + h * 128;
#pragma unroll
  for (int r = 0; r < 16; ++r) { const int orow = crow(r, hi);
#pragma unroll
    for (int d0 = 0; d0 < 4; ++d0) Ow[(size_t)orow * 4096 + d0 * 32 + r32] = f2bf(o[d0][r] * rli[r]); }
#undef ATT_SLOAD
#undef ATT_SWRITE
#undef ATT_RESC
}
}
constexpr int NWAVES = 8;
constexpr int BATCH = 2, SEQ = 4096, DM = 4096, M = BATCH * SEQ, DEPTH = 2, FF = 16384;
constexpr int INW = 6720, INP = 6912;
constexpr int C_U = 0, C_V = 1024, C_CQ = 2048, C_CKV = 3072, C_KR = 3584, C_RQ = 3648, C_RK = 4160, C_RV = 4672, C_RG = 5696;
constexpr int QW = 3072, KVW = 4096;
constexpr float EPS = 1e-6f;
constexpr size_t MiB = 1u << 20;
constexpr size_t WS_CTL = 0, CTL_ZERO_BYTES = 1 * MiB;
constexpr size_t WS_ROPE = 1 * MiB;
constexpr size_t WS_SSQ = 2 * MiB;
constexpr size_t WS_RS = 3 * MiB;
constexpr size_t WS_W = 4 * MiB, LW = 353 * MiB;
constexpr size_t W_IN = 0, W_Q = 54 * MiB, W_KV = 60 * MiB, W_OUT = 64 * MiB, W_UP = 96 * MiB, W_DOWN = 224 * MiB, W_SGU = 352 * MiB;
constexpr size_t WS_H = WS_W + 2 * LW;
constexpr size_t WS_PROJ = WS_H + 64 * MiB;
constexpr size_t WS_Q = WS_PROJ + 108 * MiB;
constexpr size_t WS_KV = WS_Q + 48 * MiB;
constexpr size_t WS_CAT = WS_KV + 64 * MiB;
constexpr size_t WS_MIX = WS_CAT + 64 * MiB;
constexpr size_t WS_ACT = WS_MIX + 64 * MiB;
constexpr size_t WS_KVS = WS_ACT + 256 * MiB;
constexpr size_t WS_SB = WS_KVS + 32 * MiB;
constexpr size_t WS_END = WS_SB + 16 * MiB;
static_assert((size_t)INP * DM * 2 == 54 * MiB && (size_t)M * INP * 2 == 108 * MiB, "map");
constexpr int CW_BAR = 4096;
constexpr int RING_OFF = 0, RING_BYTES = 131072;
constexpr int LDSCTL_OFF = RING_BYTES, MISC_OFF = LDSCTL_OFF + 320;
constexpr int LDS_BYTES = 147456;
#define GAS __attribute__((address_space(1)))
#define LAS __attribute__((address_space(3)))
typedef unsigned short bf16;
typedef unsigned v4u __attribute__((ext_vector_type(4)));
typedef float f32x4 __attribute__((ext_vector_type(4)));
typedef short bf16x8 __attribute__((ext_vector_type(8)));
typedef GAS unsigned gu32;
typedef GAS unsigned long long gu64;
#define RLX_AGENT __ATOMIC_RELAXED, __HIP_MEMORY_SCOPE_AGENT
#define LDS_WAIT() asm volatile("s_waitcnt lgkmcnt(0)" ::: "memory")
#define VM_WAIT() asm volatile("s_waitcnt vmcnt(0)" ::: "memory")
__device__ __forceinline__ unsigned long long rt() { return __builtin_amdgcn_s_memrealtime(); }
__device__ __forceinline__ unsigned f2bf(float f) { unsigned u = __builtin_bit_cast(unsigned, f); return (u + 0x7fffu + ((u >> 16) & 1u)) >> 16; }
__device__ __forceinline__ unsigned pk2(float lo, float hi) { return f2bf(lo) | (f2bf(hi) << 16); }

#define XB_TMO      128
#define XB_XCNT(j)  (256  + 64 * (j))
#define XB_XSUB(j)  (1280 + 64 * (j))
#define XB_XGEN(j)  (2304 + 64 * (j))
#define XB_TOP      3328
#define XB_TOPGEN   3392
#define XCD_BAR_WORDS 3456
#define XB_SPIN_CAP (1u << 18)

__device__ __forceinline__ unsigned xb_ld(unsigned* p)              { return __hip_atomic_load(p, __ATOMIC_RELAXED, __HIP_MEMORY_SCOPE_AGENT); }
__device__ __forceinline__ unsigned xb_add(unsigned* p, unsigned v) { return __hip_atomic_fetch_add(p, v, __ATOMIC_RELAXED, __HIP_MEMORY_SCOPE_AGENT); }
__device__ __forceinline__ unsigned xb_xcc_id() { return (unsigned)__builtin_amdgcn_s_getreg((3 << 11) | 20) & 0xFu; }
#define XB_SPIN(cond, bar) do { unsigned _sp = 0; while (cond) { __builtin_amdgcn_s_sleep(1); \
    if ((++_sp & 255u) == 0u) { if (xb_ld(&(bar)[XB_TMO])) break; if (_sp > XB_SPIN_CAP) { atomicAdd(&(bar)[XB_TMO], 1u); break; } } } } while (0)

struct XcdBarrier {
    unsigned* bar; unsigned x;
    volatile LAS unsigned* st;
};

__device__ __forceinline__ XcdBarrier xcd_barrier_post(unsigned* bar, volatile LAS unsigned* st) {
    XcdBarrier b; b.bar = bar; b.x = xb_xcc_id(); b.st = st;
    if (threadIdx.x == 0) (void)xb_add(&bar[XB_XCNT(b.x)], 1u);
    return b;
}
__device__ __forceinline__ void xcd_barrier_complete(unsigned* bar, unsigned x, unsigned& nloc, unsigned& nx) {
    const unsigned G = gridDim.x * gridDim.y * gridDim.z;
    unsigned sum, cnt, mine, sp = 0u;
    for (;;) {
        sum = 0u; cnt = 0u; mine = 0u;
#pragma unroll
        for (unsigned j = 0; j < 16; ++j) { const unsigned c = xb_ld(&bar[XB_XCNT(j)]); sum += c; cnt += (c > 0u) ? 1u : 0u; mine = (j == x) ? c : mine; }
        if (sum == G) break;
        __builtin_amdgcn_s_sleep(1);
        if ((++sp & 255u) == 0u) { if (xb_ld(&bar[XB_TMO])) break; if (sp > XB_SPIN_CAP) { atomicAdd(&bar[XB_TMO], 1u); break; } }
    }
    nloc = mine > 0u ? mine : 1u; nx = cnt > 0u ? cnt : 1u;
}

__device__ __forceinline__ void xcd_barrier(const XcdBarrier& b) {
    asm volatile("s_waitcnt vmcnt(0)" ::: "memory");
    __syncthreads();
    if (threadIdx.x == 0) {
        unsigned* bar = b.bar;
        __builtin_amdgcn_s_waitcnt(0);
        unsigned nloc = b.st[0], nx = b.st[1];
        if (nloc == 0u) { xcd_barrier_complete(bar, b.x, nloc, nx); b.st[0] = nloc; b.st[1] = nx; }
        const unsigned old = xb_add(&bar[XB_XSUB(b.x)], 1u);
        const unsigned gen = old / nloc;
        if (old + 1u == (gen + 1u) * nloc) {
            __builtin_amdgcn_fence(__ATOMIC_RELEASE, "agent");
            asm volatile("s_waitcnt vmcnt(0)" ::: "memory");
            const unsigned og = xb_add(&bar[XB_TOP], 1u);
            const unsigned tg = og / nx;
            if (og + 1u == (tg + 1u) * nx) xb_add(&bar[XB_TOPGEN], 1u);
            else XB_SPIN(xb_ld(&bar[XB_TOPGEN]) == tg, bar);
            __builtin_amdgcn_fence(__ATOMIC_ACQUIRE, "agent");
            xb_add(&bar[XB_XGEN(b.x)], 1u);
            asm volatile("s_waitcnt vmcnt(0)" ::: "memory");
        } else {
            XB_SPIN(xb_ld(&bar[XB_XGEN(b.x)]) == gen, bar);
            __builtin_amdgcn_fence(__ATOMIC_ACQUIRE, "agent");
            asm volatile("s_waitcnt vmcnt(0)" ::: "memory");
        }
    }
    __syncthreads();
}
typedef float f32x16 __attribute__((ext_vector_type(16)));
struct Frame {
    LAS unsigned char* lds; int tid, lane, wave, vcu, G;
};
__device__ __forceinline__ Frame make_frame(LAS unsigned char* lds) {
    Frame F; F.lds = lds; int t = threadIdx.x; asm volatile("" : "+v"(t)); int bx = blockIdx.x; asm volatile("" : "+s"(bx));
    F.tid = t; F.lane = t & 63; F.wave = __builtin_amdgcn_readfirstlane(t >> 6); F.G = gridDim.x;
    F.vcu = (F.G % 8 == 0) ? (bx % 8) * (F.G / 8) + bx / 8 : bx; return F;
}
__device__ __forceinline__ float bf2f(unsigned short h) { return __builtin_bit_cast(float, (unsigned)h << 16); }
__device__ __forceinline__ unsigned short f2bf16(float f) { return (unsigned short)f2bf(f); }
__device__ __forceinline__ float wave_sum(float v) {
#pragma unroll
    for (int o = 1; o < 64; o <<= 1) v += __shfl_xor(v, o);
    return v;
}
__device__ __forceinline__ int crow32(int r, int hi) { return (r & 3) + 8 * (r >> 2) + 4 * hi; }
template <int KSTEPS> __device__ __forceinline__ void mfma_lds(f32x16& acc, const LAS bf16* A, int pa, const LAS bf16* Bt, int pb, int r32, int hi) {
#pragma unroll
    for (int s = 0; s < KSTEPS; ++s) {
        const bf16x8 a = *(const LAS bf16x8*)(A + r32 * pa + s * 16 + hi * 8);
        const bf16x8 b = *(const LAS bf16x8*)(Bt + r32 * pb + s * 16 + hi * 8);
        acc = __builtin_amdgcn_mfma_f32_32x32x16_bf16(a, b, acc, 0, 0, 0);
    }
}
struct CvtDesc { const float* W; bf16* WT; const float* kgain; int K, N, k0, n0, kind; };
__device__ __forceinline__ void cvt_load(const CvtDesc& d, float (&v)[32], int lane) {
    if (d.kind == 0) {
        const int q = lane >> 3, n4 = (lane & 7) * 4; const float* src = d.W + (size_t)(d.k0 + q) * d.N + d.n0 + n4;
#pragma unroll
        for (int i = 0; i < 8; ++i) { const f32x4 t = __builtin_nontemporal_load((const f32x4*)(src + (size_t)(8 * i) * d.N)); v[4 * i] = t[0]; v[4 * i + 1] = t[1]; v[4 * i + 2] = t[2]; v[4 * i + 3] = t[3]; }
        if (d.kgain) {
#pragma unroll
            for (int i = 0; i < 8; ++i) { const float g = d.kgain[d.k0 + 8 * i + q]; v[4 * i] *= g; v[4 * i + 1] *= g; v[4 * i + 2] *= g; v[4 * i + 3] *= g; } }
        return; }
    const int nd = d.n0 + (lane & 31); bool ok = true; int sc = nd; float cs = 1.f;
    if (d.kind == 1) { ok = nd < INW; sc = (nd >= C_KR && nd < C_RV) ? (nd & ~63) + ((nd & 63) >> 1) + 32 * (nd & 1) : nd; cs = (nd >= C_RQ && nd < C_RK) ? 0.125f : 1.f; if (!ok) sc = 0; }
    if (d.kind == 2) { sc = ((nd % 192) >= 128) ? (nd & ~63) + ((nd & 63) >> 1) + 32 * (nd & 1) : nd; }
    const float* src = d.W + (size_t)(d.k0 + (lane >> 5)) * d.N + sc;
#pragma unroll
    for (int i = 0; i < 32; ++i) v[i] = __builtin_nontemporal_load(src + (size_t)(2 * i) * d.N);
    if (d.kgain) {
#pragma unroll
        for (int i = 0; i < 32; ++i) v[i] *= d.kgain[d.k0 + 2 * i + (lane >> 5)]; }
    if (d.kind == 1) {
#pragma unroll
        for (int i = 0; i < 32; ++i) v[i] = ok ? v[i] * cs : 0.f; }
}
template <bool NT = false> __device__ __forceinline__ void cvt_finish(const CvtDesc& d, const float (&v)[32], LAS float* scr, int lane) {
    if (d.kind == 0) { const int q = lane >> 3, n4 = (lane & 7) * 4;
#pragma unroll
        for (int i = 0; i < 8; ++i) { LAS float* s = scr + (8 * i + q) * 33 + n4; s[0] = v[4 * i]; s[1] = v[4 * i + 1]; s[2] = v[4 * i + 2]; s[3] = v[4 * i + 3]; } }
    else {
#pragma unroll
        for (int i = 0; i < 32; ++i) scr[(2 * i + (lane >> 5)) * 33 + (lane & 31)] = v[i]; }
    LDS_WAIT(); asm volatile("" ::: "memory");
    const int c = lane & 7;
#pragma unroll
    for (int j = 0; j < 4; ++j) { const int n = (lane >> 3) + 8 * j; const LAS float* s = scr + (8 * c) * 33 + n;
        v4u o; o.x = pk2(s[0 * 33], s[1 * 33]); o.y = pk2(s[2 * 33], s[3 * 33]); o.z = pk2(s[4 * 33], s[5 * 33]); o.w = pk2(s[6 * 33], s[7 * 33]);
        if (NT) __builtin_nontemporal_store(o, (GAS v4u*)(d.WT + (size_t)(d.n0 + n) * d.K + d.k0 + 8 * c)); else *(GAS v4u*)(d.WT + (size_t)(d.n0 + n) * d.K + d.k0 + 8 * c) = o; }
    LDS_WAIT(); asm volatile("" ::: "memory");
}
__device__ __forceinline__ void x_row_to_bf16(const float* __restrict__ xrow, bf16* __restrict__ orow, float* __restrict__ rs, int lane) {
    f32x4 v[16]; float s = 0.f;
#pragma unroll
    for (int j = 0; j < 8; ++j) { const f32x4* p = (const f32x4*)(xrow + 8 * (lane + 64 * j)); v[2 * j] = p[0]; v[2 * j + 1] = p[1]; }
#pragma unroll
    for (int j = 0; j < 16; ++j) s += (v[j][0] * v[j][0] + v[j][1] * v[j][1]) + (v[j][2] * v[j][2] + v[j][3] * v[j][3]);
    const float r = 1.0f / sqrtf(wave_sum(s) * (1.0f / 4096.0f) + EPS);
    if (lane == 0) *rs = r;
#pragma unroll
    for (int j = 0; j < 8; ++j) { const f32x4 a = v[2 * j], b = v[2 * j + 1];
        v4u o; o.x = pk2(a[0], a[1]); o.y = pk2(a[2], a[3]); o.z = pk2(b[0], b[1]); o.w = pk2(b[2], b[3]);
        *(v4u*)(orow + 8 * (lane + 64 * j)) = o; }
}
__device__ __forceinline__ void unpack8(const v4u q, float* y) {
    y[0] = __builtin_bit_cast(float, q.x << 16); y[1] = __builtin_bit_cast(float, q.x & 0xffff0000u); y[2] = __builtin_bit_cast(float, q.y << 16); y[3] = __builtin_bit_cast(float, q.y & 0xffff0000u);
    y[4] = __builtin_bit_cast(float, q.z << 16); y[5] = __builtin_bit_cast(float, q.z & 0xffff0000u); y[6] = __builtin_bit_cast(float, q.w << 16); y[7] = __builtin_bit_cast(float, q.w & 0xffff0000u);
}
__device__ __forceinline__ void residual_row(const float* __restrict__ xin32, bf16* xb, const bf16* __restrict__ yrow, const float* __restrict__ gpost, float* __restrict__ out32, float* __restrict__ rs_next, bool last, int lane) {
    float x[64], y[64]; float s = 0.f;
#pragma unroll
    for (int j = 0; j < 8; ++j) { unpack8(*(const v4u*)(yrow + 8 * (lane + 64 * j)), y + 8 * j);
        if (xin32) { const f32x4* p = (const f32x4*)(xin32 + 8 * (lane + 64 * j)); const f32x4 a = p[0], b = p[1];
#pragma unroll
            for (int e = 0; e < 4; ++e) { x[8 * j + e] = a[e]; x[8 * j + 4 + e] = b[e]; } }
        else unpack8(*(const v4u*)(xb + 8 * (lane + 64 * j)), x + 8 * j); }
#pragma unroll
    for (int i = 0; i < 64; ++i) s += y[i] * y[i];
    const float r = 1.0f / sqrtf(wave_sum(s) * (1.0f / 4096.0f) + EPS);
    float s2 = 0.f;
#pragma unroll
    for (int j = 0; j < 8; ++j) { const f32x4* gp = (const f32x4*)(gpost + 8 * (lane + 64 * j)); const f32x4 g0 = gp[0], g1 = gp[1];
#pragma unroll
        for (int e = 0; e < 4; ++e) { x[8 * j + e] += y[8 * j + e] * r * g0[e]; x[8 * j + 4 + e] += y[8 * j + 4 + e] * r * g1[e]; }
#pragma unroll
        for (int e = 0; e < 8; ++e) s2 += x[8 * j + e] * x[8 * j + e];
        if (last) { f32x4* op = (f32x4*)(out32 + 8 * (lane + 64 * j)); op[0] = (f32x4){x[8 * j], x[8 * j + 1], x[8 * j + 2], x[8 * j + 3]}; op[1] = (f32x4){x[8 * j + 4], x[8 * j + 5], x[8 * j + 6], x[8 * j + 7]}; }
        else { v4u o; o.x = pk2(x[8 * j], x[8 * j + 1]); o.y = pk2(x[8 * j + 2], x[8 * j + 3]); o.z = pk2(x[8 * j + 4], x[8 * j + 5]); o.w = pk2(x[8 * j + 6], x[8 * j + 7]);
            *(v4u*)(xb + 8 * (lane + 64 * j)) = o; } }
    if (!last) { const float r2 = 1.0f / sqrtf(wave_sum(s2) * (1.0f / 4096.0f) + EPS); if (lane == 0) *rs_next = r2; }
}
__device__ __forceinline__ float ret_lg(int h) { return log1pf(-exp2f(-5.0f - (float)h)); }
__device__ __forceinline__ void sgu_phase(LAS unsigned char* lds_, const bf16* __restrict__ PROJ, bf16* __restrict__ CAT, const bf16* __restrict__ SGW, const float* __restrict__ lng, const float* __restrict__ lnb, const float* __restrict__ bs) {
    const Frame F = make_frame(lds_);
    LAS bf16* Wm = (LAS bf16*)(F.lds + RING_OFF);
    LAS bf16* VT = Wm + 128 * 136;
    const int r32 = F.lane & 31, hi = F.lane >> 5;
    const int ib = F.wave >> 1, cb0 = (F.wave & 1) * 2;
    bf16x8 w4[4]; unsigned pv[16]; unsigned short ua[16], ub[16]; float bias[16];
#define SGU_LOAD(u_) do { const int b_ = (u_) >> 8, n_ = ((u_) >> 3) & 31, g_ = (u_) & 7; const size_t R_ = (size_t)b_ * SEQ + (size_t)n_ * 128; const int cb_ = g_ * 128; \
        _Pragma("unroll") for (int k = 0; k < 4; ++k) { const int q = F.tid + k * 512; w4[k] = *(const bf16x8*)(SGW + ((size_t)g_ * 128 + (q >> 4)) * 128 + (q & 15) * 8); } \
        _Pragma("unroll") for (int jj = 0; jj < 16; ++jj) pv[jj] = *(const unsigned*)(PROJ + (R_ + F.wave * 16 + jj) * INP + C_V + cb_ + 2 * F.lane); } while (0)
#define SGU_LOADU(u_) do { const int b_ = (u_) >> 8, n_ = ((u_) >> 3) & 31, g_ = (u_) & 7; const size_t R_ = (size_t)b_ * SEQ + (size_t)n_ * 128; const int cb_ = g_ * 128; \
        _Pragma("unroll") for (int r = 0; r < 16; ++r) { const int i = ib * 32 + crow32(r, hi); bias[r] = bs[g_ * 128 + i]; \
            ua[r] = PROJ[(R_ + i) * INP + C_U + cb_ + cb0 * 32 + r32]; ub[r] = PROJ[(R_ + i) * INP + C_U + cb_ + cb0 * 32 + r32 + 32]; } } while (0)
    if (F.vcu < 512) { SGU_LOAD(F.vcu); SGU_LOADU(F.vcu); }
    for (int unit = F.vcu; unit < 512; unit += F.G) {
        const int b = unit >> 8, n = (unit >> 3) & 31, g = unit & 7;
        const size_t R0 = (size_t)b * SEQ + (size_t)n * 128; const int cb = g * 128;
#pragma unroll
        for (int k = 0; k < 4; ++k) { const int q = F.tid + k * 512; *(LAS bf16x8*)(Wm + (q >> 4) * 136 + (q & 15) * 8) = w4[k]; }
        const float g0 = lng[cb + 2 * F.lane], g1 = lng[cb + 2 * F.lane + 1], b0 = lnb[cb + 2 * F.lane], b1 = lnb[cb + 2 * F.lane + 1];
#pragma unroll
        for (int jj = 0; jj < 16; ++jj) { const int j = F.wave * 16 + jj;
            const float x0 = __builtin_bit_cast(float, pv[jj] << 16), x1 = __builtin_bit_cast(float, pv[jj] & 0xffff0000u);
            const float mu = wave_sum(x0 + x1) * (1.0f / 128.0f), d0 = x0 - mu, d1 = x1 - mu;
            const float rstd = 1.0f / sqrtf(wave_sum(d0 * d0 + d1 * d1) * (1.0f / 128.0f) + EPS);
            VT[(2 * F.lane) * 136 + j] = f2bf16(d0 * rstd * g0 + b0); VT[(2 * F.lane + 1) * 136 + j] = f2bf16(d1 * rstd * g1 + b1); }
        __syncthreads();
        if (unit + F.G < 512) SGU_LOAD(unit + F.G);
        f32x16 acc0 = {}, acc1 = {};
        mfma_lds<8>(acc0, Wm + ib * 32 * 136, 136, VT + (cb0 * 32) * 136, 136, r32, hi);
        mfma_lds<8>(acc1, Wm + ib * 32 * 136, 136, VT + ((cb0 + 1) * 32) * 136, 136, r32, hi);
#pragma unroll
        for (int r = 0; r < 16; ++r) { const int i = ib * 32 + crow32(r, hi); const size_t row = R0 + i; const int c = cb0 * 32 + r32;
            CAT[row * DM + cb + c] = f2bf16(bf2f(ua[r]) * (acc0[r] + bias[r])); CAT[row * DM + cb + c + 32] = f2bf16(bf2f(ub[r]) * (acc1[r] + bias[r])); }
        if (unit + F.G < 512) SGU_LOADU(unit + F.G);
        __syncthreads();
    }
#undef SGU_LOAD
#undef SGU_LOADU
}
__device__ __forceinline__ void ret1_phase(LAS unsigned char* lds_, const bf16* __restrict__ PROJ, float* __restrict__ KVS) {
    const Frame F = make_frame(lds_);
    LAS bf16* KT = (LAS bf16*)(F.lds + RING_OFF);
    LAS bf16* VT = KT + 64 * 72;
    const int r32 = F.lane & 31, hi = F.lane >> 5;
    const int m = F.tid >> 3, d0 = (F.tid & 7) * 8, e0 = (F.tid & 7) * 16;
    bf16x8 kv, va, vb;
#define R1_LOAD(u_) do { const int bh_ = (u_) >> 6, c_ = (u_) & 63; const size_t R_ = (size_t)(bh_ >> 3) * SEQ + (size_t)c_ * 64 + m; const int h_ = bh_ & 7; \
        kv = *(const bf16x8*)(PROJ + R_ * INP + C_RK + h_ * 64 + d0); va = *(const bf16x8*)(PROJ + R_ * INP + C_RV + h_ * 128 + e0); vb = *(const bf16x8*)(PROJ + R_ * INP + C_RV + h_ * 128 + e0 + 8); } while (0)
    if (F.vcu < 1024) R1_LOAD(F.vcu);
    for (int unit = F.vcu; unit < 1024; unit += F.G) {
        const int bh = unit >> 6, h = bh & 7; const float lg = ret_lg(h);
        const float kd = expf(lg * (float)(63 - m));
#pragma unroll
        for (int i = 0; i < 8; ++i) KT[(d0 + i) * 72 + m] = f2bf16(bf2f((unsigned short)kv[i]) * kd);
#pragma unroll
        for (int i = 0; i < 8; ++i) { VT[(e0 + i) * 72 + m] = (unsigned short)va[i]; VT[(e0 + 8 + i) * 72 + m] = (unsigned short)vb[i]; }
        __syncthreads();
        if (unit + F.G < 1024) R1_LOAD(unit + F.G);
        const int eb = F.wave >> 1, db = F.wave & 1;
        f32x16 acc = {};
        mfma_lds<4>(acc, VT + eb * 32 * 72, 72, KT + db * 32 * 72, 72, r32, hi);
#pragma unroll
        for (int r = 0; r < 16; ++r) KVS[((size_t)unit * 128 + eb * 32 + crow32(r, hi)) * 64 + db * 32 + r32] = acc[r];
        __syncthreads();
    }
#undef R1_LOAD
}
__device__ __forceinline__ void ret2_phase(LAS unsigned char* lds_, const float* __restrict__ KVS, bf16* __restrict__ SB) {
    const Frame F = make_frame(lds_);
    for (int gid = F.vcu * (NWAVES * 64) + F.tid; gid < 16 * 8192; gid += F.G * NWAVES * 64) {
        const int bh = gid >> 13, idx = gid & 8191; const float cd = expf(ret_lg(bh & 7) * 64.0f);
        const size_t o0 = (size_t)bh * 64 * 8192 + idx;
        float S = 0.f;
#pragma unroll
        for (int c0 = 0; c0 < 64; c0 += 32) {
            float kv[32];
#pragma unroll
            for (int c = 0; c < 32; ++c) kv[c] = KVS[o0 + (size_t)(c0 + c) * 8192];
#pragma unroll
            for (int c = 0; c < 32; ++c) { SB[o0 + (size_t)(c0 + c) * 8192] = f2bf16(S); S = cd * S + kv[c]; }
        }
    }
}
__device__ __forceinline__ void ret3_phase(LAS unsigned char* lds_, const bf16* __restrict__ PROJ, const bf16* __restrict__ SB, bf16* __restrict__ CAT) {
    const Frame F = make_frame(lds_);
    LAS bf16* Qs = (LAS bf16*)(F.lds + RING_OFF);
    LAS bf16* Ks = Qs + 64 * 72;
    LAS bf16* VT = Ks + 64 * 72;
    LAS bf16* Ss = VT + 128 * 72;
    LAS bf16* Ps = Ss + 128 * 72;
    LAS float* red = (LAS float*)(Ps + 64 * 72);
    const int r32 = F.lane & 31, hi = F.lane >> 5;
    const int m = F.tid >> 3, d0 = (F.tid & 7) * 8, e0 = (F.tid & 7) * 16;
    bf16x8 rq, rk, rva, rvb, rs0, rs1;
#define R3_LOAD(u_) do { const int bh_ = (u_) >> 6, c_ = (u_) & 63; const size_t R_ = (size_t)(bh_ >> 3) * SEQ + (size_t)c_ * 64 + m; const int h_ = bh_ & 7; \
        rq = *(const bf16x8*)(PROJ + R_ * INP + C_RQ + h_ * 64 + d0); rk = *(const bf16x8*)(PROJ + R_ * INP + C_RK + h_ * 64 + d0); \
        rva = *(const bf16x8*)(PROJ + R_ * INP + C_RV + h_ * 128 + e0); rvb = *(const bf16x8*)(PROJ + R_ * INP + C_RV + h_ * 128 + e0 + 8); \
        rs0 = *(const bf16x8*)(SB + (size_t)(u_) * 8192 + F.tid * 8); rs1 = *(const bf16x8*)(SB + (size_t)(u_) * 8192 + (F.tid + 512) * 8); } while (0)
    if (F.vcu < 1024) R3_LOAD(F.vcu);
    for (int unit = F.vcu; unit < 1024; unit += F.G) {
        const int bh = unit >> 6, c = unit & 63, b = bh >> 3, h = bh & 7; const float lg = ret_lg(h);
        const size_t R0 = (size_t)b * SEQ + (size_t)c * 64;
        *(LAS bf16x8*)(Qs + m * 72 + d0) = rq; *(LAS bf16x8*)(Ks + m * 72 + d0) = rk;
#pragma unroll
        for (int i = 0; i < 8; ++i) { VT[(e0 + i) * 72 + m] = (unsigned short)rva[i]; VT[(e0 + 8 + i) * 72 + m] = (unsigned short)rvb[i]; }
        *(LAS bf16x8*)(Ss + (F.tid >> 3) * 72 + (F.tid & 7) * 8) = rs0; *(LAS bf16x8*)(Ss + ((F.tid + 512) >> 3) * 72 + (F.tid & 7) * 8) = rs1;
        __syncthreads();
        if (unit + F.G < 1024) R3_LOAD(unit + F.G);
        const int lb = F.wave & 1, eb = F.wave >> 1;
        unsigned short gt[16];
#pragma unroll
        for (int r = 0; r < 16; ++r) gt[r] = PROJ[(R0 + lb * 32 + crow32(r, hi)) * INP + C_RG + h * 128 + eb * 32 + r32];
        f32x16 cross = {};
        mfma_lds<4>(cross, Qs + lb * 32 * 72, 72, Ss + eb * 32 * 72, 72, r32, hi);
        if (F.wave < 4) { const int mb = F.wave >> 1; f32x16 sc = {};
            mfma_lds<4>(sc, Qs + lb * 32 * 72, 72, Ks + mb * 32 * 72, 72, r32, hi);
#pragma unroll
            for (int r = 0; r < 16; ++r) { const int l = lb * 32 + crow32(r, hi), mm = mb * 32 + r32; const int ad = l > mm ? l - mm : mm - l;
                Ps[l * 72 + mm] = f2bf16(sc[r] * expf(lg * (float)ad)); } }
        __syncthreads();
        f32x16 o = {};
        mfma_lds<4>(o, Ps + lb * 32 * 72, 72, VT + eb * 32 * 72, 72, r32, hi);
#pragma unroll
        for (int r = 0; r < 16; ++r) { const int l = lb * 32 + crow32(r, hi); o[r] += cross[r] * expf(lg * (float)(l + 1));
            float s = o[r] * o[r];
#pragma unroll
            for (int x = 1; x < 32; x <<= 1) s += __shfl_xor(s, x);
            if (r32 == 0) red[l * 4 + eb] = s; }
        __syncthreads();
#pragma unroll
        for (int r = 0; r < 16; ++r) { const int l = lb * 32 + crow32(r, hi); const f32x4 t = *(const LAS f32x4*)(red + l * 4);
            const float rn = 1.0f / sqrtf(((t[0] + t[1]) + (t[2] + t[3])) * (1.0f / 128.0f) + EPS); const int e = eb * 32 + r32;
            const float g = bf2f(gt[r]); const float sg = g / (1.0f + expf(-g));
            CAT[(R0 + l) * DM + 3072 + h * 128 + e] = f2bf16(sg * (o[r] * rn)); }
        __syncthreads();
    }
#undef R3_LOAD
}
#define CVT_LOOP(NITEMS, NIF, NTS) do { for (int it = gw; it < (NITEMS); it += (NIF) * NGW) { float vv[NIF][32]; \
    _Pragma("unroll") for (int j = 0; j < (NIF); ++j) if (it + j * NGW < (NITEMS)) { const CvtDesc d = desc_of(it + j * NGW); cvt_load(d, vv[j], F.lane); } \
    _Pragma("unroll") for (int j = 0; j < (NIF); ++j) if (it + j * NGW < (NITEMS)) { const CvtDesc d = desc_of(it + j * NGW); cvt_finish<NTS>(d, vv[j], scr, F.lane); } } } while (0)
#ifndef PRO_NIF
#define PRO_NIF 2
#endif
#ifndef DEF_NIF
#define DEF_NIF 1
#endif
#ifndef DEF_NT
#define DEF_NT true
#endif
#ifndef DOWN_KREV
#define DOWN_KREV 1
#endif
#ifndef UP_DEFER
#define UP_DEFER 6144
#endif
#ifndef WARM_UP
#define WARM_UP 0
#endif
#ifndef MID_CONV
#define MID_CONV 1
#endif
#ifndef DEF_WV
#define DEF_WV 8
#endif
#ifndef DN_DEFER
#define DN_DEFER 32768
#endif
#ifndef GEMM_ALIGN
#define GEMM_ALIGN true
#endif
#ifndef GEMM_SP2
#define GEMM_SP2 true
#endif
#ifndef REP_PRO
#define REP_PRO 1
#endif
#ifndef REP_ATTN
#define REP_ATTN 1
#endif
#ifndef REP_UP
#define REP_UP 1
#endif
#ifndef REP_IN
#define REP_IN 1
#endif
#ifndef REP_QKV
#define REP_QKV 1
#endif
#ifndef REP_RET3
#define REP_RET3 1
#endif
#ifndef BAR_DUP
#define BAR_DUP 1
#endif
#ifndef REP_OUT
#define REP_OUT 1
#endif
#ifndef REP_DOWN
#define REP_DOWN 1
#endif
#ifndef REP_RES
#define REP_RES 1
#endif
#ifndef REP_BAR
#define REP_BAR 0
#endif
#ifndef REP_RET2
#define REP_RET2 1
#endif
#ifndef PROBE_IDX
#define PROBE_IDX -1
#endif
#ifndef PROBE_Q
#define PROBE_Q 50
#endif
#ifndef PROBE_END
#define PROBE_END (PROBE_IDX + 1)
#endif
#ifndef PROBE_LO
#define PROBE_LO 0
#endif
#ifndef PROBE_HI
#define PROBE_HI 1000
#endif
#ifndef PROBE_L
#define PROBE_L 0
#endif
#ifndef REP_SMALL
#define REP_SMALL 1
#endif
struct Args { const float* in[17]; float* out; unsigned char* ws; };
typedef const Args __attribute__((address_space(4))) CArgs;
__device__ __forceinline__ CArgs* fresh_args() { CArgs* p = (CArgs*)__builtin_amdgcn_kernarg_segment_ptr(); asm volatile("" : "+s"(p)); return p; }
constexpr int CJ_N[6] = {(DM / 64) * (INP / 32), (1024 / 64) * (QW / 32), (512 / 64) * (KVW / 32), (DM / 64) * (DM / 32), (DM / 64) * (FF / 32), (FF / 64) * (DM / 32)};
__device__ __forceinline__ CvtDesc job_desc(CArgs* A, unsigned char* ws, int job, int l, int r) {
    unsigned char* wl = ws + WS_W + (size_t)l * LW; CvtDesc d; int nblk;
    if (job == 0) { d.W = A->in[5] + (size_t)l * DM * INW; d.WT = (bf16*)(wl + W_IN); d.kgain = A->in[1] + l * DM; d.K = DM; d.N = INW; nblk = INP / 32; d.kind = 1; }
    else if (job == 1) { d.W = A->in[11] + (size_t)l * 1024 * QW; d.WT = (bf16*)(wl + W_Q); d.kgain = A->in[10] + l * 1024; d.K = 1024; d.N = QW; nblk = QW / 32; d.kind = 2; }
    else if (job == 2) { d.W = A->in[13] + (size_t)l * 512 * KVW; d.WT = (bf16*)(wl + W_KV); d.kgain = A->in[12] + l * 512; d.K = 512; d.N = KVW; nblk = KVW / 32; d.kind = 0; }
    else if (job == 3) { d.W = A->in[14] + (size_t)l * DM * DM; d.WT = (bf16*)(wl + W_OUT); d.kgain = nullptr; d.K = DM; d.N = DM; nblk = DM / 32; d.kind = 0; }
    else if (job == 4) { d.W = A->in[15] + (size_t)l * DM * FF; d.WT = (bf16*)(wl + W_UP); d.kgain = A->in[3] + l * DM; d.K = DM; d.N = FF; nblk = FF / 32; d.kind = 0; }
    else { d.W = A->in[16] + (size_t)l * FF * DM; d.WT = (bf16*)(wl + W_DOWN); d.kgain = nullptr; d.K = FF; d.N = DM; nblk = DM / 32; d.kind = 0; }
    d.k0 = 64 * (r / nblk); d.n0 = 32 * (r % nblk); return d;
}
template <int NIF, bool NTS, int WV = NWAVES> __device__ __forceinline__ void convert_pass(LAS unsigned char* lds_, int idx, int n, int j0, int l0, int j1, int l1, int j2, int l2) {
    const Frame F = make_frame(lds_); CArgs* A = fresh_args(); unsigned char* ws = A->ws;
    LAS float* scr = (LAS float*)(F.lds + RING_OFF + F.wave * 16384);
    const int gw = idx * WV + F.wave, NGW = n * WV;
    if (F.wave >= WV) return;
    const int n0 = CJ_N[j0], n1 = j1 >= 0 ? CJ_N[j1] : 0, n2 = j2 >= 0 ? CJ_N[j2] : 0, NTOT = n0 + n1 + n2;
    auto desc_of = [&](int it) -> CvtDesc { if (it < n0) return job_desc(A, ws, j0, l0, it); it -= n0; if (it < n1) return job_desc(A, ws, j1, l1, it); return job_desc(A, ws, j2, l2, it - n1); };
    CVT_LOOP(NTOT, NIF, NTS);
}
__device__ __forceinline__ void prologue_phase(LAS unsigned char* lds_) {
    convert_pass<PRO_NIF, false>(lds_, make_frame(lds_).vcu, (int)gridDim.x, 4, 0, 0, 0, -1, 0);
    const Frame F = make_frame(lds_); CArgs* A = fresh_args(); unsigned char* ws = A->ws; float* rope = (float*)(ws + WS_ROPE); bf16* H = (bf16*)(ws + WS_H);
    const int gw = F.vcu * NWAVES + F.wave, NGW = F.G * NWAVES;
        for (int i = F.vcu * (NWAVES * 64) + F.tid; i < DEPTH * 8 * 128 * 128; i += F.G * NWAVES * 64) {
            const int l = i >> 17, r = i & 131071, ii = (r >> 7) & 127, jj = r & 127;
            ((bf16*)(ws + WS_W + (size_t)l * LW + W_SGU))[r] = ((jj >> 6) <= (ii >> 6)) ? f2bf16(A->in[8][i]) : (bf16)0; }
        for (int i = F.vcu * (NWAVES * 64) + F.tid; i < SEQ * 32; i += F.G * NWAVES * 64) {
            const int pos = i >> 5, j = i & 31; const float inv = (float)pow(10000.0, -(double)j / 32.0); const float ang = (float)pos * inv;
            float sn, cs; sincosf(ang, &sn, &cs); rope[2 * i] = cs; rope[2 * i + 1] = sn; }
        { float* rs0 = (float*)(ws + WS_RS); for (int m = gw; m < M; m += NGW) x_row_to_bf16(A->in[0] + (size_t)m * DM, H + (size_t)m * DM, rs0 + m, F.lane); }
}
__device__ __forceinline__ void residual_phase(LAS unsigned char* lds_, int l, int which, bool dry = false) {
    const Frame F = make_frame(lds_); CArgs* A = fresh_args(); unsigned char* ws = A->ws; const int gw = F.vcu * NWAVES + F.wave, NGW = F.G * NWAVES;
    const float* xin32 = (which == 0 && l == 0) ? A->in[0] : nullptr; const bf16* Y = (const bf16*)(ws + WS_MIX); bf16* XB = (bf16*)(ws + WS_H);
    const bool last = (which == 1 && l + 1 == DEPTH);
    float* out32 = dry ? (float*)(ws + WS_ACT) : A->out; float* rs_next = (float*)(ws + WS_RS) + (which == 0 ? M : 0) + (dry ? 2 * M : 0);
    if (dry) XB = (bf16*)(ws + WS_ACT + 134 * MiB);
    const float* gpost = (which == 0 ? A->in[2] : A->in[4]) + l * DM;
    for (int m = gw; m < M; m += NGW) residual_row(xin32 ? xin32 + (size_t)m * DM : nullptr, XB + (size_t)m * DM, Y + (size_t)m * DM, gpost, out32 + (size_t)m * DM, rs_next + m, last, F.lane);
}
__device__ __forceinline__ void warm_phase(LAS unsigned char* lds_, size_t off, size_t bytes, int l) {
    const Frame F = make_frame(lds_); CArgs* A = fresh_args(); const unsigned* p = (const unsigned*)(A->ws + WS_W + (size_t)l * LW + off);
    const size_t nlines = bytes / 128; unsigned acc = 0;
    for (size_t i = (size_t)F.vcu * (NWAVES * 64) + F.tid; i < nlines; i += (size_t)F.G * NWAVES * 64) acc += p[i * 32];
    if (acc == 0x12345678u) ((unsigned*)(A->ws + WS_CTL))[2048] = acc;
}
__device__ __forceinline__ void attn_phase(LAS unsigned char* lds_) {
    const Frame F = make_frame(lds_); CArgs* A = fresh_args(); unsigned char* ws = A->ws;
    const bf16* QB = (const bf16*)(ws + WS_Q); const bf16* KVB = (const bf16*)(ws + WS_KV); const bf16* PROJ = (const bf16*)(ws + WS_PROJ); bf16* CAT = (bf16*)(ws + WS_CAT);
    for (int p2 = 2 * F.vcu; p2 < 512; p2 += 2 * F.G)
        for (int k = 0; k < 2; ++k) { const int p = p2 >> 1, bh = p >> 3, s = p & 7;
            att::attn_unit(QB, KVB, PROJ, CAT, bh >> 4, bh & 15, k ? 15 - s : s, (ATT_LAS char*)(F.lds + RING_OFF)); }
}
template <int WHICH> __device__ __forceinline__ void gemm_call(LAS unsigned char* lds_, int l) {
    CArgs* A = fresh_args(); unsigned char* ws = A->ws; unsigned char* wl = ws + WS_W + (size_t)l * LW; int bx = blockIdx.x; asm volatile("" : "+s"(bx)); const int G = gridDim.x;
    float* rope = (float*)(ws + WS_ROPE); float* ssq = (float*)(ws + WS_SSQ); const float* rs = (const float*)(ws + WS_RS);
    bf16* H = (bf16*)(ws + WS_H); bf16* PROJ = (bf16*)(ws + WS_PROJ); bf16* QB = (bf16*)(ws + WS_Q); bf16* KVB = (bf16*)(ws + WS_KV);
    bf16* CAT = (bf16*)(ws + WS_CAT); bf16* MIX = (bf16*)(ws + WS_MIX); bf16* ACT = (bf16*)(ws + WS_ACT);
    pg8::StaticOrder S; const LAS float* rsl = (const LAS float*)(lds_ + LDSCTL_OFF + 1024);
    if constexpr (WHICH == 0) { pg8::Gemm g{H, (const bf16*)(wl + W_IN), M, INP, DM, DM, 0}; S.init(M, INP, G, bx); pg8::Epi<2> E{PROJ, INP, rope, ssq, rs, rsl, -1};
        pg8::gemm_phase<pg8::Epi<2>, pg8::StaticOrder, GEMM_ALIGN, GEMM_SP2>(lds_ + RING_OFF, g, S, E); }
    if constexpr (WHICH == 1) { pg8::Gemm g{PROJ + C_CQ, (const bf16*)(wl + W_Q), M, QW, 1024, INP, 0}; S.init(M, QW, G, bx); pg8::Epi<3> E{QB, QW, rope, ssq, nullptr, rsl, -1};
        pg8::gemm_phase<pg8::Epi<3>, pg8::StaticOrder, GEMM_ALIGN, GEMM_SP2>(lds_ + RING_OFF, g, S, E); }
    if constexpr (WHICH == 2) { pg8::Gemm g{PROJ + C_CKV, (const bf16*)(wl + W_KV), M, KVW, 512, INP, 0}; S.init(M, KVW, G, bx); pg8::Epi<4> E{KVB, KVW, rope, ssq, nullptr, rsl, -1};
        pg8::gemm_phase<pg8::Epi<4>, pg8::StaticOrder, GEMM_ALIGN, GEMM_SP2>(lds_ + RING_OFF, g, S, E); }
    if constexpr (WHICH == 3) { pg8::Gemm g{CAT, (const bf16*)(wl + W_OUT), M, DM, DM, DM, 0}; S.init(M, DM, G, bx); pg8::Epi<0> E{MIX, DM, rope, ssq, nullptr, rsl, -1};
        pg8::gemm_phase<pg8::Epi<0>, pg8::StaticOrder, GEMM_ALIGN, GEMM_SP2>(lds_ + RING_OFF, g, S, E); }
    if constexpr (WHICH == 4) { pg8::Gemm g{H, (const bf16*)(wl + W_UP), M, FF, DM, DM, 0}; S.init(M, FF, G, bx); pg8::Epi<1> E{ACT, FF, rope, ssq, rs + M, rsl, -1};
        pg8::gemm_phase<pg8::Epi<1>, pg8::StaticOrder, GEMM_ALIGN, GEMM_SP2>(lds_ + RING_OFF, g, S, E); }
    if constexpr (WHICH == 5) { pg8::Gemm g{ACT + (DOWN_KREV ? FF - 64 : 0), (const bf16*)(wl + W_DOWN) + (DOWN_KREV ? FF - 64 : 0), M, DM, FF, FF, DOWN_KREV};     S.init(M, DM, G, bx); pg8::Epi<0> E{MIX, DM, rope, ssq, nullptr, rsl, -1};
        pg8::gemm_phase<pg8::Epi<0>, pg8::StaticOrder, GEMM_ALIGN, GEMM_SP2>(lds_ + RING_OFF, g, S, E); }
}
__device__ __forceinline__ void mixer_small_phases(LAS unsigned char* lds_, int l) {
    CArgs* A = fresh_args(); unsigned char* ws = A->ws;
    sgu_phase(lds_, (const bf16*)(ws + WS_PROJ), (bf16*)(ws + WS_CAT), (const bf16*)(ws + WS_W + (size_t)l * LW + W_SGU), A->in[6] + l * 1024, A->in[7] + l * 1024, A->in[9] + l * 1024);
    CArgs* A2 = fresh_args(); unsigned char* ws2 = A2->ws;
    ret1_phase(lds_, (const bf16*)(ws2 + WS_PROJ), (float*)(ws2 + WS_KVS));
}
__global__ void __launch_bounds__(NWAVES * 64, 2) mega_fwd(Args args) {
    extern __shared__ __attribute__((aligned(16))) unsigned char lds[];
    LAS unsigned char* L = (LAS unsigned char*)lds;
    volatile LAS unsigned* MISC = (volatile LAS unsigned*)(L + MISC_OFF);
    for (int u = threadIdx.x; u < (LDS_BYTES - LDSCTL_OFF) / 4; u += NWAVES * 64) ((LAS unsigned*)(L + LDSCTL_OFF))[u] = 0u;
    __syncthreads();
    XcdBarrier bar = xcd_barrier_post((unsigned*)(args.ws + WS_CTL) + CW_BAR, MISC + 8);
#define GRID_BAR() do { for (int bd_ = 0; bd_ < BAR_DUP; ++bd_) { XcdBarrier b_ = bar; asm volatile("" : "+s"(b_.bar), "+s"(b_.x)); xcd_barrier(b_); } } while (0)
    unsigned long long tp0 = 0, tp1 = 0;
#define STAMP(kk, cond) do { if (PROBE_IDX >= 0 && (cond)) { if (PROBE_IDX == (kk)) tp0 = __builtin_amdgcn_s_memrealtime(); if (PROBE_END == (kk)) tp1 = __builtin_amdgcn_s_memrealtime(); } } while (0)
    STAMP(0, true);
    for (int rep_ = 0; rep_ < REP_PRO; ++rep_) prologue_phase(L);
    GRID_BAR();
    for (int l = 0; l < DEPTH; ++l) {
        STAMP(1, l == PROBE_L);
        for (int rep_ = 0; rep_ < REP_IN; ++rep_) gemm_call<0>(L, l);
        STAMP(24, l == PROBE_L);
        { int bx = blockIdx.x; asm volatile("" : "+s"(bx)); const int G = gridDim.x, NT_IN = (M / 256) * (INP / 256), nfull = NT_IN % G;
          const int idx = nfull == 0 ? bx : bx - nfull, n = nfull == 0 ? G : G - nfull;
          if (nfull == 0 || bx >= nfull) { convert_pass<DEF_NIF, true, DEF_WV>(L, idx, n, 5, l, -1, 0, -1, 0); convert_pass<DEF_NIF, false, DEF_WV>(L, idx, n, 1, l, 2, l, -1, 0); } }
        GRID_BAR();
        STAMP(2, l == PROBE_L);
        for (int rep_ = 0; rep_ < REP_QKV; ++rep_) { gemm_call<1>(L, l);
            { int bx = blockIdx.x; asm volatile("" : "+s"(bx)); const int G = gridDim.x, nfull = ((M / 256) * (QW / 256)) % G;
                if (nfull == 0) convert_pass<DEF_NIF, false>(L, bx, G, 3, l, -1, 0, -1, 0); else if (bx >= nfull) convert_pass<DEF_NIF, false>(L, bx - nfull, G - nfull, 3, l, -1, 0, -1, 0);
                __syncthreads(); }
            STAMP(20, l == PROBE_L); gemm_call<2>(L, l); STAMP(21, l == PROBE_L); }
        for (int rep_ = 0; rep_ < REP_SMALL; ++rep_) mixer_small_phases(L, l);
        STAMP(23, l == PROBE_L);
        GRID_BAR();
        STAMP(3, l == PROBE_L);
        for (int rep_ = 0; rep_ < REP_RET2; ++rep_) { CArgs* A = fresh_args(); unsigned char* ws = A->ws; ret2_phase(L, (const float*)(ws + WS_KVS), (bf16*)(ws + WS_SB)); }
        for (int rep_ = 0; rep_ < REP_ATTN; ++rep_) attn_phase(L);
        GRID_BAR();
        STAMP(4, l == PROBE_L);
        for (int rep_ = 0; rep_ < REP_RET3; ++rep_) { CArgs* A = fresh_args(); unsigned char* ws = A->ws; ret3_phase(L, (const bf16*)(ws + WS_PROJ), (const bf16*)(ws + WS_SB), (bf16*)(ws + WS_CAT)); }
        GRID_BAR();
        STAMP(5, l == PROBE_L);
        for (int rep_ = 0; rep_ < REP_OUT; ++rep_) gemm_call<3>(L, l);
        GRID_BAR();
        STAMP(6, l == PROBE_L);
        for (int rep_ = 0; rep_ < REP_RES; ++rep_) residual_phase(L, l, 0, rep_ + 1 < REP_RES);
        if (WARM_UP) warm_phase(L, W_UP, (size_t)FF * DM * 2, l);
        GRID_BAR();
        STAMP(7, l == PROBE_L);
        for (int rep_ = 0; rep_ < REP_UP; ++rep_) { if (rep_ && REP_BAR) GRID_BAR(); gemm_call<4>(L, l); }
        GRID_BAR();
        STAMP(8, l == PROBE_L);
        if (l + 1 < DEPTH) { int bx = blockIdx.x; asm volatile("" : "+s"(bx)); convert_pass<PRO_NIF, false>(L, make_frame(L).vcu, (int)gridDim.x, 4, l + 1, -1, 0, -1, 0); __syncthreads(); }
        for (int rep_ = 0; rep_ < REP_DOWN; ++rep_) gemm_call<5>(L, l);
        GRID_BAR();
        STAMP(9, l == PROBE_L);
        for (int rep_ = 0; rep_ < REP_RES; ++rep_) residual_phase(L, l, 1, rep_ + 1 < REP_RES);
        if (l + 1 < DEPTH) convert_pass<PRO_NIF, false>(L, make_frame(L).vcu, (int)gridDim.x, 0, l + 1, -1, 0, -1, 0);
        STAMP(10, l == PROBE_L);
        if (l + 1 < DEPTH) GRID_BAR();
    }
    if (PROBE_IDX >= 0 && blockIdx.x == 0 && threadIdx.x == 0) { asm volatile("s_waitcnt vmcnt(0)" ::: "memory");
        float tus = (float)(tp1 - tp0) * 0.01f; float fr = (tus - (float)PROBE_LO) / (float)(PROBE_HI - PROBE_LO); fr = fr < 0.f ? 0.f : (fr > 1.f ? 1.f : fr); args.out[0] += 0.15f + 0.24f * fr; }
}

extern "C" void kernel_launch(void* const* d_in, const int* in_sizes, int n_in, void* d_out, int out_size, void* d_ws, size_t ws_size, hipStream_t stream) {
    static int grid = 0;
    if (grid == 0) {
        if (n_in != 17 || in_sizes[0] != M * DM || out_size != M * DM || ws_size < WS_END) { fprintf(stderr, "kernel_launch: shape mismatch (n_in %d, in0 %d, out %d, ws %zu < %zu)\n", n_in, n_in > 0 ? in_sizes[0] : -1, out_size, ws_size, (size_t)WS_END); grid = -1; return; }
        int dev = 0, cus = 0, per_cu = 0;
        if (hipGetDevice(&dev) != hipSuccess || hipDeviceGetAttribute(&cus, hipDeviceAttributeMultiprocessorCount, dev) != hipSuccess) { grid = -1; return; }
        if (hipFuncSetAttribute((const void*)mega_fwd, hipFuncAttributeMaxDynamicSharedMemorySize, LDS_BYTES) != hipSuccess) { fprintf(stderr, "kernel_launch: hipFuncSetAttribute failed\n"); grid = -1; return; }
        if (hipOccupancyMaxActiveBlocksPerMultiprocessor(&per_cu, (const void*)mega_fwd, NWAVES * 64, LDS_BYTES) != hipSuccess || per_cu < 1)
            fprintf(stderr, "kernel_launch: note: occupancy query reports %d workgroups per CU\n", per_cu);
        (void)hipGetLastError();
        grid = cus;
    }
    if (grid < 0) return;
    if (hipMemsetAsync((char*)d_ws + WS_CTL, 0, CTL_ZERO_BYTES, stream) != hipSuccess) { fprintf(stderr, "kernel_launch: memset failed\n"); return; }
    Args a{};
    for (int i = 0; i < 17; ++i) a.in[i] = (const float*)d_in[i];
    a.out = (float*)d_out; a.ws = (unsigned char*)d_ws;
    hipLaunchKernelGGL(mega_fwd, dim3(grid), dim3(NWAVES * 64), LDS_BYTES, stream, a);
    const hipError_t le = hipPeekAtLastError();
    if (le != hipSuccess) fprintf(stderr, "kernel_launch: launch failed: %s\n", hipGetErrorName(le));
}
```

```cpp
#include <hip/hip_runtime.h>
#include <cstdio>
#include <cstdint>
namespace pg8 {
#define PG8_LAS __attribute__((address_space(3)))
typedef unsigned short bf16_t;
typedef short bf16x8 __attribute__((ext_vector_type(8)));
typedef float f32x4 __attribute__((ext_vector_type(4)));
typedef unsigned u32x4 __attribute__((ext_vector_type(4)));
constexpr int BM = 256, BK = 64, HALF = 128, HTB = HALF * BK * 2  , STAGE_BYTES = 8 * HTB, NXCD = 8, WGM = 8;

__host__ __device__ __forceinline__ int lds_byte(int r, int c) { const int st = (r >> 4) * 2 + (c >> 5), rr = r & 15, cc = c & 31, ob = rr * 64 + cc * 2; return st * 1024 + (ob ^ (((ob >> 9) & 1) << 5)); }
__host__ __device__ __forceinline__ void stage_rc(int b, int& R, int& C) { const int st = b / 1024, sb = b % 1024, swz = sb ^ (((sb >> 9) & 1) << 5); R = (st >> 1) * 16 + swz / 64; C = (st & 1) * 32 + (swz % 64) / 2; }
__host__ __device__ __forceinline__ int perm32(int rho) { const int n = rho >> 4, i = rho & 15; return 8 * (i >> 2) + 4 * n + (i & 3); }

struct Unit { int pm, pn; };
struct Gemm { const bf16_t* A; const bf16_t* Bt; int M, N, K, lda, krev; };

struct StaticOrder {
    int nM, nN, nwg, G, c;
    __host__ __device__ void init(int M, int N, int G_, int c_) { nM = M / BM; nN = N / BM; nwg = nM * nN; G = G_; c = c_; }
    __host__ __device__ bool next(int i, Unit& u) const {
        const long L = (long)i * G + c; if (L >= nwg) return false;
        int wgid = (int)L; { const int q = nwg / NXCD, r = nwg % NXCD, xcd = wgid % NXCD, off = wgid / NXCD; wgid = (xcd < r ? xcd * (q + 1) : r * (q + 1) + (xcd - r) * q) + off; }
        const int nig = WGM * nN, gid = wgid / nig, fm = gid * WGM, gsz = (nM - fm) < WGM ? (nM - fm) : WGM;
        u.pm = fm + ((wgid % nig) % gsz); u.pn = (wgid % nig) / gsz; return true;
    }
    __device__ __forceinline__ void a_ready(const Unit&) const {}
    __device__ __forceinline__ void done(const Unit&) const {}
};
__device__ __forceinline__ unsigned cvt_pk_bf16(float lo, float hi) { unsigned r; asm volatile("v_cvt_pk_bf16_f32 %0, %1, %2" : "=v"(r) : "v"(lo), "v"(hi)); return r; }
__device__ __forceinline__ void rope8(f32x4& v0, f32x4& v1, const float* tab) {
    const f32x4 t0 = *(const f32x4*)tab, t1 = *(const f32x4*)(tab + 4);
    f32x4 a, b;
    a[0] = v0[0] * t0[0] - v0[1] * t0[1]; a[1] = v0[0] * t0[1] + v0[1] * t0[0];
    a[2] = v0[2] * t0[2] - v0[3] * t0[3]; a[3] = v0[2] * t0[3] + v0[3] * t0[2];
    b[0] = v1[0] * t1[0] - v1[1] * t1[1]; b[1] = v1[0] * t1[1] + v1[1] * t1[0];
    b[2] = v1[2] * t1[2] - v1[3] * t1[3]; b[3] = v1[2] * t1[3] + v1[3] * t1[2];
    v0 = a; v1 = b;
}
template <int MODE> struct Epi {
    static constexpr bool PERM = true, AFTER_DRAIN = false;
    bf16_t* O; int ldc; const float* rope; float* ssq; const float* rsc; const PG8_LAS float* rs_lds; int rs_pm;
    __device__ __forceinline__ void operator()(const f32x4 (&acc)[2][2][4][2], const Unit& u, int wr, int wc, int fr, int fq) const {
        const int row0 = u.pm * BM + wr * 64 + fr, colt = u.pn * BM + wc * 32 + 8 * fq;
        const bool want_ss = (MODE == 2) && u.pn >= 8 && u.pn < 14;
#pragma unroll
        for (int ai = 0; ai < 2; ++ai)
#pragma unroll
            for (int m = 0; m < 4; ++m) {
                const int row = row0 + ai * HALF + m * 16;
                float rs = 1.f;
                if (MODE == 1 || MODE == 2) rs = rsc[row];
                if (MODE == 3) { const f32x4* s = (const f32x4*)(ssq + (size_t)row * 24); const f32x4 a = s[0], b = s[1], c = s[2], d = s[3];
                    const float t = ((a[0] + a[1]) + (a[2] + a[3])) + ((b[0] + b[1]) + (b[2] + b[3])) + ((c[0] + c[1]) + (c[2] + c[3])) + ((d[0] + d[1]) + (d[2] + d[3]));
                    rs = 1.0f / sqrtf(t * (1.0f / 1024.0f) + 1e-6f); }
                if (MODE == 4) { const f32x4* s = (const f32x4*)(ssq + (size_t)row * 24); const f32x4 a = s[4], b = s[5];
                    const float t = ((a[0] + a[1]) + (a[2] + a[3])) + ((b[0] + b[1]) + (b[2] + b[3]));
                    rs = 1.0f / sqrtf(t * (1.0f / 512.0f) + 1e-6f); }
                float part = 0.f;
#pragma unroll
                for (int bj = 0; bj < 2; ++bj) {
                    const int col = colt + bj * HALF;
                    f32x4 v0 = acc[ai][bj][m][0], v1 = acc[ai][bj][m][1];
                    if (MODE == 1) {
#pragma unroll
                        for (int j = 0; j < 4; ++j) { const float p = fmaxf(v0[j] * rs, 0.f), q = fmaxf(v1[j] * rs, 0.f); v0[j] = p * p; v1[j] = q * q; } }
                    if (MODE == 2) { v0 = v0 * rs; v1 = v1 * rs;
                        if (want_ss) part += ((v0[0] * v0[0] + v0[1] * v0[1]) + (v0[2] * v0[2] + v0[3] * v0[3])) + ((v1[0] * v1[0] + v1[1] * v1[1]) + (v1[2] * v1[2] + v1[3] * v1[3]));
                        if (col >= 3584 && col < 4672) rope8(v0, v1, rope + ((size_t)(row & 4095) * 32 + ((col & 63) >> 1)) * 2); }
                    if (MODE == 3) { v0 = v0 * rs; v1 = v1 * rs; if ((col % 192) >= 128) rope8(v0, v1, rope + ((size_t)(row & 4095) * 32 + ((col & 63) >> 1)) * 2); }
                    if (MODE == 4) { v0 = v0 * rs; v1 = v1 * rs; }
                    u32x4 w; w.x = cvt_pk_bf16(v0[0], v0[1]); w.y = cvt_pk_bf16(v0[2], v0[3]); w.z = cvt_pk_bf16(v1[0], v1[1]); w.w = cvt_pk_bf16(v1[2], v1[3]);
                    *(u32x4*)(O + (size_t)row * ldc + col) = w;
                }
                if (want_ss) { part += __shfl_xor(part, 16); part += __shfl_xor(part, 32); if (fq == 0) ssq[(size_t)row * 24 + (u.pn - 8) * 4 + wc] = part; }
            }
    }
};
template <class Epi, class Sched, bool ALIGN_EPI = false, bool SP2 = false>
__device__ __forceinline__ void gemm_phase(PG8_LAS unsigned char* lds, const Gemm g, const Sched& S, const Epi& E) {
    int tid_ = threadIdx.x; asm volatile("" : "+v"(tid_));
    const int tid = tid_, wid = __builtin_amdgcn_readfirstlane(tid >> 6), lane = tid & 63, wr = wid >> 2, wc = wid & 3, fr = lane & 15, fq = lane >> 4;
    const int K = g.K, nt = K / BK;
    unsigned voffA[2], voffB[2];
#pragma unroll
    for (int i = 0; i < 2; ++i) { int R, C; stage_rc(tid * 16 + i * 8192, R, C); const int Rb = Epi::PERM ? ((R & ~31) + perm32(R & 31)) : R;
        voffA[i] = (unsigned)(R * g.lda + C) * 2u; voffB[i] = (unsigned)(Rb * K + C) * 2u; }
    const long kstep = g.krev ? -(long)(BK * 2) : (long)(BK * 2);
    const size_t hstep = (size_t)HALF * K * 2;
    const size_t tstep = 2 * hstep; const size_t hstepA = (size_t)HALF * g.lda * 2, tstepA = 2 * hstepA;
    const unsigned ldsw = (unsigned)wid * 1024u;
    const int aoff = lds_byte(wr * 64 + fr, fq * 8), boff = lds_byte(wc * 32 + fr, fq * 8);
#define PG8_SA(b, h) (((b) * 2 + (h)) * HTB)
#define PG8_SB(b, h) ((4 + (b) * 2 + (h)) * HTB)
#define PG8_STAGE(bufoff, gbase, voff) do { _Pragma("unroll") for (int _i = 0; _i < 2; ++_i) \
        __builtin_amdgcn_global_load_lds((const unsigned*)((const char*)(gbase) + (voff)[_i]), (PG8_LAS unsigned*)(lds + (bufoff) + ldsw + _i * 8192), 16, 0, 0); } while (0)
#define PG8_LDA(dst, b, h) do { _Pragma("unroll") for (int m = 0; m < 4; ++m) _Pragma("unroll") for (int k = 0; k < 2; ++k) dst[m][k] = *(const PG8_LAS bf16x8*)(lds + PG8_SA(b, h) + aoff + m * 2048 + k * 1024); } while (0)
#define PG8_LDB(dst, b, h) do { _Pragma("unroll") for (int n = 0; n < 2; ++n) _Pragma("unroll") for (int k = 0; k < 2; ++k) dst[n][k] = *(const PG8_LAS bf16x8*)(lds + PG8_SB(b, h) + boff + n * 2048 + k * 1024); } while (0)
#define PG8_MMA(ai, bj, At, Bt) do { __builtin_amdgcn_s_setprio(1); _Pragma("unroll") for (int m = 0; m < 4; ++m) _Pragma("unroll") for (int n = 0; n < 2; ++n) _Pragma("unroll") for (int k = 0; k < 2; ++k) \
        acc[ai][bj][m][n] = __builtin_amdgcn_mfma_f32_16x16x32_bf16(Bt[n][k], At[m][k], acc[ai][bj][m][n], 0, 0, 0); __builtin_amdgcn_s_setprio(0); } while (0)
#define PG8_WAIT_V(n) asm volatile("s_waitcnt vmcnt(" #n ")" ::: "memory")
#define PG8_WAIT_L(n) asm volatile("s_waitcnt lgkmcnt(" #n ")" ::: "memory")
#define PG8_BAR __builtin_amdgcn_s_barrier()
#define PG8_SCHED __builtin_amdgcn_sched_barrier(0)
    Unit cur, nxt; int ui = 0;
    if (!S.next(0, cur)) return;
    f32x4 acc[2][2][4][2];
#pragma unroll
    for (int a = 0; a < 2; ++a)
#pragma unroll
        for (int b = 0; b < 2; ++b)
#pragma unroll
            for (int m = 0; m < 4; ++m)
#pragma unroll
                for (int n = 0; n < 2; ++n) acc[a][b][m][n] = (f32x4){0.f, 0.f, 0.f, 0.f};
    bf16x8 At[4][2], B0[2][2], B1[2][2];
    const char* cA = (const char*)g.A + (size_t)cur.pm * tstepA; const char* cB = (const char*)g.Bt + (size_t)cur.pn * tstep;
    S.a_ready(cur);
    if constexpr (SP2) {
        PG8_STAGE(PG8_SB(0, 0), cB, voffB); PG8_STAGE(PG8_SB(0, 1), cB + hstep, voffB); PG8_STAGE(PG8_SA(0, 0), cA, voffA); PG8_STAGE(PG8_SA(0, 1), cA + hstepA, voffA);
        if (wr == 1) PG8_BAR;
        PG8_WAIT_V(2); PG8_BAR;
        PG8_STAGE(PG8_SB(1, 0), cB + kstep, voffB); PG8_STAGE(PG8_SA(1, 0), cA + kstep, voffA); PG8_STAGE(PG8_SB(1, 1), cB + hstep + kstep, voffB);
        PG8_WAIT_V(6); PG8_BAR;
    } else {
        PG8_STAGE(PG8_SB(0, 0), cB, voffB); PG8_STAGE(PG8_SA(0, 0), cA, voffA); PG8_STAGE(PG8_SB(0, 1), cB + hstep, voffB); PG8_STAGE(PG8_SA(0, 1), cA + hstepA, voffA);
        if (wr == 1) PG8_BAR;
        PG8_WAIT_V(4); PG8_BAR;
        PG8_STAGE(PG8_SB(1, 0), cB + kstep, voffB); PG8_STAGE(PG8_SA(1, 0), cA + kstep, voffA); PG8_STAGE(PG8_SB(1, 1), cB + hstep + kstep, voffB);
        PG8_WAIT_V(6); PG8_BAR;
    }
    for (;;) {
        const bool has_next = S.next(ui + 1, nxt);
        const char* nA = has_next ? (const char*)g.A + (size_t)nxt.pm * tstepA : cA; const char* nB = has_next ? (const char*)g.Bt + (size_t)nxt.pn * tstep : cB;
        for (int t = 0; t < nt; t += 2) {
            const bool last = (t == nt - 2);
            const char* a1 = cA + (long)(t + 1) * kstep;
            const char* a2 = last ? nA : cA + (long)(t + 2) * kstep; const char* b2 = last ? nB : cB + (long)(t + 2) * kstep;
            const char* a3 = a2 + kstep; const char* b3 = b2 + kstep;
            if (last && has_next) S.a_ready(nxt);
            if constexpr (SP2) {
            PG8_LDB(B0, 0, 0); PG8_LDB(B1, 0, 1); PG8_SCHED; PG8_LDA(At, 0, 0); PG8_STAGE(PG8_SA(1, 1), a1 + hstepA, voffA);
            PG8_WAIT_V(8); PG8_WAIT_L(0); PG8_BAR; PG8_MMA(0, 0, At, B0); PG8_MMA(0, 1, At, B1); PG8_BAR; PG8_SCHED;
            PG8_LDA(At, 0, 1); PG8_STAGE(PG8_SB(0, 0), b2, voffB); PG8_STAGE(PG8_SB(0, 1), b2 + hstep, voffB); PG8_STAGE(PG8_SA(0, 0), a2, voffA);
            PG8_WAIT_V(8); PG8_WAIT_L(0); PG8_BAR; PG8_MMA(1, 0, At, B0); PG8_MMA(1, 1, At, B1); PG8_BAR; PG8_SCHED;
            PG8_LDB(B0, 1, 0); PG8_LDB(B1, 1, 1); PG8_SCHED; PG8_LDA(At, 1, 0); PG8_STAGE(PG8_SA(0, 1), a2 + hstepA, voffA);
            PG8_WAIT_V(8); PG8_WAIT_L(0); PG8_BAR; PG8_MMA(0, 0, At, B0); PG8_MMA(0, 1, At, B1); PG8_BAR; PG8_SCHED;
            PG8_LDA(At, 1, 1); PG8_STAGE(PG8_SB(1, 0), b3, voffB); PG8_STAGE(PG8_SB(1, 1), b3 + hstep, voffB); PG8_STAGE(PG8_SA(1, 0), a3, voffA);
            PG8_WAIT_V(8); PG8_WAIT_L(0); PG8_BAR; PG8_MMA(1, 0, At, B0); PG8_MMA(1, 1, At, B1); PG8_BAR; PG8_SCHED;
            } else {
            PG8_LDB(B0, 0, 0); PG8_SCHED; PG8_LDA(At, 0, 0); PG8_STAGE(PG8_SA(1, 1), a1 + hstepA, voffA);
            PG8_WAIT_L(8); PG8_BAR; PG8_WAIT_L(0); PG8_MMA(0, 0, At, B0); PG8_BAR; PG8_SCHED;
            PG8_LDB(B1, 0, 1); PG8_STAGE(PG8_SB(0, 0), b2, voffB);
            PG8_BAR; PG8_WAIT_L(0); PG8_MMA(0, 1, At, B1); PG8_BAR;
            PG8_LDA(At, 0, 1); PG8_STAGE(PG8_SA(0, 0), a2, voffA);
            PG8_BAR; PG8_WAIT_L(0); PG8_MMA(1, 0, At, B0); PG8_BAR; PG8_SCHED;
            PG8_STAGE(PG8_SB(0, 1), b2 + hstep, voffB);
            PG8_WAIT_V(6); PG8_BAR; PG8_MMA(1, 1, At, B1); PG8_BAR;
            PG8_LDB(B0, 1, 0); PG8_SCHED; PG8_LDA(At, 1, 0); PG8_STAGE(PG8_SA(0, 1), a2 + hstepA, voffA);
            PG8_WAIT_L(8); PG8_BAR; PG8_WAIT_L(0); PG8_MMA(0, 0, At, B0); PG8_BAR; PG8_SCHED;
            PG8_LDB(B1, 1, 1); PG8_STAGE(PG8_SB(1, 0), b3, voffB);
            PG8_BAR; PG8_WAIT_L(0); PG8_MMA(0, 1, At, B1); PG8_BAR;
            PG8_LDA(At, 1, 1); PG8_STAGE(PG8_SA(1, 0), a3, voffA);
            PG8_BAR; PG8_WAIT_L(0); PG8_MMA(1, 0, At, B0); PG8_BAR; PG8_SCHED;
            PG8_STAGE(PG8_SB(1, 1), b3 + hstep, voffB);
            PG8_WAIT_V(6); PG8_BAR; PG8_MMA(1, 1, At, B1); PG8_BAR;
            }
        }
        if constexpr (ALIGN_EPI) { if (wr == 0) PG8_BAR; }
        if constexpr (!Epi::AFTER_DRAIN) { E(acc, cur, wr, wc, fr, fq); S.done(cur); }
        if (!has_next) break;
#pragma unroll
        for (int a = 0; a < 2; ++a)
#pragma unroll
            for (int b = 0; b < 2; ++b)
#pragma unroll
                for (int m = 0; m < 4; ++m)
#pragma unroll
                    for (int n = 0; n < 2; ++n) acc[a][b][m][n] = (f32x4){0.f, 0.f, 0.f, 0.f};
        cur = nxt; cA = nA; cB = nB; ++ui;
        if constexpr (ALIGN_EPI) { if (wr == 1) PG8_BAR; }
    }
    PG8_WAIT_V(0);
    if constexpr (!ALIGN_EPI) { if (wr == 0) PG8_BAR; }
    PG8_BAR;
    if constexpr (Epi::AFTER_DRAIN) { E.fused(acc, cur, wr, wc, fr, fq, lds, wid, lane); S.done(cur); }
#undef PG8_SA
#undef PG8_SB
#undef PG8_STAGE
#undef PG8_LDA
#undef PG8_LDB
#undef PG8_MMA
#undef PG8_WAIT_V
#undef PG8_WAIT_L
#undef PG8_BAR
#undef PG8_SCHED
}
}
namespace att {
#define ATT_LAS __attribute__((address_space(3)))
typedef unsigned short bf16;
using bf16x8 = __attribute__((ext_vector_type(8))) short;
using s16x4  = __attribute__((ext_vector_type(4))) short;
using f32x16 = __attribute__((ext_vector_type(16))) float;
using u32x4  = __attribute__((ext_vector_type(4))) unsigned;
constexpr float SCALE = 0.07216878364870322f;
constexpr float THR = 8.f;
constexpr int SHM_V = 16384, SHM_K = 16384, SHM_R = 8192;
constexpr int OFF_V = 0, OFF_K = 2 * SHM_V, OFF_R = OFF_K + 2 * SHM_K, OFF_WS = OFF_R + 2 * SHM_R, ATT_LDS_BYTES = OFF_WS + 8 * 64 * 4;
#define KSWZ(row, colB) ((row) * 256 + ((colB) ^ (((row) & 7) << 4)))
#define RSWZ(row, colB) ((row) * 128 + ((colB) ^ (((row) & 7) << 4)))
#define SBAR() __builtin_amdgcn_sched_barrier(0)
__device__ __forceinline__ int crow(int r, int hi) { return (r & 3) + 8 * (r >> 2) + 4 * hi; }
__device__ __forceinline__ unsigned cvtpk(float lo, float hi) { unsigned r; asm volatile("v_cvt_pk_bf16_f32 %0, %1, %2" : "=v"(r) : "v"(lo), "v"(hi)); return r; }
__device__ __forceinline__ void partialSM(f32x16& p0, f32x16& p1, float& m_reg, float& mn, float& alpha) {
  constexpr float C = SCALE * 1.4426950408889634f;
  float pmax = p0[0];
#pragma unroll
  for (int r = 1; r < 16; ++r) pmax = fmaxf(pmax, p0[r]);
#pragma unroll
  for (int r = 0; r < 16; ++r) pmax = fmaxf(pmax, p1[r]);
  { auto rr = __builtin_amdgcn_permlane32_swap(__float_as_uint(pmax), __float_as_uint(pmax), false, false);
    pmax = fmaxf(__uint_as_float(rr[0]), __uint_as_float(rr[1])); }
  if (__builtin_expect(__all(pmax - m_reg <= THR / SCALE), 1)) { mn = m_reg; alpha = 1.f; }
  else { mn = fmaxf(m_reg, pmax); alpha = __builtin_amdgcn_exp2f((m_reg - mn) * C); m_reg = mn; }
  float mnC = -mn * C;
#pragma unroll
  for (int r = 0; r < 16; ++r) p0[r] = fmaf(p0[r], C, mnC);
#pragma unroll
  for (int r = 0; r < 16; ++r) p1[r] = fmaf(p1[r], C, mnC);
#pragma unroll
  for (int r = 0; r < 16; ++r) p0[r] = __builtin_amdgcn_exp2f(p0[r]);
}
__device__ __forceinline__ void finishSM(f32x16& p0, f32x16& p1, float alpha, float& l_reg, bf16x8& pa0, bf16x8& pa1, bf16x8& pa2, bf16x8& pa3) {
#pragma unroll
  for (int r = 0; r < 16; ++r) p1[r] = __builtin_amdgcn_exp2f(p1[r]);
  float ps = 0;
#pragma unroll
  for (int r = 0; r < 16; ++r) ps += p0[r];
#pragma unroll
  for (int r = 0; r < 16; ++r) ps += p1[r];
  { auto rr = __builtin_amdgcn_permlane32_swap(__float_as_uint(ps), __float_as_uint(ps), false, false);
    ps = __uint_as_float(rr[0]) + __uint_as_float(rr[1]); }
  l_reg = l_reg * alpha + ps;
#define PK4(P, BASE, OUT) do { unsigned a0 = cvtpk(P[BASE + 0], P[BASE + 1]), a1 = cvtpk(P[BASE + 2], P[BASE + 3]);   \
    unsigned b0 = cvtpk(P[BASE + 4], P[BASE + 5]), b1 = cvtpk(P[BASE + 6], P[BASE + 7]);                              \
    auto r0 = __builtin_amdgcn_permlane32_swap(a0, b0, false, false); auto r1 = __builtin_amdgcn_permlane32_swap(a1, b1, false, false); \
    u32x4 w = {r0[0], r1[0], r0[1], r1[1]}; OUT = *reinterpret_cast<bf16x8*>(&w); } while (0)
  PK4(p0, 0, pa0); PK4(p0, 8, pa1); PK4(p1, 0, pa2); PK4(p1, 8, pa3);
#undef PK4
}
__device__ __forceinline__ void qkt(f32x16& p0, f32x16& p1, const ATT_LAS char* Ks, const ATT_LAS char* Rs, const bf16x8* qr, int r32, int hi) {
  p0 = f32x16{}; p1 = f32x16{};
#pragma unroll
  for (int d0 = 0; d0 < 8; ++d0) { const int cb = (d0 * 16 + hi * 8) * 2;
    const bf16x8 b0 = *reinterpret_cast<const ATT_LAS bf16x8*>(Ks + KSWZ(r32, cb));
    const bf16x8 b1 = *reinterpret_cast<const ATT_LAS bf16x8*>(Ks + KSWZ(32 + r32, cb));
    p0 = __builtin_amdgcn_mfma_f32_32x32x16_bf16(b0, qr[d0], p0, 0, 0, 0);
    p1 = __builtin_amdgcn_mfma_f32_32x32x16_bf16(b1, qr[d0], p1, 0, 0, 0); }
#pragma unroll
  for (int d0 = 0; d0 < 4; ++d0) { const int cb = (d0 * 16 + hi * 8) * 2;
    const bf16x8 b0 = *reinterpret_cast<const ATT_LAS bf16x8*>(Rs + RSWZ(r32, cb));
    const bf16x8 b1 = *reinterpret_cast<const ATT_LAS bf16x8*>(Rs + RSWZ(32 + r32, cb));
    p0 = __builtin_amdgcn_mfma_f32_32x32x16_bf16(b0, qr[8 + d0], p0, 0, 0, 0);
    p1 = __builtin_amdgcn_mfma_f32_32x32x16_bf16(b1, qr[8 + d0], p1, 0, 0, 0); }
}
__device__ __forceinline__ int v_st(int k, int c) { const int kk = (k & ~0xC) | ((k & 4) << 1) | ((k & 8) >> 1); return ((kk >> 3) * 4 + (c >> 5)) * 512 + ((kk & 7) * 32 + (c & 31)) * 2; }
__device__ __forceinline__ int v_rd_base(int lane) { return ((lane & 3) << 3) | (((lane >> 2) & 3) << 6) | (((lane >> 4) & 1) << 5) | (((lane >> 5) & 1) << 8); }
constexpr int v_rd_off(int d0, int ks, int half) { return d0 * 512 + ks * 4096 + half * 2048; }
template <int OFF> __device__ __forceinline__ s16x4 tr_read(int vb) {
  s16x4 r; asm volatile("ds_read_b64_tr_b16 %0, %1 offset:%2" : "=&v"(r) : "v"(vb), "i"(OFF) : "memory"); return r;
}
template <int D0> __device__ __forceinline__ void pv_one(f32x16& od, int vb, bf16x8 pa0, bf16x8 pa1, bf16x8 pa2, bf16x8 pa3) {
  const s16x4 l0 = tr_read<v_rd_off(D0, 0, 0)>(vb), h0 = tr_read<v_rd_off(D0, 0, 1)>(vb), l1 = tr_read<v_rd_off(D0, 1, 0)>(vb), h1 = tr_read<v_rd_off(D0, 1, 1)>(vb);
  const s16x4 l2 = tr_read<v_rd_off(D0, 2, 0)>(vb), h2 = tr_read<v_rd_off(D0, 2, 1)>(vb), l3 = tr_read<v_rd_off(D0, 3, 0)>(vb), h3 = tr_read<v_rd_off(D0, 3, 1)>(vb);
  asm volatile("s_waitcnt lgkmcnt(0)" ::: "memory"); SBAR();
#define PK(L, H) (bf16x8){L[0], L[1], L[2], L[3], H[0], H[1], H[2], H[3]}
  od = __builtin_amdgcn_mfma_f32_32x32x16_bf16(pa0, PK(l0, h0), od, 0, 0, 0);
  od = __builtin_amdgcn_mfma_f32_32x32x16_bf16(pa1, PK(l1, h1), od, 0, 0, 0);
  od = __builtin_amdgcn_mfma_f32_32x32x16_bf16(pa2, PK(l2, h2), od, 0, 0, 0);
  od = __builtin_amdgcn_mfma_f32_32x32x16_bf16(pa3, PK(l3, h3), od, 0, 0, 0);
#undef PK
}
__device__ __forceinline__ void pv_d0(f32x16* o, int vb, bf16x8 pa0, bf16x8 pa1, bf16x8 pa2, bf16x8 pa3) {
  pv_one<0>(o[0], vb, pa0, pa1, pa2, pa3); pv_one<1>(o[1], vb, pa0, pa1, pa2, pa3); pv_one<2>(o[2], vb, pa0, pa1, pa2, pa3); pv_one<3>(o[3], vb, pa0, pa1, pa2, pa3);
}
__device__ __forceinline__ unsigned short f2bf(float f) { unsigned u = __builtin_bit_cast(unsigned, f); return (unsigned short)((u + 0x7fffu + ((u >> 16) & 1u)) >> 16); }
__device__ __forceinline__ void attn_unit(const bf16* __restrict__ Q, const bf16* __restrict__ KV, const bf16* __restrict__ PROJ, bf16* __restrict__ CAT, int b, int h, int qb, ATT_LAS char* lds) {
  int tid_ = threadIdx.x; asm volatile("" : "+v"(tid_));
  const int tid = tid_, wid = __builtin_amdgcn_readfirstlane(tid >> 6), lane = tid & 63, r32 = lane & 31, hi = lane >> 5;
  ATT_LAS char* V_lds = lds + OFF_V; ATT_LAS char* K_lds = lds + OFF_K; ATT_LAS char* R_lds = lds + OFF_R;
  ATT_LAS float* wsp = (ATT_LAS float*)(lds + OFF_WS) + wid * 64; ATT_LAS float* li_l = wsp; ATT_LAS float* al_l = wsp + 32;
  float m_reg = -1e30f, l_reg = 0; f32x16 o[4] = {}; bf16x8 qr[12];
  const size_t tok0 = (size_t)b * 4096;
  const bf16* Qw = Q + (tok0 + (size_t)qb * 256 + wid * 32 + r32) * 3072 + h * 192 + hi * 8;
#pragma unroll
  for (int d0 = 0; d0 < 12; ++d0) qr[d0] = *reinterpret_cast<const bf16x8*>(Qw + d0 * 16);
  const int cw = qb * 4 + (wid >> 1), NT = qb * 4 + 4;
  const int sr = tid >> 4, sc = (tid & 15) * 8, vst0 = v_st(sr, sc), vst1 = v_st(32 + sr, sc), kst0 = KSWZ(sr, sc * 2), kst1 = KSWZ(32 + sr, sc * 2);
  const int rr = tid >> 3, rc = (tid & 7) * 8, rst = RSWZ(rr, rc * 2);
  const bf16* Kg = KV + tok0 * 4096 + h * 256;
  const bf16* Rg = PROJ + tok0 * 6912 + 3584;
  const int vb0 = (int)(uintptr_t)V_lds + v_rd_base(lane);
  bf16x8 sv0, sv1, sk0, sk1, srp;
#define ATT_SLOAD(k0) do { sv0 = *reinterpret_cast<const bf16x8*>(Kg + (size_t)((k0) + sr) * 4096 + 128 + sc); sv1 = *reinterpret_cast<const bf16x8*>(Kg + (size_t)((k0) + 32 + sr) * 4096 + 128 + sc); \
    sk0 = *reinterpret_cast<const bf16x8*>(Kg + (size_t)((k0) + sr) * 4096 + sc); sk1 = *reinterpret_cast<const bf16x8*>(Kg + (size_t)((k0) + 32 + sr) * 4096 + sc); \
    srp = *reinterpret_cast<const bf16x8*>(Rg + (size_t)((k0) + rr) * 6912 + rc); } while (0)
#define ATT_SWRITE(bf) do { *reinterpret_cast<ATT_LAS bf16x8*>(V_lds + (bf) * SHM_V + vst0) = sv0; *reinterpret_cast<ATT_LAS bf16x8*>(V_lds + (bf) * SHM_V + vst1) = sv1; \
    *reinterpret_cast<ATT_LAS bf16x8*>(K_lds + (bf) * SHM_K + kst0) = sk0; *reinterpret_cast<ATT_LAS bf16x8*>(K_lds + (bf) * SHM_K + kst1) = sk1; \
    *reinterpret_cast<ATT_LAS bf16x8*>(R_lds + (bf) * SHM_R + rst) = srp; } while (0)
#define ATT_RESC(a) do { if (__any((a) < 1.f)) { if (hi == 0) al_l[r32] = (a); asm volatile("s_waitcnt lgkmcnt(0)" ::: "memory"); \
    _Pragma("unroll") for (int d = 0; d < 4; ++d) _Pragma("unroll") for (int r = 0; r < 16; ++r) o[d][r] *= al_l[crow(r, hi)]; } } while (0)
  ATT_SLOAD(0); asm volatile("s_waitcnt vmcnt(0)" ::: "memory"); ATT_SWRITE(0); __syncthreads();
  for (int t = 0; t < NT; ++t) {
    const int bf = t & 1;
    if (t + 1 < NT) ATT_SLOAD((t + 1) * 64);
    if (t <= cw) {
      f32x16 p0, p1; float mn, al; bf16x8 pa0, pa1, pa2, pa3;
      qkt(p0, p1, K_lds + bf * SHM_K, R_lds + bf * SHM_R, qr, r32, hi);
      partialSM(p0, p1, m_reg, mn, al);
      ATT_RESC(al);
      finishSM(p0, p1, al, l_reg, pa0, pa1, pa2, pa3); SBAR();
      pv_d0(o, vb0 + bf * SHM_V, pa0, pa1, pa2, pa3);
    }
    if (t + 1 < NT) { asm volatile("s_waitcnt vmcnt(0)" ::: "memory"); ATT_SWRITE(bf ^ 1); }
    __syncthreads();
  }
  if (hi == 0) li_l[r32] = l_reg; asm volatile("s_waitcnt lgkmcnt(0)" ::: "memory");
  float rli[16];
#pragma unroll
  for (int r = 0; r < 16; ++r) rli[r] = __builtin_amdgcn_rcpf(li_l[crow(r, hi)]);
  bf16* Ow = CAT + (tok0 + (size_t)qb * 256 + wid * 32) * 4096 + 1024 + h * 128;
#pragma unroll
  for (int r = 0; r < 16; ++r) { const int orow = crow(r, hi);
#pragma unroll
    for (int d0 = 0; d0 < 4; ++d0) Ow[(size_t)orow * 4096 + d0 * 32 + r32] = f2bf(o[d0][r] * rli[r]); }
#undef ATT_SLOAD
#undef ATT_SWRITE
#undef ATT_RESC
}
}
constexpr int NWAVES = 8;
constexpr int BATCH = 2, SEQ = 4096, DM = 4096, M = BATCH * SEQ, DEPTH = 2, FF = 16384;
constexpr int INW = 6720, INP = 6912;
constexpr int C_U = 0, C_V = 1024, C_CQ = 2048, C_CKV = 3072, C_KR = 3584, C_RQ = 3648, C_RK = 4160, C_RV = 4672, C_RG = 5696;
constexpr int QW = 3072, KVW = 4096;
constexpr float EPS = 1e-6f;
constexpr size_t MiB = 1u << 20;
constexpr size_t WS_CTL = 0, CTL_ZERO_BYTES = 1 * MiB;
constexpr size_t WS_ROPE = 1 * MiB;
constexpr size_t WS_SSQ = 2 * MiB;
constexpr size_t WS_RS = 3 * MiB;
constexpr size_t WS_W = 4 * MiB, LW = 353 * MiB;
constexpr size_t W_IN = 0, W_Q = 54 * MiB, W_KV = 60 * MiB, W_OUT = 64 * MiB, W_UP = 96 * MiB, W_DOWN = 224 * MiB, W_SGU = 352 * MiB;
constexpr size_t WS_H = WS_W + 2 * LW;
constexpr size_t WS_PROJ = WS_H + 64 * MiB;
constexpr size_t WS_Q = WS_PROJ + 108 * MiB;
constexpr size_t WS_KV = WS_Q + 48 * MiB;
constexpr size_t WS_CAT = WS_KV + 64 * MiB;
constexpr size_t WS_MIX = WS_CAT + 64 * MiB;
constexpr size_t WS_ACT = WS_MIX + 64 * MiB;
constexpr size_t WS_KVS = WS_ACT + 256 * MiB;
constexpr size_t WS_SB = WS_KVS + 32 * MiB;
constexpr size_t WS_END = WS_SB + 16 * MiB;
static_assert((size_t)INP * DM * 2 == 54 * MiB && (size_t)M * INP * 2 == 108 * MiB, "map");
constexpr int CW_BAR = 4096;
constexpr int RING_OFF = 0, RING_BYTES = 131072;
constexpr int LDSCTL_OFF = RING_BYTES, MISC_OFF = LDSCTL_OFF + 320;
constexpr int LDS_BYTES = 147456;
#define GAS __attribute__((address_space(1)))
#define LAS __attribute__((address_space(3)))
typedef unsigned short bf16;
typedef unsigned v4u __attribute__((ext_vector_type(4)));
typedef float f32x4 __attribute__((ext_vector_type(4)));
typedef short bf16x8 __attribute__((ext_vector_type(8)));
typedef GAS unsigned gu32;
typedef GAS unsigned long long gu64;
#define RLX_AGENT __ATOMIC_RELAXED, __HIP_MEMORY_SCOPE_AGENT
#define LDS_WAIT() asm volatile("s_waitcnt lgkmcnt(0)" ::: "memory")
#define VM_WAIT() asm volatile("s_waitcnt vmcnt(0)" ::: "memory")
__device__ __forceinline__ unsigned long long rt() { return __builtin_amdgcn_s_memrealtime(); }
__device__ __forceinline__ unsigned f2bf(float f) { unsigned u = __builtin_bit_cast(unsigned, f); return (u + 0x7fffu + ((u >> 16) & 1u)) >> 16; }
__device__ __forceinline__ unsigned pk2(float lo, float hi) { return f2bf(lo) | (f2bf(hi) << 16); }

#define XB_TMO      128
#define XB_XCNT(j)  (256  + 64 * (j))
#define XB_XSUB(j)  (1280 + 64 * (j))
#define XB_XGEN(j)  (2304 + 64 * (j))
#define XB_TOP      3328
#define XB_TOPGEN   3392
#define XCD_BAR_WORDS 3456
#define XB_SPIN_CAP (1u << 18)

__device__ __forceinline__ unsigned xb_ld(unsigned* p)              { return __hip_atomic_load(p, __ATOMIC_RELAXED, __HIP_MEMORY_SCOPE_AGENT); }
__device__ __forceinline__ unsigned xb_add(unsigned* p, unsigned v) { return __hip_atomic_fetch_add(p, v, __ATOMIC_RELAXED, __HIP_MEMORY_SCOPE_AGENT); }
__device__ __forceinline__ unsigned xb_xcc_id() { return (unsigned)__builtin_amdgcn_s_getreg((3 << 11) | 20) & 0xFu; }
#define XB_SPIN(cond, bar) do { unsigned _sp = 0; while (cond) { __builtin_amdgcn_s_sleep(1); \
    if ((++_sp & 255u) == 0u) { if (xb_ld(&(bar)[XB_TMO])) break; if (_sp > XB_SPIN_CAP) { atomicAdd(&(bar)[XB_TMO], 1u); break; } } } } while (0)

struct XcdBarrier {
    unsigned* bar; unsigned x;
    volatile LAS unsigned* st;
};

__device__ __forceinline__ XcdBarrier xcd_barrier_post(unsigned* bar, volatile LAS unsigned* st) {
    XcdBarrier b; b.bar = bar; b.x = xb_xcc_id(); b.st = st;
    if (threadIdx.x == 0) (void)xb_add(&bar[XB_XCNT(b.x)], 1u);
    return b;
}
__device__ __forceinline__ void xcd_barrier_complete(unsigned* bar, unsigned x, unsigned& nloc, unsigned& nx) {
    const unsigned G = gridDim.x * gridDim.y * gridDim.z;
    unsigned sum, cnt, mine, sp = 0u;
    for (;;) {
        sum = 0u; cnt = 0u; mine = 0u;
#pragma unroll
        for (unsigned j = 0; j < 16; ++j) { const unsigned c = xb_ld(&bar[XB_XCNT(j)]); sum += c; cnt += (c > 0u) ? 1u : 0u; mine = (j == x) ? c : mine; }
        if (sum == G) break;
        __builtin_amdgcn_s_sleep(1);
        if ((++sp & 255u) == 0u) { if (xb_ld(&bar[XB_TMO])) break; if (sp > XB_SPIN_CAP) { atomicAdd(&bar[XB_TMO], 1u); break; } }
    }
    nloc = mine > 0u ? mine : 1u; nx = cnt > 0u ? cnt : 1u;
}

__device__ __forceinline__ void xcd_barrier(const XcdBarrier& b) {
    asm volatile("s_waitcnt vmcnt(0)" ::: "memory");
    __syncthreads();
    if (threadIdx.x == 0) {
        unsigned* bar = b.bar;
        __builtin_amdgcn_s_waitcnt(0);
        unsigned nloc = b.st[0], nx = b.st[1];
        if (nloc == 0u) { xcd_barrier_complete(bar, b.x, nloc, nx); b.st[0] = nloc; b.st[1] = nx; }
        const unsigned old = xb_add(&bar[XB_XSUB(b.x)], 1u);
        const unsigned gen = old / nloc;
        if (old + 1u == (gen + 1u) * nloc) {
            __builtin_amdgcn_fence(__ATOMIC_RELEASE, "agent");
            asm volatile("s_waitcnt vmcnt(0)" ::: "memory");
            const unsigned og = xb_add(&bar[XB_TOP], 1u);
            const unsigned tg = og / nx;
            if (og + 1u == (tg + 1u) * nx) xb_add(&bar[XB_TOPGEN], 1u);
            else XB_SPIN(xb_ld(&bar[XB_TOPGEN]) == tg, bar);
            __builtin_amdgcn_fence(__ATOMIC_ACQUIRE, "agent");
            xb_add(&bar[XB_XGEN(b.x)], 1u);
            asm volatile("s_waitcnt vmcnt(0)" ::: "memory");
        } else {
            XB_SPIN(xb_ld(&bar[XB_XGEN(b.x)]) == gen, bar);
            __builtin_amdgcn_fence(__ATOMIC_ACQUIRE, "agent");
            asm volatile("s_waitcnt vmcnt(0)" ::: "memory");
        }
    }
    __syncthreads();
}
typedef float f32x16 __attribute__((ext_vector_type(16)));
struct Frame {
    LAS unsigned char* lds; int tid, lane, wave, vcu, G;
};
__device__ __forceinline__ Frame make_frame(LAS unsigned char* lds) {
    Frame F; F.lds = lds; int t = threadIdx.x; asm volatile("" : "+v"(t)); int bx = blockIdx.x; asm volatile("" : "+s"(bx));
    F.tid = t; F.lane = t & 63; F.wave = __builtin_amdgcn_readfirstlane(t >> 6); F.G = gridDim.x;
    F.vcu = (F.G % 8 == 0) ? (bx % 8) * (F.G / 8) + bx / 8 : bx; return F;
}
__device__ __forceinline__ float bf2f(unsigned short h) { return __builtin_bit_cast(float, (unsigned)h << 16); }
__device__ __forceinline__ unsigned short f2bf16(float f) { return (unsigned short)f2bf(f); }
__device__ __forceinline__ float wave_sum(float v) {
#pragma unroll
    for (int o = 1; o < 64; o <<= 1) v += __shfl_xor(v, o);
    return v;
}
__device__ __forceinline__ int crow32(int r, int hi) { return (r & 3) + 8 * (r >> 2) + 4 * hi; }
template <int KSTEPS> __device__ __forceinline__ void mfma_lds(f32x16& acc, const LAS bf16* A, int pa, const LAS bf16* Bt, int pb, int r32, int hi) {
#pragma unroll
    for (int s = 0; s < KSTEPS; ++s) {
        const bf16x8 a = *(const LAS bf16x8*)(A + r32 * pa + s * 16 + hi * 8);
        const bf16x8 b = *(const LAS bf16x8*)(Bt + r32 * pb + s * 16 + hi * 8);
        acc = __builtin_amdgcn_mfma_f32_32x32x16_bf16(a, b, acc, 0, 0, 0);
    }
}
struct CvtDesc { const float* W; bf16* WT; const float* kgain; int K, N, k0, n0, kind; };
__device__ __forceinline__ void cvt_load(const CvtDesc& d, float (&v)[32], int lane) {
    if (d.kind == 0) {
        const int q = lane >> 3, n4 = (lane & 7) * 4; const float* src = d.W + (size_t)(d.k0 + q) * d.N + d.n0 + n4;
#pragma unroll
        for (int i = 0; i < 8; ++i) { const f32x4 t = __builtin_nontemporal_load((const f32x4*)(src + (size_t)(8 * i) * d.N)); v[4 * i] = t[0]; v[4 * i + 1] = t[1]; v[4 * i + 2] = t[2]; v[4 * i + 3] = t[3]; }
        if (d.kgain) {
#pragma unroll
            for (int i = 0; i < 8; ++i) { const float g = d.kgain[d.k0 + 8 * i + q]; v[4 * i] *= g; v[4 * i + 1] *= g; v[4 * i + 2] *= g; v[4 * i + 3] *= g; } }
        return; }
    const int nd = d.n0 + (lane & 31); bool ok = true; int sc = nd; float cs = 1.f;
    if (d.kind == 1) { ok = nd < INW; sc = (nd >= C_KR && nd < C_RV) ? (nd & ~63) + ((nd & 63) >> 1) + 32 * (nd & 1) : nd; cs = (nd >= C_RQ && nd < C_RK) ? 0.125f : 1.f; if (!ok) sc = 0; }
    if (d.kind == 2) { sc = ((nd % 192) >= 128) ? (nd & ~63) + ((nd & 63) >> 1) + 32 * (nd & 1) : nd; }
    const float* src = d.W + (size_t)(d.k0 + (lane >> 5)) * d.N + sc;
#pragma unroll
    for (int i = 0; i < 32; ++i) v[i] = __builtin_nontemporal_load(src + (size_t)(2 * i) * d.N);
    if (d.kgain) {
#pragma unroll
        for (int i = 0; i < 32; ++i) v[i] *= d.kgain[d.k0 + 2 * i + (lane >> 5)]; }
    if (d.kind == 1) {
#pragma unroll
        for (int i = 0; i < 32; ++i) v[i] = ok ? v[i] * cs : 0.f; }
}
template <bool NT = false> __device__ __forceinline__ void cvt_finish(const CvtDesc& d, const float (&v)[32], LAS float* scr, int lane) {
    if (d.kind == 0) { const int q = lane >> 3, n4 = (lane & 7) * 4;
#pragma unroll
        for (int i = 0; i < 8; ++i) { LAS float* s = scr + (8 * i + q) * 33 + n4; s[0] = v[4 * i]; s[1] = v[4 * i + 1]; s[2] = v[4 * i + 2]; s[3] = v[4 * i + 3]; } }
    else {
#pragma unroll
        for (int i = 0; i < 32; ++i) scr[(2 * i + (lane >> 5)) * 33 + (lane & 31)] = v[i]; }
    LDS_WAIT(); asm volatile("" ::: "memory");
    const int c = lane & 7;
#pragma unroll
    for (int j = 0; j < 4; ++j) { const int n = (lane >> 3) + 8 * j; const LAS float* s = scr + (8 * c) * 33 + n;
        v4u o; o.x = pk2(s[0 * 33], s[1 * 33]); o.y = pk2(s[2 * 33], s[3 * 33]); o.z = pk2(s[4 * 33], s[5 * 33]); o.w = pk2(s[6 * 33], s[7 * 33]);
        if (NT) __builtin_nontemporal_store(o, (GAS v4u*)(d.WT + (size_t)(d.n0 + n) * d.K + d.k0 + 8 * c)); else *(GAS v4u*)(d.WT + (size_t)(d.n0 + n) * d.K + d.k0 + 8 * c) = o; }
    LDS_WAIT(); asm volatile("" ::: "memory");
}
__device__ __forceinline__ void x_row_to_bf16(const float* __restrict__ xrow, bf16* __restrict__ orow, float* __restrict__ rs, int lane) {
    f32x4 v[16]; float s = 0.f;
#pragma unroll
    for (int j = 0; j < 8; ++j) { const f32x4* p = (const f32x4*)(xrow + 8 * (lane + 64 * j)); v[2 * j] = p[0]; v[2 * j + 1] = p[1]; }
#pragma unroll
    for (int j = 0; j < 16; ++j) s += (v[j][0] * v[j][0] + v[j][1] * v[j][1]) + (v[j][2] * v[j][2] + v[j][3] * v[j][3]);
    const float r = 1.0f / sqrtf(wave_sum(s) * (1.0f / 4096.0f) + EPS);
    if (lane == 0) *rs = r;
#pragma unroll
    for (int j = 0; j < 8; ++j) { const f32x4 a = v[2 * j], b = v[2 * j + 1];
        v4u o; o.x = pk2(a[0], a[1]); o.y = pk2(a[2], a[3]); o.z = pk2(b[0], b[1]); o.w = pk2(b[2], b[3]);
        *(v4u*)(orow + 8 * (lane + 64 * j)) = o; }
}
__device__ __forceinline__ void unpack8(const v4u q, float* y) {
    y[0] = __builtin_bit_cast(float, q.x << 16); y[1] = __builtin_bit_cast(float, q.x & 0xffff0000u); y[2] = __builtin_bit_cast(float, q.y << 16); y[3] = __builtin_bit_cast(float, q.y & 0xffff0000u);
    y[4] = __builtin_bit_cast(float, q.z << 16); y[5] = __builtin_bit_cast(float, q.z & 0xffff0000u); y[6] = __builtin_bit_cast(float, q.w << 16); y[7] = __builtin_bit_cast(float, q.w & 0xffff0000u);
}
__device__ __forceinline__ void residual_row(const float* __restrict__ xin32, bf16* xb, const bf16* __restrict__ yrow, const f32x4 (&gv)[16], float* __restrict__ out32, float* __restrict__ rs_next, bool last, int lane) {
    float x[64], y[64]; float s = 0.f;
#pragma unroll
    for (int j = 0; j < 8; ++j) { unpack8(*(const v4u*)(yrow + 8 * (lane + 64 * j)), y + 8 * j);
        if (xin32) { const f32x4* p = (const f32x4*)(xin32 + 8 * (lane + 64 * j)); const f32x4 a = p[0], b = p[1];
#pragma unroll
            for (int e = 0; e < 4; ++e) { x[8 * j + e] = a[e]; x[8 * j + 4 + e] = b[e]; } }
        else unpack8(*(const v4u*)(xb + 8 * (lane + 64 * j)), x + 8 * j); }
#pragma unroll
    for (int i = 0; i < 64; ++i) s += y[i] * y[i];
    const float r = 1.0f / sqrtf(wave_sum(s) * (1.0f / 4096.0f) + EPS);
    float s2 = 0.f;
#pragma unroll
    for (int j = 0; j < 8; ++j) { const f32x4 g0 = gv[2 * j], g1 = gv[2 * j + 1];
#pragma unroll
        for (int e = 0; e < 4; ++e) { x[8 * j + e] += y[8 * j + e] * r * g0[e]; x[8 * j + 4 + e] += y[8 * j + 4 + e] * r * g1[e]; }
#pragma unroll
        for (int e = 0; e < 8; ++e) s2 += x[8 * j + e] * x[8 * j + e];
        if (last) { f32x4* op = (f32x4*)(out32 + 8 * (lane + 64 * j)); op[0] = (f32x4){x[8 * j], x[8 * j + 1], x[8 * j + 2], x[8 * j + 3]}; op[1] = (f32x4){x[8 * j + 4], x[8 * j + 5], x[8 * j + 6], x[8 * j + 7]}; }
        else { v4u o; o.x = pk2(x[8 * j], x[8 * j + 1]); o.y = pk2(x[8 * j + 2], x[8 * j + 3]); o.z = pk2(x[8 * j + 4], x[8 * j + 5]); o.w = pk2(x[8 * j + 6], x[8 * j + 7]);
            *(v4u*)(xb + 8 * (lane + 64 * j)) = o; } }
    if (!last) { const float r2 = 1.0f / sqrtf(wave_sum(s2) * (1.0f / 4096.0f) + EPS); if (lane == 0) *rs_next = r2; }
}
__device__ __forceinline__ float ret_lg(int h) { return log1pf(-exp2f(-5.0f - (float)h)); }
__device__ __forceinline__ void sgu_phase(LAS unsigned char* lds_, const bf16* __restrict__ PROJ, bf16* __restrict__ CAT, const bf16* __restrict__ SGW, const float* __restrict__ lng, const float* __restrict__ lnb, const float* __restrict__ bs) {
    const Frame F = make_frame(lds_);
    LAS bf16* Wm = (LAS bf16*)(F.lds + RING_OFF);
    LAS bf16* VT = Wm + 128 * 136;
    const int r32 = F.lane & 31, hi = F.lane >> 5;
    const int ib = F.wave >> 1, cb0 = (F.wave & 1) * 2;
    bf16x8 w4[4]; unsigned pv[16]; unsigned short ua[16], ub[16]; float bias[16];
#define SGU_LOAD(u_) do { const int b_ = (u_) >> 8, n_ = ((u_) >> 3) & 31, g_ = (u_) & 7; const size_t R_ = (size_t)b_ * SEQ + (size_t)n_ * 128; const int cb_ = g_ * 128; \
        _Pragma("unroll") for (int k = 0; k < 4; ++k) { const int q = F.tid + k * 512; w4[k] = *(const bf16x8*)(SGW + ((size_t)g_ * 128 + (q >> 4)) * 128 + (q & 15) * 8); } \
        _Pragma("unroll") for (int jj = 0; jj < 16; ++jj) pv[jj] = *(const unsigned*)(PROJ + (R_ + F.wave * 16 + jj) * INP + C_V + cb_ + 2 * F.lane); } while (0)
#define SGU_LOADU(u_) do { const int b_ = (u_) >> 8, n_ = ((u_) >> 3) & 31, g_ = (u_) & 7; const size_t R_ = (size_t)b_ * SEQ + (size_t)n_ * 128; const int cb_ = g_ * 128; \
        _Pragma("unroll") for (int r = 0; r < 16; ++r) { const int i = ib * 32 + crow32(r, hi); bias[r] = bs[g_ * 128 + i]; \
            ua[r] = PROJ[(R_ + i) * INP + C_U + cb_ + cb0 * 32 + r32]; ub[r] = PROJ[(R_ + i) * INP + C_U + cb_ + cb0 * 32 + r32 + 32]; } } while (0)
    if (F.vcu < 512) { SGU_LOAD(F.vcu); SGU_LOADU(F.vcu); }
    for (int unit = F.vcu; unit < 512; unit += F.G) {
        const int b = unit >> 8, n = (unit >> 3) & 31, g = unit & 7;
        const size_t R0 = (size_t)b * SEQ + (size_t)n * 128; const int cb = g * 128;
#pragma unroll
        for (int k = 0; k < 4; ++k) { const int q = F.tid + k * 512; *(LAS bf16x8*)(Wm + (q >> 4) * 136 + (q & 15) * 8) = w4[k]; }
        const float g0 = lng[cb + 2 * F.lane], g1 = lng[cb + 2 * F.lane + 1], b0 = lnb[cb + 2 * F.lane], b1 = lnb[cb + 2 * F.lane + 1];
#pragma unroll
        for (int jj = 0; jj < 16; ++jj) { const int j = F.wave * 16 + jj;
            const float x0 = __builtin_bit_cast(float, pv[jj] << 16), x1 = __builtin_bit_cast(float, pv[jj] & 0xffff0000u);
            const float mu = wave_sum(x0 + x1) * (1.0f / 128.0f), d0 = x0 - mu, d1 = x1 - mu;
            const float rstd = 1.0f / sqrtf(wave_sum(d0 * d0 + d1 * d1) * (1.0f / 128.0f) + EPS);
            VT[(2 * F.lane) * 136 + j] = f2bf16(d0 * rstd * g0 + b0); VT[(2 * F.lane + 1) * 136 + j] = f2bf16(d1 * rstd * g1 + b1); }
        __syncthreads();
        if (unit + F.G < 512) SGU_LOAD(unit + F.G);
        f32x16 acc0 = {}, acc1 = {};
        mfma_lds<8>(acc0, Wm + ib * 32 * 136, 136, VT + (cb0 * 32) * 136, 136, r32, hi);
        mfma_lds<8>(acc1, Wm + ib * 32 * 136, 136, VT + ((cb0 + 1) * 32) * 136, 136, r32, hi);
#pragma unroll
        for (int r = 0; r < 16; ++r) { const int i = ib * 32 + crow32(r, hi); const size_t row = R0 + i; const int c = cb0 * 32 + r32;
            CAT[row * DM + cb + c] = f2bf16(bf2f(ua[r]) * (acc0[r] + bias[r])); CAT[row * DM + cb + c + 32] = f2bf16(bf2f(ub[r]) * (acc1[r] + bias[r])); }
        if (unit + F.G < 512) SGU_LOADU(unit + F.G);
        __syncthreads();
    }
#undef SGU_LOAD
#undef SGU_LOADU
}
__device__ __forceinline__ void ret1_phase(LAS unsigned char* lds_, const bf16* __restrict__ PROJ, float* __restrict__ KVS) {
    const Frame F = make_frame(lds_);
    LAS bf16* KT = (LAS bf16*)(F.lds + RING_OFF);
    LAS bf16* VT = KT + 64 * 72;
    const int r32 = F.lane & 31, hi = F.lane >> 5;
    const int m = F.tid >> 3, d0 = (F.tid & 7) * 8, e0 = (F.tid & 7) * 16;
    bf16x8 kv, va, vb;
#define R1_LOAD(u_) do { const int bh_ = (u_) >> 6, c_ = (u_) & 63; const size_t R_ = (size_t)(bh_ >> 3) * SEQ + (size_t)c_ * 64 + m; const int h_ = bh_ & 7; \
        kv = *(const bf16x8*)(PROJ + R_ * INP + C_RK + h_ * 64 + d0); va = *(const bf16x8*)(PROJ + R_ * INP + C_RV + h_ * 128 + e0); vb = *(const bf16x8*)(PROJ + R_ * INP + C_RV + h_ * 128 + e0 + 8); } while (0)
    if (F.vcu < 1024) R1_LOAD(F.vcu);
    for (int unit = F.vcu; unit < 1024; unit += F.G) {
        const int bh = unit >> 6, h = bh & 7; const float lg = ret_lg(h);
        const float kd = expf(lg * (float)(63 - m));
#pragma unroll
        for (int i = 0; i < 8; ++i) KT[(d0 + i) * 72 + m] = f2bf16(bf2f((unsigned short)kv[i]) * kd);
#pragma unroll
        for (int i = 0; i < 8; ++i) { VT[(e0 + i) * 72 + m] = (unsigned short)va[i]; VT[(e0 + 8 + i) * 72 + m] = (unsigned short)vb[i]; }
        __syncthreads();
        if (unit + F.G < 1024) R1_LOAD(unit + F.G);
        const int eb = F.wave >> 1, db = F.wave & 1;
        f32x16 acc = {};
        mfma_lds<4>(acc, VT + eb * 32 * 72, 72, KT + db * 32 * 72, 72, r32, hi);
#pragma unroll
        for (int r = 0; r < 16; ++r) KVS[((size_t)unit * 128 + eb * 32 + crow32(r, hi)) * 64 + db * 32 + r32] = acc[r];
        __syncthreads();
    }
#undef R1_LOAD
}
__device__ __forceinline__ void ret2_phase(LAS unsigned char* lds_, const float* __restrict__ KVS, bf16* __restrict__ SB) {
    const Frame F = make_frame(lds_);
    for (int gid = F.vcu * (NWAVES * 64) + F.tid; gid < 16 * 8192; gid += F.G * NWAVES * 64) {
        const int bh = gid >> 13, idx = gid & 8191; const float cd = expf(ret_lg(bh & 7) * 64.0f);
        const size_t o0 = (size_t)bh * 64 * 8192 + idx;
        float S = 0.f;
#pragma unroll
        for (int c0 = 0; c0 < 64; c0 += 32) {
            float kv[32];
#pragma unroll
            for (int c = 0; c < 32; ++c) kv[c] = KVS[o0 + (size_t)(c0 + c) * 8192];
#pragma unroll
            for (int c = 0; c < 32; ++c) { SB[o0 + (size_t)(c0 + c) * 8192] = f2bf16(S); S = cd * S + kv[c]; }
        }
    }
}
__device__ __forceinline__ void ret3_phase(LAS unsigned char* lds_, const bf16* __restrict__ PROJ, const bf16* __restrict__ SB, bf16* __restrict__ CAT) {
    const Frame F = make_frame(lds_);
    LAS bf16* Qs = (LAS bf16*)(F.lds + RING_OFF);
    LAS bf16* Ks = Qs + 64 * 72;
    LAS bf16* VT = Ks + 64 * 72;
    LAS bf16* Ss = VT + 128 * 72;
    LAS bf16* Ps = Ss + 128 * 72;
    LAS float* red = (LAS float*)(Ps + 64 * 72);
    const int r32 = F.lane & 31, hi = F.lane >> 5;
    const int m = F.tid >> 3, d0 = (F.tid & 7) * 8, e0 = (F.tid & 7) * 16;
    bf16x8 rq, rk, rva, rvb, rs0, rs1;
#define R3_LOAD(u_) do { const int bh_ = (u_) >> 6, c_ = (u_) & 63; const size_t R_ = (size_t)(bh_ >> 3) * SEQ + (size_t)c_ * 64 + m; const int h_ = bh_ & 7; \
        rq = *(const bf16x8*)(PROJ + R_ * INP + C_RQ + h_ * 64 + d0); rk = *(const bf16x8*)(PROJ + R_ * INP + C_RK + h_ * 64 + d0); \
        rva = *(const bf16x8*)(PROJ + R_ * INP + C_RV + h_ * 128 + e0); rvb = *(const bf16x8*)(PROJ + R_ * INP + C_RV + h_ * 128 + e0 + 8); \
        rs0 = *(const bf16x8*)(SB + (size_t)(u_) * 8192 + F.tid * 8); rs1 = *(const bf16x8*)(SB + (size_t)(u_) * 8192 + (F.tid + 512) * 8); } while (0)
    if (F.vcu < 1024) R3_LOAD(F.vcu);
    for (int unit = F.vcu; unit < 1024; unit += F.G) {
        const int bh = unit >> 6, c = unit & 63, b = bh >> 3, h = bh & 7; const float lg = ret_lg(h);
        const size_t R0 = (size_t)b * SEQ + (size_t)c * 64;
        *(LAS bf16x8*)(Qs + m * 72 + d0) = rq; *(LAS bf16x8*)(Ks + m * 72 + d0) = rk;
#pragma unroll
        for (int i = 0; i < 8; ++i) { VT[(e0 + i) * 72 + m] = (unsigned short)rva[i]; VT[(e0 + 8 + i) * 72 + m] = (unsigned short)rvb[i]; }
        *(LAS bf16x8*)(Ss + (F.tid >> 3) * 72 + (F.tid & 7) * 8) = rs0; *(LAS bf16x8*)(Ss + ((F.tid + 512) >> 3) * 72 + (F.tid & 7) * 8) = rs1;
        __syncthreads();
        if (unit + F.G < 1024) R3_LOAD(unit + F.G);
        const int lb = F.wave & 1, eb = F.wave >> 1;
        unsigned short gt[16];
#pragma unroll
        for (int r = 0; r < 16; ++r) gt[r] = PROJ[(R0 + lb * 32 + crow32(r, hi)) * INP + C_RG + h * 128 + eb * 32 + r32];
        f32x16 cross = {};
        mfma_lds<4>(cross, Qs + lb * 32 * 72, 72, Ss + eb * 32 * 72, 72, r32, hi);
        if (F.wave < 4) { const int mb = F.wave >> 1; f32x16 sc = {};
            mfma_lds<4>(sc, Qs + lb * 32 * 72, 72, Ks + mb * 32 * 72, 72, r32, hi);
#pragma unroll
            for (int r = 0; r < 16; ++r) { const int l = lb * 32 + crow32(r, hi), mm = mb * 32 + r32; const int ad = l > mm ? l - mm : mm - l;
                Ps[l * 72 + mm] = f2bf16(sc[r] * expf(lg * (float)ad)); } }
        __syncthreads();
        f32x16 o = {};
        mfma_lds<4>(o, Ps + lb * 32 * 72, 72, VT + eb * 32 * 72, 72, r32, hi);
#pragma unroll
        for (int r = 0; r < 16; ++r) { const int l = lb * 32 + crow32(r, hi); o[r] += cross[r] * expf(lg * (float)(l + 1));
            float s = o[r] * o[r];
#pragma unroll
            for (int x = 1; x < 32; x <<= 1) s += __shfl_xor(s, x);
            if (r32 == 0) red[l * 4 + eb] = s; }
        __syncthreads();
#pragma unroll
        for (int r = 0; r < 16; ++r) { const int l = lb * 32 + crow32(r, hi); const f32x4 t = *(const LAS f32x4*)(red + l * 4);
            const float rn = 1.0f / sqrtf(((t[0] + t[1]) + (t[2] + t[3])) * (1.0f / 128.0f) + EPS); const int e = eb * 32 + r32;
            const float g = bf2f(gt[r]); const float sg = g / (1.0f + expf(-g));
            CAT[(R0 + l) * DM + 3072 + h * 128 + e] = f2bf16(sg * (o[r] * rn)); }
        __syncthreads();
    }
#undef R3_LOAD
}
#define CVT_LOOP(NITEMS, NIF, NTS) do { for (int it = gw; it < (NITEMS); it += (NIF) * NGW) { float vv[NIF][32]; \
    _Pragma("unroll") for (int j = 0; j < (NIF); ++j) if (it + j * NGW < (NITEMS)) { const CvtDesc d = desc_of(it + j * NGW); cvt_load(d, vv[j], F.lane); } \
    _Pragma("unroll") for (int j = 0; j < (NIF); ++j) if (it + j * NGW < (NITEMS)) { const CvtDesc d = desc_of(it + j * NGW); cvt_finish<NTS>(d, vv[j], scr, F.lane); } } } while (0)
#ifndef PRO_NIF
#define PRO_NIF 2
#endif
#ifndef DEF_NIF
#define DEF_NIF 1
#endif
#ifndef DEF_NT
#define DEF_NT true
#endif
#ifndef DOWN_KREV
#define DOWN_KREV 1
#endif
#ifndef UP_DEFER
#define UP_DEFER 6144
#endif
#ifndef WARM_UP
#define WARM_UP 0
#endif
#ifndef MID_CONV
#define MID_CONV 1
#endif
#ifndef DEF_WV
#define DEF_WV 8
#endif
#ifndef DN_DEFER
#define DN_DEFER 32768
#endif
#ifndef GEMM_ALIGN
#define GEMM_ALIGN true
#endif
#ifndef GEMM_SP2
#define GEMM_SP2 true
#endif
#ifndef REP_PRO
#define REP_PRO 1
#endif
#ifndef REP_ATTN
#define REP_ATTN 1
#endif
#ifndef REP_UP
#define REP_UP 1
#endif
#ifndef REP_IN
#define REP_IN 1
#endif
#ifndef REP_QKV
#define REP_QKV 1
#endif
#ifndef REP_RET3
#define REP_RET3 1
#endif
#ifndef BAR_DUP
#define BAR_DUP 1
#endif
#ifndef REP_OUT
#define REP_OUT 1
#endif
#ifndef REP_DOWN
#define REP_DOWN 1
#endif
#ifndef REP_RES
#define REP_RES 1
#endif
#ifndef REP_BAR
#define REP_BAR 0
#endif
#ifndef REP_RET2
#define REP_RET2 1
#endif
#ifndef PROBE_IDX
#define PROBE_IDX -1
#endif
#ifndef PROBE_Q
#define PROBE_Q 50
#endif
#ifndef PROBE_END
#define PROBE_END (PROBE_IDX + 1)
#endif
#ifndef PROBE_LO
#define PROBE_LO 0
#endif
#ifndef PROBE_HI
#define PROBE_HI 1000
#endif
#ifndef PROBE_L
#define PROBE_L 0
#endif
#ifndef REP_SMALL
#define REP_SMALL 1
#endif
struct Args { const float* in[17]; float* out; unsigned char* ws; };
typedef const Args __attribute__((address_space(4))) CArgs;
__device__ __forceinline__ CArgs* fresh_args() { CArgs* p = (CArgs*)__builtin_amdgcn_kernarg_segment_ptr(); asm volatile("" : "+s"(p)); return p; }
constexpr int CJ_N[6] = {(DM / 64) * (INP / 32), (1024 / 64) * (QW / 32), (512 / 64) * (KVW / 32), (DM / 64) * (DM / 32), (DM / 64) * (FF / 32), (FF / 64) * (DM / 32)};
__device__ __forceinline__ CvtDesc job_desc(CArgs* A, unsigned char* ws, int job, int l, int r) {
    unsigned char* wl = ws + WS_W + (size_t)l * LW; CvtDesc d; int nblk;
    if (job == 0) { d.W = A->in[5] + (size_t)l * DM * INW; d.WT = (bf16*)(wl + W_IN); d.kgain = A->in[1] + l * DM; d.K = DM; d.N = INW; nblk = INP / 32; d.kind = 1; }
    else if (job == 1) { d.W = A->in[11] + (size_t)l * 1024 * QW; d.WT = (bf16*)(wl + W_Q); d.kgain = A->in[10] + l * 1024; d.K = 1024; d.N = QW; nblk = QW / 32; d.kind = 2; }
    else if (job == 2) { d.W = A->in[13] + (size_t)l * 512 * KVW; d.WT = (bf16*)(wl + W_KV); d.kgain = A->in[12] + l * 512; d.K = 512; d.N = KVW; nblk = KVW / 32; d.kind = 0; }
    else if (job == 3) { d.W = A->in[14] + (size_t)l * DM * DM; d.WT = (bf16*)(wl + W_OUT); d.kgain = nullptr; d.K = DM; d.N = DM; nblk = DM / 32; d.kind = 0; }
    else if (job == 4) { d.W = A->in[15] + (size_t)l * DM * FF; d.WT = (bf16*)(wl + W_UP); d.kgain = A->in[3] + l * DM; d.K = DM; d.N = FF; nblk = FF / 32; d.kind = 0; }
    else { d.W = A->in[16] + (size_t)l * FF * DM; d.WT = (bf16*)(wl + W_DOWN); d.kgain = nullptr; d.K = FF; d.N = DM; nblk = DM / 32; d.kind = 0; }
    d.k0 = 64 * (r / nblk); d.n0 = 32 * (r % nblk); return d;
}
template <int NIF, bool NTS, int WV = NWAVES> __device__ __forceinline__ void convert_pass(LAS unsigned char* lds_, int idx, int n, int j0, int l0, int j1, int l1, int j2, int l2) {
    const Frame F = make_frame(lds_); CArgs* A = fresh_args(); unsigned char* ws = A->ws;
    LAS float* scr = (LAS float*)(F.lds + RING_OFF + F.wave * 16384);
    const int gw = idx * WV + F.wave, NGW = n * WV;
    if (F.wave >= WV) return;
    const int n0 = CJ_N[j0], n1 = j1 >= 0 ? CJ_N[j1] : 0, n2 = j2 >= 0 ? CJ_N[j2] : 0, NTOT = n0 + n1 + n2;
    auto desc_of = [&](int it) -> CvtDesc { if (it < n0) return job_desc(A, ws, j0, l0, it); it -= n0; if (it < n1) return job_desc(A, ws, j1, l1, it); return job_desc(A, ws, j2, l2, it - n1); };
    CVT_LOOP(NTOT, NIF, NTS);
}
__device__ __forceinline__ void prologue_phase(LAS unsigned char* lds_) {
    convert_pass<PRO_NIF, false>(lds_, make_frame(lds_).vcu, (int)gridDim.x, 4, 0, 0, 0, -1, 0);
    const Frame F = make_frame(lds_); CArgs* A = fresh_args(); unsigned char* ws = A->ws; float* rope = (float*)(ws + WS_ROPE); bf16* H = (bf16*)(ws + WS_H);
    const int gw = F.vcu * NWAVES + F.wave, NGW = F.G * NWAVES;
        for (int i = F.vcu * (NWAVES * 64) + F.tid; i < DEPTH * 8 * 128 * 128; i += F.G * NWAVES * 64) {
            const int l = i >> 17, r = i & 131071, ii = (r >> 7) & 127, jj = r & 127;
            ((bf16*)(ws + WS_W + (size_t)l * LW + W_SGU))[r] = ((jj >> 6) <= (ii >> 6)) ? f2bf16(A->in[8][i]) : (bf16)0; }
        for (int i = F.vcu * (NWAVES * 64) + F.tid; i < SEQ * 32; i += F.G * NWAVES * 64) {
            const int pos = i >> 5, j = i & 31; const float inv = (float)pow(10000.0, -(double)j / 32.0); const float ang = (float)pos * inv;
            float sn, cs; sincosf(ang, &sn, &cs); rope[2 * i] = cs; rope[2 * i + 1] = sn; }
        { float* rs0 = (float*)(ws + WS_RS); for (int m = gw; m < M; m += NGW) x_row_to_bf16(A->in[0] + (size_t)m * DM, H + (size_t)m * DM, rs0 + m, F.lane); }
}
__device__ __forceinline__ void residual_phase(LAS unsigned char* lds_, int l, int which, bool dry = false) {
    const Frame F = make_frame(lds_); CArgs* A = fresh_args(); unsigned char* ws = A->ws; const int gw = F.vcu * NWAVES + F.wave, NGW = F.G * NWAVES;
    const float* xin32 = (which == 0 && l == 0) ? A->in[0] : nullptr; const bf16* Y = (const bf16*)(ws + WS_MIX); bf16* XB = (bf16*)(ws + WS_H);
    const bool last = (which == 1 && l + 1 == DEPTH);
    float* out32 = dry ? (float*)(ws + WS_ACT) : A->out; float* rs_next = (float*)(ws + WS_RS) + (which == 0 ? M : 0) + (dry ? 2 * M : 0);
    if (dry) XB = (bf16*)(ws + WS_ACT + 134 * MiB);
    const float* gpost = (which == 0 ? A->in[2] : A->in[4]) + l * DM;
    f32x4 gv[16];
#pragma unroll
    for (int j = 0; j < 8; ++j) { const f32x4* gp = (const f32x4*)(gpost + 8 * (F.lane + 64 * j)); gv[2 * j] = gp[0]; gv[2 * j + 1] = gp[1]; }
    for (int m = gw; m < M; m += NGW) residual_row(xin32 ? xin32 + (size_t)m * DM : nullptr, XB + (size_t)m * DM, Y + (size_t)m * DM, gv, out32 + (size_t)m * DM, rs_next + m, last, F.lane);
}
__device__ __forceinline__ void warm_phase(LAS unsigned char* lds_, size_t off, size_t bytes, int l) {
    const Frame F = make_frame(lds_); CArgs* A = fresh_args(); const unsigned* p = (const unsigned*)(A->ws + WS_W + (size_t)l * LW + off);
    const size_t nlines = bytes / 128; unsigned acc = 0;
    for (size_t i = (size_t)F.vcu * (NWAVES * 64) + F.tid; i < nlines; i += (size_t)F.G * NWAVES * 64) acc += p[i * 32];
    if (acc == 0x12345678u) ((unsigned*)(A->ws + WS_CTL))[2048] = acc;
}
__device__ __forceinline__ void attn_phase(LAS unsigned char* lds_) {
    const Frame F = make_frame(lds_); CArgs* A = fresh_args(); unsigned char* ws = A->ws;
    const bf16* QB = (const bf16*)(ws + WS_Q); const bf16* KVB = (const bf16*)(ws + WS_KV); const bf16* PROJ = (const bf16*)(ws + WS_PROJ); bf16* CAT = (bf16*)(ws + WS_CAT);
    for (int p2 = 2 * F.vcu; p2 < 512; p2 += 2 * F.G)
        for (int k = 0; k < 2; ++k) { const int p = p2 >> 1, bh = p >> 3, s = p & 7;
            att::attn_unit(QB, KVB, PROJ, CAT, bh >> 4, bh & 15, k ? 15 - s : s, (ATT_LAS char*)(F.lds + RING_OFF)); }
}
template <int WHICH> __device__ __forceinline__ void gemm_call(LAS unsigned char* lds_, int l) {
    CArgs* A = fresh_args(); unsigned char* ws = A->ws; unsigned char* wl = ws + WS_W + (size_t)l * LW; int bx = blockIdx.x; asm volatile("" : "+s"(bx)); const int G = gridDim.x;
    float* rope = (float*)(ws + WS_ROPE); float* ssq = (float*)(ws + WS_SSQ); const float* rs = (const float*)(ws + WS_RS);
    bf16* H = (bf16*)(ws + WS_H); bf16* PROJ = (bf16*)(ws + WS_PROJ); bf16* QB = (bf16*)(ws + WS_Q); bf16* KVB = (bf16*)(ws + WS_KV);
    bf16* CAT = (bf16*)(ws + WS_CAT); bf16* MIX = (bf16*)(ws + WS_MIX); bf16* ACT = (bf16*)(ws + WS_ACT);
    pg8::StaticOrder S; const LAS float* rsl = (const LAS float*)(lds_ + LDSCTL_OFF + 1024);
    if constexpr (WHICH == 0) { pg8::Gemm g{H, (const bf16*)(wl + W_IN), M, INP, DM, DM, 0}; S.init(M, INP, G, bx); pg8::Epi<2> E{PROJ, INP, rope, ssq, rs, rsl, -1};
        pg8::gemm_phase<pg8::Epi<2>, pg8::StaticOrder, GEMM_ALIGN, GEMM_SP2>(lds_ + RING_OFF, g, S, E); }
    if constexpr (WHICH == 1) { pg8::Gemm g{PROJ + C_CQ, (const bf16*)(wl + W_Q), M, QW, 1024, INP, 0}; S.init(M, QW, G, bx); pg8::Epi<3> E{QB, QW, rope, ssq, nullptr, rsl, -1};
        pg8::gemm_phase<pg8::Epi<3>, pg8::StaticOrder, GEMM_ALIGN, GEMM_SP2>(lds_ + RING_OFF, g, S, E); }
    if constexpr (WHICH == 2) { pg8::Gemm g{PROJ + C_CKV, (const bf16*)(wl + W_KV), M, KVW, 512, INP, 0}; S.init(M, KVW, G, bx); pg8::Epi<4> E{KVB, KVW, rope, ssq, nullptr, rsl, -1};
        pg8::gemm_phase<pg8::Epi<4>, pg8::StaticOrder, GEMM_ALIGN, GEMM_SP2>(lds_ + RING_OFF, g, S, E); }
    if constexpr (WHICH == 3) { pg8::Gemm g{CAT, (const bf16*)(wl + W_OUT), M, DM, DM, DM, 0}; S.init(M, DM, G, bx); pg8::Epi<0> E{MIX, DM, rope, ssq, nullptr, rsl, -1};
        pg8::gemm_phase<pg8::Epi<0>, pg8::StaticOrder, GEMM_ALIGN, GEMM_SP2>(lds_ + RING_OFF, g, S, E); }
    if constexpr (WHICH == 4) { pg8::Gemm g{H, (const bf16*)(wl + W_UP), M, FF, DM, DM, 0}; S.init(M, FF, G, bx); pg8::Epi<1> E{ACT, FF, rope, ssq, rs + M, rsl, -1};
        pg8::gemm_phase<pg8::Epi<1>, pg8::StaticOrder, GEMM_ALIGN, GEMM_SP2>(lds_ + RING_OFF, g, S, E); }
    if constexpr (WHICH == 5) { pg8::Gemm g{ACT + (DOWN_KREV ? FF - 64 : 0), (const bf16*)(wl + W_DOWN) + (DOWN_KREV ? FF - 64 : 0), M, DM, FF, FF, DOWN_KREV};     S.init(M, DM, G, bx); pg8::Epi<0> E{MIX, DM, rope, ssq, nullptr, rsl, -1};
        pg8::gemm_phase<pg8::Epi<0>, pg8::StaticOrder, GEMM_ALIGN, GEMM_SP2>(lds_ + RING_OFF, g, S, E); }
}
__device__ __forceinline__ void mixer_small_phases(LAS unsigned char* lds_, int l) {
    CArgs* A = fresh_args(); unsigned char* ws = A->ws;
    sgu_phase(lds_, (const bf16*)(ws + WS_PROJ), (bf16*)(ws + WS_CAT), (const bf16*)(ws + WS_W + (size_t)l * LW + W_SGU), A->in[6] + l * 1024, A->in[7] + l * 1024, A->in[9] + l * 1024);
    CArgs* A2 = fresh_args(); unsigned char* ws2 = A2->ws;
    ret1_phase(lds_, (const bf16*)(ws2 + WS_PROJ), (float*)(ws2 + WS_KVS));
}
__global__ void __launch_bounds__(NWAVES * 64, 2) mega_fwd(Args args) {
    extern __shared__ __attribute__((aligned(16))) unsigned char lds[];
    LAS unsigned char* L = (LAS unsigned char*)lds;
    volatile LAS unsigned* MISC = (volatile LAS unsigned*)(L + MISC_OFF);
    for (int u = threadIdx.x; u < (LDS_BYTES - LDSCTL_OFF) / 4; u += NWAVES * 64) ((LAS unsigned*)(L + LDSCTL_OFF))[u] = 0u;
    __syncthreads();
    XcdBarrier bar = xcd_barrier_post((unsigned*)(args.ws + WS_CTL) + CW_BAR, MISC + 8);
#define GRID_BAR() do { for (int bd_ = 0; bd_ < BAR_DUP; ++bd_) { XcdBarrier b_ = bar; asm volatile("" : "+s"(b_.bar), "+s"(b_.x)); xcd_barrier(b_); } } while (0)
    unsigned long long tp0 = 0, tp1 = 0;
#define STAMP(kk, cond) do { if (PROBE_IDX >= 0 && (cond)) { if (PROBE_IDX == (kk)) tp0 = __builtin_amdgcn_s_memrealtime(); if (PROBE_END == (kk)) tp1 = __builtin_amdgcn_s_memrealtime(); } } while (0)
    STAMP(0, true);
    for (int rep_ = 0; rep_ < REP_PRO; ++rep_) prologue_phase(L);
    GRID_BAR();
    for (int l = 0; l < DEPTH; ++l) {
        STAMP(1, l == PROBE_L);
        for (int rep_ = 0; rep_ < REP_IN; ++rep_) gemm_call<0>(L, l);
        STAMP(24, l == PROBE_L);
        { int bx = blockIdx.x; asm volatile("" : "+s"(bx)); const int G = gridDim.x, NT_IN = (M / 256) * (INP / 256), nfull = NT_IN % G;
          const int idx = nfull == 0 ? bx : bx - nfull, n = nfull == 0 ? G : G - nfull;
          if (nfull == 0 || bx >= nfull) { convert_pass<DEF_NIF, true, DEF_WV>(L, idx, n, 5, l, -1, 0, -1, 0); convert_pass<DEF_NIF, false, DEF_WV>(L, idx, n, 1, l, 2, l, -1, 0); } }
        GRID_BAR();
        STAMP(2, l == PROBE_L);
        for (int rep_ = 0; rep_ < REP_QKV; ++rep_) { gemm_call<1>(L, l);
            { int bx = blockIdx.x; asm volatile("" : "+s"(bx)); const int G = gridDim.x, nfull = ((M / 256) * (QW / 256)) % G;
                if (nfull == 0) convert_pass<DEF_NIF, false>(L, bx, G, 3, l, -1, 0, -1, 0); else if (bx >= nfull) convert_pass<DEF_NIF, false>(L, bx - nfull, G - nfull, 3, l, -1, 0, -1, 0);
                __syncthreads(); }
            STAMP(20, l == PROBE_L); gemm_call<2>(L, l); STAMP(21, l == PROBE_L); }
        for (int rep_ = 0; rep_ < REP_SMALL; ++rep_) mixer_small_phases(L, l);
        STAMP(23, l == PROBE_L);
        GRID_BAR();
        STAMP(3, l == PROBE_L);
        for (int rep_ = 0; rep_ < REP_RET2; ++rep_) { CArgs* A = fresh_args(); unsigned char* ws = A->ws; ret2_phase(L, (const float*)(ws + WS_KVS), (bf16*)(ws + WS_SB)); }
        for (int rep_ = 0; rep_ < REP_ATTN; ++rep_) attn_phase(L);
        GRID_BAR();
        STAMP(4, l == PROBE_L);
        for (int rep_ = 0; rep_ < REP_RET3; ++rep_) { CArgs* A = fresh_args(); unsigned char* ws = A->ws; ret3_phase(L, (const bf16*)(ws + WS_PROJ), (const bf16*)(ws + WS_SB), (bf16*)(ws + WS_CAT)); }
        GRID_BAR();
        STAMP(5, l == PROBE_L);
        for (int rep_ = 0; rep_ < REP_OUT; ++rep_) gemm_call<3>(L, l);
        GRID_BAR();
        STAMP(6, l == PROBE_L);
        for (int rep_ = 0; rep_ < REP_RES; ++rep_) residual_phase(L, l, 0, rep_ + 1 < REP_RES);
        if (WARM_UP) warm_phase(L, W_UP, (size_t)FF * DM * 2, l);
        GRID_BAR();
        STAMP(7, l == PROBE_L);
        for (int rep_ = 0; rep_ < REP_UP; ++rep_) { if (rep_ && REP_BAR) GRID_BAR(); gemm_call<4>(L, l); }
        GRID_BAR();
        STAMP(8, l == PROBE_L);
        if (l + 1 < DEPTH) { int bx = blockIdx.x; asm volatile("" : "+s"(bx)); convert_pass<PRO_NIF, false>(L, make_frame(L).vcu, (int)gridDim.x, 4, l + 1, -1, 0, -1, 0); __syncthreads(); }
        for (int rep_ = 0; rep_ < REP_DOWN; ++rep_) gemm_call<5>(L, l);
        GRID_BAR();
        STAMP(9, l == PROBE_L);
        for (int rep_ = 0; rep_ < REP_RES; ++rep_) residual_phase(L, l, 1, rep_ + 1 < REP_RES);
        if (l + 1 < DEPTH) convert_pass<PRO_NIF, false>(L, make_frame(L).vcu, (int)gridDim.x, 0, l + 1, -1, 0, -1, 0);
        STAMP(10, l == PROBE_L);
        if (l + 1 < DEPTH) GRID_BAR();
    }
    if (PROBE_IDX >= 0 && blockIdx.x == 0 && threadIdx.x == 0) { asm volatile("s_waitcnt vmcnt(0)" ::: "memory");
        float tus = (float)(tp1 - tp0) * 0.01f; float fr = (tus - (float)PROBE_LO) / (float)(PROBE_HI - PROBE_LO); fr = fr < 0.f ? 0.f : (fr > 1.f ? 1.f : fr); args.out[0] += 0.15f + 0.24f * fr; }
}

extern "C" void kernel_launch(void* const* d_in, const int* in_sizes, int n_in, void* d_out, int out_size, void* d_ws, size_t ws_size, hipStream_t stream) {
    static int grid = 0;
    if (grid == 0) {
        if (n_in != 17 || in_sizes[0] != M * DM || out_size != M * DM || ws_size < WS_END) { fprintf(stderr, "kernel_launch: shape mismatch (n_in %d, in0 %d, out %d, ws %zu < %zu)\n", n_in, n_in > 0 ? in_sizes[0] : -1, out_size, ws_size, (size_t)WS_END); grid = -1; return; }
        int dev = 0, cus = 0, per_cu = 0;
        if (hipGetDevice(&dev) != hipSuccess || hipDeviceGetAttribute(&cus, hipDeviceAttributeMultiprocessorCount, dev) != hipSuccess) { grid = -1; return; }
        if (hipFuncSetAttribute((const void*)mega_fwd, hipFuncAttributeMaxDynamicSharedMemorySize, LDS_BYTES) != hipSuccess) { fprintf(stderr, "kernel_launch: hipFuncSetAttribute failed\n"); grid = -1; return; }
        if (hipOccupancyMaxActiveBlocksPerMultiprocessor(&per_cu, (const void*)mega_fwd, NWAVES * 64, LDS_BYTES) != hipSuccess || per_cu < 1)
            fprintf(stderr, "kernel_launch: note: occupancy query reports %d workgroups per CU\n", per_cu);
        (void)hipGetLastError();
        grid = cus;
    }
    if (grid < 0) return;
    if (hipMemsetAsync((char*)d_ws + WS_CTL, 0, CTL_ZERO_BYTES, stream) != hipSuccess) { fprintf(stderr, "kernel_launch: memset failed\n"); return; }
    Args a{};
    for (int i = 0; i < 17; ++i) a.in[i] = (const float*)d_in[i];
    a.out = (float*)d_out; a.ws = (unsigned char*)d_ws;
    hipLaunchKernelGGL(mega_fwd, dim3(grid), dim3(NWAVES * 64), LDS_BYTES, stream, a);
    const hipError_t le = hipPeekAtLastError();
    if (le != hipSuccess) fprintf(stderr, "kernel_launch: launch failed: %s\n", hipGetErrorName(le));
}
```
